# Optimizing an MI355X kernel written in HIP

```python
import math
import jax, jax.numpy as jnp
from jax import lax
import numpy as np

D_MODEL = 2048
BATCH = 8
SEQ = 2048
DEPTH = 2

ATT_HEADS = 8
ATT_HEAD_DIM = 64
ATT_V_DIM = 2 * ATT_HEAD_DIM
ATT_QK_WIDTH = ATT_HEADS * 2 * ATT_HEAD_DIM
ATT_WIDTH = ATT_HEADS * ATT_V_DIM
LRU_WIDTH = D_MODEL // 2
LRU_BLOCKS = 8
LRU_BLOCK_W = LRU_WIDTH // LRU_BLOCKS
CONV_WIDTH = 4
LRU_C = 8.0
Q_BLOCK = 128
LN_EPS = 1e-5
SUBLN_EPS = 1e-5
DN_ALPHA = (2 * DEPTH) ** 0.25
DN_BETA = (8 * DEPTH) ** -0.25

IN_WIDTHS = [ATT_QK_WIDTH, ATT_QK_WIDTH, ATT_WIDTH, ATT_WIDTH,
             LRU_WIDTH, LRU_WIDTH, D_MODEL, D_MODEL]
IN_TOTAL = int(sum(IN_WIDTHS))
SPLIT_IDX = [int(v) for v in np.cumsum(IN_WIDTHS)[:-1]]

kernel_name = "hybrid_diffattn_rglru_deepnorm"


def _layer_norm(x, g, b):
    xf = x.astype(jnp.float32)
    mu = jnp.mean(xf, axis=-1, keepdims=True)
    var = jnp.mean(jnp.square(xf - mu), axis=-1, keepdims=True)
    y = (xf - mu) * lax.rsqrt(var + LN_EPS) * g.astype(jnp.float32) + b.astype(jnp.float32)
    return y.astype(x.dtype)


def _diff_attention(q, k, v, lam, lam_init, subln_g):
    B, S = q.shape[0], q.shape[1]
    nb = S // Q_BLOCK
    scale = ATT_HEAD_DIM ** -0.5
    slopes = jnp.exp2(-(8.0 / ATT_HEADS) * jnp.arange(1, ATT_HEADS + 1, dtype=jnp.float32))
    kpos = jnp.arange(S)
    vf = v.astype(jnp.float32)
    qb = q.reshape(B, nb, Q_BLOCK, ATT_HEADS, 2, ATT_HEAD_DIM).transpose(1, 0, 2, 3, 4, 5)

    def block(args):
        qi, i = args
        qpos = i * Q_BLOCK + jnp.arange(Q_BLOCK)
        dist = (qpos[:, None] - kpos[None, :]).astype(jnp.float32)
        bias = jnp.where(dist >= 0, -slopes[:, None, None] * dist, -jnp.inf)
        s = jnp.einsum('bqhcd,bkhcd->bchqk', qi, k,
                       preferred_element_type=jnp.float32) * scale + bias
        p = jax.nn.softmax(s, axis=-1)
        w = p[:, 0] - lam * p[:, 1]
        return jnp.einsum('bhqk,bkhe->bqhe', w, vf)

    o = lax.map(block, (qb, jnp.arange(nb)))
    o = o.transpose(1, 0, 2, 3, 4).reshape(B, S, ATT_HEADS, ATT_V_DIM)
    o = o * lax.rsqrt(jnp.mean(jnp.square(o), axis=-1, keepdims=True) + SUBLN_EPS)
    o = o * subln_g.astype(jnp.float32) * (1.0 - lam_init)
    return o.reshape(B, S, ATT_WIDTH).astype(q.dtype)


def _rg_lru(xb, conv_w, conv_b, w_r, b_r, w_i, b_i, lru_lambda):
    B, S, C = xb.shape
    xc = lax.conv_general_dilated(
        xb, conv_w[:, None, :], window_strides=(1,), padding=[(CONV_WIDTH - 1, 0)],
        dimension_numbers=('NWC', 'WIO', 'NWC'), feature_group_count=C) + conv_b
    xblk = xc.reshape(B, S, LRU_BLOCKS, LRU_BLOCK_W)
    r = jax.nn.sigmoid(jnp.einsum('bsni,nio->bsno', xblk, w_r).reshape(B, S, C) + b_r)
    ig = jax.nn.sigmoid(jnp.einsum('bsni,nio->bsno', xblk, w_i).reshape(B, S, C) + b_i)
    log_a = -LRU_C * r.astype(jnp.float32) * jax.nn.softplus(-lru_lambda.astype(jnp.float32))
    a = jnp.exp(log_a)
    u = jnp.sqrt(-jnp.expm1(2.0 * log_a)) * (ig * xc).astype(jnp.float32)

    def combine(left, right):
        a_l, b_l = left
        a_r, b_r = right
        return a_r * a_l, a_r * b_l + b_r

    _, h = lax.associative_scan(combine, (a, u), axis=1)
    return h.astype(xb.dtype)


def setup_inputs(seed: int = 0) -> dict:
    key = jax.random.key(seed)
    ks = jax.random.split(key, 24)
    L, D = DEPTH, D_MODEL
    col_scale = np.concatenate([
        np.ones(ATT_QK_WIDTH * 2, np.float32),
        np.full(ATT_WIDTH, DN_BETA, np.float32),
        np.ones(ATT_WIDTH, np.float32),
        np.full(LRU_WIDTH, DN_BETA, np.float32),
        np.ones(LRU_WIDTH + 2 * D, np.float32)])
    x = jax.random.normal(ks[0], (BATCH, SEQ, D), jnp.float32)
    w_in = jax.random.normal(ks[1], (L, D, IN_TOTAL), jnp.float32) * (D ** -0.5) * jnp.asarray(col_scale)
    conv_w = jax.random.normal(ks[2], (L, CONV_WIDTH, LRU_WIDTH), jnp.float32) * (CONV_WIDTH ** -0.5)
    conv_b = 0.01 * jax.random.normal(ks[3], (L, LRU_WIDTH), jnp.float32)
    w_rgate = jax.random.normal(ks[4], (L, LRU_BLOCKS, LRU_BLOCK_W, LRU_BLOCK_W), jnp.float32) * (LRU_BLOCK_W ** -0.5)
    b_rgate = 0.01 * jax.random.normal(ks[5], (L, LRU_WIDTH), jnp.float32)
    w_igate = jax.random.normal(ks[6], (L, LRU_BLOCKS, LRU_BLOCK_W, LRU_BLOCK_W), jnp.float32) * (LRU_BLOCK_W ** -0.5)
    b_igate = 0.01 * jax.random.normal(ks[7], (L, LRU_WIDTH), jnp.float32)
    a_pow = jax.random.uniform(ks[8], (L, LRU_WIDTH), jnp.float32, 0.9, 0.999)
    a0 = a_pow ** (1.0 / LRU_C)
    lru_lambda = jnp.log(a0) - jnp.log1p(-a0)
    lam_q1 = 0.1 * jax.random.normal(ks[9], (L, ATT_HEAD_DIM), jnp.float32)
    lam_k1 = 0.1 * jax.random.normal(ks[10], (L, ATT_HEAD_DIM), jnp.float32)
    lam_q2 = 0.1 * jax.random.normal(ks[11], (L, ATT_HEAD_DIM), jnp.float32)
    lam_k2 = 0.1 * jax.random.normal(ks[12], (L, ATT_HEAD_DIM), jnp.float32)
    subln_g = 1.0 + 0.01 * jax.random.normal(ks[13], (L, ATT_V_DIM), jnp.float32)
    w_pa = jax.random.normal(ks[14], (L, ATT_WIDTH, D), jnp.float32) * (ATT_WIDTH ** -0.5) * DN_BETA
    w_pb = jax.random.normal(ks[15], (L, LRU_WIDTH, D), jnp.float32) * (LRU_WIDTH ** -0.5) * DN_BETA
    w_out = jax.random.normal(ks[16], (L, D, D), jnp.float32) * (D ** -0.5) * DN_BETA
    ln_g = 1.0 + 0.01 * jax.random.normal(ks[17], (L, D), jnp.float32)
    ln_b = 0.01 * jax.random.normal(ks[18], (L, D), jnp.float32)
    return {"x": x, "w_in": w_in, "conv_w": conv_w, "conv_b": conv_b,
            "w_rgate": w_rgate, "b_rgate": b_rgate, "w_igate": w_igate, "b_igate": b_igate,
            "lru_lambda": lru_lambda, "lam_q1": lam_q1, "lam_k1": lam_k1,
            "lam_q2": lam_q2, "lam_k2": lam_k2, "subln_g": subln_g,
            "w_pa": w_pa, "w_pb": w_pb, "w_out": w_out, "ln_g": ln_g, "ln_b": ln_b}


def reference(x, w_in, conv_w, conv_b, w_rgate, b_rgate, w_igate, b_igate, lru_lambda,
              lam_q1, lam_k1, lam_q2, lam_k2, subln_g, w_pa, w_pb, w_out, ln_g, ln_b):
    B, S, D = x.shape
    for l in range(DEPTH):
        proj = jnp.einsum('bsd,dn->bsn', x, w_in[l])
        q, k, v, g_a, x_b, g_b, m_a, m_b = jnp.split(proj, SPLIT_IDX, axis=-1)
        q = q.reshape(B, S, ATT_HEADS, 2, ATT_HEAD_DIM)
        k = k.reshape(B, S, ATT_HEADS, 2, ATT_HEAD_DIM)
        v = v.reshape(B, S, ATT_HEADS, ATT_V_DIM)
        lam_init = 0.8 - 0.6 * math.exp(-0.3 * l)
        lam = (jnp.exp(jnp.sum(lam_q1[l].astype(jnp.float32) * lam_k1[l].astype(jnp.float32)))
               - jnp.exp(jnp.sum(lam_q2[l].astype(jnp.float32) * lam_k2[l].astype(jnp.float32)))
               + lam_init)
        att = _diff_attention(q, k, v, lam, lam_init, subln_g[l]) * jax.nn.silu(g_a)
        rec = _rg_lru(x_b, conv_w[l], conv_b[l], w_rgate[l], b_rgate[l],
                      w_igate[l], b_igate[l], lru_lambda[l]) * jax.nn.silu(g_b)
        merged = (jax.nn.sigmoid(m_a) * jnp.einsum('bse,ed->bsd', att, w_pa[l])
                  + jax.nn.sigmoid(m_b) * jnp.einsum('bse,ed->bsd', rec, w_pb[l]))
        out = jnp.einsum('bsd,de->bse', merged, w_out[l])
        x = _layer_norm(DN_ALPHA * x + out, ln_g[l], ln_b[l])
    return x
```

```cpp
#include <hip/hip_runtime.h>
#include <cstdio>
#include <cstdint>

typedef unsigned short bf16_t;
constexpr int D_MODEL = 2048, BATCH = 8, SEQ = 2048, DEPTH = 2, M = BATCH * SEQ;
constexpr int HEADS = 8, HD = 64, VD = 128, QKW = 1024, ATTW = 1024, LRUW = 1024, NBLK = 8, BLKW = 128;
constexpr int IN_TOTAL = 10240;
constexpr float LN_EPS = 1e-5f, SUBLN_EPS = 1e-5f;

__device__ __forceinline__ float bf2f(bf16_t v) { return __uint_as_float((unsigned)v << 16); }
__device__ __forceinline__ bf16_t f2bf(float f) { unsigned u = __float_as_uint(f); return (bf16_t)((u + 0x7fffu + ((u >> 16) & 1u)) >> 16); }
__device__ __forceinline__ float sigmoidf_(float x) { return 1.f / (1.f + __expf(-x)); }
__device__ __forceinline__ float siluf_(float x) { return x / (1.f + __expf(-x)); }

__global__ void cvt_kernel(const float* __restrict__ x, bf16_t* __restrict__ o, size_t n) {
    for (size_t i = (size_t)blockIdx.x * blockDim.x + threadIdx.x; i < n; i += (size_t)gridDim.x * blockDim.x) o[i] = f2bf(x[i]);
}

struct GemmArgs {
    const bf16_t* A; const float* B; const bf16_t* A2; const float* B2; int Mr, N, K, lda, ldb;
    bf16_t* Ob; float* Of; int ldc; const bf16_t* ma; const bf16_t* mb; int ldm; const float* xres; float alpha;
};
template <int MODE>
__global__ void __launch_bounds__(256) gemm_naive(GemmArgs g) {
    __shared__ float As[16][64 + 4];
    __shared__ float Bs[16][64 + 4];
    const int tid = threadIdx.x, tx = tid & 15, ty = tid >> 4;
    const int m0 = blockIdx.y * 64, n0 = blockIdx.x * 64;
    float acc[4][4] = {}, acc2[4][4] = {};
    const int npass = (MODE == 1) ? 2 : 1;
    for (int pass = 0; pass < npass; ++pass) {
        const bf16_t* A = pass ? g.A2 : g.A; const float* B = pass ? g.B2 : g.B;
        for (int k0 = 0; k0 < g.K; k0 += 16) {
            {
                const int r = tid >> 2, c = (tid & 3) * 4;
                const bf16_t* ap = A + (size_t)(m0 + r) * g.lda + k0 + c;
#pragma unroll
                for (int j = 0; j < 4; ++j) As[c + j][r] = bf2f(ap[j]);
            }
            {
                const int r = tid >> 4, c = (tid & 15) * 4;
                const float4 v = *(const float4*)(B + (size_t)(k0 + r) * g.ldb + n0 + c);
                Bs[r][c] = v.x; Bs[r][c + 1] = v.y; Bs[r][c + 2] = v.z; Bs[r][c + 3] = v.w;
            }
            __syncthreads();
#pragma unroll
            for (int k = 0; k < 16; ++k) {
                float a[4], b[4];
#pragma unroll
                for (int i = 0; i < 4; ++i) { a[i] = As[k][ty * 4 + i]; b[i] = Bs[k][tx * 4 + i]; }
#pragma unroll
                for (int i = 0; i < 4; ++i)
#pragma unroll
                    for (int j = 0; j < 4; ++j) { if (pass == 0) acc[i][j] += a[i] * b[j]; else acc2[i][j] += a[i] * b[j]; }
            }
            __syncthreads();
        }
    }
#pragma unroll
    for (int i = 0; i < 4; ++i) {
        const int row = m0 + ty * 4 + i;
#pragma unroll
        for (int j = 0; j < 4; ++j) {
            const int col = n0 + tx * 4 + j; const size_t o = (size_t)row * g.ldc + col;
            if (MODE == 0) g.Ob[o] = f2bf(acc[i][j]);
            else if (MODE == 1) { const size_t om = (size_t)row * g.ldm + col; g.Ob[o] = f2bf(sigmoidf_(bf2f(g.ma[om])) * acc[i][j] + sigmoidf_(bf2f(g.mb[om])) * acc2[i][j]); }
            else g.Of[o] = g.alpha * g.xres[o] + acc[i][j];
        }
    }
}

__global__ void __launch_bounds__(256) attn_naive(const bf16_t* __restrict__ proj, bf16_t* __restrict__ att, const float* __restrict__ subln_g,
                                                  const float* lq1, const float* lk1, const float* lq2, const float* lk2, float lam_init) {
    const int lane = threadIdx.x & 63, wv = threadIdx.x >> 6;
    const int gid = blockIdx.x * 4 + wv;
    const int q = gid % SEQ, h = (gid / SEQ) % HEADS, b = gid / (SEQ * HEADS);
    float d1 = lq1[lane] * lk1[lane], d2 = lq2[lane] * lk2[lane];
    for (int o = 32; o; o >>= 1) { d1 += __shfl_xor(d1, o); d2 += __shfl_xor(d2, o); }
    const float lam = __expf(d1) - __expf(d2) + lam_init;
    const float slope = exp2f(-(float)(h + 1));
    const bf16_t* qrow = proj + (size_t)(b * SEQ + q) * IN_TOTAL + h * 128;
    float q1[64], q2[64];
#pragma unroll
    for (int d = 0; d < 64; ++d) { q1[d] = bf2f(qrow[d]) * 0.125f; q2[d] = bf2f(qrow[64 + d]) * 0.125f; }
    float m1 = -INFINITY, m2 = -INFINITY, l1 = 0.f, l2 = 0.f;
    for (int k0 = 0; k0 <= q; k0 += 64) {
        const int k = k0 + lane; float s1 = -INFINITY, s2 = -INFINITY;
        if (k <= q) {
            const bf16_t* krow = proj + (size_t)(b * SEQ + k) * IN_TOTAL + QKW + h * 128;
            float a1 = 0.f, a2 = 0.f;
#pragma unroll
            for (int d = 0; d < 64; ++d) { a1 += q1[d] * bf2f(krow[d]); a2 += q2[d] * bf2f(krow[64 + d]); }
            const float bias = -slope * (float)(q - k); s1 = a1 + bias; s2 = a2 + bias;
        }
        float t1 = s1, t2 = s2;
        for (int o = 32; o; o >>= 1) { t1 = fmaxf(t1, __shfl_xor(t1, o)); t2 = fmaxf(t2, __shfl_xor(t2, o)); }
        const float n1 = fmaxf(m1, t1), n2 = fmaxf(m2, t2);
        float e1 = (k <= q) ? __expf(s1 - n1) : 0.f, e2 = (k <= q) ? __expf(s2 - n2) : 0.f;
        for (int o = 32; o; o >>= 1) { e1 += __shfl_xor(e1, o); e2 += __shfl_xor(e2, o); }
        l1 = l1 * __expf(m1 - n1) + e1; l2 = l2 * __expf(m2 - n2) + e2; m1 = n1; m2 = n2;
    }
    float o0 = 0.f, o1 = 0.f; const float il1 = 1.f / l1, il2 = 1.f / l2;
    for (int k0 = 0; k0 <= q; k0 += 64) {
        const int k = k0 + lane; float w = 0.f;
        if (k <= q) {
            const bf16_t* krow = proj + (size_t)(b * SEQ + k) * IN_TOTAL + QKW + h * 128;
            float a1 = 0.f, a2 = 0.f;
#pragma unroll
            for (int d = 0; d < 64; ++d) { a1 += q1[d] * bf2f(krow[d]); a2 += q2[d] * bf2f(krow[64 + d]); }
            const float bias = -slope * (float)(q - k);
            w = __expf(a1 + bias - m1) * il1 - lam * __expf(a2 + bias - m2) * il2;
        }
        const int kn = min(64, q - k0 + 1);
        for (int j = 0; j < kn; ++j) {
            const float wj = __shfl(w, j);
            const bf16_t* vrow = proj + (size_t)(b * SEQ + k0 + j) * IN_TOTAL + 2 * QKW + h * 128;
            o0 += wj * bf2f(vrow[lane]); o1 += wj * bf2f(vrow[64 + lane]);
        }
    }
    float ss = o0 * o0 + o1 * o1;
    for (int o = 32; o; o >>= 1) ss += __shfl_xor(ss, o);
    const float rn = rsqrtf(ss * (1.f / 128.f) + SUBLN_EPS) * (1.f - lam_init);
    const bf16_t* grow = proj + (size_t)(b * SEQ + q) * IN_TOTAL + 3 * QKW + h * 128;
    bf16_t* orow = att + (size_t)(b * SEQ + q) * ATTW + h * 128;
    orow[lane] = f2bf(o0 * rn * subln_g[lane] * siluf_(bf2f(grow[lane])));
    orow[64 + lane] = f2bf(o1 * rn * subln_g[64 + lane] * siluf_(bf2f(grow[64 + lane])));
}

__global__ void __launch_bounds__(128) lru_naive(const bf16_t* __restrict__ proj, bf16_t* __restrict__ rec, const float* __restrict__ conv_w, const float* __restrict__ conv_b,
                                                 const float* __restrict__ w_r, const float* __restrict__ b_r, const float* __restrict__ w_i, const float* __restrict__ b_i,
                                                 const float* __restrict__ lam) {
    __shared__ float xc_s[128];
    const int o = threadIdx.x, n = blockIdx.x % NBLK, b = blockIdx.x / NBLK, c = n * BLKW + o;
    const float cw0 = conv_w[0 * LRUW + c], cw1 = conv_w[1 * LRUW + c], cw2 = conv_w[2 * LRUW + c], cw3 = conv_w[3 * LRUW + c], cb = conv_b[c];
    const float br = b_r[c], bi = b_i[c], sp = log1pf(__expf(-lam[c]));
    const float* wr = w_r + (size_t)n * BLKW * BLKW + o; const float* wi = w_i + (size_t)n * BLKW * BLKW + o;
    float xm3 = 0.f, xm2 = 0.f, xm1 = 0.f, h = 0.f;
    for (int t = 0; t < SEQ; ++t) {
        const size_t row = (size_t)(b * SEQ + t) * IN_TOTAL;
        const float x0 = bf2f(proj[row + 4096 + c]);
        const float xc = cw0 * xm3 + cw1 * xm2 + cw2 * xm1 + cw3 * x0 + cb;
        xm3 = xm2; xm2 = xm1; xm1 = x0;
        __syncthreads();
        xc_s[o] = xc;
        __syncthreads();
        float ar = br, ai = bi;
#pragma unroll 8
        for (int i = 0; i < 128; ++i) { const float xi = xc_s[i]; ar += xi * wr[i * BLKW]; ai += xi * wi[i * BLKW]; }
        const float r = sigmoidf_(ar), ig = sigmoidf_(ai);
        const float la = -8.f * r * sp, a = __expf(la);
        const float u = sqrtf(-expm1f(2.f * la)) * (ig * xc);
        h = a * h + u;
        rec[(size_t)(b * SEQ + t) * LRUW + c] = f2bf(h * siluf_(bf2f(proj[row + 5120 + c])));
    }
}

__global__ void __launch_bounds__(256) ln_kernel(float* __restrict__ y, bf16_t* __restrict__ xb, const float* __restrict__ g, const float* __restrict__ bta) {
    const int lane = threadIdx.x & 63, row = blockIdx.x * 4 + (threadIdx.x >> 6);
    float* yr = y + (size_t)row * D_MODEL; float v[32]; float s = 0.f;
#pragma unroll
    for (int j = 0; j < 32; ++j) { v[j] = yr[lane + 64 * j]; s += v[j]; }
    for (int o = 32; o; o >>= 1) s += __shfl_xor(s, o);
    const float mean = s * (1.f / D_MODEL); float q = 0.f;
#pragma unroll
    for (int j = 0; j < 32; ++j) { v[j] -= mean; q += v[j] * v[j]; }
    for (int o = 32; o; o >>= 1) q += __shfl_xor(q, o);
    const float rstd = rsqrtf(q * (1.f / D_MODEL) + LN_EPS);
#pragma unroll
    for (int j = 0; j < 32; ++j) { const int c = lane + 64 * j; const float o_ = v[j] * rstd * g[c] + bta[c]; yr[c] = o_; xb[(size_t)row * D_MODEL + c] = f2bf(o_); }
}

extern "C" void kernel_launch(void* const* d_in, const int* in_sizes, int n_in, void* d_out, int out_size, void* d_ws, size_t ws_size, hipStream_t stream) {
    const float* x = (const float*)d_in[0]; const float* w_in = (const float*)d_in[1];
    const float* conv_w = (const float*)d_in[2]; const float* conv_b = (const float*)d_in[3];
    const float* w_rg = (const float*)d_in[4]; const float* b_rg = (const float*)d_in[5]; const float* w_ig = (const float*)d_in[6]; const float* b_ig = (const float*)d_in[7];
    const float* lru_lambda = (const float*)d_in[8];
    const float* lq1 = (const float*)d_in[9]; const float* lk1 = (const float*)d_in[10]; const float* lq2 = (const float*)d_in[11]; const float* lk2 = (const float*)d_in[12];
    const float* subln_g = (const float*)d_in[13]; const float* w_pa = (const float*)d_in[14]; const float* w_pb = (const float*)d_in[15]; const float* w_out = (const float*)d_in[16];
    const float* ln_g = (const float*)d_in[17]; const float* ln_b = (const float*)d_in[18];
    float* out = (float*)d_out;
    constexpr size_t MiB = 1u << 20;
    unsigned char* ws = (unsigned char*)d_ws;
    bf16_t* xb16 = (bf16_t*)(ws + 0);
    bf16_t* proj = (bf16_t*)(ws + 64 * MiB);
    bf16_t* att = (bf16_t*)(ws + 384 * MiB);
    bf16_t* rec = (bf16_t*)(ws + 416 * MiB);
    bf16_t* merged = (bf16_t*)(ws + 448 * MiB);
    if (ws_size < 512 * MiB) { fprintf(stderr, "workspace too small: %zu\n", ws_size); return; }
    cvt_kernel<<<2048, 256, 0, stream>>>(x, xb16, (size_t)M * D_MODEL);
    for (int l = 0; l < DEPTH; ++l) {
        const float lam_init = 0.8f - 0.6f * expf(-0.3f * (float)l);
        const float* xres = (l == 0) ? x : out;
        GemmArgs g{};
        g.A = xb16; g.B = w_in + (size_t)l * D_MODEL * IN_TOTAL; g.Mr = M; g.N = IN_TOTAL; g.K = D_MODEL; g.lda = D_MODEL; g.ldb = IN_TOTAL; g.Ob = proj; g.ldc = IN_TOTAL;
        gemm_naive<0><<<dim3(IN_TOTAL / 64, M / 64), 256, 0, stream>>>(g);
        attn_naive<<<BATCH * HEADS * SEQ / 4, 256, 0, stream>>>(proj, att, subln_g + l * VD, lq1 + l * HD, lk1 + l * HD, lq2 + l * HD, lk2 + l * HD, lam_init);
        lru_naive<<<BATCH * NBLK, 128, 0, stream>>>(proj, rec, conv_w + (size_t)l * 4 * LRUW, conv_b + l * LRUW, w_rg + (size_t)l * NBLK * BLKW * BLKW, b_rg + l * LRUW,
                                                   w_ig + (size_t)l * NBLK * BLKW * BLKW, b_ig + l * LRUW, lru_lambda + l * LRUW);
        GemmArgs g1{};
        g1.A = att; g1.B = w_pa + (size_t)l * ATTW * D_MODEL; g1.A2 = rec; g1.B2 = w_pb + (size_t)l * LRUW * D_MODEL; g1.Mr = M; g1.N = D_MODEL; g1.K = 1024; g1.lda = 1024; g1.ldb = D_MODEL;
        g1.Ob = merged; g1.ldc = D_MODEL; g1.ma = proj + 6144; g1.mb = proj + 8192; g1.ldm = IN_TOTAL;
        gemm_naive<1><<<dim3(D_MODEL / 64, M / 64), 256, 0, stream>>>(g1);
        GemmArgs g2{};
        g2.A = merged; g2.B = w_out + (size_t)l * D_MODEL * D_MODEL; g2.Mr = M; g2.N = D_MODEL; g2.K = D_MODEL; g2.lda = D_MODEL; g2.ldb = D_MODEL;
        g2.Of = out; g2.ldc = D_MODEL; g2.xres = xres; g2.alpha = 1.41421356237f;
        gemm_naive<2><<<dim3(D_MODEL / 64, M / 64), 256, 0, stream>>>(g2);
        ln_kernel<<<M / 4, 256, 0, stream>>>(out, xb16, ln_g + l * D_MODEL, ln_b + l * D_MODEL);
    }
}
```

```cpp
#include <hip/hip_runtime.h>
#include <cstdio>
#include <cstdint>
namespace pg8 {
#define PG8_LAS __attribute__((address_space(3)))
typedef unsigned short bf16_t;
typedef short bf16x8 __attribute__((ext_vector_type(8)));
typedef float f32x4 __attribute__((ext_vector_type(4)));
typedef unsigned u32x4 __attribute__((ext_vector_type(4)));
constexpr int BM = 256, BK = 64, HALF = 128, HTB = HALF * BK * 2  , STAGE_BYTES = 8 * HTB, NXCD = 8, WGM = 8;

__host__ __device__ __forceinline__ int lds_byte(int r, int c) { const int st = (r >> 4) * 2 + (c >> 5), rr = r & 15, cc = c & 31, ob = rr * 64 + cc * 2; return st * 1024 + (ob ^ (((ob >> 9) & 1) << 5)); }
__host__ __device__ __forceinline__ void stage_rc(int b, int& R, int& C) { const int st = b / 1024, sb = b % 1024, swz = sb ^ (((sb >> 9) & 1) << 5); R = (st >> 1) * 16 + swz / 64; C = (st & 1) * 32 + (swz % 64) / 2; }
__host__ __device__ __forceinline__ int perm32(int rho) { const int n = rho >> 4, i = rho & 15; return 8 * (i >> 2) + 4 * n + (i & 3); }

struct Unit { int pm, pn; };
struct Gemm { const bf16_t* A; const bf16_t* Bt; int M, N, K; };

struct StaticOrder {
    int nM, nN, nwg, G, c;
    __host__ __device__ void init(int M, int N, int G_, int c_) { nM = M / BM; nN = N / BM; nwg = nM * nN; G = G_; c = c_; }
    __host__ __device__ bool next(int i, Unit& u) const {
        const long L = (long)i * G + c; if (L >= nwg) return false;
        int wgid = (int)L; { const int q = nwg / NXCD, r = nwg % NXCD, xcd = wgid % NXCD, off = wgid / NXCD; wgid = (xcd < r ? xcd * (q + 1) : r * (q + 1) + (xcd - r) * q) + off; }
        const int nig = WGM * nN, gid = wgid / nig, fm = gid * WGM, gsz = (nM - fm) < WGM ? (nM - fm) : WGM;
        u.pm = fm + ((wgid % nig) % gsz); u.pn = (wgid % nig) / gsz; return true;
    }
    __device__ __forceinline__ void a_ready(const Unit&) const {}
    __device__ __forceinline__ void done(const Unit&) const {}
};

__device__ __forceinline__ unsigned cvt_pk_bf16(float lo, float hi) { unsigned r; asm volatile("v_cvt_pk_bf16_f32 %0, %1, %2" : "=v"(r) : "v"(lo), "v"(hi)); return r; }
typedef short s16x8_t __attribute__((ext_vector_type(8)));
__device__ __forceinline__ float bfbits2f(short v) { return __uint_as_float(((unsigned)(unsigned short)v) << 16); }
struct EpiProj {
    static constexpr bool PERM = true, AFTER_DRAIN = false, HAS_MID = false;
    bf16_t* base6; bf16_t* ma; bf16_t* mb; size_t stride6; float qscale;
    __device__ __forceinline__ void operator()(const f32x4 (&acc)[2][2][4][2], const Unit& u, int wr, int wc, int fr, int fq) const {
        const int pn = u.pn; bf16_t* base; int ldc, colt; float sc = 1.f;
        if (pn < 24) { const int t = pn >> 2; base = base6 + (size_t)t * stride6; ldc = 1024; colt = (pn & 3) * BM; if (t == 0) sc = qscale; }
        else if (pn < 32) { base = ma; ldc = 2048; colt = (pn - 24) * BM; }
        else { base = mb; ldc = 2048; colt = (pn - 32) * BM; }
        const int row0 = u.pm * BM + wr * 64 + fr, col0 = colt + wc * 32 + 8 * fq;
#pragma unroll
        for (int ai = 0; ai < 2; ++ai)
#pragma unroll
            for (int m = 0; m < 4; ++m) { bf16_t* rowp = base + (size_t)(row0 + ai * HALF + m * 16) * ldc + col0;
#pragma unroll
                for (int bj = 0; bj < 2; ++bj) { const f32x4 v0 = acc[ai][bj][m][0] * sc, v1 = acc[ai][bj][m][1] * sc;
                    u32x4 w; w.x = cvt_pk_bf16(v0[0], v0[1]); w.y = cvt_pk_bf16(v0[2], v0[3]); w.z = cvt_pk_bf16(v1[0], v1[1]); w.w = cvt_pk_bf16(v1[2], v1[3]);
                    *(u32x4*)(rowp + bj * HALF) = w; } }
    }
};
struct EpiMerge {
    static constexpr bool PERM = true, AFTER_DRAIN = false, HAS_MID = true;
    const bf16_t* ma; const bf16_t* mb; bf16_t* out;
    __device__ __forceinline__ void mid(f32x4 (&acc)[2][2][4][2], const Unit& u, int wr, int wc, int fr, int fq) const {
        unsigned lofs = (unsigned)((wr * 64 + fr) * 2048 + wc * 32 + 8 * fq); asm volatile("" : "+v"(lofs));
        const size_t tofs = (size_t)u.pm * BM * 2048 + (size_t)u.pn * BM;
#pragma unroll
        for (int ai = 0; ai < 2; ++ai)
#pragma unroll
            for (int m = 0; m < 4; ++m) { const size_t off = tofs + lofs + (size_t)(ai * HALF + m * 16) * 2048;
#pragma unroll
                for (int bj = 0; bj < 2; ++bj) { const s16x8_t a = *(const s16x8_t*)(ma + off + bj * HALF), b = *(const s16x8_t*)(mb + off + bj * HALF);
#pragma unroll
                    for (int j = 0; j < 8; ++j) { const float xa = bfbits2f(a[j]), xb = fmaxf(bfbits2f(b[j]), -30.f);
                        const float f = (1.f + __expf(-xb)) * __builtin_amdgcn_rcpf(1.f + __expf(-xa)); acc[ai][bj][m][j >> 2][j & 3] *= f; } }
                asm volatile("" ::: "memory"); }
    }
    __device__ __forceinline__ void operator()(const f32x4 (&acc)[2][2][4][2], const Unit& u, int wr, int wc, int fr, int fq) const {
        unsigned lofs = (unsigned)((wr * 64 + fr) * 2048 + wc * 32 + 8 * fq); asm volatile("" : "+v"(lofs));
        const size_t tofs = (size_t)u.pm * BM * 2048 + (size_t)u.pn * BM;
#pragma unroll
        for (int ai = 0; ai < 2; ++ai)
#pragma unroll
            for (int m = 0; m < 4; ++m) { const size_t off = tofs + lofs + (size_t)(ai * HALF + m * 16) * 2048;
#pragma unroll
                for (int bj = 0; bj < 2; ++bj) { const s16x8_t b = *(const s16x8_t*)(mb + off + bj * HALF); float v[8];
#pragma unroll
                    for (int j = 0; j < 8; ++j) { const float xb = fmaxf(bfbits2f(b[j]), -30.f); v[j] = acc[ai][bj][m][j >> 2][j & 3] * __builtin_amdgcn_rcpf(1.f + __expf(-xb)); }
                    u32x4 w; w.x = cvt_pk_bf16(v[0], v[1]); w.y = cvt_pk_bf16(v[2], v[3]); w.z = cvt_pk_bf16(v[4], v[5]); w.w = cvt_pk_bf16(v[6], v[7]);
                    *(u32x4*)(out + off + bj * HALF) = w; }
                asm volatile("" ::: "memory"); }
    }
};
struct EpiRes {
    static constexpr bool PERM = false, AFTER_DRAIN = false, HAS_MID = false;
    const float* base; float* out; float alpha;
    __device__ __forceinline__ void operator()(const f32x4 (&acc)[2][2][4][2], const Unit& u, int wr, int wc, int fr, int fq) const {
        const int row0 = u.pm * BM + wr * 64 + fr, col0 = u.pn * BM + wc * 32 + 4 * fq;
#pragma unroll
        for (int ai = 0; ai < 2; ++ai)
#pragma unroll
            for (int m = 0; m < 4; ++m) { const size_t off = (size_t)(row0 + ai * HALF + m * 16) * 2048 + col0;
#pragma unroll
                for (int bj = 0; bj < 2; ++bj)
#pragma unroll
                    for (int n = 0; n < 2; ++n) { const f32x4 bs = *(const f32x4*)(base + off + bj * HALF + n * 16); *(f32x4*)(out + off + bj * HALF + n * 16) = bs * alpha + acc[ai][bj][m][n]; }
                if (m & 1) asm volatile("" ::: "memory"); }
    }
};
template <class Epi, class Sched, bool ALIGN_EPI = false, bool SP2 = false>
__device__ __forceinline__ void gemm_phase(PG8_LAS unsigned char* lds, const Gemm g, const Sched& S, const Epi& E) {
    int tid_ = threadIdx.x; asm volatile("" : "+v"(tid_));
    const int tid = tid_, wid = __builtin_amdgcn_readfirstlane(tid >> 6), lane = tid & 63, wr = wid >> 2, wc = wid & 3, fr = lane & 15, fq = lane >> 4;
    const int K = g.K, nt = K / BK;
    unsigned voffA[2], voffB[2];
#pragma unroll
    for (int i = 0; i < 2; ++i) { int R, C; stage_rc(tid * 16 + i * 8192, R, C); const int Rb = Epi::PERM ? ((R & ~31) + perm32(R & 31)) : R;
        voffA[i] = (unsigned)(R * K + C) * 2u; voffB[i] = (unsigned)(Rb * K + C) * 2u; }
    const size_t kstep = (size_t)(BK * 2);
    const size_t hstep = (size_t)HALF * K * 2;
    const size_t tstep = 2 * hstep;
    const unsigned ldsw = (unsigned)wid * 1024u;
    const int aoff = lds_byte(wr * 64 + fr, fq * 8), boff = lds_byte(wc * 32 + fr, fq * 8);
#define PG8_SA(b, h) (((b) * 2 + (h)) * HTB)
#define PG8_SB(b, h) ((4 + (b) * 2 + (h)) * HTB)
#define PG8_STAGE(bufoff, gbase, voff) do { _Pragma("unroll") for (int _i = 0; _i < 2; ++_i) \
        __builtin_amdgcn_global_load_lds((const unsigned*)((const char*)(gbase) + (voff)[_i]), (PG8_LAS unsigned*)(lds + (bufoff) + ldsw + _i * 8192), 16, 0, 0); } while (0)
#define PG8_LDA(dst, b, h) do { _Pragma("unroll") for (int m = 0; m < 4; ++m) _Pragma("unroll") for (int k = 0; k < 2; ++k) dst[m][k] = *(const PG8_LAS bf16x8*)(lds + PG8_SA(b, h) + aoff + m * 2048 + k * 1024); } while (0)
#define PG8_LDB(dst, b, h) do { _Pragma("unroll") for (int n = 0; n < 2; ++n) _Pragma("unroll") for (int k = 0; k < 2; ++k) dst[n][k] = *(const PG8_LAS bf16x8*)(lds + PG8_SB(b, h) + boff + n * 2048 + k * 1024); } while (0)
#define PG8_MMA(ai, bj, At, Bt) do { __builtin_amdgcn_s_setprio(1); _Pragma("unroll") for (int m = 0; m < 4; ++m) _Pragma("unroll") for (int n = 0; n < 2; ++n) _Pragma("unroll") for (int k = 0; k < 2; ++k) \
        acc[ai][bj][m][n] = __builtin_amdgcn_mfma_f32_16x16x32_bf16(Bt[n][k], At[m][k], acc[ai][bj][m][n], 0, 0, 0); __builtin_amdgcn_s_setprio(0); } while (0)
#define PG8_WAIT_V(n) asm volatile("s_waitcnt vmcnt(" #n ")" ::: "memory")
#define PG8_WAIT_L(n) asm volatile("s_waitcnt lgkmcnt(" #n ")" ::: "memory")
#define PG8_BAR __builtin_amdgcn_s_barrier()
#define PG8_SCHED __builtin_amdgcn_sched_barrier(0)
    Unit cur, nxt; int ui = 0;
    if (!S.next(0, cur)) return;
    f32x4 acc[2][2][4][2];
#pragma unroll
    for (int a = 0; a < 2; ++a)
#pragma unroll
        for (int b = 0; b < 2; ++b)
#pragma unroll
            for (int m = 0; m < 4; ++m)
#pragma unroll
                for (int n = 0; n < 2; ++n) acc[a][b][m][n] = (f32x4){0.f, 0.f, 0.f, 0.f};
    bf16x8 At[4][2], B0[2][2], B1[2][2];
    const char* cA = (const char*)g.A + (size_t)cur.pm * tstep; const char* cB = (const char*)g.Bt + (size_t)cur.pn * tstep;
    S.a_ready(cur);
    if constexpr (SP2) {
        PG8_STAGE(PG8_SB(0, 0), cB, voffB); PG8_STAGE(PG8_SB(0, 1), cB + hstep, voffB); PG8_STAGE(PG8_SA(0, 0), cA, voffA); PG8_STAGE(PG8_SA(0, 1), cA + hstep, voffA);
        if (wr == 1) PG8_BAR;
        PG8_WAIT_V(2); PG8_BAR;
        PG8_STAGE(PG8_SB(1, 0), cB + kstep, voffB); PG8_STAGE(PG8_SA(1, 0), cA + kstep, voffA); PG8_STAGE(PG8_SB(1, 1), cB + hstep + kstep, voffB);
        PG8_WAIT_V(6); PG8_BAR;
    } else {
        PG8_STAGE(PG8_SB(0, 0), cB, voffB); PG8_STAGE(PG8_SA(0, 0), cA, voffA); PG8_STAGE(PG8_SB(0, 1), cB + hstep, voffB); PG8_STAGE(PG8_SA(0, 1), cA + hstep, voffA);
        if (wr == 1) PG8_BAR;
        PG8_WAIT_V(4); PG8_BAR;
        PG8_STAGE(PG8_SB(1, 0), cB + kstep, voffB); PG8_STAGE(PG8_SA(1, 0), cA + kstep, voffA); PG8_STAGE(PG8_SB(1, 1), cB + hstep + kstep, voffB);
        PG8_WAIT_V(6); PG8_BAR;
    }
    for (;;) {
        const bool has_next = S.next(ui + 1, nxt);
        const char* nA = has_next ? (const char*)g.A + (size_t)nxt.pm * tstep : cA; const char* nB = has_next ? (const char*)g.Bt + (size_t)nxt.pn * tstep : cB;
        for (int t = 0; t < nt; t += 2) {
            const bool last = (t == nt - 2);
            if constexpr (Epi::HAS_MID) { if (t == nt / 2) E.mid(acc, cur, wr, wc, fr, fq); }
            const char* a1 = cA + (size_t)(t + 1) * kstep;
            const char* a2 = last ? nA : cA + (size_t)(t + 2) * kstep; const char* b2 = last ? nB : cB + (size_t)(t + 2) * kstep;
            const char* a3 = a2 + kstep; const char* b3 = b2 + kstep;
            if (last && has_next) S.a_ready(nxt);
            if constexpr (SP2) {
            PG8_LDB(B0, 0, 0); PG8_LDB(B1, 0, 1); PG8_SCHED; PG8_LDA(At, 0, 0); PG8_STAGE(PG8_SA(1, 1), a1 + hstep, voffA);
            PG8_WAIT_V(8); PG8_WAIT_L(0); PG8_BAR; PG8_MMA(0, 0, At, B0); PG8_MMA(0, 1, At, B1); PG8_BAR; PG8_SCHED;
            PG8_LDA(At, 0, 1); PG8_STAGE(PG8_SB(0, 0), b2, voffB); PG8_STAGE(PG8_SB(0, 1), b2 + hstep, voffB); PG8_STAGE(PG8_SA(0, 0), a2, voffA);
            PG8_WAIT_V(8); PG8_WAIT_L(0); PG8_BAR; PG8_MMA(1, 0, At, B0); PG8_MMA(1, 1, At, B1); PG8_BAR; PG8_SCHED;
            PG8_LDB(B0, 1, 0); PG8_LDB(B1, 1, 1); PG8_SCHED; PG8_LDA(At, 1, 0); PG8_STAGE(PG8_SA(0, 1), a2 + hstep, voffA);
            PG8_WAIT_V(8); PG8_WAIT_L(0); PG8_BAR; PG8_MMA(0, 0, At, B0); PG8_MMA(0, 1, At, B1); PG8_BAR; PG8_SCHED;
            PG8_LDA(At, 1, 1); PG8_STAGE(PG8_SB(1, 0), b3, voffB); PG8_STAGE(PG8_SB(1, 1), b3 + hstep, voffB); PG8_STAGE(PG8_SA(1, 0), a3, voffA);
            PG8_WAIT_V(8); PG8_WAIT_L(0); PG8_BAR; PG8_MMA(1, 0, At, B0); PG8_MMA(1, 1, At, B1); PG8_BAR; PG8_SCHED;
            } else {
            PG8_LDB(B0, 0, 0); PG8_SCHED; PG8_LDA(At, 0, 0); PG8_STAGE(PG8_SA(1, 1), a1 + hstep, voffA);
            PG8_WAIT_L(8); PG8_BAR; PG8_WAIT_L(0); PG8_MMA(0, 0, At, B0); PG8_BAR; PG8_SCHED;
            PG8_LDB(B1, 0, 1); PG8_STAGE(PG8_SB(0, 0), b2, voffB);
            PG8_BAR; PG8_WAIT_L(0); PG8_MMA(0, 1, At, B1); PG8_BAR;
            PG8_LDA(At, 0, 1); PG8_STAGE(PG8_SA(0, 0), a2, voffA);
            PG8_BAR; PG8_WAIT_L(0); PG8_MMA(1, 0, At, B0); PG8_BAR; PG8_SCHED;
            PG8_STAGE(PG8_SB(0, 1), b2 + hstep, voffB);
            PG8_WAIT_V(6); PG8_BAR; PG8_MMA(1, 1, At, B1); PG8_BAR;
            PG8_LDB(B0, 1, 0); PG8_SCHED; PG8_LDA(At, 1, 0); PG8_STAGE(PG8_SA(0, 1), a2 + hstep, voffA);
            PG8_WAIT_L(8); PG8_BAR; PG8_WAIT_L(0); PG8_MMA(0, 0, At, B0); PG8_BAR; PG8_SCHED;
            PG8_LDB(B1, 1, 1); PG8_STAGE(PG8_SB(1, 0), b3, voffB);
            PG8_BAR; PG8_WAIT_L(0); PG8_MMA(0, 1, At, B1); PG8_BAR;
            PG8_LDA(At, 1, 1); PG8_STAGE(PG8_SA(1, 0), a3, voffA);
            PG8_BAR; PG8_WAIT_L(0); PG8_MMA(1, 0, At, B0); PG8_BAR; PG8_SCHED;
            PG8_STAGE(PG8_SB(1, 1), b3 + hstep, voffB);
            PG8_WAIT_V(6); PG8_BAR; PG8_MMA(1, 1, At, B1); PG8_BAR;
            }
        }
        if constexpr (ALIGN_EPI) { if (wr == 0) PG8_BAR; }
        if constexpr (!Epi::AFTER_DRAIN) { E(acc, cur, wr, wc, fr, fq); S.done(cur); }
        if (!has_next) break;
#pragma unroll
        for (int a = 0; a < 2; ++a)
#pragma unroll
            for (int b = 0; b < 2; ++b)
#pragma unroll
                for (int m = 0; m < 4; ++m)
#pragma unroll
                    for (int n = 0; n < 2; ++n) acc[a][b][m][n] = (f32x4){0.f, 0.f, 0.f, 0.f};
        cur = nxt; cA = nA; cB = nB; ++ui;
        if constexpr (ALIGN_EPI) { if (wr == 1) PG8_BAR; }
    }
    PG8_WAIT_V(0);
    if constexpr (!ALIGN_EPI) { if (wr == 0) PG8_BAR; }
    PG8_BAR;
    if constexpr (Epi::AFTER_DRAIN) { E.fused(acc, cur, wr, wc, fr, fq, lds, wid, lane); S.done(cur); }
#undef PG8_SA
#undef PG8_SB
#undef PG8_STAGE
#undef PG8_LDA
#undef PG8_LDB
#undef PG8_MMA
#undef PG8_WAIT_V
#undef PG8_WAIT_L
#undef PG8_BAR
#undef PG8_SCHED
}
}

#ifndef PG8_SP2
#define PG8_SP2 true
#endif
#ifndef PG8_ALIGN
#define PG8_ALIGN true
#endif
#include <hip/hip_bf16.h>
#include <cmath>
namespace attn_body {
using bf16=__hip_bfloat16;
using bf16x8=__attribute__((ext_vector_type(8)))short;
using s16x4=__attribute__((ext_vector_type(4)))short;
using f32x16=__attribute__((ext_vector_type(16)))float;
using u32x4=__attribute__((ext_vector_type(4)))unsigned;
constexpr int BATCH=8,NHEAD=16,SEQ=2048,D=64,DM=NHEAD*D;
constexpr int NW=8,QBLK=32,QB=QBLK*NW,KVBLK=64,NQB=SEQ/QB;
constexpr int ATTN_PITCH=DM, ATTN_UNIT_ROWS=QB;
__device__ __forceinline__ int crow(int r,int hi){return (r&3)+8*(r>>2)+4*hi;}
#define SBAR() __builtin_amdgcn_sched_barrier(0)
__device__ __forceinline__ void cmask(f32x16&p0,f32x16&p1,int jb,int qrel,int hi){
  const float NEG=-INFINITY; int kb=64*jb+4*hi;
  #pragma unroll
  for(int r=0;r<16;++r){int kv=kb+(r&3)+8*(r>>2); if(kv>qrel)p0[r]=NEG; if(kv+32>qrel)p1[r]=NEG;}
}

constexpr int NSLOT=3, SLOTB=8192;
constexpr int LDS_K=0, LDS_V=NSLOT*SLOTB, LDS_WS=2*NSLOT*SLOTB, LDS_OST=LDS_WS+NW*64*4, LDS_BYTES=LDS_OST+NW*4096;
constexpr float C2=0.125f*1.4426950408889634f;
__device__ __forceinline__ void glds16(const void*gsrc,unsigned lds_dst){unsigned keep;
  asm volatile("s_mov_b32 %0, m0\n\ts_mov_b32 m0, %2\n\ts_nop 0\n\tglobal_load_lds_dwordx4 %1, off\n\ts_mov_b32 m0, %0":"=&s"(keep):"v"(gsrc),"s"(lds_dst):"memory");}
__device__ __forceinline__ void glds16o(const void*sbase,unsigned voff,unsigned lds_dst){unsigned keep;
  asm volatile("s_mov_b32 %0, m0\n\ts_mov_b32 m0, %3\n\ts_nop 4\n\tglobal_load_lds_dwordx4 %1, %2\n\ts_mov_b32 m0, %0":"=&s"(keep):"v"(voff),"s"(sbase),"s"(lds_dst):"memory");}
__device__ __forceinline__ float max3f(float a,float b,float c){float r;asm("v_max3_f32 %0, %1, %2, %3":"=v"(r):"v"(a),"v"(b),"v"(c));return r;}
__device__ __forceinline__ float max2f(float a,float b){float r;asm("v_max_f32_e32 %0, %1, %2":"=v"(r):"v"(a),"v"(b));return r;}
__device__ __forceinline__ float fadd_s(float a,float b){float r;asm("v_add_f32_e32 %0, %1, %2":"=v"(r):"v"(a),"v"(b));return r;}
__device__ __forceinline__ float fsub_s(float a,float b){float r;asm("v_sub_f32_e32 %0, %1, %2":"=v"(r):"v"(a),"v"(b));return r;}
typedef float f32x2_t __attribute__((ext_vector_type(2))); typedef __bf16 bf16x2_t __attribute__((ext_vector_type(2)));
__device__ __forceinline__ unsigned cvtpk_s(float lo,float hi){f32x2_t v={lo,hi};bf16x2_t b=__builtin_convertvector(v,bf16x2_t);return __builtin_bit_cast(unsigned,b);}
#define WAIT_BAR(N) asm volatile("s_waitcnt vmcnt(" #N ") lgkmcnt(0)\n\ts_barrier":::"memory")

__device__ __forceinline__ void qkt(f32x16&p0,f32x16&p1,const char*Kslot,const bf16x8*qr,int r32,int hi){
  const char*kb=Kslot+hi*1024+r32*16;
  #pragma unroll
  for(int d0=0;d0<4;++d0){
    const bf16x8 b0=*reinterpret_cast<const bf16x8*>(kb+d0*2048);
    const bf16x8 b1=*reinterpret_cast<const bf16x8*>(kb+d0*2048+512);
    {p0=__builtin_amdgcn_mfma_f32_32x32x16_bf16(b0,qr[d0],p0,0,0,0);p1=__builtin_amdgcn_mfma_f32_32x32x16_bf16(b1,qr[d0],p1,0,0,0);}}
}
typedef __attribute__((address_space(3))) const char* lds_cptr;
typedef short v4i16_t __attribute__((ext_vector_type(4)));
__device__ __forceinline__ void kload8(bf16x8*kf,lds_cptr kp){
  kf[0]=*(const __attribute__((address_space(3))) bf16x8*)(kp);      kf[1]=*(const __attribute__((address_space(3))) bf16x8*)(kp+512);
  kf[2]=*(const __attribute__((address_space(3))) bf16x8*)(kp+2048); kf[3]=*(const __attribute__((address_space(3))) bf16x8*)(kp+2560);
  kf[4]=*(const __attribute__((address_space(3))) bf16x8*)(kp+4096); kf[5]=*(const __attribute__((address_space(3))) bf16x8*)(kp+4608);
  kf[6]=*(const __attribute__((address_space(3))) bf16x8*)(kp+6144); kf[7]=*(const __attribute__((address_space(3))) bf16x8*)(kp+6656);
}
__device__ __forceinline__ void kload2(bf16x8*kf,lds_cptr kp,int j){ kf[2*j]=*(const __attribute__((address_space(3))) bf16x8*)(kp+j*2048); kf[2*j+1]=*(const __attribute__((address_space(3))) bf16x8*)(kp+j*2048+512); }
__device__ __forceinline__ s16x4 vtr(lds_cptr p){ return __builtin_bit_cast(s16x4,__builtin_amdgcn_ds_read_tr16_b64_v4i16((__attribute__((address_space(3))) v4i16_t*)p)); }
__device__ __forceinline__ float rowmax(const f32x16&p0,const f32x16&p1){
  float a=max3f(p0[0],p0[1],p1[0]),b=max3f(p0[2],p0[3],p1[1]);a=max3f(a,p1[2],p1[3]);
  #pragma unroll
  for(int r=4;r<16;r+=4){a=max3f(a,p0[r],p0[r+1]);b=max3f(b,p0[r+2],p0[r+3]);a=max3f(a,p1[r],p1[r+1]);b=max3f(b,p1[r+2],p1[r+3]);}
  const float m=max2f(a,b);
  auto rr=__builtin_amdgcn_permlane32_swap(__float_as_uint(m),__float_as_uint(m),false,false);
  return max2f(__uint_as_float(rr[0]),__uint_as_float(rr[1]));
}
__device__ __forceinline__ void pv(f32x16*o,int vb,bf16x8 pa0,bf16x8 pa1,bf16x8 pa2,bf16x8 pa3){
  #pragma unroll
  for(int d0=0;d0<2;++d0){s16x4 lo[4],hi[4];
    #pragma unroll
    for(int ks=0;ks<4;++ks){
      asm volatile("ds_read_b64_tr_b16 %0,%1 offset:%c2":"=&v"(lo[ks]):"v"(vb),"i"(d0*4096+ks*1024):"memory");
      asm volatile("ds_read_b64_tr_b16 %0,%1 offset:%c2":"=&v"(hi[ks]):"v"(vb),"i"(d0*4096+ks*1024+512):"memory");}
    asm volatile("s_waitcnt lgkmcnt(0)":::"memory");SBAR();
    #define PK(k) (bf16x8){lo[k][0],lo[k][1],lo[k][2],lo[k][3],hi[k][0],hi[k][1],hi[k][2],hi[k][3]}
    o[d0]=__builtin_amdgcn_mfma_f32_32x32x16_bf16(pa0,PK(0),o[d0],0,0,0);
    o[d0]=__builtin_amdgcn_mfma_f32_32x32x16_bf16(pa1,PK(1),o[d0],0,0,0);
    o[d0]=__builtin_amdgcn_mfma_f32_32x32x16_bf16(pa2,PK(2),o[d0],0,0,0);
    o[d0]=__builtin_amdgcn_mfma_f32_32x32x16_bf16(pa3,PK(3),o[d0],0,0,0);
    #undef PK
  }
}

#ifndef ATTN_STORE16
#define ATTN_STORE16(p,v) (*(u32x4*)(p)=(v))
#endif
template<int THRL> __device__ __forceinline__ void attn_unit(int b,int hq,int hv,int qb,float slope2,const bf16*Q,const bf16*__restrict__ K,const bf16*__restrict__ V,bf16*O,char*shm){
  int tid_=threadIdx.x; asm volatile("":"+v"(tid_)); const int tid=tid_,lane=tid&63,r32=lane&31,hi=lane>>5; const int wid=__builtin_amdgcn_readfirstlane(tid>>6);
  const long rowbase=(long)b*SEQ; const int q0=qb*QB;
  const bf16*Qw=Q+(rowbase+q0+wid*QBLK)*DM+hq*D;
  const bf16*Kh=K+rowbase*DM+hq*D,*Vh=V+rowbase*DM+hv*D;
  const unsigned lds0=(unsigned)(uintptr_t)shm;
  float*wsf=(float*)(shm+LDS_WS)+wid*64;
  const unsigned koff=(unsigned)((lane*DM+wid*8)*2);
  const unsigned voff=(unsigned)(((16*(wid&3)+(lane>>2))*DM+(wid>>2)*32+(lane&3)*8)*2);
  const unsigned kdst=lds0+LDS_K+wid*1024, vdst=lds0+LDS_V+wid*1024;
  #define DMA_K(t,slot) glds16o(Kh+(long)(t)*KVBLK*DM,koff,(unsigned)__builtin_amdgcn_readfirstlane(kdst+(slot)))
  #define DMA_V(t,slot) glds16o(Vh+(long)(t)*KVBLK*DM,voff,(unsigned)__builtin_amdgcn_readfirstlane(vdst+(slot)))
  const int vb0=(int)(lds0+LDS_V)+((lane>>4)&1)*32+(lane&3)*8+(4*hi+((lane&15)>>2))*64;
  const char*Kbase=shm+LDS_K; bf16x8 kf[8];
  const lds_cptr shm3=(lds_cptr)shm; const lds_cptr kp0=shm3+LDS_K+hi*1024+r32*16; const lds_cptr vp0=shm3+LDS_V+((lane>>4)&1)*32+(lane&3)*8+(4*hi+((lane&15)>>2))*64;
  const int NT=(q0+QB)/KVBLK;
  DMA_K(0,0);DMA_V(0,0);DMA_K(1,SLOTB);
  bf16x8 qr[4];
  #pragma unroll
  for(int d0=0;d0<4;++d0)qr[d0]=*reinterpret_cast<const bf16x8*>(&Qw[(long)r32*DM+d0*16+hi*8]);
  float l_reg=0.f;f32x16 o[2];o[0]=f32x16{};o[1]=f32x16{};
  float nb=slope2*(float)(4*hi-q0-255); const float sl64=64.f*slope2;
  #define BINIT0(C0,t) do{ _Pragma("unroll") for(int r=0;r<16;++r)C0[r]=fmaf(slope2,(float)((r&3)+8*(r>>2)),nb); }while(0)
  #define BINIT1(C1,t) do{ _Pragma("unroll") for(int r=0;r<16;++r)C1[r]=fmaf(slope2,(float)((r&3)+8*(r>>2)+32),nb); nb+=sl64; }while(0)
  const int qrel=wid*QBLK+r32;
  #define CMASK(P0,P1,t) do{int jb_=(t)-(NT-4); if(jb_>=0)cmask(P0,P1,jb_,qrel,hi);}while(0)
  bool resc=false;
  #define START(P0,P1) do{ const float rm=rowmax(P0,P1); resc=false; \
    { const float dl=rm; nb=fsub_s(nb,dl); \
      _Pragma("unroll") for(int r=0;r<16;++r){P0[r]=fsub_s(P0[r],dl);P1[r]=fsub_s(P1[r],dl);} } \
    _Pragma("unroll") for(int r=0;r<16;++r)P0[r]=__builtin_amdgcn_exp2f(P0[r]); }while(0)
  #define RESC() do{ if(resc){ asm volatile("s_waitcnt lgkmcnt(0)":::"memory"); \
      _Pragma("unroll") for(int d_=0;d_<2;++d_) _Pragma("unroll") for(int r=0;r<16;++r)o[d_][r]*=wsf[crow(r,hi)]; } }while(0)
  f32x16 pA0,pA1,pB0,pB1;
  int sl_prev=0,sl_cur=0,sl_next=SLOTB;
  #define ROT() do{sl_prev=sl_cur;sl_cur=sl_next;sl_next=(sl_next==(NSLOT-1)*SLOTB)?0:sl_next+SLOTB;}while(0)
  DMA_K(2,2*SLOTB);
  WAIT_BAR(3);
  asm volatile("":"+v"(nb));
  BINIT0(pA0,0);BINIT1(pA1,0);qkt(pA0,pA1,Kbase,qr,r32,hi);asm volatile("s_nop 15\n\ts_nop 7":"+v"(pA0),"+v"(pA1));CMASK(pA0,pA1,0);
  START(pA0,pA1);
  _Pragma("unroll") for(int r=0;r<16;++r)pA1[r]=__builtin_amdgcn_exp2f(pA1[r]);
  WAIT_BAR(0);
  DMA_K(3,0);DMA_V(1,SLOTB);
  ROT();
  kload8(kf,kp0+sl_cur);
  WAIT_BAR(2);
  s16x4 vlo[8],vhi[8]; u32x4 pw0,pw1,pw2,pw3;
  #define PKW(P,B) cvtpk_s(P[B],P[B+1])
  #define PAF(k) __builtin_bit_cast(bf16x8,pw##k)
  #define VFR(i) (bf16x8){vlo[i][0],vlo[i][1],vlo[i][2],vlo[i][3],vhi[i][0],vhi[i][1],vhi[i][2],vhi[i][3]}
  #define PIN(x) asm volatile("":"+v"(x))
  #define MX3(a,b,c) __builtin_fmaxf(__builtin_fmaxf((a),(b)),(c))
  #define GAPA(MF,A0,A1,A2,A3,W0,W1,PW) do{ MF; sacc+=A0; sacc+=A1; sacc+=A2; sacc+=A3; PIN(sacc); W0; W1; PIN(PW); SBAR(); }while(0)
  #define EX(v) __builtin_amdgcn_exp2f(v)
  #define GAPB(MF,X,B) do{ MF; X[B]=EX(X[B]); X[B+1]=EX(X[B+1]); X[B+2]=EX(X[B+2]); X[B+3]=EX(X[B+3]); PIN(X); SBAR(); }while(0)
  #define VRD(i) do{ vlo[i]=vtr(vp_+(((i)>>2)*4096+((i)&3)*1024)); vhi[i]=vtr(vp_+(((i)>>2)*4096+((i)&3)*1024+512)); }while(0)
  #define KRD(G,j) do{ if(G){ kload2(kf,kp0+sl_next,j); SBAR(); } }while(0)
  #define STEP(C0,C1,P0,P1,t,GK,GV,GL) do{ SBAR(); \
    const lds_cptr vp_=vp0+sl_prev; \
    BINIT0(C0,t); PIN(C0); VRD(0); SBAR(); float sacc=(P0[0]+P0[1]); \
    GAPA(C0=__builtin_amdgcn_mfma_f32_32x32x16_bf16(kf[0],qr[0],C0,0,0,0), P0[2],P0[3],P0[4],P0[5],     pw0[0]=PKW(P0,0), pw0[1]=PKW(P0,2), pw0); \
    BINIT1(C1,t); PIN(C1); VRD(4); SBAR(); GAPA(C1=__builtin_amdgcn_mfma_f32_32x32x16_bf16(kf[1],qr[0],C1,0,0,0), P0[6],P0[7],P0[8],P0[9],     pw0[2]=PKW(P0,4), pw0[3]=PKW(P0,6), pw0); \
    VRD(1); SBAR(); GAPA(C0=__builtin_amdgcn_mfma_f32_32x32x16_bf16(kf[2],qr[1],C0,0,0,0),   P0[10],P0[11],P0[12],P0[13], pw1[0]=PKW(P0,8), pw1[1]=PKW(P0,10), pw1); \
    VRD(5); SBAR(); GAPA(C1=__builtin_amdgcn_mfma_f32_32x32x16_bf16(kf[3],qr[1],C1,0,0,0),   P0[14],P0[15],P1[0],P1[1],   pw1[2]=PKW(P0,12),pw1[3]=PKW(P0,14), pw1); \
    VRD(2); SBAR(); GAPA(C0=__builtin_amdgcn_mfma_f32_32x32x16_bf16(kf[4],qr[2],C0,0,0,0),   P1[2],P1[3],P1[4],P1[5],     pw2[0]=PKW(P1,0), pw2[1]=PKW(P1,2), pw2); \
    VRD(6); SBAR(); GAPA(C1=__builtin_amdgcn_mfma_f32_32x32x16_bf16(kf[5],qr[2],C1,0,0,0),   P1[6],P1[7],P1[8],P1[9],     pw2[2]=PKW(P1,4), pw2[3]=PKW(P1,6), pw2); \
    VRD(3); SBAR(); GAPA(C0=__builtin_amdgcn_mfma_f32_32x32x16_bf16(kf[6],qr[3],C0,0,0,0),   P1[10],P1[11],P1[12],P1[13], pw3[0]=PKW(P1,8), pw3[1]=PKW(P1,10), pw3); \
    VRD(7); SBAR(); GAPA(C1=__builtin_amdgcn_mfma_f32_32x32x16_bf16(kf[7],qr[3],C1,0,0,0),   P1[14],P1[15],0.f,0.f,       pw3[2]=PKW(P1,12),pw3[3]=PKW(P1,14), pw3); \
    l_reg+=sacc; \
    if(GK){DMA_K((t)+3,sl_cur);} if(GV){DMA_V((t)+1,sl_next);} \
    CMASK(C0,C1,t); \
    { float a=MX3(C0[0],C0[1],C1[0]),b=MX3(C0[2],C0[3],C1[1]); a=MX3(a,C1[2],C1[3]); \
      _Pragma("unroll") for(int r=4;r<16;r+=4){a=MX3(a,C0[r],C0[r+1]);b=MX3(b,C0[r+2],C0[r+3]);a=MX3(a,C1[r],C1[r+1]);b=MX3(b,C1[r+2],C1[r+3]);} \
      float rm=__builtin_fmaxf(a,b); { auto rr=__builtin_amdgcn_permlane32_swap(__float_as_uint(rm),__float_as_uint(rm),false,false); rm=__builtin_fmaxf(__uint_as_float(rr[0]),__uint_as_float(rr[1])); } \
      resc=false; \
      if(__builtin_expect(__any(rm>(float)THRL),0)){ const float dl=__builtin_fmaxf(rm,0.f); nb-=dl; \
        _Pragma("unroll") for(int r=0;r<16;++r){C0[r]-=dl;C1[r]-=dl;} \
        const float f=__builtin_amdgcn_exp2f(-dl); l_reg*=f; if(hi==0)wsf[r32]=f; resc=true; } } \
    SBAR(); \
    GAPB(o[0]=__builtin_amdgcn_mfma_f32_32x32x16_bf16(PAF(0),VFR(0),o[0],0,0,0), C0,0); \
    GAPB(o[1]=__builtin_amdgcn_mfma_f32_32x32x16_bf16(PAF(0),VFR(4),o[1],0,0,0), C0,4); \
    KRD(GL,0); GAPB(o[0]=__builtin_amdgcn_mfma_f32_32x32x16_bf16(PAF(1),VFR(1),o[0],0,0,0), C0,8); \
    KRD(GL,1); GAPB(o[1]=__builtin_amdgcn_mfma_f32_32x32x16_bf16(PAF(1),VFR(5),o[1],0,0,0), C0,12); \
    KRD(GL,2); GAPB(o[0]=__builtin_amdgcn_mfma_f32_32x32x16_bf16(PAF(2),VFR(2),o[0],0,0,0), C1,0); \
    KRD(GL,3); GAPB(o[1]=__builtin_amdgcn_mfma_f32_32x32x16_bf16(PAF(2),VFR(6),o[1],0,0,0), C1,4); \
    GAPB(o[0]=__builtin_amdgcn_mfma_f32_32x32x16_bf16(PAF(3),VFR(3),o[0],0,0,0), C1,8); \
    GAPB(o[1]=__builtin_amdgcn_mfma_f32_32x32x16_bf16(PAF(3),VFR(7),o[1],0,0,0), C1,12); \
    }while(0)
  int t=1;
  #undef CMASK
  #define CMASK(P0,P1,t) do{}while(0)
  for(;t+5<NT;t+=2){
    STEP(pB0,pB1,pA0,pA1,t,true,true,true);     WAIT_BAR(2); RESC(); ROT();
    STEP(pA0,pA1,pB0,pB1,t+1,true,true,true);   WAIT_BAR(2); RESC(); ROT();
  }
  #undef CMASK
  #define CMASK(P0,P1,t) do{int jb_=(t)-(NT-4); if(jb_>=0)cmask(P0,P1,jb_,qrel,hi);}while(0)
  #define ENDW(tt) do{ if((tt)+3<NT){WAIT_BAR(2);} else if((tt)+2<NT){WAIT_BAR(1);} else {WAIT_BAR(0);} }while(0)
  for(;t+1<NT;t+=2){
    STEP(pB0,pB1,pA0,pA1,t,(t+3<NT),(t+1<NT),(t+1<NT));       ENDW(t);   RESC(); ROT();
    STEP(pA0,pA1,pB0,pB1,t+1,(t+4<NT),(t+2<NT),(t+2<NT));     ENDW(t+1); RESC(); ROT();
  }
  STEP(pB0,pB1,pA0,pA1,NT-1,false,false,false); RESC();
  { float sacc=pB0[0]+pB0[1]; _Pragma("unroll") for(int r=2;r<16;++r)sacc+=pB0[r]; _Pragma("unroll") for(int r=0;r<16;++r)sacc+=pB1[r]; l_reg+=sacc;
    pw0=(u32x4){PKW(pB0,0),PKW(pB0,2),PKW(pB0,4),PKW(pB0,6)};pw1=(u32x4){PKW(pB0,8),PKW(pB0,10),PKW(pB0,12),PKW(pB0,14)};pw2=(u32x4){PKW(pB1,0),PKW(pB1,2),PKW(pB1,4),PKW(pB1,6)};pw3=(u32x4){PKW(pB1,8),PKW(pB1,10),PKW(pB1,12),PKW(pB1,14)};
    SBAR(); pv(o,vb0+sl_cur,PAF(0),PAF(1),PAF(2),PAF(3)); }
  #undef PKW
  #undef PAF
  #undef VFR
  #undef PIN
  #undef MX3
  #undef GAPA
  #undef GAPB
  #undef EX
  #undef VRD
  #undef KRD
  #undef STEP
  #undef ENDW
  {auto rr=__builtin_amdgcn_permlane32_swap(__float_as_uint(l_reg),__float_as_uint(l_reg),false,false);l_reg=__uint_as_float(rr[0])+__uint_as_float(rr[1]);}
  if(hi==0)wsf[32+r32]=l_reg;asm volatile("s_waitcnt lgkmcnt(0)":::"memory");
  float rli[16];
  #pragma unroll
  for(int r=0;r<16;++r)rli[r]=__builtin_amdgcn_rcpf(wsf[32+crow(r,hi)]);
  bf16*Ow=O+(rowbase+q0+wid*QBLK)*DM+hv*D;
  { bf16*stg=(bf16*)(shm+LDS_OST)+wid*2048;
    #pragma unroll
    for(int r=0;r<16;++r){const int orow=crow(r,hi);
      #pragma unroll
      for(int d0=0;d0<2;++d0)stg[orow*64+d0*32+r32]=__float2bfloat16(o[d0][r]*rli[r]);}
    asm volatile("s_waitcnt lgkmcnt(0)":::"memory");
    #pragma unroll
    for(int i=0;i<4;++i){const int row=i*8+(lane>>3),ch=lane&7; const u32x4 v=*(const u32x4*)(stg+row*64+ch*8); ATTN_STORE16(Ow+(long)row*DM+ch*8,v);} }
  asm volatile("s_waitcnt lgkmcnt(0)\n\ts_barrier":::"memory");
  #undef DMA_K
  #undef DMA_V
  #undef BINIT0
  #undef BINIT1
  #undef CMASK
  #undef START
  #undef RESC
  #undef ROT
}
constexpr int ATTN_LDS_BYTES=LDS_BYTES;
#undef SBAR
#undef WAIT_BAR
}
#define GAS __attribute__((address_space(1)))
#define LAS __attribute__((address_space(3)))
typedef unsigned short bf16;
typedef unsigned v4u __attribute__((ext_vector_type(4)));
typedef float f32x4 __attribute__((ext_vector_type(4)));
typedef short bf16x8 __attribute__((ext_vector_type(8)));
typedef GAS unsigned gu32;
typedef GAS unsigned long long gu64;
#define RLX_AGENT __ATOMIC_RELAXED, __HIP_MEMORY_SCOPE_AGENT
#define LDS_WAIT() asm volatile("s_waitcnt lgkmcnt(0)" ::: "memory")
#define VM_WAIT() asm volatile("s_waitcnt vmcnt(0)" ::: "memory")
__device__ __forceinline__ unsigned long long rt() { return __builtin_amdgcn_s_memrealtime(); }
__device__ __forceinline__ unsigned f2bf(float f) { unsigned u = __builtin_bit_cast(unsigned, f); return (u + 0x7fffu + ((u >> 16) & 1u)) >> 16; }
typedef float f32x2_pk __attribute__((ext_vector_type(2))); typedef __bf16 bf16x2_pk __attribute__((ext_vector_type(2)));
__device__ __forceinline__ unsigned pk2(float lo, float hi) { f32x2_pk v = {lo, hi}; bf16x2_pk b = __builtin_convertvector(v, bf16x2_pk); return __builtin_bit_cast(unsigned, b); }

#define XB_TMO      128
#define XB_XCNT(j)  (256  + 64 * (j))
#define XB_XSUB(j)  (1280 + 64 * (j))
#define XB_XGEN(j)  (2304 + 64 * (j))
#define XB_TOP      3328
#define XB_TOPGEN   3392
#define XCD_BAR_WORDS 3456
#define XB_SPIN_CAP (1u << 18)

__device__ __forceinline__ unsigned xb_ld(unsigned* p)              { return __hip_atomic_load(p, __ATOMIC_RELAXED, __HIP_MEMORY_SCOPE_AGENT); }
__device__ __forceinline__ unsigned xb_add(unsigned* p, unsigned v) { return __hip_atomic_fetch_add(p, v, __ATOMIC_RELAXED, __HIP_MEMORY_SCOPE_AGENT); }
__device__ __forceinline__ unsigned xb_xcc_id() { return (unsigned)__builtin_amdgcn_s_getreg((3 << 11) | 20) & 0xFu; }
#define XB_SPIN(cond, bar) do { unsigned _sp = 0; while (cond) { __builtin_amdgcn_s_sleep(1); \
    if ((++_sp & 255u) == 0u) { if (xb_ld(&(bar)[XB_TMO])) break; if (_sp > XB_SPIN_CAP) { atomicAdd(&(bar)[XB_TMO], 1u); break; } } } } while (0)

struct XcdBarrier {
    unsigned* bar; unsigned x;
    volatile LAS unsigned* st;
};

__device__ __forceinline__ XcdBarrier xcd_barrier_post(unsigned* bar, volatile LAS unsigned* st) {
    XcdBarrier b; b.bar = bar; b.x = xb_xcc_id(); b.st = st;
    if (threadIdx.x == 0) (void)xb_add(&bar[XB_XCNT(b.x)], 1u);
    return b;
}
__device__ __forceinline__ void xcd_barrier_complete(unsigned* bar, unsigned x, unsigned& nloc, unsigned& nx) {
    const unsigned G = gridDim.x * gridDim.y * gridDim.z;
    unsigned sum, cnt, mine, sp = 0u;
    for (;;) {
        sum = 0u; cnt = 0u; mine = 0u;
#pragma unroll
        for (unsigned j = 0; j < 16; ++j) { const unsigned c = xb_ld(&bar[XB_XCNT(j)]); sum += c; cnt += (c > 0u) ? 1u : 0u; mine = (j == x) ? c : mine; }
        if (sum == G) break;
        __builtin_amdgcn_s_sleep(1);
        if ((++sp & 255u) == 0u) { if (xb_ld(&bar[XB_TMO])) break; if (sp > XB_SPIN_CAP) { atomicAdd(&bar[XB_TMO], 1u); break; } }
    }
    nloc = mine > 0u ? mine : 1u; nx = cnt > 0u ? cnt : 1u;
}

__device__ __forceinline__ void xcd_barrier(const XcdBarrier& b) {
    asm volatile("s_waitcnt vmcnt(0)" ::: "memory");
    __syncthreads();
    if (threadIdx.x == 0) {
        unsigned* bar = b.bar;
        __builtin_amdgcn_s_waitcnt(0);
        unsigned nloc = b.st[0], nx = b.st[1];
        if (nloc == 0u) { xcd_barrier_complete(bar, b.x, nloc, nx); b.st[0] = nloc; b.st[1] = nx; }
        const unsigned old = xb_add(&bar[XB_XSUB(b.x)], 1u);
        const unsigned gen = old / nloc;
        if (old + 1u == (gen + 1u) * nloc) {
            __builtin_amdgcn_fence(__ATOMIC_RELEASE, "agent");
            asm volatile("s_waitcnt vmcnt(0)" ::: "memory");
            const unsigned og = xb_add(&bar[XB_TOP], 1u);
            const unsigned tg = og / nx;
            if (og + 1u == (tg + 1u) * nx) xb_add(&bar[XB_TOPGEN], 1u);
            else XB_SPIN(xb_ld(&bar[XB_TOPGEN]) == tg, bar);
            __builtin_amdgcn_fence(__ATOMIC_ACQUIRE, "agent");
            xb_add(&bar[XB_XGEN(b.x)], 1u);
            asm volatile("s_waitcnt vmcnt(0)" ::: "memory");
        } else {
            XB_SPIN(xb_ld(&bar[XB_XGEN(b.x)]) == gen, bar);
            __builtin_amdgcn_fence(__ATOMIC_ACQUIRE, "agent");
            asm volatile("s_waitcnt vmcnt(0)" ::: "memory");
        }
    }
    __syncthreads();
}
constexpr int NWAVES = 8;
constexpr int BATCH = 8, SEQ = 2048, DM = 2048, DEPTH = 2, M = BATCH * SEQ;
constexpr int HEADS = 8, IN_TOTAL = 10240, LRUW = 1024, NBLK = 8, BLKW = 128;
constexpr float LN_EPS = 1e-5f, SUBLN_EPS = 1e-5f, DN_ALPHA = 1.41421356237309515f, LOG2E = 1.4426950408889634f;

constexpr size_t MiB = 1u << 20;
constexpr size_t WS_CTL = 0, CTL_ZERO_BYTES = 1 * MiB;
constexpr size_t WS_GW = 1 * MiB;
constexpr size_t WS_WIN = 2 * MiB;
constexpr size_t WS_WPAB = 82 * MiB;
constexpr size_t WS_WOUT = 98 * MiB;
constexpr size_t WS_XB16 = 114 * MiB;
constexpr size_t WS_O1 = 114 * MiB, WS_O2 = 146 * MiB, WS_MERGED = 114 * MiB;
constexpr size_t WS_P6 = 178 * MiB;
constexpr size_t WS_MA = 370 * MiB, WS_MB = 434 * MiB;
constexpr size_t WS_AR = 498 * MiB;
constexpr size_t WS_END = 562 * MiB;
constexpr int CW_TMO = 0, CW_BAR = 4096;

constexpr int RING_OFF = 0, RING_BYTES = 151552;
constexpr int LDSCTL_OFF = RING_BYTES, MISC_OFF = LDSCTL_OFF + 320;
constexpr int LDS_BYTES = 153600;
static_assert(MISC_OFF + 128 <= LDS_BYTES && attn_body::ATTN_LDS_BYTES <= RING_BYTES && pg8::STAGE_BYTES <= RING_BYTES, "LDS map");

struct Frame {
    LAS unsigned char* lds; volatile LAS unsigned* MISC; gu32* ctl;
    int tid, lane, wave, vcu, G;
};
__device__ __forceinline__ float wave_sum(float v, int lane) {
#pragma unroll
    for (int o = 1; o < 64; o <<= 1) v += __int_as_float(__builtin_amdgcn_ds_bpermute((lane ^ o) << 2, __float_as_int(v)));
    return v;
}
__device__ __forceinline__ void p0_transpose_item(const float* W, int N, bf16* WT, int ldt, int koff, LAS float* scr, int item, int lane) {
    const int nblk = N / 32, kb = item / nblk, nb = item % nblk, k0 = 64 * kb, n0 = 32 * nb;
#pragma unroll 8
    for (int i = 0; i < 32; ++i) { const int kk = 2 * i + (lane >> 5); scr[kk * 33 + (lane & 31)] = W[(size_t)(k0 + kk) * N + n0 + (lane & 31)]; }
    LDS_WAIT(); asm volatile("" ::: "memory");
    const int c = lane & 7;
#pragma unroll
    for (int j = 0; j < 4; ++j) { const int n = (lane >> 3) + 8 * j; const LAS float* s = scr + (8 * c) * 33 + n;
        v4u o; o.x = pk2(s[0 * 33], s[1 * 33]); o.y = pk2(s[2 * 33], s[3 * 33]); o.z = pk2(s[4 * 33], s[5 * 33]); o.w = pk2(s[6 * 33], s[7 * 33]);
        *(GAS v4u*)(WT + (size_t)(n0 + n) * ldt + koff + k0 + 8 * c) = o; }
    LDS_WAIT(); asm volatile("" ::: "memory");
}
struct Args { const float* in[19]; float* out; unsigned char* ws; int ph_lo, ph_hi; };

__device__ __forceinline__ void p0_prologue(Frame& F, const Args& a) {
    LAS float* scr = (LAS float*)(F.lds + RING_OFF + F.wave * 16384);
    const int gw = F.vcu * NWAVES + F.wave, NGW = F.G * NWAVES;
    constexpr int I_IN = (DM / 64) * (IN_TOTAL / 32), I_P = (1024 / 64) * (DM / 32), I_O = (DM / 64) * (DM / 32), I_L = I_IN + 2 * I_P + I_O;
    for (int it = gw; it < DEPTH * I_L; it += NGW) {
        const int l = it / I_L; int r = it % I_L;
        bf16* win = (bf16*)(a.ws + WS_WIN) + (size_t)l * IN_TOTAL * DM; bf16* wpab = (bf16*)(a.ws + WS_WPAB) + (size_t)l * DM * DM; bf16* wout = (bf16*)(a.ws + WS_WOUT) + (size_t)l * DM * DM;
        if (r < I_IN) { p0_transpose_item(a.in[1] + (size_t)l * DM * IN_TOTAL, IN_TOTAL, win, DM, 0, scr, r, F.lane); continue; } r -= I_IN;
        if (r < I_P) { p0_transpose_item(a.in[14] + (size_t)l * 1024 * DM, DM, wpab, DM, 0, scr, r, F.lane); continue; } r -= I_P;
        if (r < I_P) { p0_transpose_item(a.in[15] + (size_t)l * 1024 * DM, DM, wpab, DM, 1024, scr, r, F.lane); continue; } r -= I_P;
        p0_transpose_item(a.in[16] + (size_t)l * DM * DM, DM, wout, DM, 0, scr, r, F.lane);
    }
    for (int it = gw; it < DEPTH * NBLK * 4 * 2 * 8; it += NGW) {
        const int s_ = it & 7, g_ = (it >> 3) & 1, jq = (it >> 4) & 3, n = (it >> 6) & 7, l = it >> 9;
        const float* w = a.in[g_ ? 6 : 4] + ((size_t)(l * NBLK + n) * BLKW + 16 * s_ + 8 * (F.lane >> 5)) * BLKW + jq * 32 + (F.lane & 31);
        v4u o; o.x = pk2(w[0], w[BLKW]); o.y = pk2(w[2 * BLKW], w[3 * BLKW]); o.z = pk2(w[4 * BLKW], w[5 * BLKW]); o.w = pk2(w[6 * BLKW], w[7 * BLKW]);
        *(GAS v4u*)((bf16*)(a.ws + WS_GW) + (size_t)it * 512 + F.lane * 8) = o; }
    bf16* xb = (bf16*)(a.ws + WS_XB16); const float* x = a.in[0];
    for (int m = gw; m < M; m += NGW) {
        const GAS f32x4* xr = (const GAS f32x4*)(x + (size_t)m * DM) + F.lane; GAS unsigned long long* o8 = (GAS unsigned long long*)(xb + (size_t)m * DM) + F.lane;
#pragma unroll
        for (int j = 0; j < 8; ++j) { const f32x4 v = xr[64 * j]; o8[64 * j] = (unsigned long long)pk2(v.x, v.y) | ((unsigned long long)pk2(v.z, v.w) << 32); }
    }
}
__device__ __forceinline__ void ln_phase(Frame& F, float* y, bf16* xb, const float* g, const float* bta) {
    const int gw = F.vcu * NWAVES + F.wave, NGW = F.G * NWAVES; int lane = F.lane; asm volatile("" : "+v"(lane));
    for (int m = gw; m < M; m += NGW) {
        GAS f32x4* yr = (GAS f32x4*)(y + (size_t)m * DM) + lane; f32x4 v[8]; float s = 0.f;
#pragma unroll
        for (int j = 0; j < 8; ++j) { v[j] = yr[64 * j]; s += (v[j].x + v[j].y) + (v[j].z + v[j].w); }
        const float mean = wave_sum(s, lane) * (1.f / DM); float s2 = 0.f;
#pragma unroll
        for (int j = 0; j < 8; ++j) { v[j] = v[j] - mean; s2 += (v[j].x * v[j].x + v[j].y * v[j].y) + (v[j].z * v[j].z + v[j].w * v[j].w); }
        const float rstd = 1.f / sqrtf(wave_sum(s2, lane) * (1.f / DM) + LN_EPS);
        GAS unsigned long long* o8 = (GAS unsigned long long*)(xb + (size_t)m * DM) + lane;
#pragma unroll
        for (int j = 0; j < 8; ++j) { const f32x4 gg = *((const GAS f32x4*)g + lane + 64 * j), bb = *((const GAS f32x4*)bta + lane + 64 * j);
            const f32x4 o = v[j] * rstd * gg + bb; yr[64 * j] = o; o8[64 * j] = (unsigned long long)pk2(o.x, o.y) | ((unsigned long long)pk2(o.z, o.w) << 32); }
    }
}
__device__ __forceinline__ void combine_block(Frame& F, int b, int h, int qb, const bf16* O1, const bf16* O2, const bf16* GA, bf16* AR, const float* subln_g, float lam, float lam_init) {
    typedef short s16x8 __attribute__((ext_vector_type(8)));
    int tid = F.tid; asm volatile("" : "+v"(tid));
#pragma unroll 1
    for (int it = 0; it < 4; ++it) {
        const int idx = tid + 512 * it, row = b * SEQ + qb * 256 + (idx >> 3), c16 = idx & 7, col = h * 128 + c16 * 16;
        const size_t off = (size_t)row * 1024 + col;
        const s16x8 a0 = *(const GAS s16x8*)(O1 + off), a1 = *(const GAS s16x8*)(O1 + off + 8), b0 = *(const GAS s16x8*)(O2 + off), b1 = *(const GAS s16x8*)(O2 + off + 8);
        const s16x8 g0 = *(const GAS s16x8*)(GA + off), g1 = *(const GAS s16x8*)(GA + off + 8);
        float o[16]; float ss = 0.f;
#pragma unroll
        for (int j = 0; j < 8; ++j) { o[j] = pg8::bfbits2f(a0[j]) - lam * pg8::bfbits2f(b0[j]); o[8 + j] = pg8::bfbits2f(a1[j]) - lam * pg8::bfbits2f(b1[j]); }
#pragma unroll
        for (int j = 0; j < 16; ++j) ss += o[j] * o[j];
        ss += __shfl_xor(ss, 1); ss += __shfl_xor(ss, 2); ss += __shfl_xor(ss, 4);
        const float rn = (1.f / sqrtf(ss * (1.f / 128.f) + SUBLN_EPS)) * (1.f - lam_init);
        unsigned w[8];
#pragma unroll
        for (int j = 0; j < 8; ++j) {
            const float ga0 = pg8::bfbits2f(j < 4 ? g0[2 * j] : g1[2 * j - 8]), ga1 = pg8::bfbits2f(j < 4 ? g0[2 * j + 1] : g1[2 * j - 7]);
            const float v0 = o[2 * j] * rn * subln_g[c16 * 16 + 2 * j] * (ga0 / (1.f + __expf(-ga0))), v1 = o[2 * j + 1] * rn * subln_g[c16 * 16 + 2 * j + 1] * (ga1 / (1.f + __expf(-ga1)));
            w[j] = pk2(v0, v1); }
        bf16* op = AR + (size_t)row * 2048 + col;
        *(GAS v4u*)op = (v4u){w[0], w[1], w[2], w[3]}; *(GAS v4u*)(op + 8) = (v4u){w[4], w[5], w[6], w[7]};
    }
}
constexpr int LRU_TM = 256, XCS_PITCH = 272, LRU_XCS = 0, LRU_AS = LRU_XCS + LRU_TM * XCS_PITCH, LRU_US = LRU_AS + LRU_TM * 32 * 4, LRU_AH = LRU_US + LRU_TM * 32 * 4, LRU_CARRY = LRU_AH + 16 * 32 * 8, LRU_WI = LRU_CARRY + 2 * 32 * 4, LRU_CW = LRU_WI + 8 * 64 * 16, LRU_END = LRU_CW + 5 * 128 * 4;
static_assert(LRU_END <= RING_BYTES, "LRU LDS map");
constexpr size_t GW_ITEM = 2 * 8 * 64 * 8;
#define LBAR() asm volatile("s_waitcnt lgkmcnt(0)\n\ts_barrier" ::: "memory")
__device__ __forceinline__ void lru_item(Frame& F, int b, int n, int jq, const bf16* XB, const bf16* GB, bf16* AR, const float* conv_w, const float* conv_b, const bf16* gwf, const float* b_r,
                                         const float* b_i, const float* lam) {
    typedef short s16x8 __attribute__((ext_vector_type(8))); typedef float f32x16 __attribute__((ext_vector_type(16))); typedef float f32x2 __attribute__((ext_vector_type(2)));
    LAS unsigned char* L = F.lds + RING_OFF;
    int tid = F.tid; asm volatile("" : "+v"(tid));
    const int lane = tid & 63, wave = F.wave, r32 = lane & 31, hi = lane >> 5;
    const int ch8 = tid & 15, tq = tid >> 4;
    const int cch = n * BLKW + jq * 32 + r32;
    s16x8 wfr[8];
#pragma unroll
    for (int s = 0; s < 8; ++s) wfr[s] = *(const GAS s16x8*)(gwf + (size_t)(s * 64 + lane) * 8);
    *(LAS s16x8*)(L + LRU_WI + tid * 16) = *(const GAS s16x8*)(gwf + (size_t)(8 * 64 + tid) * 8);
    const float bias_r = b_r[cch], bias_i = b_i[cch], lc = -8.f * log1pf(__expf(-lam[cch])), lc2 = lc * LOG2E;
    if (tid < 64) ((LAS float*)(L + LRU_CARRY))[tid] = 0.f;
    const bf16* xbase = XB + (size_t)b * SEQ * 1024 + n * BLKW + ch8 * 8;
    if (tid < 128) { LAS float* cwl = (LAS float*)(L + LRU_CW); cwl[tid] = conv_b[n * BLKW + tid];
#pragma unroll
        for (int j = 0; j < 4; ++j) cwl[(1 + j) * 128 + tid] = conv_w[j * LRUW + n * BLKW + tid]; }
    s16x8 xq[2][7];
#define LRU_LOADX(t0_) do { _Pragma("unroll") for (int g = 0; g < 2; ++g) _Pragma("unroll") for (int rr = 0; rr < 7; ++rr) { const int t = (t0_) + (tq + 32 * g) * 4 - 3 + rr; \
        xq[g][rr] = (t >= 0) ? *(const GAS s16x8*)(xbase + (size_t)t * 1024) : (s16x8){0, 0, 0, 0, 0, 0, 0, 0}; } } while (0)
    LRU_LOADX(0);
    LBAR();
#pragma unroll 1
    for (int ms = 0; ms < SEQ / LRU_TM; ++ms) {
        const int t0 = ms * LRU_TM;
        {
            float cw[4][8], cb[8];
            { unsigned cwb = (unsigned)(LRU_CW + ch8 * 32); asm volatile("" : "+v"(cwb));
              const f32x4 b0 = *(const LAS f32x4*)(L + cwb), b1 = *(const LAS f32x4*)(L + cwb + 16);
              cb[0] = b0.x; cb[1] = b0.y; cb[2] = b0.z; cb[3] = b0.w; cb[4] = b1.x; cb[5] = b1.y; cb[6] = b1.z; cb[7] = b1.w;
#pragma unroll
              for (int j = 0; j < 4; ++j) { const f32x4 w0 = *(const LAS f32x4*)(L + cwb + (1 + j) * 512), w1 = *(const LAS f32x4*)(L + cwb + (1 + j) * 512 + 16);
                  cw[j][0] = w0.x; cw[j][1] = w0.y; cw[j][2] = w0.z; cw[j][3] = w0.w; cw[j][4] = w1.x; cw[j][5] = w1.y; cw[j][6] = w1.z; cw[j][7] = w1.w; } }
            unsigned s1b = (unsigned)(LRU_XCS + tq * 4 * XCS_PITCH + ch8 * 16); asm volatile("" : "+v"(s1b));
#pragma unroll
            for (int g = 0; g < 2; ++g) {
                unsigned w[4][4];
#pragma unroll
                for (int i2 = 0; i2 < 4; ++i2) {
                    float x0[7], x1[7];
#pragma unroll
                    for (int rr = 0; rr < 7; ++rr) { const unsigned d = ((const unsigned*)&xq[g][rr])[i2]; x0[rr] = __uint_as_float(d << 16); x1[rr] = __uint_as_float(d & 0xffff0000u); }
#pragma unroll
                    for (int q = 0; q < 4; ++q) {
                        const float v0 = cb[2 * i2] + cw[0][2 * i2] * x0[q] + cw[1][2 * i2] * x0[q + 1] + cw[2][2 * i2] * x0[q + 2] + cw[3][2 * i2] * x0[q + 3];
                        const float v1 = cb[2 * i2 + 1] + cw[0][2 * i2 + 1] * x1[q] + cw[1][2 * i2 + 1] * x1[q + 1] + cw[2][2 * i2 + 1] * x1[q + 2] + cw[3][2 * i2 + 1] * x1[q + 3];
                        w[q][i2] = pk2(v0, v1); }
                    asm volatile("" : "+v"(w[0][i2]), "+v"(w[1][i2]), "+v"(w[2][i2]), "+v"(w[3][i2]));
                }
#pragma unroll
                for (int q = 0; q < 4; ++q) *(LAS v4u*)(L + s1b + (32 * g * 4 + q) * XCS_PITCH) = (v4u){w[q][0], w[q][1], w[q][2], w[q][3]};
            }
        }
        if (ms + 1 < SEQ / LRU_TM) LRU_LOADX(t0 + LRU_TM);
        LBAR();
        {
            f32x16 ar, ai;
#pragma unroll
            for (int r = 0; r < 16; ++r) { ar[r] = bias_r; ai[r] = bias_i; }
            unsigned s2a = (unsigned)(LRU_XCS + (32 * wave + r32) * XCS_PITCH + hi * 16), s2i = (unsigned)(LRU_WI + lane * 16); asm volatile("" : "+v"(s2a), "+v"(s2i));
#pragma unroll
            for (int s = 0; s < 8; ++s) { const s16x8 af = *(const LAS s16x8*)(L + s2a + s * 32), wi = *(const LAS s16x8*)(L + s2i + s * 1024);
                ar = __builtin_amdgcn_mfma_f32_32x32x16_bf16(af, wfr[s], ar, 0, 0, 0); ai = __builtin_amdgcn_mfma_f32_32x32x16_bf16(af, wi, ai, 0, 0, 0); }
            unsigned s2x = (unsigned)(LRU_XCS + (32 * wave + 4 * hi) * XCS_PITCH + (jq * 32 + r32) * 2), s2w = (unsigned)((32 * wave + 4 * hi) * 128 + r32 * 4); asm volatile("" : "+v"(s2x), "+v"(s2w));
#pragma unroll
            for (int r = 0; r < 16; ++r) { const int cr = (r & 3) + 8 * (r >> 2);
                const float rg = __builtin_amdgcn_rcpf(1.f + __builtin_amdgcn_exp2f(-LOG2E * ar[r])), ig = __builtin_amdgcn_rcpf(1.f + __builtin_amdgcn_exp2f(-LOG2E * ai[r]));
                const float av = __builtin_amdgcn_exp2f(lc2 * rg), t = 2.f * lc * rg;
                const float ser = -t * (1.f + t * (0.5f + t * (0.16666667f + t * (0.041666668f + t * 0.0083333338f))));
                const float om = (t > -0.1f) ? ser : (1.f - av * av);
                const float xc = __uint_as_float(((unsigned)*(const LAS unsigned short*)(L + s2x + cr * XCS_PITCH)) << 16);
                const float uv = __builtin_amdgcn_sqrtf(om) * (ig * xc);
                *(LAS float*)(L + LRU_AS + s2w + cr * 128) = av; *(LAS float*)(L + LRU_US + s2w + cr * 128) = uv; }
        }
        LBAR();
        s16x8 gbv[2];
#pragma unroll
        for (int g = 0; g < 2; ++g) { const int idx = tid + 512 * g, tl = idx >> 2, c8 = idx & 3; gbv[g] = *(const GAS s16x8*)(GB + ((size_t)b * SEQ + t0 + tl) * 1024 + n * BLKW + jq * 32 + c8 * 8); }
        {
            const int sc = tid >> 5, o = tid & 31; unsigned s3b = (unsigned)(((sc * 16) * 32 + o) * 4); asm volatile("" : "+v"(s3b));
            LAS float* as = (LAS float*)(L + LRU_AS + s3b); LAS float* us = (LAS float*)(L + LRU_US + s3b);
            float a[16], u[16];
#pragma unroll
            for (int i = 0; i < 16; ++i) { a[i] = as[i * 32]; u[i] = us[i * 32]; }
            float A = 1.f, H = 0.f;
#pragma unroll
            for (int i = 0; i < 16; ++i) { H = a[i] * H + u[i]; A *= a[i]; }
            unsigned s3o = (unsigned)(LRU_AH + o * 8); asm volatile("" : "+v"(s3o));
            *(LAS f32x2*)(L + s3o + sc * 256) = (f32x2){A, H};
            LBAR();
            float h = ((LAS float*)(L + LRU_CARRY))[(ms & 1) * 32 + o];
            f32x2 p[15];
#pragma unroll
            for (int s2 = 0; s2 < 15; ++s2) p[s2] = *(const LAS f32x2*)(L + s3o + s2 * 256);
#pragma unroll
            for (int s2 = 0; s2 < 15; ++s2) h = (s2 < sc) ? p[s2].x * h + p[s2].y : h;
#pragma unroll
            for (int i = 0; i < 16; ++i) { h = a[i] * h + u[i]; us[i * 32] = h; }
            if (sc == 15) ((LAS float*)(L + LRU_CARRY))[((ms + 1) & 1) * 32 + o] = h;
        }
        LBAR();
#pragma unroll
        for (int g = 0; g < 2; ++g) { const int idx = tid + 512 * g, tl = idx >> 2, c8 = idx & 3; const size_t row = (size_t)b * SEQ + t0 + tl; const int col = n * BLKW + jq * 32 + c8 * 8;
            unsigned s4b = (unsigned)(LRU_US + (tl * 32 + c8 * 8) * 4); asm volatile("" : "+v"(s4b));
            const f32x4 h0 = *(const LAS f32x4*)(L + s4b), h1 = *(const LAS f32x4*)(L + s4b + 16);
            const s16x8 gv = gbv[g]; float hv[8] = {h0.x, h0.y, h0.z, h0.w, h1.x, h1.y, h1.z, h1.w}; unsigned w[4];
#pragma unroll
            for (int i2 = 0; i2 < 4; ++i2) { const float g0 = pg8::bfbits2f(gv[2 * i2]), g1 = pg8::bfbits2f(gv[2 * i2 + 1]);
                w[i2] = pk2(hv[2 * i2] * g0 * __builtin_amdgcn_rcpf(1.f + __builtin_amdgcn_exp2f(-LOG2E * g0)), hv[2 * i2 + 1] * g1 * __builtin_amdgcn_rcpf(1.f + __builtin_amdgcn_exp2f(-LOG2E * g1))); }
            *(GAS v4u*)(AR + row * 2048 + 1024 + col) = (v4u){w[0], w[1], w[2], w[3]}; }
    }
#undef LRU_LOADX
    LBAR();
}

#ifndef MK_DBL
#define MK_DBL 0
#endif
#define DBL(k) for (int rep_ = 0; rep_ < 1 + ((MK_DBL >> (k)) & 1); ++rep_)
constexpr int N_PH_LAYER = 5, N_PHASES = 1 + DEPTH * N_PH_LAYER;
__global__ void __launch_bounds__(NWAVES * 64, 2) mk_fwd(Args args) {
    extern __shared__ __attribute__((aligned(16))) unsigned char lds[];
    Frame F;
    F.lds = (LAS unsigned char*)lds; F.MISC = (volatile LAS unsigned*)(F.lds + MISC_OFF);
    F.tid = threadIdx.x; F.lane = F.tid & 63; F.wave = __builtin_amdgcn_readfirstlane(F.tid >> 6);
    F.G = gridDim.x; { const int bx = blockIdx.x; F.vcu = (F.G % 8 == 0) ? (bx % 8) * (F.G / 8) + bx / 8 : bx; }
    unsigned char* ws = args.ws; F.ctl = (gu32*)(ws + WS_CTL);
    for (int u = F.tid; u < (LDS_BYTES - LDSCTL_OFF) / 4; u += NWAVES * 64) ((LAS unsigned*)(F.lds + LDSCTL_OFF))[u] = 0u;
    __syncthreads();
    const int lo = args.ph_lo, hi = args.ph_hi;
    const bool use_bar = (hi - lo) > 1;
    XcdBarrier bar; bar.bar = (unsigned*)(F.ctl + CW_BAR); bar.x = 0; bar.st = nullptr;
    if (use_bar) bar = xcd_barrier_post((unsigned*)(F.ctl + CW_BAR), F.MISC + 8);
#define IN(k) (lo <= (k) && (k) < hi)
#define SEAM(k) do { if (IN(k) && IN((k) + 1)) xcd_barrier(bar); } while (0)
    bf16* WIN = (bf16*)(ws + WS_WIN); bf16* WPAB = (bf16*)(ws + WS_WPAB); bf16* WOUT = (bf16*)(ws + WS_WOUT); bf16* XB16 = (bf16*)(ws + WS_XB16);
    bf16* O1 = (bf16*)(ws + WS_O1); bf16* O2 = (bf16*)(ws + WS_O2); bf16* MERGED = (bf16*)(ws + WS_MERGED); bf16* P6 = (bf16*)(ws + WS_P6);
    bf16* MA = (bf16*)(ws + WS_MA); bf16* MB = (bf16*)(ws + WS_MB); bf16* AR = (bf16*)(ws + WS_AR);
    bf16* Qb = P6; bf16* Kb = P6 + (size_t)M * 1024; bf16* Vb = P6 + (size_t)2 * M * 1024; bf16* GA = P6 + (size_t)3 * M * 1024; bf16* XBb = P6 + (size_t)4 * M * 1024; bf16* GBb = P6 + (size_t)5 * M * 1024;

    if (IN(0)) { DBL(0) p0_prologue(F, args); } SEAM(0);
#pragma unroll 1
    for (int l = 0; l < DEPTH; ++l) {
        const int pb = 1 + l * N_PH_LAYER;
        const float lam_init = 0.8f - 0.6f * __expf(-0.3f * (float)l);
        if (IN(pb)) {
            pg8::Gemm g{XB16, WIN + (size_t)l * IN_TOTAL * DM, M, IN_TOTAL, DM}; pg8::StaticOrder S; S.init(M, IN_TOTAL, F.G, (int)blockIdx.x);
            pg8::EpiProj E{P6, MA, MB, (size_t)M * 1024, attn_body::C2};
            DBL(1) pg8::gemm_phase<pg8::EpiProj, pg8::StaticOrder, PG8_ALIGN, PG8_SP2>(F.lds + RING_OFF, g, S, E);
        }
        SEAM(pb);
        if (IN(pb + 1)) {
            float d1 = args.in[9][l * 64 + F.lane] * args.in[10][l * 64 + F.lane], d2 = args.in[11][l * 64 + F.lane] * args.in[12][l * 64 + F.lane];
            d1 = wave_sum(d1, F.lane); d2 = wave_sum(d2, F.lane);
            const float lam = __uint_as_float(__builtin_amdgcn_readfirstlane(__float_as_uint(__expf(d1) - __expf(d2) + lam_init)));
            const int bh = F.vcu >> 2, p = F.vcu & 3, b = bh >> 3, h = bh & 7;
            const float slope2 = exp2f(-(float)(h + 1)) * LOG2E;
            if (F.G == 256) {
#pragma unroll 1
                for (int i = 0; i < 2; ++i) {
                    const int qb = i ? (7 - p) : p;
#pragma unroll 1
                    DBL(2) for (int ce = 0; ce < 4; ++ce) {
                        const int c = ce >> 1, e = ce & 1;
                        attn_body::attn_unit<8>(b, 2 * h + c, 2 * h + e, qb, slope2, (const attn_body::bf16*)Qb, (const attn_body::bf16*)Kb, (const attn_body::bf16*)Vb, (attn_body::bf16*)(c ? O2 : O1), (char*)lds + RING_OFF);
                    }
                    VM_WAIT(); __syncthreads();
                    DBL(6) combine_block(F, b, h, qb, O1, O2, GA, AR, args.in[13] + l * 128, lam, lam_init);
                }
                DBL(3) lru_item(F, F.vcu >> 5, (F.vcu >> 2) & 7, F.vcu & 3, XBb, GBb, AR, args.in[2] + (size_t)l * 4 * LRUW, args.in[3] + l * LRUW,
                         (const bf16*)(ws + WS_GW) + ((size_t)(l * NBLK + ((F.vcu >> 2) & 7)) * 4 + (F.vcu & 3)) * GW_ITEM, args.in[5] + l * LRUW, args.in[7] + l * LRUW, args.in[8] + l * LRUW);
            }
        }
        SEAM(pb + 1);
        if (IN(pb + 2)) {
            pg8::Gemm g{AR, WPAB + (size_t)l * DM * DM, M, DM, DM}; pg8::StaticOrder S; S.init(M, DM, F.G, (int)blockIdx.x);
            pg8::EpiMerge E{MA, MB, MERGED};
            DBL(4) pg8::gemm_phase<pg8::EpiMerge, pg8::StaticOrder, PG8_ALIGN, PG8_SP2>(F.lds + RING_OFF, g, S, E);
        }
        SEAM(pb + 2);
        if (IN(pb + 3)) {
            pg8::Gemm g{MERGED, WOUT + (size_t)l * DM * DM, M, DM, DM}; pg8::StaticOrder S; S.init(M, DM, F.G, (int)blockIdx.x);
            pg8::EpiRes E{l == 0 ? args.in[0] : args.out, args.out, DN_ALPHA};
            for (int rep_ = 0; rep_ < 1 + (((MK_DBL >> 5) & 1) && l == 0); ++rep_) pg8::gemm_phase<pg8::EpiRes, pg8::StaticOrder, PG8_ALIGN, PG8_SP2>(F.lds + RING_OFF, g, S, E);
        }
        SEAM(pb + 3);
        if (IN(pb + 4)) { ln_phase(F, args.out, XB16, args.in[17] + l * DM, args.in[18] + l * DM); }
        SEAM(pb + 4);
    }
#undef IN
#undef SEAM
}

#ifndef MK_PER_PHASE
#define MK_PER_PHASE 0
#endif
extern "C" void kernel_launch(void* const* d_in, const int* in_sizes, int n_in, void* d_out, int out_size, void* d_ws, size_t ws_size, hipStream_t stream) {
    static int grid = 0;
    if (grid == 0) {
        if (n_in != 19 || in_sizes[0] != M * DM || out_size != M * DM || ws_size < WS_END) { fprintf(stderr, "kernel_launch: unexpected shapes / workspace (n_in %d, ws %zu); nothing launched\n", n_in, ws_size); grid = -1; return; }
        int dev = 0, cus = 0;
        if (hipGetDevice(&dev) != hipSuccess || hipDeviceGetAttribute(&cus, hipDeviceAttributeMultiprocessorCount, dev) != hipSuccess) { grid = -1; return; }
        if (hipFuncSetAttribute((const void*)mk_fwd, hipFuncAttributeMaxDynamicSharedMemorySize, LDS_BYTES) != hipSuccess) { fprintf(stderr, "kernel_launch: hipFuncSetAttribute failed\n"); grid = -1; return; }
        int per_cu = 0;
        if (hipOccupancyMaxActiveBlocksPerMultiprocessor(&per_cu, (const void*)mk_fwd, NWAVES * 64, LDS_BYTES) != hipSuccess || per_cu < 1) fprintf(stderr, "kernel_launch: occupancy query reports %d blocks per CU\n", per_cu);
        (void)hipGetLastError();
        grid = cus;
        if (grid != 256) fprintf(stderr, "kernel_launch: %d CUs; the attention/LRU phase is built for 256\n", grid);
    }
    if (grid < 0) return;
    if (hipMemsetAsync((char*)d_ws + WS_CTL, 0, CTL_ZERO_BYTES, stream) != hipSuccess) return;
    Args a{};
    for (int i = 0; i < 19; ++i) a.in[i] = (const float*)d_in[i];
    a.out = (float*)d_out; a.ws = (unsigned char*)d_ws;
#if MK_PER_PHASE
    for (int p = 0; p < N_PHASES; ++p) { a.ph_lo = p; a.ph_hi = p + 1; hipLaunchKernelGGL(mk_fwd, dim3(grid), dim3(NWAVES * 64), LDS_BYTES, stream, a); }
#else
    a.ph_lo = 0; a.ph_hi = N_PHASES;
    hipLaunchKernelGGL(mk_fwd, dim3(grid), dim3(NWAVES * 64), LDS_BYTES, stream, a);
#endif
}
```

```cpp
#include <hip/hip_runtime.h>
#include <cstdio>
#include <cstdint>
namespace pg8 {
#define PG8_LAS __attribute__((address_space(3)))
typedef unsigned short bf16_t;
typedef short bf16x8 __attribute__((ext_vector_type(8)));
typedef float f32x4 __attribute__((ext_vector_type(4)));
typedef unsigned u32x4 __attribute__((ext_vector_type(4)));
constexpr int BM = 256, BK = 64, HALF = 128, HTB = HALF * BK * 2  , STAGE_BYTES = 8 * HTB, NXCD = 8, WGM = 8;

__host__ __device__ __forceinline__ int lds_byte(int r, int c) { const int st = (r >> 4) * 2 + (c >> 5), rr = r & 15, cc = c & 31, ob = rr * 64 + cc * 2; return st * 1024 + (ob ^ (((ob >> 9) & 1) << 5)); }
__host__ __device__ __forceinline__ void stage_rc(int b, int& R, int& C) { const int st = b / 1024, sb = b % 1024, swz = sb ^ (((sb >> 9) & 1) << 5); R = (st >> 1) * 16 + swz / 64; C = (st & 1) * 32 + (swz % 64) / 2; }
__host__ __device__ __forceinline__ int perm32(int rho) { const int n = rho >> 4, i = rho & 15; return 8 * (i >> 2) + 4 * n + (i & 3); }

struct Unit { int pm, pn; };
struct Gemm { const bf16_t* A; const bf16_t* Bt; int M, N, K; };

struct StaticOrder {
    int nM, nN, nwg, G, c;
    __host__ __device__ void init(int M, int N, int G_, int c_) { nM = M / BM; nN = N / BM; nwg = nM * nN; G = G_; c = c_; }
    __host__ __device__ bool next(int i, Unit& u) const {
        const long L = (long)i * G + c; if (L >= nwg) return false;
        int wgid = (int)L; { const int q = nwg / NXCD, r = nwg % NXCD, xcd = wgid % NXCD, off = wgid / NXCD; wgid = (xcd < r ? xcd * (q + 1) : r * (q + 1) + (xcd - r) * q) + off; }
        const int nig = WGM * nN, gid = wgid / nig, fm = gid * WGM, gsz = (nM - fm) < WGM ? (nM - fm) : WGM;
        u.pm = fm + ((wgid % nig) % gsz); u.pn = (wgid % nig) / gsz; return true;
    }
    __device__ __forceinline__ void a_ready(const Unit&) const {}
    __device__ __forceinline__ void done(const Unit&) const {}
};

__device__ __forceinline__ unsigned cvt_pk_bf16(float lo, float hi) { unsigned r; asm volatile("v_cvt_pk_bf16_f32 %0, %1, %2" : "=v"(r) : "v"(lo), "v"(hi)); return r; }
typedef short s16x8_t __attribute__((ext_vector_type(8)));
__device__ __forceinline__ float bfbits2f(short v) { return __uint_as_float(((unsigned)(unsigned short)v) << 16); }
struct EpiProj {
    static constexpr bool PERM = true, AFTER_DRAIN = false, HAS_MID = false;
    bf16_t* base6; bf16_t* ma; bf16_t* mb; size_t stride6; float qscale; int pn_off; float gscale;
    __device__ __forceinline__ void operator()(const f32x4 (&acc)[2][2][4][2], const Unit& u, int wr, int wc, int fr, int fq) const {
        const int pn = u.pn + pn_off; bf16_t* base; int ldc, colt; float sc = 1.f;
        if (pn < 24) { const int t = pn >> 2; base = base6 + (size_t)t * stride6; ldc = 1024; colt = (pn & 3) * BM; if (t == 0) sc = qscale; }
        else if (pn < 32) { base = ma; ldc = 2048; colt = (pn - 24) * BM; sc = gscale; }
        else { base = mb; ldc = 2048; colt = (pn - 32) * BM; sc = gscale; }
        int t_ = threadIdx.x; asm volatile("" : "+v"(t_));
        const int lrow = (t_ >> 8) * 64 + (t_ & 15), lcol = ((t_ >> 6) & 3) * 32 + 8 * ((t_ >> 4) & 3);
        const int row0 = u.pm * BM + lrow, col0 = colt + lcol;
#pragma unroll
        for (int ai = 0; ai < 2; ++ai)
#pragma unroll
            for (int m = 0; m < 4; ++m) { bf16_t* rowp = base + (size_t)(row0 + ai * HALF + m * 16) * ldc + col0;
#pragma unroll
                for (int bj = 0; bj < 2; ++bj) { const f32x4 v0 = acc[ai][bj][m][0] * sc, v1 = acc[ai][bj][m][1] * sc;
                    u32x4 w; w.x = cvt_pk_bf16(v0[0], v0[1]); w.y = cvt_pk_bf16(v0[2], v0[3]); w.z = cvt_pk_bf16(v1[0], v1[1]); w.w = cvt_pk_bf16(v1[2], v1[3]);
                    *(u32x4*)(rowp + bj * HALF) = w; } }
    }
};
struct EpiMerge {
    static constexpr bool PERM = true, AFTER_DRAIN = false, HAS_MID = true;
    const bf16_t* ma; const bf16_t* mb; bf16_t* out;
    __device__ __forceinline__ void mid(f32x4 (&acc)[2][2][4][2], const Unit& u, int wr, int wc, int fr, int fq) const {
        unsigned lofs = (unsigned)((wr * 64 + fr) * 2048 + wc * 32 + 8 * fq); asm volatile("" : "+v"(lofs));
        const size_t tofs = (size_t)u.pm * BM * 2048 + (size_t)u.pn * BM;
#pragma unroll
        for (int ai = 0; ai < 2; ++ai)
#pragma unroll
            for (int m = 0; m < 4; ++m) { const size_t off = tofs + lofs + (size_t)(ai * HALF + m * 16) * 2048;
#pragma unroll
                for (int bj = 0; bj < 2; ++bj) { const s16x8_t a = *(const s16x8_t*)(ma + off + bj * HALF), b = *(const s16x8_t*)(mb + off + bj * HALF);
#pragma unroll
                    for (int j = 0; j < 8; ++j) { const float xa = bfbits2f(a[j]), xb = fmaxf(bfbits2f(b[j]), -30.f);
                        const float f = (1.f + __expf(-xb)) * __builtin_amdgcn_rcpf(1.f + __expf(-xa)); acc[ai][bj][m][j >> 2][j & 3] *= f; } }
                asm volatile("" ::: "memory"); }
    }
    __device__ __forceinline__ void operator()(const f32x4 (&acc)[2][2][4][2], const Unit& u, int wr, int wc, int fr, int fq) const {
        unsigned lofs = (unsigned)((wr * 64 + fr) * 2048 + wc * 32 + 8 * fq); asm volatile("" : "+v"(lofs));
        const size_t tofs = (size_t)u.pm * BM * 2048 + (size_t)u.pn * BM;
#pragma unroll
        for (int ai = 0; ai < 2; ++ai)
#pragma unroll
            for (int m = 0; m < 4; ++m) { const size_t off = tofs + lofs + (size_t)(ai * HALF + m * 16) * 2048;
#pragma unroll
                for (int bj = 0; bj < 2; ++bj) { const s16x8_t b = *(const s16x8_t*)(mb + off + bj * HALF); float v[8];
#pragma unroll
                    for (int j = 0; j < 8; ++j) { const float xb = fmaxf(bfbits2f(b[j]), -30.f); v[j] = acc[ai][bj][m][j >> 2][j & 3] * __builtin_amdgcn_rcpf(1.f + __expf(-xb)); }
                    u32x4 w; w.x = cvt_pk_bf16(v[0], v[1]); w.y = cvt_pk_bf16(v[2], v[3]); w.z = cvt_pk_bf16(v[4], v[5]); w.w = cvt_pk_bf16(v[6], v[7]);
                    *(u32x4*)(out + off + bj * HALF) = w; }
                asm volatile("" ::: "memory"); }
    }
};
struct EpiRes {
    static constexpr bool PERM = false, AFTER_DRAIN = false, HAS_MID = false;
    const float* base; float* out; float alpha;
    __device__ __forceinline__ void operator()(const f32x4 (&acc)[2][2][4][2], const Unit& u, int wr, int wc, int fr, int fq) const {
        const int row0 = u.pm * BM + wr * 64 + fr, col0 = u.pn * BM + wc * 32 + 4 * fq;
#pragma unroll
        for (int ai = 0; ai < 2; ++ai)
#pragma unroll
            for (int m = 0; m < 4; ++m) { const size_t off = (size_t)(row0 + ai * HALF + m * 16) * 2048 + col0;
#pragma unroll
                for (int bj = 0; bj < 2; ++bj)
#pragma unroll
                    for (int n = 0; n < 2; ++n) { const f32x4 bs = *(const f32x4*)(base + off + bj * HALF + n * 16); *(f32x4*)(out + off + bj * HALF + n * 16) = bs * alpha + acc[ai][bj][m][n]; }
                if (m & 1) asm volatile("" ::: "memory"); }
    }
};
typedef int pg8_v4i __attribute__((ext_vector_type(4))); typedef int pg8_v8i __attribute__((ext_vector_type(8)));
template <bool FP8> struct FragSel { struct type { bf16x8 k[2]; }; };
template <> struct FragSel<true> { typedef pg8_v8i type; };
template <bool FP8, class F> __device__ __forceinline__ void ld_frag(F& d, const PG8_LAS unsigned char* p) {
    if constexpr (FP8) { const pg8_v4i lo = *(const PG8_LAS pg8_v4i*)p, hi = *(const PG8_LAS pg8_v4i*)(p + 16); d = __builtin_shufflevector(lo, hi, 0, 1, 2, 3, 4, 5, 6, 7); }
    else { d.k[0] = *(const PG8_LAS bf16x8*)p; d.k[1] = *(const PG8_LAS bf16x8*)(p + 1024); }
}
template <bool FP8, class F> __device__ __forceinline__ void mma_frag(f32x4& c, const F& b, const F& a) {
    if constexpr (FP8) c = __builtin_amdgcn_mfma_scale_f32_16x16x128_f8f6f4(b, a, c, 0, 0, 0, 0, 0, 0);
    else { c = __builtin_amdgcn_mfma_f32_16x16x32_bf16(b.k[0], a.k[0], c, 0, 0, 0); c = __builtin_amdgcn_mfma_f32_16x16x32_bf16(b.k[1], a.k[1], c, 0, 0, 0); }
}
template <class Epi, class Sched, bool ALIGN_EPI = false, bool SP2 = false, bool FP8 = false>
__device__ __forceinline__ void gemm_phase(PG8_LAS unsigned char* lds, const Gemm g, const Sched& S, const Epi& E) {
    int tid_ = threadIdx.x; asm volatile("" : "+v"(tid_));
    const int tid = tid_, wid = __builtin_amdgcn_readfirstlane(tid >> 6), lane = tid & 63, wr = wid >> 2, wc = wid & 3, fr = lane & 15, fq = lane >> 4;
    const int K = g.K, nt = K / BK;
    unsigned voffA[2], voffB[2];
#pragma unroll
    for (int i = 0; i < 2; ++i) { int R, C; stage_rc(tid * 16 + i * 8192, R, C); const int Rb = Epi::PERM ? ((R & ~31) + perm32(R & 31)) : R;
        voffA[i] = (unsigned)(R * K + C) * 2u; voffB[i] = (unsigned)(Rb * K + C) * 2u; }
    const size_t kstep = (size_t)(BK * 2);
    const size_t hstep = (size_t)HALF * K * 2;
    const size_t tstep = 2 * hstep;
    const unsigned lds0 = (unsigned)(uintptr_t)lds;
    const unsigned ldsw = (unsigned)wid * 1024u;
    const int fcol = FP8 ? 32 * (fq >> 1) + 16 * (fq & 1) : fq * 8;
    const int aoff = lds_byte(wr * 64 + fr, fcol), boff = lds_byte(wc * 32 + fr, fcol);
#define PG8_SA(b, h) (((b) * 2 + (h)) * HTB)
#define PG8_SB(b, h) ((4 + (b) * 2 + (h)) * HTB)
#define PG8_STAGE(bufoff, gbase, voff) do { _Pragma("unroll") for (int _i = 0; _i < 2; ++_i) { unsigned keep_; \
        asm volatile("s_mov_b32 %0, m0\n\ts_mov_b32 m0, %3\n\ts_nop 4\n\tglobal_load_lds_dwordx4 %1, %2\n\ts_mov_b32 m0, %0" : "=&s"(keep_) : "v"((voff)[_i]), "s"((const char*)(gbase)), \
                     "s"((unsigned)__builtin_amdgcn_readfirstlane((int)(lds0 + (unsigned)(bufoff) + ldsw + (unsigned)(_i * 8192)))) : "memory"); } } while (0)
#define PG8_LDA(dst, b, h) do { _Pragma("unroll") for (int m = 0; m < 4; ++m) ld_frag<FP8>(dst[m], lds + PG8_SA(b, h) + aoff + m * 2048); } while (0)
#define PG8_LDB(dst, b, h) do { _Pragma("unroll") for (int n = 0; n < 2; ++n) ld_frag<FP8>(dst[n], lds + PG8_SB(b, h) + boff + n * 2048); } while (0)
#define PG8_MMA(ai, bj, At, Bt) do { __builtin_amdgcn_s_setprio(1); _Pragma("unroll") for (int m = 0; m < 4; ++m) _Pragma("unroll") for (int n = 0; n < 2; ++n) \
        mma_frag<FP8>(acc[ai][bj][m][n], Bt[n], At[m]); __builtin_amdgcn_s_setprio(0); } while (0)
#define PG8_WAIT_V(n) asm volatile("s_waitcnt vmcnt(" #n ")" ::: "memory")
#define PG8_WAIT_L(n) asm volatile("s_waitcnt lgkmcnt(" #n ")" ::: "memory")
#define PG8_BAR __builtin_amdgcn_s_barrier()
#define PG8_SCHED __builtin_amdgcn_sched_barrier(0)
    Unit cur, nxt; int ui = 0;
    if (!S.next(0, cur)) return;
    f32x4 acc[2][2][4][2];
#pragma unroll
    for (int a = 0; a < 2; ++a)
#pragma unroll
        for (int b = 0; b < 2; ++b)
#pragma unroll
            for (int m = 0; m < 4; ++m)
#pragma unroll
                for (int n = 0; n < 2; ++n) acc[a][b][m][n] = (f32x4){0.f, 0.f, 0.f, 0.f};
    typename FragSel<FP8>::type At[4], B0[2], B1[2];
    const char* cA = (const char*)g.A + (size_t)cur.pm * tstep; const char* cB = (const char*)g.Bt + (size_t)cur.pn * tstep;
    S.a_ready(cur);
    if constexpr (SP2) {
        PG8_STAGE(PG8_SB(0, 0), cB, voffB); PG8_STAGE(PG8_SB(0, 1), cB + hstep, voffB); PG8_STAGE(PG8_SA(0, 0), cA, voffA); PG8_STAGE(PG8_SA(0, 1), cA + hstep, voffA);
        if (wr == 1) PG8_BAR;
        PG8_WAIT_V(2); PG8_BAR;
        PG8_STAGE(PG8_SB(1, 0), cB + kstep, voffB); PG8_STAGE(PG8_SA(1, 0), cA + kstep, voffA); PG8_STAGE(PG8_SB(1, 1), cB + hstep + kstep, voffB);
        PG8_WAIT_V(6); PG8_BAR;
    } else {
        PG8_STAGE(PG8_SB(0, 0), cB, voffB); PG8_STAGE(PG8_SA(0, 0), cA, voffA); PG8_STAGE(PG8_SB(0, 1), cB + hstep, voffB); PG8_STAGE(PG8_SA(0, 1), cA + hstep, voffA);
        if (wr == 1) PG8_BAR;
        PG8_WAIT_V(4); PG8_BAR;
        PG8_STAGE(PG8_SB(1, 0), cB + kstep, voffB); PG8_STAGE(PG8_SA(1, 0), cA + kstep, voffA); PG8_STAGE(PG8_SB(1, 1), cB + hstep + kstep, voffB);
        PG8_WAIT_V(6); PG8_BAR;
    }
    for (;;) {
        const bool has_next = S.next(ui + 1, nxt);
        const char* nA = has_next ? (const char*)g.A + (size_t)nxt.pm * tstep : cA; const char* nB = has_next ? (const char*)g.Bt + (size_t)nxt.pn * tstep : cB;
        for (int t = 0; t < nt; t += 2) {
            const bool last = (t == nt - 2);
            if constexpr (Epi::HAS_MID) { if (t == nt / 2) E.mid(acc, cur, wr, wc, fr, fq); }
            const char* a1 = cA + (size_t)(t + 1) * kstep;
            const char* a2 = last ? nA : cA + (size_t)(t + 2) * kstep; const char* b2 = last ? nB : cB + (size_t)(t + 2) * kstep;
            const char* a3 = a2 + kstep; const char* b3 = b2 + kstep;
            if (last && has_next) S.a_ready(nxt);
            if constexpr (SP2) {
            PG8_LDB(B0, 0, 0); PG8_LDB(B1, 0, 1); PG8_SCHED; PG8_LDA(At, 0, 0); PG8_STAGE(PG8_SA(1, 1), a1 + hstep, voffA);
            PG8_WAIT_V(8); PG8_WAIT_L(0); PG8_BAR; PG8_MMA(0, 0, At, B0); PG8_MMA(0, 1, At, B1); PG8_BAR; PG8_SCHED;
            PG8_LDA(At, 0, 1); PG8_STAGE(PG8_SB(0, 0), b2, voffB); PG8_STAGE(PG8_SB(0, 1), b2 + hstep, voffB); PG8_STAGE(PG8_SA(0, 0), a2, voffA);
            PG8_WAIT_V(8); PG8_WAIT_L(0); PG8_BAR; PG8_MMA(1, 0, At, B0); PG8_MMA(1, 1, At, B1); PG8_BAR; PG8_SCHED;
            PG8_LDB(B0, 1, 0); PG8_LDB(B1, 1, 1); PG8_SCHED; PG8_LDA(At, 1, 0); PG8_STAGE(PG8_SA(0, 1), a2 + hstep, voffA);
            PG8_WAIT_V(8); PG8_WAIT_L(0); PG8_BAR; PG8_MMA(0, 0, At, B0); PG8_MMA(0, 1, At, B1); PG8_BAR; PG8_SCHED;
            PG8_LDA(At, 1, 1); PG8_STAGE(PG8_SB(1, 0), b3, voffB); PG8_STAGE(PG8_SB(1, 1), b3 + hstep, voffB); PG8_STAGE(PG8_SA(1, 0), a3, voffA);
            PG8_WAIT_V(8); PG8_WAIT_L(0); PG8_BAR; PG8_MMA(1, 0, At, B0); PG8_MMA(1, 1, At, B1); PG8_BAR; PG8_SCHED;
            } else {
            PG8_LDB(B0, 0, 0); PG8_SCHED; PG8_LDA(At, 0, 0); PG8_STAGE(PG8_SA(1, 1), a1 + hstep, voffA);
            PG8_WAIT_L(8); PG8_BAR; PG8_WAIT_L(0); PG8_MMA(0, 0, At, B0); PG8_BAR; PG8_SCHED;
            PG8_LDB(B1, 0, 1); PG8_STAGE(PG8_SB(0, 0), b2, voffB);
            PG8_BAR; PG8_WAIT_L(0); PG8_MMA(0, 1, At, B1); PG8_BAR;
            PG8_LDA(At, 0, 1); PG8_STAGE(PG8_SA(0, 0), a2, voffA);
            PG8_BAR; PG8_WAIT_L(0); PG8_MMA(1, 0, At, B0); PG8_BAR; PG8_SCHED;
            PG8_STAGE(PG8_SB(0, 1), b2 + hstep, voffB);
            PG8_WAIT_V(6); PG8_BAR; PG8_MMA(1, 1, At, B1); PG8_BAR;
            PG8_LDB(B0, 1, 0); PG8_SCHED; PG8_LDA(At, 1, 0); PG8_STAGE(PG8_SA(0, 1), a2 + hstep, voffA);
            PG8_WAIT_L(8); PG8_BAR; PG8_WAIT_L(0); PG8_MMA(0, 0, At, B0); PG8_BAR; PG8_SCHED;
            PG8_LDB(B1, 1, 1); PG8_STAGE(PG8_SB(1, 0), b3, voffB);
            PG8_BAR; PG8_WAIT_L(0); PG8_MMA(0, 1, At, B1); PG8_BAR;
            PG8_LDA(At, 1, 1); PG8_STAGE(PG8_SA(1, 0), a3, voffA);
            PG8_BAR; PG8_WAIT_L(0); PG8_MMA(1, 0, At, B0); PG8_BAR; PG8_SCHED;
            PG8_STAGE(PG8_SB(1, 1), b3 + hstep, voffB);
            PG8_WAIT_V(6); PG8_BAR; PG8_MMA(1, 1, At, B1); PG8_BAR;
            }
        }
        if constexpr (ALIGN_EPI) { if (wr == 0) PG8_BAR; }
        if constexpr (!Epi::AFTER_DRAIN) { E(acc, cur, wr, wc, fr, fq); S.done(cur); }
        if (!has_next) break;
#pragma unroll
        for (int a = 0; a < 2; ++a)
#pragma unroll
            for (int b = 0; b < 2; ++b)
#pragma unroll
                for (int m = 0; m < 4; ++m)
#pragma unroll
                    for (int n = 0; n < 2; ++n) acc[a][b][m][n] = (f32x4){0.f, 0.f, 0.f, 0.f};
        cur = nxt; cA = nA; cB = nB; ++ui;
        if constexpr (ALIGN_EPI) { if (wr == 1) PG8_BAR; }
    }
    PG8_WAIT_V(0);
    if constexpr (!ALIGN_EPI) { if (wr == 0) PG8_BAR; }
    PG8_BAR;
    if constexpr (Epi::AFTER_DRAIN) { E.fused(acc, cur, wr, wc, fr, fq, lds, wid, lane); S.done(cur); }
#undef PG8_SA
#undef PG8_SB
#undef PG8_STAGE
#undef PG8_LDA
#undef PG8_LDB
#undef PG8_MMA
#undef PG8_WAIT_V
#undef PG8_WAIT_L
#undef PG8_BAR
#undef PG8_SCHED
}
}

#ifndef PG8_SP2
#define PG8_SP2 true
#endif
#ifndef PG8_ALIGN
#define PG8_ALIGN true
#endif
#include <hip/hip_bf16.h>
#include <cmath>
namespace attn_body {
using bf16=__hip_bfloat16;
using bf16x8=__attribute__((ext_vector_type(8)))short;
using s16x4=__attribute__((ext_vector_type(4)))short;
using f32x16=__attribute__((ext_vector_type(16)))float;
using u32x4=__attribute__((ext_vector_type(4)))unsigned;
constexpr int BATCH=8,NHEAD=16,SEQ=2048,D=64,DM=NHEAD*D;
constexpr int NW=8,QBLK=32,QB=QBLK*NW,KVBLK=64,NQB=SEQ/QB;
constexpr int ATTN_PITCH=DM, ATTN_UNIT_ROWS=QB;
__device__ __forceinline__ int crow(int r,int hi){return (r&3)+8*(r>>2)+4*hi;}
#define SBAR() __builtin_amdgcn_sched_barrier(0)
__device__ __forceinline__ void cmask(f32x16&p0,f32x16&p1,int jb,int qrel,int hi){
  const float NEG=-INFINITY; int kb=64*jb+4*hi;
  #pragma unroll
  for(int r=0;r<16;++r){int kv=kb+(r&3)+8*(r>>2); if(kv>qrel)p0[r]=NEG; if(kv+32>qrel)p1[r]=NEG;}
}

constexpr int NSLOT=3, SLOTB=8192;
constexpr int LDS_K=0, LDS_V=NSLOT*SLOTB, LDS_WS=2*NSLOT*SLOTB, LDS_OST=LDS_WS+NW*64*4, LDS_BYTES=LDS_OST+NW*4096;
constexpr float C2=0.125f*1.4426950408889634f;
__device__ __forceinline__ void glds16(const void*gsrc,unsigned lds_dst){unsigned keep;
  asm volatile("s_mov_b32 %0, m0\n\ts_mov_b32 m0, %2\n\ts_nop 0\n\tglobal_load_lds_dwordx4 %1, off\n\ts_mov_b32 m0, %0":"=&s"(keep):"v"(gsrc),"s"(lds_dst):"memory");}
__device__ __forceinline__ void glds16o(const void*sbase,unsigned voff,unsigned lds_dst){unsigned keep;
  asm volatile("s_mov_b32 %0, m0\n\ts_mov_b32 m0, %3\n\ts_nop 4\n\tglobal_load_lds_dwordx4 %1, %2\n\ts_mov_b32 m0, %0":"=&s"(keep):"v"(voff),"s"(sbase),"s"(lds_dst):"memory");}
__device__ __forceinline__ float max3f(float a,float b,float c){float r;asm("v_max3_f32 %0, %1, %2, %3":"=v"(r):"v"(a),"v"(b),"v"(c));return r;}
__device__ __forceinline__ float max2f(float a,float b){float r;asm("v_max_f32_e32 %0, %1, %2":"=v"(r):"v"(a),"v"(b));return r;}
__device__ __forceinline__ float fadd_s(float a,float b){float r;asm("v_add_f32_e32 %0, %1, %2":"=v"(r):"v"(a),"v"(b));return r;}
__device__ __forceinline__ float fsub_s(float a,float b){float r;asm("v_sub_f32_e32 %0, %1, %2":"=v"(r):"v"(a),"v"(b));return r;}
typedef float f32x2_t __attribute__((ext_vector_type(2))); typedef __bf16 bf16x2_t __attribute__((ext_vector_type(2)));
__device__ __forceinline__ unsigned cvtpk_s(float lo,float hi){f32x2_t v={lo,hi};bf16x2_t b=__builtin_convertvector(v,bf16x2_t);return __builtin_bit_cast(unsigned,b);}
#define WAIT_BAR(N) asm volatile("s_waitcnt vmcnt(" #N ") lgkmcnt(0)\n\ts_barrier":::"memory")

__device__ __forceinline__ void qkt(f32x16&p0,f32x16&p1,const char*Kslot,const bf16x8*qr,int r32,int hi){
  const char*kb=Kslot+hi*1024+r32*16;
  #pragma unroll
  for(int d0=0;d0<4;++d0){
    const bf16x8 b0=*reinterpret_cast<const bf16x8*>(kb+d0*2048);
    const bf16x8 b1=*reinterpret_cast<const bf16x8*>(kb+d0*2048+512);
    {p0=__builtin_amdgcn_mfma_f32_32x32x16_bf16(b0,qr[d0],p0,0,0,0);p1=__builtin_amdgcn_mfma_f32_32x32x16_bf16(b1,qr[d0],p1,0,0,0);}}
}
typedef __attribute__((address_space(3))) const char* lds_cptr;
typedef short v4i16_t __attribute__((ext_vector_type(4)));
__device__ __forceinline__ void kload8(bf16x8*kf,lds_cptr kp){
  kf[0]=*(const __attribute__((address_space(3))) bf16x8*)(kp);      kf[1]=*(const __attribute__((address_space(3))) bf16x8*)(kp+512);
  kf[2]=*(const __attribute__((address_space(3))) bf16x8*)(kp+2048); kf[3]=*(const __attribute__((address_space(3))) bf16x8*)(kp+2560);
  kf[4]=*(const __attribute__((address_space(3))) bf16x8*)(kp+4096); kf[5]=*(const __attribute__((address_space(3))) bf16x8*)(kp+4608);
  kf[6]=*(const __attribute__((address_space(3))) bf16x8*)(kp+6144); kf[7]=*(const __attribute__((address_space(3))) bf16x8*)(kp+6656);
}
__device__ __forceinline__ void kload2(bf16x8*kf,lds_cptr kp,int j){ kf[2*j]=*(const __attribute__((address_space(3))) bf16x8*)(kp+j*2048); kf[2*j+1]=*(const __attribute__((address_space(3))) bf16x8*)(kp+j*2048+512); }
__device__ __forceinline__ s16x4 vtr(lds_cptr p){ return __builtin_bit_cast(s16x4,__builtin_amdgcn_ds_read_tr16_b64_v4i16((__attribute__((address_space(3))) v4i16_t*)p)); }
__device__ __forceinline__ float rowmax(const f32x16&p0,const f32x16&p1){
  float a=max3f(p0[0],p0[1],p1[0]),b=max3f(p0[2],p0[3],p1[1]);a=max3f(a,p1[2],p1[3]);
  #pragma unroll
  for(int r=4;r<16;r+=4){a=max3f(a,p0[r],p0[r+1]);b=max3f(b,p0[r+2],p0[r+3]);a=max3f(a,p1[r],p1[r+1]);b=max3f(b,p1[r+2],p1[r+3]);}
  const float m=max2f(a,b);
  auto rr=__builtin_amdgcn_permlane32_swap(__float_as_uint(m),__float_as_uint(m),false,false);
  return max2f(__uint_as_float(rr[0]),__uint_as_float(rr[1]));
}
__device__ __forceinline__ void pv(f32x16*o,int vb,bf16x8 pa0,bf16x8 pa1,bf16x8 pa2,bf16x8 pa3){
  #pragma unroll
  for(int d0=0;d0<2;++d0){s16x4 lo[4],hi[4];
    #pragma unroll
    for(int ks=0;ks<4;++ks){
      asm volatile("ds_read_b64_tr_b16 %0,%1 offset:%c2":"=&v"(lo[ks]):"v"(vb),"i"(d0*4096+ks*1024):"memory");
      asm volatile("ds_read_b64_tr_b16 %0,%1 offset:%c2":"=&v"(hi[ks]):"v"(vb),"i"(d0*4096+ks*1024+512):"memory");}
    asm volatile("s_waitcnt lgkmcnt(0)":::"memory");SBAR();
    #define PK(k) (bf16x8){lo[k][0],lo[k][1],lo[k][2],lo[k][3],hi[k][0],hi[k][1],hi[k][2],hi[k][3]}
    o[d0]=__builtin_amdgcn_mfma_f32_32x32x16_bf16(pa0,PK(0),o[d0],0,0,0);
    o[d0]=__builtin_amdgcn_mfma_f32_32x32x16_bf16(pa1,PK(1),o[d0],0,0,0);
    o[d0]=__builtin_amdgcn_mfma_f32_32x32x16_bf16(pa2,PK(2),o[d0],0,0,0);
    o[d0]=__builtin_amdgcn_mfma_f32_32x32x16_bf16(pa3,PK(3),o[d0],0,0,0);
    #undef PK
  }
}

#ifndef ATTN_STORE16
#define ATTN_STORE16(p,v) (*(u32x4*)(p)=(v))
#endif
template<int THRL> __device__ __forceinline__ void attn_unit(int b,int hq,int hv,int qb,float slope2,const bf16*Q,const bf16*__restrict__ K,const bf16*__restrict__ V,bf16*O,char*shm){
  int tid_=threadIdx.x; asm volatile("":"+v"(tid_)); const int tid=tid_,lane=tid&63,r32=lane&31,hi=lane>>5; const int wid=__builtin_amdgcn_readfirstlane(tid>>6);
  const long rowbase=(long)b*SEQ; const int q0=qb*QB;
  const bf16*Qw=Q+(rowbase+q0+wid*QBLK)*DM+hq*D;
  const bf16*Kh=K+rowbase*DM+hq*D,*Vh=V+rowbase*DM+hv*D;
  const unsigned lds0=(unsigned)(uintptr_t)shm;
  float*wsf=(float*)(shm+LDS_WS)+wid*64;
  const unsigned koff=(unsigned)((lane*DM+wid*8)*2);
  const unsigned voff=(unsigned)(((16*(wid&3)+(lane>>2))*DM+(wid>>2)*32+(lane&3)*8)*2);
  const unsigned kdst=lds0+LDS_K+wid*1024, vdst=lds0+LDS_V+wid*1024;
  #define DMA_K(t,slot) glds16o(Kh+(long)(t)*KVBLK*DM,koff,(unsigned)__builtin_amdgcn_readfirstlane(kdst+(slot)))
  #define DMA_V(t,slot) glds16o(Vh+(long)(t)*KVBLK*DM,voff,(unsigned)__builtin_amdgcn_readfirstlane(vdst+(slot)))
  const int vb0=(int)(lds0+LDS_V)+((lane>>4)&1)*32+(lane&3)*8+(4*hi+((lane&15)>>2))*64;
  const char*Kbase=shm+LDS_K; bf16x8 kf[8];
  const lds_cptr shm3=(lds_cptr)shm; const lds_cptr kp0=shm3+LDS_K+hi*1024+r32*16; const lds_cptr vp0=shm3+LDS_V+((lane>>4)&1)*32+(lane&3)*8+(4*hi+((lane&15)>>2))*64;
  const int NT=(q0+QB)/KVBLK;
  DMA_K(0,0);DMA_V(0,0);DMA_K(1,SLOTB);
  bf16x8 qr[4];
  #pragma unroll
  for(int d0=0;d0<4;++d0)qr[d0]=*reinterpret_cast<const bf16x8*>(&Qw[(long)r32*DM+d0*16+hi*8]);
  float l_reg=0.f;f32x16 o[2];o[0]=f32x16{};o[1]=f32x16{};
  float nb=slope2*(float)(4*hi-q0-255); const float sl64=64.f*slope2;
  #define BINIT0(C0,t) do{ _Pragma("unroll") for(int r=0;r<16;++r)C0[r]=fmaf(slope2,(float)((r&3)+8*(r>>2)),nb); }while(0)
  #define BINIT1(C1,t) do{ _Pragma("unroll") for(int r=0;r<16;++r)C1[r]=fmaf(slope2,(float)((r&3)+8*(r>>2)+32),nb); nb+=sl64; }while(0)
  const int qrel=wid*QBLK+r32;
  #define CMASK(P0,P1,t) do{int jb_=(t)-(NT-4); if(jb_>=0)cmask(P0,P1,jb_,qrel,hi);}while(0)
  bool resc=false;
  #define START(P0,P1) do{ const float rm=rowmax(P0,P1); resc=false; \
    { const float dl=rm; nb=fsub_s(nb,dl); \
      _Pragma("unroll") for(int r=0;r<16;++r){P0[r]=fsub_s(P0[r],dl);P1[r]=fsub_s(P1[r],dl);} } \
    _Pragma("unroll") for(int r=0;r<16;++r)P0[r]=__builtin_amdgcn_exp2f(P0[r]); }while(0)
  #define RESC() do{ if(resc){ asm volatile("s_waitcnt lgkmcnt(0)":::"memory"); \
      _Pragma("unroll") for(int d_=0;d_<2;++d_) _Pragma("unroll") for(int r=0;r<16;++r)o[d_][r]*=wsf[crow(r,hi)]; } }while(0)
  f32x16 pA0,pA1,pB0,pB1;
  int sl_prev=0,sl_cur=0,sl_next=SLOTB;
  #define ROT() do{sl_prev=sl_cur;sl_cur=sl_next;sl_next=(sl_next==(NSLOT-1)*SLOTB)?0:sl_next+SLOTB;}while(0)
  DMA_K(2,2*SLOTB);
  WAIT_BAR(3);
  asm volatile("":"+v"(nb));
  BINIT0(pA0,0);BINIT1(pA1,0);qkt(pA0,pA1,Kbase,qr,r32,hi);asm volatile("s_nop 15\n\ts_nop 7":"+v"(pA0),"+v"(pA1));CMASK(pA0,pA1,0);
  START(pA0,pA1);
  _Pragma("unroll") for(int r=0;r<16;++r)pA1[r]=__builtin_amdgcn_exp2f(pA1[r]);
  WAIT_BAR(0);
  DMA_K(3,0);DMA_V(1,SLOTB);
  ROT();
  kload8(kf,kp0+sl_cur);
  WAIT_BAR(2);
  s16x4 vlo[8],vhi[8]; u32x4 pw0,pw1,pw2,pw3;
  #define PKW(P,B) cvtpk_s(P[B],P[B+1])
  #define PAF(k) __builtin_bit_cast(bf16x8,pw##k)
  #define VFR(i) (bf16x8){vlo[i][0],vlo[i][1],vlo[i][2],vlo[i][3],vhi[i][0],vhi[i][1],vhi[i][2],vhi[i][3]}
  #define PIN(x) asm volatile("":"+v"(x))
  #define MX3(a,b,c) __builtin_fmaxf(__builtin_fmaxf((a),(b)),(c))
  #define GAPA(MF,A0,A1,A2,A3,W0,W1,PW) do{ MF; sacc+=A0; sacc+=A1; sacc+=A2; sacc+=A3; PIN(sacc); W0; W1; PIN(PW); SBAR(); }while(0)
  #define EX(v) __builtin_amdgcn_exp2f(v)
  #define GAPB(MF,X,B) do{ MF; X[B]=EX(X[B]); X[B+1]=EX(X[B+1]); X[B+2]=EX(X[B+2]); X[B+3]=EX(X[B+3]); PIN(X); SBAR(); }while(0)
  #define VRD(i) do{ vlo[i]=vtr(vp_+(((i)>>2)*4096+((i)&3)*1024)); vhi[i]=vtr(vp_+(((i)>>2)*4096+((i)&3)*1024+512)); }while(0)
  #define KRD(G,j) do{ if(G){ kload2(kf,kp0+sl_next,j); SBAR(); } }while(0)
  #define STEP(C0,C1,P0,P1,t,GK,GV,GL) do{ SBAR(); \
    const lds_cptr vp_=vp0+sl_prev; \
    BINIT0(C0,t); PIN(C0); VRD(0); SBAR(); float sacc=(P0[0]+P0[1]); \
    GAPA(C0=__builtin_amdgcn_mfma_f32_32x32x16_bf16(kf[0],qr[0],C0,0,0,0), P0[2],P0[3],P0[4],P0[5],     pw0[0]=PKW(P0,0), pw0[1]=PKW(P0,2), pw0); \
    BINIT1(C1,t); PIN(C1); VRD(4); SBAR(); GAPA(C1=__builtin_amdgcn_mfma_f32_32x32x16_bf16(kf[1],qr[0],C1,0,0,0), P0[6],P0[7],P0[8],P0[9],     pw0[2]=PKW(P0,4), pw0[3]=PKW(P0,6), pw0); \
    VRD(1); SBAR(); GAPA(C0=__builtin_amdgcn_mfma_f32_32x32x16_bf16(kf[2],qr[1],C0,0,0,0),   P0[10],P0[11],P0[12],P0[13], pw1[0]=PKW(P0,8), pw1[1]=PKW(P0,10), pw1); \
    VRD(5); SBAR(); GAPA(C1=__builtin_amdgcn_mfma_f32_32x32x16_bf16(kf[3],qr[1],C1,0,0,0),   P0[14],P0[15],P1[0],P1[1],   pw1[2]=PKW(P0,12),pw1[3]=PKW(P0,14), pw1); \
    VRD(2); SBAR(); GAPA(C0=__builtin_amdgcn_mfma_f32_32x32x16_bf16(kf[4],qr[2],C0,0,0,0),   P1[2],P1[3],P1[4],P1[5],     pw2[0]=PKW(P1,0), pw2[1]=PKW(P1,2), pw2); \
    VRD(6); SBAR(); GAPA(C1=__builtin_amdgcn_mfma_f32_32x32x16_bf16(kf[5],qr[2],C1,0,0,0),   P1[6],P1[7],P1[8],P1[9],     pw2[2]=PKW(P1,4), pw2[3]=PKW(P1,6), pw2); \
    VRD(3); SBAR(); GAPA(C0=__builtin_amdgcn_mfma_f32_32x32x16_bf16(kf[6],qr[3],C0,0,0,0),   P1[10],P1[11],P1[12],P1[13], pw3[0]=PKW(P1,8), pw3[1]=PKW(P1,10), pw3); \
    VRD(7); SBAR(); GAPA(C1=__builtin_amdgcn_mfma_f32_32x32x16_bf16(kf[7],qr[3],C1,0,0,0),   P1[14],P1[15],0.f,0.f,       pw3[2]=PKW(P1,12),pw3[3]=PKW(P1,14), pw3); \
    l_reg+=sacc; \
    if(GK){DMA_K((t)+3,sl_cur);} if(GV){DMA_V((t)+1,sl_next);} \
    CMASK(C0,C1,t); \
    { float a=MX3(C0[0],C0[1],C1[0]),b=MX3(C0[2],C0[3],C1[1]); a=MX3(a,C1[2],C1[3]); \
      _Pragma("unroll") for(int r=4;r<16;r+=4){a=MX3(a,C0[r],C0[r+1]);b=MX3(b,C0[r+2],C0[r+3]);a=MX3(a,C1[r],C1[r+1]);b=MX3(b,C1[r+2],C1[r+3]);} \
      float rm=__builtin_fmaxf(a,b); { auto rr=__builtin_amdgcn_permlane32_swap(__float_as_uint(rm),__float_as_uint(rm),false,false); rm=__builtin_fmaxf(__uint_as_float(rr[0]),__uint_as_float(rr[1])); } \
      resc=false; \
      if(__builtin_expect(__any(rm>(float)THRL),0)){ const float dl=__builtin_fmaxf(rm,0.f); nb-=dl; \
        _Pragma("unroll") for(int r=0;r<16;++r){C0[r]-=dl;C1[r]-=dl;} \
        const float f=__builtin_amdgcn_exp2f(-dl); l_reg*=f; if(hi==0)wsf[r32]=f; resc=true; } } \
    SBAR(); \
    GAPB(o[0]=__builtin_amdgcn_mfma_f32_32x32x16_bf16(PAF(0),VFR(0),o[0],0,0,0), C0,0); \
    GAPB(o[1]=__builtin_amdgcn_mfma_f32_32x32x16_bf16(PAF(0),VFR(4),o[1],0,0,0), C0,4); \
    KRD(GL,0); GAPB(o[0]=__builtin_amdgcn_mfma_f32_32x32x16_bf16(PAF(1),VFR(1),o[0],0,0,0), C0,8); \
    KRD(GL,1); GAPB(o[1]=__builtin_amdgcn_mfma_f32_32x32x16_bf16(PAF(1),VFR(5),o[1],0,0,0), C0,12); \
    KRD(GL,2); GAPB(o[0]=__builtin_amdgcn_mfma_f32_32x32x16_bf16(PAF(2),VFR(2),o[0],0,0,0), C1,0); \
    KRD(GL,3); GAPB(o[1]=__builtin_amdgcn_mfma_f32_32x32x16_bf16(PAF(2),VFR(6),o[1],0,0,0), C1,4); \
    GAPB(o[0]=__builtin_amdgcn_mfma_f32_32x32x16_bf16(PAF(3),VFR(3),o[0],0,0,0), C1,8); \
    GAPB(o[1]=__builtin_amdgcn_mfma_f32_32x32x16_bf16(PAF(3),VFR(7),o[1],0,0,0), C1,12); \
    }while(0)
  int t=1;
  #undef CMASK
  #define CMASK(P0,P1,t) do{}while(0)
  for(;t+5<NT;t+=2){
    STEP(pB0,pB1,pA0,pA1,t,true,true,true);     WAIT_BAR(2); RESC(); ROT();
    STEP(pA0,pA1,pB0,pB1,t+1,true,true,true);   WAIT_BAR(2); RESC(); ROT();
  }
  #undef CMASK
  #define CMASK(P0,P1,t) do{int jb_=(t)-(NT-4); if(jb_>=0)cmask(P0,P1,jb_,qrel,hi);}while(0)
  #define ENDW(tt) do{ if((tt)+3<NT){WAIT_BAR(2);} else if((tt)+2<NT){WAIT_BAR(1);} else {WAIT_BAR(0);} }while(0)
  for(;t+1<NT;t+=2){
    STEP(pB0,pB1,pA0,pA1,t,(t+3<NT),(t+1<NT),(t+1<NT));       ENDW(t);   RESC(); ROT();
    STEP(pA0,pA1,pB0,pB1,t+1,(t+4<NT),(t+2<NT),(t+2<NT));     ENDW(t+1); RESC(); ROT();
  }
  STEP(pB0,pB1,pA0,pA1,NT-1,false,false,false); RESC();
  { float sacc=pB0[0]+pB0[1]; _Pragma("unroll") for(int r=2;r<16;++r)sacc+=pB0[r]; _Pragma("unroll") for(int r=0;r<16;++r)sacc+=pB1[r]; l_reg+=sacc;
    pw0=(u32x4){PKW(pB0,0),PKW(pB0,2),PKW(pB0,4),PKW(pB0,6)};pw1=(u32x4){PKW(pB0,8),PKW(pB0,10),PKW(pB0,12),PKW(pB0,14)};pw2=(u32x4){PKW(pB1,0),PKW(pB1,2),PKW(pB1,4),PKW(pB1,6)};pw3=(u32x4){PKW(pB1,8),PKW(pB1,10),PKW(pB1,12),PKW(pB1,14)};
    SBAR(); pv(o,vb0+sl_cur,PAF(0),PAF(1),PAF(2),PAF(3)); }
  #undef PKW
  #undef PAF
  #undef VFR
  #undef PIN
  #undef MX3
  #undef GAPA
  #undef GAPB
  #undef EX
  #undef VRD
  #undef KRD
  #undef STEP
  #undef ENDW
  {auto rr=__builtin_amdgcn_permlane32_swap(__float_as_uint(l_reg),__float_as_uint(l_reg),false,false);l_reg=__uint_as_float(rr[0])+__uint_as_float(rr[1]);}
  if(hi==0)wsf[32+r32]=l_reg;asm volatile("s_waitcnt lgkmcnt(0)":::"memory");
  float rli[16];
  #pragma unroll
  for(int r=0;r<16;++r)rli[r]=__builtin_amdgcn_rcpf(wsf[32+crow(r,hi)]);
  bf16*Ow=O+(rowbase+q0+wid*QBLK)*DM+hv*D;
  { bf16*stg=(bf16*)(shm+LDS_OST)+wid*2048;
    #pragma unroll
    for(int r=0;r<16;++r){const int orow=crow(r,hi);
      #pragma unroll
      for(int d0=0;d0<2;++d0)stg[orow*64+d0*32+r32]=__float2bfloat16(o[d0][r]*rli[r]);}
    asm volatile("s_waitcnt lgkmcnt(0)":::"memory");
    #pragma unroll
    for(int i=0;i<4;++i){const int row=i*8+(lane>>3),ch=lane&7; const u32x4 v=*(const u32x4*)(stg+row*64+ch*8); ATTN_STORE16(Ow+(long)row*DM+ch*8,v);} }
  asm volatile("s_waitcnt lgkmcnt(0)\n\ts_barrier":::"memory");
  #undef DMA_K
  #undef DMA_V
  #undef BINIT0
  #undef BINIT1
  #undef CMASK
  #undef START
  #undef RESC
  #undef ROT
}
constexpr int ATTN_LDS_BYTES=LDS_BYTES;
#undef SBAR
#undef WAIT_BAR
}
#define GAS __attribute__((address_space(1)))
#define LAS __attribute__((address_space(3)))
typedef unsigned short bf16;
typedef unsigned v4u __attribute__((ext_vector_type(4)));
typedef float f32x4 __attribute__((ext_vector_type(4)));
typedef short bf16x8 __attribute__((ext_vector_type(8)));
typedef GAS unsigned gu32;
typedef GAS unsigned long long gu64;
#define RLX_AGENT __ATOMIC_RELAXED, __HIP_MEMORY_SCOPE_AGENT
#define LDS_WAIT() asm volatile("s_waitcnt lgkmcnt(0)" ::: "memory")
#define VM_WAIT() asm volatile("s_waitcnt vmcnt(0)" ::: "memory")
__device__ __forceinline__ unsigned long long rt() { return __builtin_amdgcn_s_memrealtime(); }
__device__ __forceinline__ unsigned f2bf(float f) { unsigned u = __builtin_bit_cast(unsigned, f); return (u + 0x7fffu + ((u >> 16) & 1u)) >> 16; }
typedef float f32x2_pk __attribute__((ext_vector_type(2))); typedef __bf16 bf16x2_pk __attribute__((ext_vector_type(2)));
__device__ __forceinline__ unsigned pk2(float lo, float hi) { f32x2_pk v = {lo, hi}; bf16x2_pk b = __builtin_convertvector(v, bf16x2_pk); return __builtin_bit_cast(unsigned, b); }

#define XB_TMO      128
#define XB_XCNT(j)  (256  + 64 * (j))
#define XB_XSUB(j)  (1280 + 64 * (j))
#define XB_XGEN(j)  (2304 + 64 * (j))
#define XB_TOP      3328
#define XB_TOPGEN   3392
#define XCD_BAR_WORDS 3456
#define XB_SPIN_CAP (1u << 18)

__device__ __forceinline__ unsigned xb_ld(unsigned* p)              { return __hip_atomic_load(p, __ATOMIC_RELAXED, __HIP_MEMORY_SCOPE_AGENT); }
__device__ __forceinline__ unsigned xb_add(unsigned* p, unsigned v) { return __hip_atomic_fetch_add(p, v, __ATOMIC_RELAXED, __HIP_MEMORY_SCOPE_AGENT); }
__device__ __forceinline__ unsigned xb_xcc_id() { return (unsigned)__builtin_amdgcn_s_getreg((3 << 11) | 20) & 0xFu; }
#define XB_SPIN(cond, bar) do { unsigned _sp = 0; while (cond) { __builtin_amdgcn_s_sleep(1); \
    if ((++_sp & 255u) == 0u) { if (xb_ld(&(bar)[XB_TMO])) break; if (_sp > XB_SPIN_CAP) { atomicAdd(&(bar)[XB_TMO], 1u); break; } } } } while (0)

struct XcdBarrier {
    unsigned* bar; unsigned x;
    volatile LAS unsigned* st;
};

__device__ __forceinline__ XcdBarrier xcd_barrier_post(unsigned* bar, volatile LAS unsigned* st) {
    XcdBarrier b; b.bar = bar; b.x = xb_xcc_id(); b.st = st;
    if (threadIdx.x == 0) (void)xb_add(&bar[XB_XCNT(b.x)], 1u);
    return b;
}
__device__ __forceinline__ void xcd_barrier_complete(unsigned* bar, unsigned x, unsigned& nloc, unsigned& nx) {
    const unsigned G = gridDim.x * gridDim.y * gridDim.z;
    unsigned sum, cnt, mine, sp = 0u;
    for (;;) {
        sum = 0u; cnt = 0u; mine = 0u;
#pragma unroll
        for (unsigned j = 0; j < 16; ++j) { const unsigned c = xb_ld(&bar[XB_XCNT(j)]); sum += c; cnt += (c > 0u) ? 1u : 0u; mine = (j == x) ? c : mine; }
        if (sum == G) break;
        __builtin_amdgcn_s_sleep(1);
        if ((++sp & 255u) == 0u) { if (xb_ld(&bar[XB_TMO])) break; if (sp > XB_SPIN_CAP) { atomicAdd(&bar[XB_TMO], 1u); break; } }
    }
    nloc = mine > 0u ? mine : 1u; nx = cnt > 0u ? cnt : 1u;
}

__device__ __forceinline__ void xcd_barrier(const XcdBarrier& b) {
    asm volatile("s_waitcnt vmcnt(0)" ::: "memory");
    __syncthreads();
    if (threadIdx.x == 0) {
        unsigned* bar = b.bar;
        __builtin_amdgcn_s_waitcnt(0);
        unsigned nloc = b.st[0], nx = b.st[1];
        if (nloc == 0u) { xcd_barrier_complete(bar, b.x, nloc, nx); b.st[0] = nloc; b.st[1] = nx; }
        const unsigned old = xb_add(&bar[XB_XSUB(b.x)], 1u);
        const unsigned gen = old / nloc;
        if (old + 1u == (gen + 1u) * nloc) {
            __builtin_amdgcn_fence(__ATOMIC_RELEASE, "agent");
            asm volatile("s_waitcnt vmcnt(0)" ::: "memory");
            const unsigned og = xb_add(&bar[XB_TOP], 1u);
            const unsigned tg = og / nx;
            if (og + 1u == (tg + 1u) * nx) xb_add(&bar[XB_TOPGEN], 1u);
            else XB_SPIN(xb_ld(&bar[XB_TOPGEN]) == tg, bar);
            __builtin_amdgcn_fence(__ATOMIC_ACQUIRE, "agent");
            xb_add(&bar[XB_XGEN(b.x)], 1u);
            asm volatile("s_waitcnt vmcnt(0)" ::: "memory");
        } else {
            XB_SPIN(xb_ld(&bar[XB_XGEN(b.x)]) == gen, bar);
            __builtin_amdgcn_fence(__ATOMIC_ACQUIRE, "agent");
            asm volatile("s_waitcnt vmcnt(0)" ::: "memory");
        }
    }
    __syncthreads();
}
constexpr int NWAVES = 8;
constexpr int BATCH = 8, SEQ = 2048, DM = 2048, DEPTH = 2, M = BATCH * SEQ;
constexpr int HEADS = 8, IN_TOTAL = 10240, LRUW = 1024, NBLK = 8, BLKW = 128;
constexpr float LN_EPS = 1e-5f, SUBLN_EPS = 1e-5f, DN_ALPHA = 1.41421356237309515f, LOG2E = 1.4426950408889634f;

constexpr size_t MiB = 1u << 20;
constexpr size_t WS_CTL = 0, CTL_ZERO_BYTES = 1 * MiB;
constexpr size_t WS_GW = 1 * MiB;
constexpr int N_BF = 6144, N_F8 = 4096;
constexpr float W8_SCALE = 64.f;
constexpr size_t WS_WIN = 2 * MiB;
constexpr size_t WS_WG8 = 50 * MiB;
constexpr size_t WS_XQ8 = 66 * MiB;
constexpr size_t WS_WPAB = 98 * MiB;
constexpr size_t WS_WOUT = 114 * MiB;
constexpr size_t WS_XB16 = 130 * MiB;
constexpr size_t WS_O1 = 130 * MiB, WS_O2 = 162 * MiB, WS_MERGED = 130 * MiB;
constexpr size_t WS_P6 = 194 * MiB;
constexpr size_t WS_MA = 386 * MiB, WS_MB = 450 * MiB;
constexpr size_t WS_AR = 514 * MiB;
constexpr size_t WS_END = 578 * MiB;
constexpr int CW_TMO = 0, CW_BAR = 4096;

constexpr int RING_OFF = 0, RING_BYTES = 151552;
constexpr int LDSCTL_OFF = RING_BYTES, MISC_OFF = LDSCTL_OFF + 320;
constexpr int LDS_BYTES = 153600;
static_assert(MISC_OFF + 128 <= LDS_BYTES && attn_body::ATTN_LDS_BYTES <= RING_BYTES && pg8::STAGE_BYTES <= RING_BYTES, "LDS map");

struct Frame {
    LAS unsigned char* lds; volatile LAS unsigned* MISC; gu32* ctl;
    int tid, lane, wave, vcu, G;
};
__device__ __forceinline__ float wave_sum(float v, int lane) {
#pragma unroll
    for (int o = 1; o < 64; o <<= 1) v += __int_as_float(__builtin_amdgcn_ds_bpermute((lane ^ o) << 2, __float_as_int(v)));
    return v;
}
__device__ __forceinline__ void p0_transpose_item(const float* W, int ldw, int ncols, bf16* WT, int ldt, int koff, LAS float* scr, int item, int lane) {
    const int nblk = ncols / 32, kb = item / nblk, nb = item % nblk, k0 = 64 * kb, n0 = 32 * nb;
#pragma unroll 8
    for (int i = 0; i < 32; ++i) { const int kk = 2 * i + (lane >> 5); scr[kk * 33 + (lane & 31)] = W[(size_t)(k0 + kk) * ldw + n0 + (lane & 31)]; }
    LDS_WAIT(); asm volatile("" ::: "memory");
    const int c = lane & 7;
#pragma unroll
    for (int j = 0; j < 4; ++j) { const int n = (lane >> 3) + 8 * j; const LAS float* s = scr + (8 * c) * 33 + n;
        v4u o; o.x = pk2(s[0 * 33], s[1 * 33]); o.y = pk2(s[2 * 33], s[3 * 33]); o.z = pk2(s[4 * 33], s[5 * 33]); o.w = pk2(s[6 * 33], s[7 * 33]);
        *(GAS v4u*)(WT + (size_t)(n0 + n) * ldt + koff + k0 + 8 * c) = o; }
    LDS_WAIT(); asm volatile("" ::: "memory");
}
__device__ __forceinline__ unsigned pk4_fp8(float a, float b, float c, float d) { int w = __builtin_amdgcn_cvt_pk_fp8_f32(a, b, 0, false); w = __builtin_amdgcn_cvt_pk_fp8_f32(c, d, w, true); return (unsigned)w; }
__device__ __forceinline__ void p0_transpose_item8(const float* W, int ldw, int ncols, unsigned char* WT8, int ldt, float scale, LAS float* scr, int item, int lane) {
    const int nblk = ncols / 32, kb = item / nblk, nb = item % nblk, k0 = 64 * kb, n0 = 32 * nb;
#pragma unroll 8
    for (int i = 0; i < 32; ++i) { const int kk = 2 * i + (lane >> 5); scr[kk * 33 + (lane & 31)] = W[(size_t)(k0 + kk) * ldw + n0 + (lane & 31)] * scale; }
    LDS_WAIT(); asm volatile("" ::: "memory");
    const int c = lane & 3;
#pragma unroll
    for (int j = 0; j < 2; ++j) { const int n = (lane >> 2) + 16 * j; const LAS float* s = scr + (16 * c) * 33 + n;
        v4u o; o.x = pk4_fp8(s[0 * 33], s[1 * 33], s[2 * 33], s[3 * 33]); o.y = pk4_fp8(s[4 * 33], s[5 * 33], s[6 * 33], s[7 * 33]);
        o.z = pk4_fp8(s[8 * 33], s[9 * 33], s[10 * 33], s[11 * 33]); o.w = pk4_fp8(s[12 * 33], s[13 * 33], s[14 * 33], s[15 * 33]);
        *(GAS v4u*)(WT8 + (size_t)(n0 + n) * ldt + k0 + 16 * c) = o; }
    LDS_WAIT(); asm volatile("" ::: "memory");
}
struct Args { const float* in[19]; float* out; unsigned char* ws; int ph_lo, ph_hi; };

__device__ __forceinline__ void p0_prologue(Frame& F, const Args& a) {
    LAS float* scr = (LAS float*)(F.lds + RING_OFF + F.wave * 16384);
    const int gw = F.vcu * NWAVES + F.wave, NGW = F.G * NWAVES;
    constexpr int I_IN = (DM / 64) * (N_BF / 32), I_G8 = (DM / 64) * (N_F8 / 32), I_P = (1024 / 64) * (DM / 32), I_O = (DM / 64) * (DM / 32), I_L = I_IN + I_G8 + 2 * I_P + I_O;
    for (int it = gw; it < DEPTH * I_L; it += NGW) {
        const int l = it / I_L; int r = it % I_L;
        bf16* win = (bf16*)(a.ws + WS_WIN) + (size_t)l * N_BF * DM; bf16* wpab = (bf16*)(a.ws + WS_WPAB) + (size_t)l * DM * DM; bf16* wout = (bf16*)(a.ws + WS_WOUT) + (size_t)l * DM * DM;
        if (r < I_IN) { p0_transpose_item(a.in[1] + (size_t)l * DM * IN_TOTAL, IN_TOTAL, N_BF, win, DM, 0, scr, r, F.lane); continue; } r -= I_IN;
        if (r < I_G8) { p0_transpose_item8(a.in[1] + (size_t)l * DM * IN_TOTAL + N_BF, IN_TOTAL, N_F8, a.ws + WS_WG8 + (size_t)l * N_F8 * DM, DM, W8_SCALE, scr, r, F.lane); continue; } r -= I_G8;
        if (r < I_P) { p0_transpose_item(a.in[14] + (size_t)l * 1024 * DM, DM, DM, wpab, DM, 0, scr, r, F.lane); continue; } r -= I_P;
        if (r < I_P) { p0_transpose_item(a.in[15] + (size_t)l * 1024 * DM, DM, DM, wpab, DM, 1024, scr, r, F.lane); continue; } r -= I_P;
        p0_transpose_item(a.in[16] + (size_t)l * DM * DM, DM, DM, wout, DM, 0, scr, r, F.lane);
    }
    for (int it = gw; it < DEPTH * NBLK * 4 * 2 * 8; it += NGW) {
        const int s_ = it & 7, g_ = (it >> 3) & 1, jq = (it >> 4) & 3, n = (it >> 6) & 7, l = it >> 9;
        const float* w = a.in[g_ ? 6 : 4] + ((size_t)(l * NBLK + n) * BLKW + 16 * s_ + 8 * (F.lane >> 5)) * BLKW + jq * 32 + (F.lane & 31);
        v4u o; o.x = pk2(w[0], w[BLKW]); o.y = pk2(w[2 * BLKW], w[3 * BLKW]); o.z = pk2(w[4 * BLKW], w[5 * BLKW]); o.w = pk2(w[6 * BLKW], w[7 * BLKW]);
        *(GAS v4u*)((bf16*)(a.ws + WS_GW) + (size_t)it * 512 + F.lane * 8) = o; }
    bf16* xb = (bf16*)(a.ws + WS_XB16); const float* x = a.in[0];
    for (int m = gw; m < M; m += NGW) {
        const GAS f32x4* xr = (const GAS f32x4*)(x + (size_t)m * DM) + F.lane; GAS unsigned long long* o8 = (GAS unsigned long long*)(xb + (size_t)m * DM) + F.lane;
        GAS unsigned* q8 = (GAS unsigned*)(a.ws + WS_XQ8 + (size_t)m * DM) + F.lane;
#pragma unroll
        for (int j = 0; j < 8; ++j) { const f32x4 v = xr[64 * j]; o8[64 * j] = (unsigned long long)pk2(v.x, v.y) | ((unsigned long long)pk2(v.z, v.w) << 32); q8[64 * j] = pk4_fp8(v.x, v.y, v.z, v.w); }
    }
}
__device__ __forceinline__ void ln_phase(Frame& F, float* y, bf16* xb, unsigned char* xq8, const float* g, const float* bta) {
    const int gw = F.vcu * NWAVES + F.wave, NGW = F.G * NWAVES; int lane = F.lane; asm volatile("" : "+v"(lane));
    for (int m = gw; m < M; m += NGW) {
        GAS f32x4* yr = (GAS f32x4*)(y + (size_t)m * DM) + lane; f32x4 v[8]; float s = 0.f;
#pragma unroll
        for (int j = 0; j < 8; ++j) { v[j] = yr[64 * j]; s += (v[j].x + v[j].y) + (v[j].z + v[j].w); }
        const float mean = wave_sum(s, lane) * (1.f / DM); float s2 = 0.f;
#pragma unroll
        for (int j = 0; j < 8; ++j) { v[j] = v[j] - mean; s2 += (v[j].x * v[j].x + v[j].y * v[j].y) + (v[j].z * v[j].z + v[j].w * v[j].w); }
        const float rstd = 1.f / sqrtf(wave_sum(s2, lane) * (1.f / DM) + LN_EPS);
        GAS unsigned long long* o8 = (GAS unsigned long long*)(xb + (size_t)m * DM) + lane; GAS unsigned* q8 = (GAS unsigned*)(xq8 + (size_t)m * DM) + lane;
#pragma unroll
        for (int j = 0; j < 8; ++j) { const f32x4 gg = *((const GAS f32x4*)g + lane + 64 * j), bb = *((const GAS f32x4*)bta + lane + 64 * j);
            const f32x4 o = v[j] * rstd * gg + bb; yr[64 * j] = o; o8[64 * j] = (unsigned long long)pk2(o.x, o.y) | ((unsigned long long)pk2(o.z, o.w) << 32); q8[64 * j] = pk4_fp8(o.x, o.y, o.z, o.w); }
    }
}
__device__ __forceinline__ void combine_block(Frame& F, int b, int h, int qb, const bf16* O1, const bf16* O2, const bf16* GA, bf16* AR, const float* subln_g, float lam, float lam_init) {
    typedef short s16x8 __attribute__((ext_vector_type(8)));
    int tid = F.tid; asm volatile("" : "+v"(tid));
#pragma unroll 1
    for (int it = 0; it < 4; ++it) {
        const int idx = tid + 512 * it, row = b * SEQ + qb * 256 + (idx >> 3), c16 = idx & 7, col = h * 128 + c16 * 16;
        const size_t off = (size_t)row * 1024 + col;
        const s16x8 a0 = *(const GAS s16x8*)(O1 + off), a1 = *(const GAS s16x8*)(O1 + off + 8), b0 = *(const GAS s16x8*)(O2 + off), b1 = *(const GAS s16x8*)(O2 + off + 8);
        const s16x8 g0 = *(const GAS s16x8*)(GA + off), g1 = *(const GAS s16x8*)(GA + off + 8);
        float o[16]; float ss = 0.f;
#pragma unroll
        for (int j = 0; j < 8; ++j) { o[j] = pg8::bfbits2f(a0[j]) - lam * pg8::bfbits2f(b0[j]); o[8 + j] = pg8::bfbits2f(a1[j]) - lam * pg8::bfbits2f(b1[j]); }
#pragma unroll
        for (int j = 0; j < 16; ++j) ss += o[j] * o[j];
        ss += __int_as_float(__builtin_amdgcn_ds_swizzle(__float_as_int(ss), 0x041f)); ss += __int_as_float(__builtin_amdgcn_ds_swizzle(__float_as_int(ss), 0x081f)); ss += __int_as_float(__builtin_amdgcn_ds_swizzle(__float_as_int(ss), 0x101f));
        const float rn = (1.f / sqrtf(ss * (1.f / 128.f) + SUBLN_EPS)) * (1.f - lam_init);
        unsigned w[8];
#pragma unroll
        for (int j = 0; j < 8; ++j) {
            const float ga0 = pg8::bfbits2f(j < 4 ? g0[2 * j] : g1[2 * j - 8]), ga1 = pg8::bfbits2f(j < 4 ? g0[2 * j + 1] : g1[2 * j - 7]);
            const float v0 = o[2 * j] * rn * subln_g[c16 * 16 + 2 * j] * (ga0 / (1.f + __expf(-ga0))), v1 = o[2 * j + 1] * rn * subln_g[c16 * 16 + 2 * j + 1] * (ga1 / (1.f + __expf(-ga1)));
            w[j] = pk2(v0, v1); }
        bf16* op = AR + (size_t)row * 2048 + col;
        *(GAS v4u*)op = (v4u){w[0], w[1], w[2], w[3]}; *(GAS v4u*)(op + 8) = (v4u){w[4], w[5], w[6], w[7]};
    }
}
constexpr int LRU_TM = 256, XCS_PITCH = 272, LRU_XCS = 0, LRU_AS = LRU_XCS + LRU_TM * XCS_PITCH, LRU_US = LRU_AS + LRU_TM * 32 * 4, LRU_AH = LRU_US + LRU_TM * 32 * 4, LRU_CARRY = LRU_AH + 16 * 32 * 8, LRU_WI = LRU_CARRY + 2 * 32 * 4, LRU_CW = LRU_WI + 8 * 64 * 16, LRU_END = LRU_CW + 5 * 128 * 4;
static_assert(LRU_END <= RING_BYTES, "LRU LDS map");
constexpr size_t GW_ITEM = 2 * 8 * 64 * 8;
#define LBAR() asm volatile("s_waitcnt lgkmcnt(0)\n\ts_barrier" ::: "memory")
__device__ __forceinline__ void lru_item(Frame& F, int b, int n, int jq, const bf16* XB, const bf16* GB, bf16* AR, const float* conv_w, const float* conv_b, const bf16* gwf, const float* b_r,
                                         const float* b_i, const float* lam) {
    typedef short s16x8 __attribute__((ext_vector_type(8))); typedef float f32x16 __attribute__((ext_vector_type(16))); typedef float f32x2 __attribute__((ext_vector_type(2)));
    LAS unsigned char* L = F.lds + RING_OFF;
    int tid = F.tid; asm volatile("" : "+v"(tid));
    const int lane = tid & 63, wave = F.wave, r32 = lane & 31, hi = lane >> 5;
    const int ch8 = tid & 15, tq = tid >> 4;
    const int cch = n * BLKW + jq * 32 + r32;
    s16x8 wfr[8];
#pragma unroll
    for (int s = 0; s < 8; ++s) wfr[s] = *(const GAS s16x8*)(gwf + (size_t)(s * 64 + lane) * 8);
    *(LAS s16x8*)(L + LRU_WI + tid * 16) = *(const GAS s16x8*)(gwf + (size_t)(8 * 64 + tid) * 8);
    const float bias_r = b_r[cch], bias_i = b_i[cch], lc = -8.f * log1pf(__expf(-lam[cch])), lc2 = lc * LOG2E;
    if (tid < 64) ((LAS float*)(L + LRU_CARRY))[tid] = 0.f;
    const bf16* xbase = XB + (size_t)b * SEQ * 1024 + n * BLKW + ch8 * 8;
    if (tid < 128) { LAS float* cwl = (LAS float*)(L + LRU_CW); cwl[tid] = conv_b[n * BLKW + tid];
#pragma unroll
        for (int j = 0; j < 4; ++j) cwl[(1 + j) * 128 + tid] = conv_w[j * LRUW + n * BLKW + tid]; }
    s16x8 xq[2][7];
#define LRU_LOADX(t0_) do { _Pragma("unroll") for (int g = 0; g < 2; ++g) _Pragma("unroll") for (int rr = 0; rr < 7; ++rr) { const int t = (t0_) + (tq + 32 * g) * 4 - 3 + rr; \
        xq[g][rr] = (t >= 0) ? *(const GAS s16x8*)(xbase + (size_t)t * 1024) : (s16x8){0, 0, 0, 0, 0, 0, 0, 0}; } } while (0)
    LRU_LOADX(0);
    LBAR();
#pragma unroll 1
    for (int ms = 0; ms < SEQ / LRU_TM; ++ms) {
        const int t0 = ms * LRU_TM;
        {
            float cw[4][8], cb[8];
            { unsigned cwb = (unsigned)(LRU_CW + ch8 * 32); asm volatile("" : "+v"(cwb));
              const f32x4 b0 = *(const LAS f32x4*)(L + cwb), b1 = *(const LAS f32x4*)(L + cwb + 16);
              cb[0] = b0.x; cb[1] = b0.y; cb[2] = b0.z; cb[3] = b0.w; cb[4] = b1.x; cb[5] = b1.y; cb[6] = b1.z; cb[7] = b1.w;
#pragma unroll
              for (int j = 0; j < 4; ++j) { const f32x4 w0 = *(const LAS f32x4*)(L + cwb + (1 + j) * 512), w1 = *(const LAS f32x4*)(L + cwb + (1 + j) * 512 + 16);
                  cw[j][0] = w0.x; cw[j][1] = w0.y; cw[j][2] = w0.z; cw[j][3] = w0.w; cw[j][4] = w1.x; cw[j][5] = w1.y; cw[j][6] = w1.z; cw[j][7] = w1.w; } }
            unsigned s1b = (unsigned)(LRU_XCS + tq * 4 * XCS_PITCH + ch8 * 16); asm volatile("" : "+v"(s1b));
#pragma unroll
            for (int g = 0; g < 2; ++g) {
                unsigned w[4][4];
#pragma unroll
                for (int i2 = 0; i2 < 4; ++i2) {
                    float x0[7], x1[7];
#pragma unroll
                    for (int rr = 0; rr < 7; ++rr) { const unsigned d = ((const unsigned*)&xq[g][rr])[i2]; x0[rr] = __uint_as_float(d << 16); x1[rr] = __uint_as_float(d & 0xffff0000u); }
#pragma unroll
                    for (int q = 0; q < 4; ++q) {
                        const float v0 = cb[2 * i2] + cw[0][2 * i2] * x0[q] + cw[1][2 * i2] * x0[q + 1] + cw[2][2 * i2] * x0[q + 2] + cw[3][2 * i2] * x0[q + 3];
                        const float v1 = cb[2 * i2 + 1] + cw[0][2 * i2 + 1] * x1[q] + cw[1][2 * i2 + 1] * x1[q + 1] + cw[2][2 * i2 + 1] * x1[q + 2] + cw[3][2 * i2 + 1] * x1[q + 3];
                        w[q][i2] = pk2(v0, v1); }
                    asm volatile("" : "+v"(w[0][i2]), "+v"(w[1][i2]), "+v"(w[2][i2]), "+v"(w[3][i2]));
                }
#pragma unroll
                for (int q = 0; q < 4; ++q) *(LAS v4u*)(L + s1b + (32 * g * 4 + q) * XCS_PITCH) = (v4u){w[q][0], w[q][1], w[q][2], w[q][3]};
            }
        }
        if (ms + 1 < SEQ / LRU_TM) LRU_LOADX(t0 + LRU_TM);
        LBAR();
        {
            f32x16 ar, ai;
#pragma unroll
            for (int r = 0; r < 16; ++r) { ar[r] = bias_r; ai[r] = bias_i; }
            unsigned s2a = (unsigned)(LRU_XCS + (32 * wave + r32) * XCS_PITCH + hi * 16), s2i = (unsigned)(LRU_WI + lane * 16); asm volatile("" : "+v"(s2a), "+v"(s2i));
#pragma unroll
            for (int s = 0; s < 8; ++s) { const s16x8 af = *(const LAS s16x8*)(L + s2a + s * 32), wi = *(const LAS s16x8*)(L + s2i + s * 1024);
                ar = __builtin_amdgcn_mfma_f32_32x32x16_bf16(af, wfr[s], ar, 0, 0, 0); ai = __builtin_amdgcn_mfma_f32_32x32x16_bf16(af, wi, ai, 0, 0, 0); }
            unsigned s2x = (unsigned)(LRU_XCS + (32 * wave + 4 * hi) * XCS_PITCH + (jq * 32 + r32) * 2), s2w = (unsigned)((32 * wave + 4 * hi) * 128 + r32 * 4); asm volatile("" : "+v"(s2x), "+v"(s2w));
#pragma unroll
            for (int r = 0; r < 16; ++r) { const int cr = (r & 3) + 8 * (r >> 2);
                const float rg = __builtin_amdgcn_rcpf(1.f + __builtin_amdgcn_exp2f(-LOG2E * ar[r])), ig = __builtin_amdgcn_rcpf(1.f + __builtin_amdgcn_exp2f(-LOG2E * ai[r]));
                const float av = __builtin_amdgcn_exp2f(lc2 * rg), t = 2.f * lc * rg;
                const float ser = -t * (1.f + t * (0.5f + t * (0.16666667f + t * (0.041666668f + t * 0.0083333338f))));
                const float om = (t > -0.1f) ? ser : (1.f - av * av);
                const float xc = __uint_as_float(((unsigned)*(const LAS unsigned short*)(L + s2x + cr * XCS_PITCH)) << 16);
                const float uv = __builtin_amdgcn_sqrtf(om) * (ig * xc);
                *(LAS float*)(L + LRU_AS + s2w + cr * 128) = av; *(LAS float*)(L + LRU_US + s2w + cr * 128) = uv; }
        }
        LBAR();
        s16x8 gbv[2];
#pragma unroll
        for (int g = 0; g < 2; ++g) { const int idx = tid + 512 * g, tl = idx >> 2, c8 = idx & 3; gbv[g] = *(const GAS s16x8*)(GB + ((size_t)b * SEQ + t0 + tl) * 1024 + n * BLKW + jq * 32 + c8 * 8); }
        {
            const int sc = tid >> 5, o = tid & 31; unsigned s3b = (unsigned)(((sc * 16) * 32 + o) * 4); asm volatile("" : "+v"(s3b));
            LAS float* as = (LAS float*)(L + LRU_AS + s3b); LAS float* us = (LAS float*)(L + LRU_US + s3b);
            float a[16], u[16];
#pragma unroll
            for (int i = 0; i < 16; ++i) { a[i] = as[i * 32]; u[i] = us[i * 32]; }
            float A = 1.f, H = 0.f;
#pragma unroll
            for (int i = 0; i < 16; ++i) { H = a[i] * H + u[i]; A *= a[i]; }
            unsigned s3o = (unsigned)(LRU_AH + o * 8); asm volatile("" : "+v"(s3o));
            *(LAS f32x2*)(L + s3o + sc * 256) = (f32x2){A, H};
            LBAR();
            float h = ((LAS float*)(L + LRU_CARRY))[(ms & 1) * 32 + o];
            f32x2 p[15];
#pragma unroll
            for (int s2 = 0; s2 < 15; ++s2) p[s2] = *(const LAS f32x2*)(L + s3o + s2 * 256);
#pragma unroll
            for (int s2 = 0; s2 < 15; ++s2) h = (s2 < sc) ? p[s2].x * h + p[s2].y : h;
#pragma unroll
            for (int i = 0; i < 16; ++i) { h = a[i] * h + u[i]; us[i * 32] = h; }
            if (sc == 15) ((LAS float*)(L + LRU_CARRY))[((ms + 1) & 1) * 32 + o] = h;
        }
        LBAR();
#pragma unroll
        for (int g = 0; g < 2; ++g) { const int idx = tid + 512 * g, tl = idx >> 2, c8 = idx & 3; const size_t row = (size_t)b * SEQ + t0 + tl; const int col = n * BLKW + jq * 32 + c8 * 8;
            unsigned s4b = (unsigned)(LRU_US + (tl * 32 + c8 * 8) * 4); asm volatile("" : "+v"(s4b));
            const f32x4 h0 = *(const LAS f32x4*)(L + s4b), h1 = *(const LAS f32x4*)(L + s4b + 16);
            const s16x8 gv = gbv[g]; float hv[8] = {h0.x, h0.y, h0.z, h0.w, h1.x, h1.y, h1.z, h1.w}; unsigned w[4];
#pragma unroll
            for (int i2 = 0; i2 < 4; ++i2) { const float g0 = pg8::bfbits2f(gv[2 * i2]), g1 = pg8::bfbits2f(gv[2 * i2 + 1]);
                w[i2] = pk2(hv[2 * i2] * g0 * __builtin_amdgcn_rcpf(1.f + __builtin_amdgcn_exp2f(-LOG2E * g0)), hv[2 * i2 + 1] * g1 * __builtin_amdgcn_rcpf(1.f + __builtin_amdgcn_exp2f(-LOG2E * g1))); }
            *(GAS v4u*)(AR + row * 2048 + 1024 + col) = (v4u){w[0], w[1], w[2], w[3]}; }
    }
#undef LRU_LOADX
    LBAR();
}

#ifndef MK_DBL
#define MK_DBL 0
#endif
#define DBL(k) for (int rep_ = 0; rep_ < 1 + ((MK_DBL >> (k)) & 1); ++rep_)
constexpr int N_PH_LAYER = 5, N_PHASES = 1 + DEPTH * N_PH_LAYER;
__global__ void __launch_bounds__(NWAVES * 64, 2) mk_fwd(Args args) {
    extern __shared__ __attribute__((aligned(16))) unsigned char lds[];
    Frame F;
    F.lds = (LAS unsigned char*)lds; F.MISC = (volatile LAS unsigned*)(F.lds + MISC_OFF);
    F.tid = threadIdx.x; F.lane = F.tid & 63; F.wave = __builtin_amdgcn_readfirstlane(F.tid >> 6);
    F.G = gridDim.x; { const int bx = blockIdx.x; F.vcu = (F.G % 8 == 0) ? (bx % 8) * (F.G / 8) + bx / 8 : bx; }
    F.ctl = (gu32*)(args.ws + WS_CTL);
    for (int u = F.tid; u < (LDS_BYTES - LDSCTL_OFF) / 4; u += NWAVES * 64) ((LAS unsigned*)(F.lds + LDSCTL_OFF))[u] = 0u;
    __syncthreads();
    const int lo = args.ph_lo, hi = args.ph_hi;
    const bool use_bar = (hi - lo) > 1;
    XcdBarrier bar; bar.bar = (unsigned*)(F.ctl + CW_BAR); bar.x = 0; bar.st = nullptr;
    if (use_bar) bar = xcd_barrier_post((unsigned*)(F.ctl + CW_BAR), F.MISC + 8);
#define IN(k) (lo <= (k) && (k) < hi)
#define SEAM(k) do { if (IN(k) && IN((k) + 1)) xcd_barrier(bar); } while (0)
#define CAS __attribute__((address_space(4)))
    typedef unsigned char* ucp_t; typedef float* fp_t; typedef const float* cfp_t;
#define KARGS() CAS const char* ka_ = (CAS const char*)__builtin_amdgcn_kernarg_segment_ptr(); asm volatile("" : "+s"(ka_)); unsigned char* const ws = *(CAS const ucp_t*)(ka_ + 160); float* const outp = *(CAS const fp_t*)(ka_ + 152); (void)outp; (void)ws
#define KIN(k) (*(CAS const cfp_t*)(ka_ + 8 * (k)))
#define WSP(off) ((bf16*)(ws + (off)))
    if (IN(0)) { DBL(0) p0_prologue(F, args); } SEAM(0);
#pragma unroll 1
    for (int l = 0; l < DEPTH; ++l) {
        const int pb = 1 + l * N_PH_LAYER;
        const float lam_init = 0.8f - 0.6f * __expf(-0.3f * (float)l);
        if (IN(pb)) {
            KARGS(); bf16* const P6 = WSP(WS_P6); bf16* const MA = WSP(WS_MA); bf16* const MB = WSP(WS_MB);
            { pg8::Gemm g{WSP(WS_XB16), WSP(WS_WIN) + (size_t)l * N_BF * DM, M, N_BF, DM}; pg8::StaticOrder S; S.init(M, N_BF, F.G, (int)blockIdx.x);
              pg8::EpiProj E{P6, MA, MB, (size_t)M * 1024, attn_body::C2, 0, 1.f};
              DBL(1) pg8::gemm_phase<pg8::EpiProj, pg8::StaticOrder, PG8_ALIGN, PG8_SP2>(F.lds + RING_OFF, g, S, E); }
            { pg8::Gemm g{(const pg8::bf16_t*)(ws + WS_XQ8), (const pg8::bf16_t*)(ws + WS_WG8 + (size_t)l * N_F8 * DM), M, N_F8, DM / 2}; pg8::StaticOrder S; S.init(M, N_F8, F.G, (int)blockIdx.x);
              pg8::EpiProj E{P6, MA, MB, (size_t)M * 1024, attn_body::C2, 24, 1.f / W8_SCALE};
              DBL(1) pg8::gemm_phase<pg8::EpiProj, pg8::StaticOrder, PG8_ALIGN, PG8_SP2, true>(F.lds + RING_OFF, g, S, E); }
        }
        SEAM(pb);
        if (IN(pb + 1)) {
            KARGS(); bf16* const P6 = WSP(WS_P6); bf16* const O1 = WSP(WS_O1); bf16* const O2 = WSP(WS_O2); bf16* const AR = WSP(WS_AR);
            bf16* const Qb = P6; bf16* const Kb = P6 + (size_t)M * 1024; bf16* const Vb = P6 + (size_t)2 * M * 1024; bf16* const GA = P6 + (size_t)3 * M * 1024; bf16* const XBb = P6 + (size_t)4 * M * 1024; bf16* const GBb = P6 + (size_t)5 * M * 1024;
            int ln_ = F.lane; asm volatile("" : "+v"(ln_));
            float d1 = KIN(9)[l * 64 + ln_] * KIN(10)[l * 64 + ln_], d2 = KIN(11)[l * 64 + ln_] * KIN(12)[l * 64 + ln_];
            d1 = wave_sum(d1, ln_); d2 = wave_sum(d2, ln_);
            const float lam = __uint_as_float(__builtin_amdgcn_readfirstlane(__float_as_uint(__expf(d1) - __expf(d2) + lam_init)));
            const int bh = F.vcu >> 2, p = F.vcu & 3, b = bh >> 3, h = bh & 7;
            const float slope2 = exp2f(-(float)(h + 1)) * LOG2E;
            if (F.G == 256) {
#pragma unroll 1
                for (int i = 0; i < 2; ++i) {
                    const int qb = i ? (7 - p) : p;
#pragma unroll 1
                    DBL(2) for (int ce = 0; ce < 4; ++ce) {
                        const int c = ce >> 1, e = ce & 1;
                        attn_body::attn_unit<8>(b, 2 * h + c, 2 * h + e, qb, slope2, (const attn_body::bf16*)Qb, (const attn_body::bf16*)Kb, (const attn_body::bf16*)Vb, (attn_body::bf16*)(c ? O2 : O1), (char*)lds + RING_OFF);
                    }
                    VM_WAIT(); __syncthreads();
                    DBL(6) combine_block(F, b, h, qb, O1, O2, GA, AR, KIN(13) + l * 128, lam, lam_init);
                }
                DBL(3) lru_item(F, F.vcu >> 5, (F.vcu >> 2) & 7, F.vcu & 3, XBb, GBb, AR, KIN(2) + (size_t)l * 4 * LRUW, KIN(3) + l * LRUW,
                         (const bf16*)(ws + WS_GW) + ((size_t)(l * NBLK + ((F.vcu >> 2) & 7)) * 4 + (F.vcu & 3)) * GW_ITEM, KIN(5) + l * LRUW, KIN(7) + l * LRUW, KIN(8) + l * LRUW);
            }
        }
        SEAM(pb + 1);
        if (IN(pb + 2)) {
            KARGS();
            pg8::Gemm g{WSP(WS_AR), WSP(WS_WPAB) + (size_t)l * DM * DM, M, DM, DM}; pg8::StaticOrder S; S.init(M, DM, F.G, (int)blockIdx.x);
            pg8::EpiMerge E{WSP(WS_MA), WSP(WS_MB), WSP(WS_MERGED)};
            DBL(4) pg8::gemm_phase<pg8::EpiMerge, pg8::StaticOrder, PG8_ALIGN, PG8_SP2>(F.lds + RING_OFF, g, S, E);
        }
        SEAM(pb + 2);
        if (IN(pb + 3)) {
            KARGS();
            pg8::Gemm g{WSP(WS_MERGED), WSP(WS_WOUT) + (size_t)l * DM * DM, M, DM, DM}; pg8::StaticOrder S; S.init(M, DM, F.G, (int)blockIdx.x);
            pg8::EpiRes E{l == 0 ? KIN(0) : outp, outp, DN_ALPHA};
            for (int rep_ = 0; rep_ < 1 + (((MK_DBL >> 5) & 1) && l == 0); ++rep_) pg8::gemm_phase<pg8::EpiRes, pg8::StaticOrder, PG8_ALIGN, PG8_SP2>(F.lds + RING_OFF, g, S, E);
        }
        SEAM(pb + 3);
        if (IN(pb + 4)) { KARGS(); ln_phase(F, outp, WSP(WS_XB16), ws + WS_XQ8, KIN(17) + l * DM, KIN(18) + l * DM); }
        SEAM(pb + 4);
    }
#undef IN
#undef SEAM
#undef KARGS
#undef KIN
#undef WSP
#undef CAS
}

#ifndef MK_PER_PHASE
#define MK_PER_PHASE 0
#endif
extern "C" void kernel_launch(void* const* d_in, const int* in_sizes, int n_in, void* d_out, int out_size, void* d_ws, size_t ws_size, hipStream_t stream) {
    static int grid = 0;
    if (grid == 0) {
        if (n_in != 19 || in_sizes[0] != M * DM || out_size != M * DM || ws_size < WS_END) { fprintf(stderr, "kernel_launch: unexpected shapes / workspace (n_in %d, ws %zu); nothing launched\n", n_in, ws_size); grid = -1; return; }
        int dev = 0, cus = 0;
        if (hipGetDevice(&dev) != hipSuccess || hipDeviceGetAttribute(&cus, hipDeviceAttributeMultiprocessorCount, dev) != hipSuccess) { grid = -1; return; }
        if (hipFuncSetAttribute((const void*)mk_fwd, hipFuncAttributeMaxDynamicSharedMemorySize, LDS_BYTES) != hipSuccess) { fprintf(stderr, "kernel_launch: hipFuncSetAttribute failed\n"); grid = -1; return; }
        int per_cu = 0;
        if (hipOccupancyMaxActiveBlocksPerMultiprocessor(&per_cu, (const void*)mk_fwd, NWAVES * 64, LDS_BYTES) != hipSuccess || per_cu < 1) fprintf(stderr, "kernel_launch: occupancy query reports %d blocks per CU\n", per_cu);
        (void)hipGetLastError();
        grid = cus;
        if (grid != 256) fprintf(stderr, "kernel_launch: %d CUs; the attention/LRU phase is built for 256\n", grid);
    }
    if (grid < 0) return;
    if (hipMemsetAsync((char*)d_ws + WS_CTL, 0, CTL_ZERO_BYTES, stream) != hipSuccess) return;
    Args a{};
    for (int i = 0; i < 19; ++i) a.in[i] = (const float*)d_in[i];
    a.out = (float*)d_out; a.ws = (unsigned char*)d_ws;
#if MK_PER_PHASE
    for (int p = 0; p < N_PHASES; ++p) { a.ph_lo = p; a.ph_hi = p + 1; hipLaunchKernelGGL(mk_fwd, dim3(grid), dim3(NWAVES * 64), LDS_BYTES, stream, a); }
#else
    a.ph_lo = 0; a.ph_hi = N_PHASES;
    hipLaunchKernelGGL(mk_fwd, dim3(grid), dim3(NWAVES * 64), LDS_BYTES, stream, a);
#endif
}
```

```cpp
#include <hip/hip_runtime.h>
#include <cstdio>
#include <cstdint>
namespace pg8 {
#define PG8_LAS __attribute__((address_space(3)))
typedef unsigned short bf16_t;
typedef short bf16x8 __attribute__((ext_vector_type(8)));
typedef float f32x4 __attribute__((ext_vector_type(4)));
typedef unsigned u32x4 __attribute__((ext_vector_type(4)));
constexpr int BM = 256, BK = 64, HALF = 128, HTB = HALF * BK * 2  , STAGE_BYTES = 8 * HTB, NXCD = 8, WGM = 8;

__host__ __device__ __forceinline__ int lds_byte(int r, int c) { const int st = (r >> 4) * 2 + (c >> 5), rr = r & 15, cc = c & 31, ob = rr * 64 + cc * 2; return st * 1024 + (ob ^ (((ob >> 9) & 1) << 5)); }
__host__ __device__ __forceinline__ void stage_rc(int b, int& R, int& C) { const int st = b / 1024, sb = b % 1024, swz = sb ^ (((sb >> 9) & 1) << 5); R = (st >> 1) * 16 + swz / 64; C = (st & 1) * 32 + (swz % 64) / 2; }
__host__ __device__ __forceinline__ int perm32(int rho) { const int n = rho >> 4, i = rho & 15; return 8 * (i >> 2) + 4 * n + (i & 3); }

struct Unit { int pm, pn; };
struct Gemm { const bf16_t* A; const bf16_t* Bt; int M, N, K; };

struct StaticOrder {
    int nM, nN, nwg, G, c;
    __host__ __device__ void init(int M, int N, int G_, int c_) { nM = M / BM; nN = N / BM; nwg = nM * nN; G = G_; c = c_; }
    __host__ __device__ bool next(int i, Unit& u) const {
        const long L = (long)i * G + c; if (L >= nwg) return false;
        int wgid = (int)L; { const int q = nwg / NXCD, r = nwg % NXCD, xcd = wgid % NXCD, off = wgid / NXCD; wgid = (xcd < r ? xcd * (q + 1) : r * (q + 1) + (xcd - r) * q) + off; }
        const int nig = WGM * nN, gid = wgid / nig, fm = gid * WGM, gsz = (nM - fm) < WGM ? (nM - fm) : WGM;
        u.pm = fm + ((wgid % nig) % gsz); u.pn = (wgid % nig) / gsz; return true;
    }
    __device__ __forceinline__ void a_ready(const Unit&) const {}
    __device__ __forceinline__ void done(const Unit&) const {}
};

__device__ __forceinline__ unsigned cvt_pk_bf16(float lo, float hi) { unsigned r; asm volatile("v_cvt_pk_bf16_f32 %0, %1, %2" : "=v"(r) : "v"(lo), "v"(hi)); return r; }
typedef short s16x8_t __attribute__((ext_vector_type(8)));
__device__ __forceinline__ float bfbits2f(short v) { return __uint_as_float(((unsigned)(unsigned short)v) << 16); }
struct EpiProj {
    static constexpr bool PERM = true, AFTER_DRAIN = false, HAS_MID = false;
    bf16_t* base6; bf16_t* ma; bf16_t* mb; size_t stride6; float qscale; int pn_off; float gscale;
    __device__ __forceinline__ void operator()(const f32x4 (&acc)[2][2][4][2], const Unit& u, int wr, int wc, int fr, int fq) const {
        const int pn = u.pn + pn_off; bf16_t* base; int ldc, colt; float sc = 1.f;
        if (pn < 24) { const int t = pn >> 2; base = base6 + (size_t)t * stride6; ldc = 1024; colt = (pn & 3) * BM; if (t == 0) sc = qscale; }
        else if (pn < 32) { base = ma; ldc = 2048; colt = (pn - 24) * BM; sc = gscale; }
        else { base = mb; ldc = 2048; colt = (pn - 32) * BM; sc = gscale; }
        int t_ = threadIdx.x; asm volatile("" : "+v"(t_));
        const int lrow = (t_ >> 8) * 64 + (t_ & 15), lcol = ((t_ >> 6) & 3) * 32 + 8 * ((t_ >> 4) & 3);
        const int row0 = u.pm * BM + lrow, col0 = colt + lcol;
#pragma unroll
        for (int ai = 0; ai < 2; ++ai)
#pragma unroll
            for (int m = 0; m < 4; ++m) { bf16_t* rowp = base + (size_t)(row0 + ai * HALF + m * 16) * ldc + col0;
#pragma unroll
                for (int bj = 0; bj < 2; ++bj) { const f32x4 v0 = acc[ai][bj][m][0] * sc, v1 = acc[ai][bj][m][1] * sc;
                    u32x4 w; w.x = cvt_pk_bf16(v0[0], v0[1]); w.y = cvt_pk_bf16(v0[2], v0[3]); w.z = cvt_pk_bf16(v1[0], v1[1]); w.w = cvt_pk_bf16(v1[2], v1[3]);
                    *(u32x4*)(rowp + bj * HALF) = w; } }
    }
};
struct EpiMerge {
    static constexpr bool PERM = true, AFTER_DRAIN = false, HAS_MID = true;
    const bf16_t* ma; const bf16_t* mb; bf16_t* out;
    __device__ __forceinline__ void mid(f32x4 (&acc)[2][2][4][2], const Unit& u, int wr, int wc, int fr, int fq) const {
        unsigned lofs = (unsigned)((wr * 64 + fr) * 2048 + wc * 32 + 8 * fq); asm volatile("" : "+v"(lofs));
        const size_t tofs = (size_t)u.pm * BM * 2048 + (size_t)u.pn * BM;
#pragma unroll
        for (int ai = 0; ai < 2; ++ai)
#pragma unroll
            for (int m = 0; m < 4; ++m) { const size_t off = tofs + lofs + (size_t)(ai * HALF + m * 16) * 2048;
#pragma unroll
                for (int bj = 0; bj < 2; ++bj) { const s16x8_t a = *(const s16x8_t*)(ma + off + bj * HALF), b = *(const s16x8_t*)(mb + off + bj * HALF);
#pragma unroll
                    for (int j = 0; j < 8; ++j) { const float xa = bfbits2f(a[j]), xb = fmaxf(bfbits2f(b[j]), -30.f);
                        const float f = (1.f + __expf(-xb)) * __builtin_amdgcn_rcpf(1.f + __expf(-xa)); acc[ai][bj][m][j >> 2][j & 3] *= f; } }
                asm volatile("" ::: "memory"); }
    }
    __device__ __forceinline__ void operator()(const f32x4 (&acc)[2][2][4][2], const Unit& u, int wr, int wc, int fr, int fq) const {
        unsigned lofs = (unsigned)((wr * 64 + fr) * 2048 + wc * 32 + 8 * fq); asm volatile("" : "+v"(lofs));
        const size_t tofs = (size_t)u.pm * BM * 2048 + (size_t)u.pn * BM;
#pragma unroll
        for (int ai = 0; ai < 2; ++ai)
#pragma unroll
            for (int m = 0; m < 4; ++m) { const size_t off = tofs + lofs + (size_t)(ai * HALF + m * 16) * 2048;
#pragma unroll
                for (int bj = 0; bj < 2; ++bj) { const s16x8_t b = *(const s16x8_t*)(mb + off + bj * HALF); float v[8];
#pragma unroll
                    for (int j = 0; j < 8; ++j) { const float xb = fmaxf(bfbits2f(b[j]), -30.f); v[j] = acc[ai][bj][m][j >> 2][j & 3] * __builtin_amdgcn_rcpf(1.f + __expf(-xb)); }
                    u32x4 w; w.x = cvt_pk_bf16(v[0], v[1]); w.y = cvt_pk_bf16(v[2], v[3]); w.z = cvt_pk_bf16(v[4], v[5]); w.w = cvt_pk_bf16(v[6], v[7]);
                    *(u32x4*)(out + off + bj * HALF) = w; }
                asm volatile("" ::: "memory"); }
    }
};
struct EpiRes {
    static constexpr bool PERM = false, AFTER_DRAIN = false, HAS_MID = false;
    const float* base; float* out; float alpha;
    __device__ __forceinline__ void operator()(const f32x4 (&acc)[2][2][4][2], const Unit& u, int wr, int wc, int fr, int fq) const {
        const int row0 = u.pm * BM + wr * 64 + fr, col0 = u.pn * BM + wc * 32 + 4 * fq;
#pragma unroll
        for (int ai = 0; ai < 2; ++ai)
#pragma unroll
            for (int m = 0; m < 4; ++m) { const size_t off = (size_t)(row0 + ai * HALF + m * 16) * 2048 + col0;
#pragma unroll
                for (int bj = 0; bj < 2; ++bj)
#pragma unroll
                    for (int n = 0; n < 2; ++n) { const f32x4 bs = *(const f32x4*)(base + off + bj * HALF + n * 16); *(f32x4*)(out + off + bj * HALF + n * 16) = bs * alpha + acc[ai][bj][m][n]; }
                if (m & 1) asm volatile("" ::: "memory"); }
    }
};
typedef int pg8_v4i __attribute__((ext_vector_type(4))); typedef int pg8_v8i __attribute__((ext_vector_type(8)));
template <bool FP8> struct FragSel { struct type { bf16x8 k[2]; }; };
template <> struct FragSel<true> { typedef pg8_v8i type; };
template <bool FP8, class F> __device__ __forceinline__ void ld_frag(F& d, const PG8_LAS unsigned char* p) {
    if constexpr (FP8) { const pg8_v4i lo = *(const PG8_LAS pg8_v4i*)p, hi = *(const PG8_LAS pg8_v4i*)(p + 16); d = __builtin_shufflevector(lo, hi, 0, 1, 2, 3, 4, 5, 6, 7); }
    else { d.k[0] = *(const PG8_LAS bf16x8*)p; d.k[1] = *(const PG8_LAS bf16x8*)(p + 1024); }
}
template <bool FP8, class F> __device__ __forceinline__ void mma_frag(f32x4& c, const F& b, const F& a) {
    if constexpr (FP8) c = __builtin_amdgcn_mfma_scale_f32_16x16x128_f8f6f4(b, a, c, 0, 0, 0, 0, 0, 0);
    else { c = __builtin_amdgcn_mfma_f32_16x16x32_bf16(b.k[0], a.k[0], c, 0, 0, 0); c = __builtin_amdgcn_mfma_f32_16x16x32_bf16(b.k[1], a.k[1], c, 0, 0, 0); }
}
template <class Epi, class Sched, bool ALIGN_EPI = false, bool SP2 = false, bool FP8 = false>
__device__ __forceinline__ void gemm_phase(PG8_LAS unsigned char* lds, const Gemm g, const Sched& S, const Epi& E) {
    int tid_ = threadIdx.x; asm volatile("" : "+v"(tid_));
    const int tid = tid_, wid = __builtin_amdgcn_readfirstlane(tid >> 6), lane = tid & 63, wr = wid >> 2, wc = wid & 3, fr = lane & 15, fq = lane >> 4;
    const int K = g.K, nt = K / BK;
    unsigned voffA[2], voffB[2];
#pragma unroll
    for (int i = 0; i < 2; ++i) { int R, C; stage_rc(tid * 16 + i * 8192, R, C); const int Rb = Epi::PERM ? ((R & ~31) + perm32(R & 31)) : R;
        voffA[i] = (unsigned)(R * K + C) * 2u; voffB[i] = (unsigned)(Rb * K + C) * 2u; }
    const size_t kstep = (size_t)(BK * 2);
    const size_t hstep = (size_t)HALF * K * 2;
    const size_t tstep = 2 * hstep;
    const unsigned lds0 = (unsigned)(uintptr_t)lds;
    const unsigned ldsw = (unsigned)wid * 1024u;
    const int fcol = FP8 ? 32 * (fq >> 1) + 16 * (fq & 1) : fq * 8;
    const int aoff = lds_byte(wr * 64 + fr, fcol), boff = lds_byte(wc * 32 + fr, fcol);
#define PG8_SA(b, h) (((b) * 2 + (h)) * HTB)
#define PG8_SB(b, h) ((4 + (b) * 2 + (h)) * HTB)
#define PG8_STAGE(bufoff, gbase, voff) do { _Pragma("unroll") for (int _i = 0; _i < 2; ++_i) { unsigned keep_; \
        asm volatile("s_mov_b32 %0, m0\n\ts_mov_b32 m0, %3\n\ts_nop 4\n\tglobal_load_lds_dwordx4 %1, %2\n\ts_mov_b32 m0, %0" : "=&s"(keep_) : "v"((voff)[_i]), "s"((const char*)(gbase)), \
                     "s"((unsigned)__builtin_amdgcn_readfirstlane((int)(lds0 + (unsigned)(bufoff) + ldsw + (unsigned)(_i * 8192)))) : "memory"); } } while (0)
#define PG8_LDA(dst, b, h) do { _Pragma("unroll") for (int m = 0; m < 4; ++m) ld_frag<FP8>(dst[m], lds + PG8_SA(b, h) + aoff + m * 2048); } while (0)
#define PG8_LDB(dst, b, h) do { _Pragma("unroll") for (int n = 0; n < 2; ++n) ld_frag<FP8>(dst[n], lds + PG8_SB(b, h) + boff + n * 2048); } while (0)
#define PG8_MMA(ai, bj, At, Bt) do { __builtin_amdgcn_s_setprio(1); _Pragma("unroll") for (int m = 0; m < 4; ++m) _Pragma("unroll") for (int n = 0; n < 2; ++n) \
        mma_frag<FP8>(acc[ai][bj][m][n], Bt[n], At[m]); __builtin_amdgcn_s_setprio(0); } while (0)
#define PG8_WAIT_V(n) asm volatile("s_waitcnt vmcnt(" #n ")" ::: "memory")
#define PG8_WAIT_L(n) asm volatile("s_waitcnt lgkmcnt(" #n ")" ::: "memory")
#define PG8_BAR __builtin_amdgcn_s_barrier()
#define PG8_SCHED __builtin_amdgcn_sched_barrier(0)
    Unit cur, nxt; int ui = 0;
    if (!S.next(0, cur)) return;
    f32x4 acc[2][2][4][2];
#pragma unroll
    for (int a = 0; a < 2; ++a)
#pragma unroll
        for (int b = 0; b < 2; ++b)
#pragma unroll
            for (int m = 0; m < 4; ++m)
#pragma unroll
                for (int n = 0; n < 2; ++n) acc[a][b][m][n] = (f32x4){0.f, 0.f, 0.f, 0.f};
    typename FragSel<FP8>::type At[4], B0[2], B1[2];
    const char* cA = (const char*)g.A + (size_t)cur.pm * tstep; const char* cB = (const char*)g.Bt + (size_t)cur.pn * tstep;
    S.a_ready(cur);
    if constexpr (SP2) {
        PG8_STAGE(PG8_SB(0, 0), cB, voffB); PG8_STAGE(PG8_SB(0, 1), cB + hstep, voffB); PG8_STAGE(PG8_SA(0, 0), cA, voffA); PG8_STAGE(PG8_SA(0, 1), cA + hstep, voffA);
        if (wr == 1) PG8_BAR;
        PG8_WAIT_V(2); PG8_BAR;
        PG8_STAGE(PG8_SB(1, 0), cB + kstep, voffB); PG8_STAGE(PG8_SA(1, 0), cA + kstep, voffA); PG8_STAGE(PG8_SB(1, 1), cB + hstep + kstep, voffB);
        PG8_WAIT_V(6); PG8_BAR;
    } else {
        PG8_STAGE(PG8_SB(0, 0), cB, voffB); PG8_STAGE(PG8_SA(0, 0), cA, voffA); PG8_STAGE(PG8_SB(0, 1), cB + hstep, voffB); PG8_STAGE(PG8_SA(0, 1), cA + hstep, voffA);
        if (wr == 1) PG8_BAR;
        PG8_WAIT_V(4); PG8_BAR;
        PG8_STAGE(PG8_SB(1, 0), cB + kstep, voffB); PG8_STAGE(PG8_SA(1, 0), cA + kstep, voffA); PG8_STAGE(PG8_SB(1, 1), cB + hstep + kstep, voffB);
        PG8_WAIT_V(6); PG8_BAR;
    }
    for (;;) {
        const bool has_next = S.next(ui + 1, nxt);
        const char* nA = has_next ? (const char*)g.A + (size_t)nxt.pm * tstep : cA; const char* nB = has_next ? (const char*)g.Bt + (size_t)nxt.pn * tstep : cB;
        for (int t = 0; t < nt; t += 2) {
            const bool last = (t == nt - 2);
            if constexpr (Epi::HAS_MID) { if (t == nt / 2) E.mid(acc, cur, wr, wc, fr, fq); }
            const char* a1 = cA + (size_t)(t + 1) * kstep;
            const char* a2 = last ? nA : cA + (size_t)(t + 2) * kstep; const char* b2 = last ? nB : cB + (size_t)(t + 2) * kstep;
            const char* a3 = a2 + kstep; const char* b3 = b2 + kstep;
            if (last && has_next) S.a_ready(nxt);
            if constexpr (SP2) {
            PG8_LDB(B0, 0, 0); PG8_LDB(B1, 0, 1); PG8_SCHED; PG8_LDA(At, 0, 0); PG8_STAGE(PG8_SA(1, 1), a1 + hstep, voffA);
            PG8_WAIT_V(8); PG8_WAIT_L(0); PG8_BAR; PG8_MMA(0, 0, At, B0); PG8_MMA(0, 1, At, B1); PG8_BAR; PG8_SCHED;
            PG8_LDA(At, 0, 1); PG8_STAGE(PG8_SB(0, 0), b2, voffB); PG8_STAGE(PG8_SB(0, 1), b2 + hstep, voffB); PG8_STAGE(PG8_SA(0, 0), a2, voffA);
            PG8_WAIT_V(8); PG8_WAIT_L(0); PG8_BAR; PG8_MMA(1, 0, At, B0); PG8_MMA(1, 1, At, B1); PG8_BAR; PG8_SCHED;
            PG8_LDB(B0, 1, 0); PG8_LDB(B1, 1, 1); PG8_SCHED; PG8_LDA(At, 1, 0); PG8_STAGE(PG8_SA(0, 1), a2 + hstep, voffA);
            PG8_WAIT_V(8); PG8_WAIT_L(0); PG8_BAR; PG8_MMA(0, 0, At, B0); PG8_MMA(0, 1, At, B1); PG8_BAR; PG8_SCHED;
            PG8_LDA(At, 1, 1); PG8_STAGE(PG8_SB(1, 0), b3, voffB); PG8_STAGE(PG8_SB(1, 1), b3 + hstep, voffB); PG8_STAGE(PG8_SA(1, 0), a3, voffA);
            PG8_WAIT_V(8); PG8_WAIT_L(0); PG8_BAR; PG8_MMA(1, 0, At, B0); PG8_MMA(1, 1, At, B1); PG8_BAR; PG8_SCHED;
            } else {
            PG8_LDB(B0, 0, 0); PG8_SCHED; PG8_LDA(At, 0, 0); PG8_STAGE(PG8_SA(1, 1), a1 + hstep, voffA);
            PG8_WAIT_L(8); PG8_BAR; PG8_WAIT_L(0); PG8_MMA(0, 0, At, B0); PG8_BAR; PG8_SCHED;
            PG8_LDB(B1, 0, 1); PG8_STAGE(PG8_SB(0, 0), b2, voffB);
            PG8_BAR; PG8_WAIT_L(0); PG8_MMA(0, 1, At, B1); PG8_BAR;
            PG8_LDA(At, 0, 1); PG8_STAGE(PG8_SA(0, 0), a2, voffA);
            PG8_BAR; PG8_WAIT_L(0); PG8_MMA(1, 0, At, B0); PG8_BAR; PG8_SCHED;
            PG8_STAGE(PG8_SB(0, 1), b2 + hstep, voffB);
            PG8_WAIT_V(6); PG8_BAR; PG8_MMA(1, 1, At, B1); PG8_BAR;
            PG8_LDB(B0, 1, 0); PG8_SCHED; PG8_LDA(At, 1, 0); PG8_STAGE(PG8_SA(0, 1), a2 + hstep, voffA);
            PG8_WAIT_L(8); PG8_BAR; PG8_WAIT_L(0); PG8_MMA(0, 0, At, B0); PG8_BAR; PG8_SCHED;
            PG8_LDB(B1, 1, 1); PG8_STAGE(PG8_SB(1, 0), b3, voffB);
            PG8_BAR; PG8_WAIT_L(0); PG8_MMA(0, 1, At, B1); PG8_BAR;
            PG8_LDA(At, 1, 1); PG8_STAGE(PG8_SA(1, 0), a3, voffA);
            PG8_BAR; PG8_WAIT_L(0); PG8_MMA(1, 0, At, B0); PG8_BAR; PG8_SCHED;
            PG8_STAGE(PG8_SB(1, 1), b3 + hstep, voffB);
            PG8_WAIT_V(6); PG8_BAR; PG8_MMA(1, 1, At, B1); PG8_BAR;
            }
        }
        if constexpr (ALIGN_EPI) { if (wr == 0) PG8_BAR; }
        if constexpr (!Epi::AFTER_DRAIN) { E(acc, cur, wr, wc, fr, fq); S.done(cur); }
        if (!has_next) break;
#pragma unroll
        for (int a = 0; a < 2; ++a)
#pragma unroll
            for (int b = 0; b < 2; ++b)
#pragma unroll
                for (int m = 0; m < 4; ++m)
#pragma unroll
                    for (int n = 0; n < 2; ++n) acc[a][b][m][n] = (f32x4){0.f, 0.f, 0.f, 0.f};
        cur = nxt; cA = nA; cB = nB; ++ui;
        if constexpr (ALIGN_EPI) { if (wr == 1) PG8_BAR; }
    }
    PG8_WAIT_V(0);
    if constexpr (!ALIGN_EPI) { if (wr == 0) PG8_BAR; }
    PG8_BAR;
    if constexpr (Epi::AFTER_DRAIN) { E.fused(acc, cur, wr, wc, fr, fq, lds, wid, lane); S.done(cur); }
#undef PG8_SA
#undef PG8_SB
#undef PG8_STAGE
#undef PG8_LDA
#undef PG8_LDB
#undef PG8_MMA
#undef PG8_WAIT_V
#undef PG8_WAIT_L
#undef PG8_BAR
#undef PG8_SCHED
}
}

#ifndef PG8_SP2
#define PG8_SP2 true
#endif
#ifndef PG8_ALIGN
#define PG8_ALIGN true
#endif
#include <hip/hip_bf16.h>
#include <cmath>
namespace attn_body {
using bf16=__hip_bfloat16;
using bf16x8=__attribute__((ext_vector_type(8)))short;
using s16x4=__attribute__((ext_vector_type(4)))short;
using f32x16=__attribute__((ext_vector_type(16)))float;
using u32x4=__attribute__((ext_vector_type(4)))unsigned;
constexpr int BATCH=8,NHEAD=16,SEQ=2048,D=64,DM=NHEAD*D;
constexpr int NW=8,QBLK=32,QB=QBLK*NW,KVBLK=64,NQB=SEQ/QB;
constexpr int ATTN_PITCH=DM, ATTN_UNIT_ROWS=QB;
__device__ __forceinline__ int crow(int r,int hi){return (r&3)+8*(r>>2)+4*hi;}
#define SBAR() __builtin_amdgcn_sched_barrier(0)
__device__ __forceinline__ void cmask(f32x16&p0,f32x16&p1,int jb,int qrel,int hi){
  const float NEG=-INFINITY; int kb=64*jb+4*hi;
  #pragma unroll
  for(int r=0;r<16;++r){int kv=kb+(r&3)+8*(r>>2); if(kv>qrel)p0[r]=NEG; if(kv+32>qrel)p1[r]=NEG;}
}

constexpr int NSLOT=3, SLOTB=8192, VD=128;
constexpr int LDS_K=0, LDS_V=NSLOT*SLOTB, LDS_WS=3*NSLOT*SLOTB, LDS_OST=LDS_WS+NW*64*4, LDS_BYTES=LDS_OST+NW*8192;
constexpr float C2=0.125f*1.4426950408889634f;
__device__ __forceinline__ void glds16(const void*gsrc,unsigned lds_dst){unsigned keep;
  asm volatile("s_mov_b32 %0, m0\n\ts_mov_b32 m0, %2\n\ts_nop 0\n\tglobal_load_lds_dwordx4 %1, off\n\ts_mov_b32 m0, %0":"=&s"(keep):"v"(gsrc),"s"(lds_dst):"memory");}
__device__ __forceinline__ void glds16o(const void*sbase,unsigned voff,unsigned lds_dst){unsigned keep;
  asm volatile("s_mov_b32 %0, m0\n\ts_mov_b32 m0, %3\n\ts_nop 4\n\tglobal_load_lds_dwordx4 %1, %2\n\ts_mov_b32 m0, %0":"=&s"(keep):"v"(voff),"s"(sbase),"s"(lds_dst):"memory");}
__device__ __forceinline__ float max3f(float a,float b,float c){float r;asm("v_max3_f32 %0, %1, %2, %3":"=v"(r):"v"(a),"v"(b),"v"(c));return r;}
__device__ __forceinline__ float max2f(float a,float b){float r;asm("v_max_f32_e32 %0, %1, %2":"=v"(r):"v"(a),"v"(b));return r;}
__device__ __forceinline__ float fadd_s(float a,float b){float r;asm("v_add_f32_e32 %0, %1, %2":"=v"(r):"v"(a),"v"(b));return r;}
__device__ __forceinline__ float fsub_s(float a,float b){float r;asm("v_sub_f32_e32 %0, %1, %2":"=v"(r):"v"(a),"v"(b));return r;}
typedef float f32x2_t __attribute__((ext_vector_type(2))); typedef __bf16 bf16x2_t __attribute__((ext_vector_type(2)));
__device__ __forceinline__ unsigned cvtpk_s(float lo,float hi){f32x2_t v={lo,hi};bf16x2_t b=__builtin_convertvector(v,bf16x2_t);return __builtin_bit_cast(unsigned,b);}
#define WAIT_BAR(N) asm volatile("s_waitcnt vmcnt(" #N ") lgkmcnt(0)\n\ts_barrier":::"memory")

__device__ __forceinline__ void qkt(f32x16&p0,f32x16&p1,const char*Kslot,const bf16x8*qr,int r32,int hi){
  const char*kb=Kslot+hi*1024+r32*16;
  #pragma unroll
  for(int d0=0;d0<4;++d0){
    const bf16x8 b0=*reinterpret_cast<const bf16x8*>(kb+d0*2048);
    const bf16x8 b1=*reinterpret_cast<const bf16x8*>(kb+d0*2048+512);
    {p0=__builtin_amdgcn_mfma_f32_32x32x16_bf16(b0,qr[d0],p0,0,0,0);p1=__builtin_amdgcn_mfma_f32_32x32x16_bf16(b1,qr[d0],p1,0,0,0);}}
}
typedef __attribute__((address_space(3))) const char* lds_cptr;
typedef short v4i16_t __attribute__((ext_vector_type(4)));
__device__ __forceinline__ void kload8(bf16x8*kf,lds_cptr kp){
  kf[0]=*(const __attribute__((address_space(3))) bf16x8*)(kp);      kf[1]=*(const __attribute__((address_space(3))) bf16x8*)(kp+512);
  kf[2]=*(const __attribute__((address_space(3))) bf16x8*)(kp+2048); kf[3]=*(const __attribute__((address_space(3))) bf16x8*)(kp+2560);
  kf[4]=*(const __attribute__((address_space(3))) bf16x8*)(kp+4096); kf[5]=*(const __attribute__((address_space(3))) bf16x8*)(kp+4608);
  kf[6]=*(const __attribute__((address_space(3))) bf16x8*)(kp+6144); kf[7]=*(const __attribute__((address_space(3))) bf16x8*)(kp+6656);
}
__device__ __forceinline__ void kload2(bf16x8*kf,lds_cptr kp,int j){ kf[2*j]=*(const __attribute__((address_space(3))) bf16x8*)(kp+j*2048); kf[2*j+1]=*(const __attribute__((address_space(3))) bf16x8*)(kp+j*2048+512); }
__device__ __forceinline__ s16x4 vtr(lds_cptr p){ return __builtin_bit_cast(s16x4,__builtin_amdgcn_ds_read_tr16_b64_v4i16((__attribute__((address_space(3))) v4i16_t*)p)); }
__device__ __forceinline__ float rowmax(const f32x16&p0,const f32x16&p1){
  float a=max3f(p0[0],p0[1],p1[0]),b=max3f(p0[2],p0[3],p1[1]);a=max3f(a,p1[2],p1[3]);
  #pragma unroll
  for(int r=4;r<16;r+=4){a=max3f(a,p0[r],p0[r+1]);b=max3f(b,p0[r+2],p0[r+3]);a=max3f(a,p1[r],p1[r+1]);b=max3f(b,p1[r+2],p1[r+3]);}
  const float m=max2f(a,b);
  auto rr=__builtin_amdgcn_permlane32_swap(__float_as_uint(m),__float_as_uint(m),false,false);
  return max2f(__uint_as_float(rr[0]),__uint_as_float(rr[1]));
}
__device__ __forceinline__ void pv(f32x16*o,int vb,bf16x8 pa0,bf16x8 pa1,bf16x8 pa2,bf16x8 pa3){
  #pragma unroll
  for(int d0=0;d0<4;++d0){s16x4 lo[4],hi[4];
    #pragma unroll
    for(int ks=0;ks<4;++ks){
      asm volatile("ds_read_b64_tr_b16 %0,%1 offset:%c2":"=&v"(lo[ks]):"v"(vb),"i"(d0*4096+ks*1024):"memory");
      asm volatile("ds_read_b64_tr_b16 %0,%1 offset:%c2":"=&v"(hi[ks]):"v"(vb),"i"(d0*4096+ks*1024+512):"memory");}
    asm volatile("s_waitcnt lgkmcnt(0)":::"memory");SBAR();
    #define PK(k) (bf16x8){lo[k][0],lo[k][1],lo[k][2],lo[k][3],hi[k][0],hi[k][1],hi[k][2],hi[k][3]}
    o[d0]=__builtin_amdgcn_mfma_f32_32x32x16_bf16(pa0,PK(0),o[d0],0,0,0);
    o[d0]=__builtin_amdgcn_mfma_f32_32x32x16_bf16(pa1,PK(1),o[d0],0,0,0);
    o[d0]=__builtin_amdgcn_mfma_f32_32x32x16_bf16(pa2,PK(2),o[d0],0,0,0);
    o[d0]=__builtin_amdgcn_mfma_f32_32x32x16_bf16(pa3,PK(3),o[d0],0,0,0);
    #undef PK
  }
}

#ifndef ATTN_STORE16
#define ATTN_STORE16(p,v) (*(u32x4*)(p)=(v))
#endif
template<int THRL> __device__ __forceinline__ void attn_unit(int b,int hq,int hh,int qb,float slope2,const bf16*Q,const bf16*__restrict__ K,const bf16*__restrict__ V,bf16*O,char*shm){
  int tid_=threadIdx.x; asm volatile("":"+v"(tid_)); const int tid=tid_,lane=tid&63,r32=lane&31,hi=lane>>5; const int wid=__builtin_amdgcn_readfirstlane(tid>>6);
  const long rowbase=(long)b*SEQ; const int q0=qb*QB;
  const bf16*Qw=Q+(rowbase+q0+wid*QBLK)*DM+hq*D;
  const bf16*Kh=K+rowbase*DM+hq*D,*Vh=V+rowbase*DM+hh*VD;
  const unsigned lds0=(unsigned)(uintptr_t)shm;
  float*wsf=(float*)(shm+LDS_WS)+wid*64;
  const unsigned koff=(unsigned)((lane*DM+wid*8)*2);
  const unsigned voff=(unsigned)(((16*(wid&3)+(lane>>2))*DM+(wid>>2)*32+(lane&3)*8)*2);
  const unsigned kdst=lds0+LDS_K+wid*1024, vdst=lds0+LDS_V+wid*1024;
  #define DMA_K(t,slot) glds16o(Kh+(long)(t)*KVBLK*DM,koff,(unsigned)__builtin_amdgcn_readfirstlane(kdst+(slot)))
  #define DMA_V(t,slot) do{ glds16o(Vh+(long)(t)*KVBLK*DM,voff,(unsigned)__builtin_amdgcn_readfirstlane(vdst+2*(slot))); glds16o(Vh+(long)(t)*KVBLK*DM+64,voff,(unsigned)__builtin_amdgcn_readfirstlane(vdst+2*(slot)+8192)); }while(0)
  const int vb0=(int)(lds0+LDS_V)+((lane>>4)&1)*32+(lane&3)*8+(4*hi+((lane&15)>>2))*64;
  const char*Kbase=shm+LDS_K; bf16x8 kf[8];
  const lds_cptr shm3=(lds_cptr)shm; const lds_cptr kp0=shm3+LDS_K+hi*1024+r32*16; const lds_cptr vp0=shm3+LDS_V+((lane>>4)&1)*32+(lane&3)*8+(4*hi+((lane&15)>>2))*64;
  const int NT=(q0+QB)/KVBLK;
  DMA_K(0,0);DMA_V(0,0);DMA_K(1,SLOTB);
  bf16x8 qr[4];
  #pragma unroll
  for(int d0=0;d0<4;++d0)qr[d0]=*reinterpret_cast<const bf16x8*>(&Qw[(long)r32*DM+d0*16+hi*8]);
  float l_reg=0.f;f32x16 o[4];o[0]=f32x16{};o[1]=f32x16{};o[2]=f32x16{};o[3]=f32x16{};
  float nb=slope2*(float)(4*hi-q0-255); const float sl64=64.f*slope2;
  #define BINIT0(C0,t) do{ _Pragma("unroll") for(int r=0;r<16;++r)C0[r]=fmaf(slope2,(float)((r&3)+8*(r>>2)),nb); }while(0)
  #define BINIT1(C1,t) do{ _Pragma("unroll") for(int r=0;r<16;++r)C1[r]=fmaf(slope2,(float)((r&3)+8*(r>>2)+32),nb); nb+=sl64; }while(0)
  const int qrel=wid*QBLK+r32;
  #define CMASK(P0,P1,t) do{int jb_=(t)-(NT-4); if(jb_>=0)cmask(P0,P1,jb_,qrel,hi);}while(0)
  bool resc=false;
  #define START(P0,P1) do{ const float rm=rowmax(P0,P1); resc=false; \
    { const float dl=rm; nb=fsub_s(nb,dl); \
      _Pragma("unroll") for(int r=0;r<16;++r){P0[r]=fsub_s(P0[r],dl);P1[r]=fsub_s(P1[r],dl);} } \
    _Pragma("unroll") for(int r=0;r<16;++r)P0[r]=__builtin_amdgcn_exp2f(P0[r]); }while(0)
  #define RESC() do{ if(resc){ asm volatile("s_waitcnt lgkmcnt(0)":::"memory"); \
      _Pragma("unroll") for(int d_=0;d_<4;++d_) _Pragma("unroll") for(int r=0;r<16;++r)o[d_][r]*=wsf[crow(r,hi)]; } }while(0)
  f32x16 pA0,pA1,pB0,pB1;
  int sl_prev=0,sl_cur=0,sl_next=SLOTB;
  #define ROT() do{sl_prev=sl_cur;sl_cur=sl_next;sl_next=(sl_next==(NSLOT-1)*SLOTB)?0:sl_next+SLOTB;}while(0)
  DMA_K(2,2*SLOTB);
  WAIT_BAR(3);
  asm volatile("":"+v"(nb));
  BINIT0(pA0,0);BINIT1(pA1,0);qkt(pA0,pA1,Kbase,qr,r32,hi);asm volatile("s_nop 15\n\ts_nop 7":"+v"(pA0),"+v"(pA1));CMASK(pA0,pA1,0);
  START(pA0,pA1);
  _Pragma("unroll") for(int r=0;r<16;++r)pA1[r]=__builtin_amdgcn_exp2f(pA1[r]);
  WAIT_BAR(0);
  DMA_K(3,0);DMA_V(1,SLOTB);
  ROT();
  kload8(kf,kp0+sl_cur);
  WAIT_BAR(3);
  s16x4 vlo[16],vhi[16]; u32x4 pw0,pw1,pw2,pw3;
  #define PKW(P,B) cvtpk_s(P[B],P[B+1])
  #define PAF(k) __builtin_bit_cast(bf16x8,pw##k)
  #define VFR(i) (bf16x8){vlo[i][0],vlo[i][1],vlo[i][2],vlo[i][3],vhi[i][0],vhi[i][1],vhi[i][2],vhi[i][3]}
  #define PIN(x) asm volatile("":"+v"(x))
  #define MX3(a,b,c) __builtin_fmaxf(__builtin_fmaxf((a),(b)),(c))
  #define GAPA(MF,A0,A1,A2,A3,W0,W1,PW) do{ MF; sacc+=A0; sacc+=A1; sacc+=A2; sacc+=A3; PIN(sacc); W0; W1; PIN(PW); SBAR(); }while(0)
  #define EX(v) __builtin_amdgcn_exp2f(v)
  #define VRD(j) do{ vlo[j]=vtr(vp_+(((j)&3)*4096+((j)>>2)*1024)); vhi[j]=vtr(vp_+(((j)&3)*4096+((j)>>2)*1024+512)); }while(0)
  #define GAPB(j,k,X,B) do{ asm volatile("s_waitcnt lgkmcnt(0)":::"memory"); SBAR(); o[(j)&3]=__builtin_amdgcn_mfma_f32_32x32x16_bf16(PAF(k),VFR(j),o[(j)&3],0,0,0); X[B]=EX(X[B]); X[B+1]=EX(X[B+1]); PIN(X); if((j)+4<16){VRD(((j)+4)&15);} SBAR(); }while(0)
  #define KRD(G,j) do{ if(G){ kload2(kf,kp0+sl_next,j); SBAR(); } }while(0)
  #define STEP(C0,C1,P0,P1,t,GK,GV,GL) do{ SBAR(); \
    const lds_cptr vp_=vp0+2*sl_prev; \
    BINIT0(C0,t); PIN(C0); SBAR(); float sacc=(P0[0]+P0[1]); \
    GAPA(C0=__builtin_amdgcn_mfma_f32_32x32x16_bf16(kf[0],qr[0],C0,0,0,0), P0[2],P0[3],P0[4],P0[5],     pw0[0]=PKW(P0,0), pw0[1]=PKW(P0,2), pw0); \
    BINIT1(C1,t); PIN(C1); SBAR(); GAPA(C1=__builtin_amdgcn_mfma_f32_32x32x16_bf16(kf[1],qr[0],C1,0,0,0), P0[6],P0[7],P0[8],P0[9],     pw0[2]=PKW(P0,4), pw0[3]=PKW(P0,6), pw0); \
    GAPA(C0=__builtin_amdgcn_mfma_f32_32x32x16_bf16(kf[2],qr[1],C0,0,0,0),   P0[10],P0[11],P0[12],P0[13], pw1[0]=PKW(P0,8), pw1[1]=PKW(P0,10), pw1); \
    GAPA(C1=__builtin_amdgcn_mfma_f32_32x32x16_bf16(kf[3],qr[1],C1,0,0,0),   P0[14],P0[15],P1[0],P1[1],   pw1[2]=PKW(P0,12),pw1[3]=PKW(P0,14), pw1); \
    VRD(0); SBAR(); GAPA(C0=__builtin_amdgcn_mfma_f32_32x32x16_bf16(kf[4],qr[2],C0,0,0,0),   P1[2],P1[3],P1[4],P1[5],     pw2[0]=PKW(P1,0), pw2[1]=PKW(P1,2), pw2); \
    VRD(1); SBAR(); GAPA(C1=__builtin_amdgcn_mfma_f32_32x32x16_bf16(kf[5],qr[2],C1,0,0,0),   P1[6],P1[7],P1[8],P1[9],     pw2[2]=PKW(P1,4), pw2[3]=PKW(P1,6), pw2); \
    VRD(2); SBAR(); GAPA(C0=__builtin_amdgcn_mfma_f32_32x32x16_bf16(kf[6],qr[3],C0,0,0,0),   P1[10],P1[11],P1[12],P1[13], pw3[0]=PKW(P1,8), pw3[1]=PKW(P1,10), pw3); \
    VRD(3); SBAR(); GAPA(C1=__builtin_amdgcn_mfma_f32_32x32x16_bf16(kf[7],qr[3],C1,0,0,0),   P1[14],P1[15],0.f,0.f,       pw3[2]=PKW(P1,12),pw3[3]=PKW(P1,14), pw3); \
    l_reg+=sacc; \
    if(GK){DMA_K((t)+3,sl_cur);} if(GV){DMA_V((t)+1,sl_next);} \
    CMASK(C0,C1,t); \
    { float a=MX3(C0[0],C0[1],C1[0]),b=MX3(C0[2],C0[3],C1[1]); a=MX3(a,C1[2],C1[3]); \
      _Pragma("unroll") for(int r=4;r<16;r+=4){a=MX3(a,C0[r],C0[r+1]);b=MX3(b,C0[r+2],C0[r+3]);a=MX3(a,C1[r],C1[r+1]);b=MX3(b,C1[r+2],C1[r+3]);} \
      float rm=__builtin_fmaxf(a,b); { auto rr=__builtin_amdgcn_permlane32_swap(__float_as_uint(rm),__float_as_uint(rm),false,false); rm=__builtin_fmaxf(__uint_as_float(rr[0]),__uint_as_float(rr[1])); } \
      resc=false; \
      if(__builtin_expect(__any(rm>(float)THRL),0)){ const float dl=__builtin_fmaxf(rm,0.f); nb-=dl; \
        _Pragma("unroll") for(int r=0;r<16;++r){C0[r]-=dl;C1[r]-=dl;} \
        const float f=__builtin_amdgcn_exp2f(-dl); l_reg*=f; if(hi==0)wsf[r32]=f; resc=true; } } \
    SBAR(); \
    GAPB(0,0,C0,0); GAPB(1,0,C0,2); GAPB(2,0,C0,4); GAPB(3,0,C0,6); \
    GAPB(4,1,C0,8); GAPB(5,1,C0,10); KRD(GL,0); GAPB(6,1,C0,12); GAPB(7,1,C0,14); \
    KRD(GL,1); GAPB(8,2,C1,0); GAPB(9,2,C1,2); KRD(GL,2); GAPB(10,2,C1,4); GAPB(11,2,C1,6); \
    KRD(GL,3); GAPB(12,3,C1,8); GAPB(13,3,C1,10); GAPB(14,3,C1,12); GAPB(15,3,C1,14); \
    }while(0)
  int t=1;
  #undef CMASK
  #define CMASK(P0,P1,t) do{}while(0)
  for(;t+5<NT;t+=2){
    STEP(pB0,pB1,pA0,pA1,t,true,true,true);     WAIT_BAR(3); RESC(); ROT();
    STEP(pA0,pA1,pB0,pB1,t+1,true,true,true);   WAIT_BAR(3); RESC(); ROT();
  }
  #undef CMASK
  #define CMASK(P0,P1,t) do{int jb_=(t)-(NT-4); if(jb_>=0)cmask(P0,P1,jb_,qrel,hi);}while(0)
  #define ENDW(tt) do{ if((tt)+3<NT){WAIT_BAR(3);} else if((tt)+2<NT){WAIT_BAR(2);} else {WAIT_BAR(0);} }while(0)
  for(;t+1<NT;t+=2){
    STEP(pB0,pB1,pA0,pA1,t,(t+3<NT),(t+1<NT),(t+1<NT));       ENDW(t);   RESC(); ROT();
    STEP(pA0,pA1,pB0,pB1,t+1,(t+4<NT),(t+2<NT),(t+2<NT));     ENDW(t+1); RESC(); ROT();
  }
  STEP(pB0,pB1,pA0,pA1,NT-1,false,false,false); RESC();
  { float sacc=pB0[0]+pB0[1]; _Pragma("unroll") for(int r=2;r<16;++r)sacc+=pB0[r]; _Pragma("unroll") for(int r=0;r<16;++r)sacc+=pB1[r]; l_reg+=sacc;
    pw0=(u32x4){PKW(pB0,0),PKW(pB0,2),PKW(pB0,4),PKW(pB0,6)};pw1=(u32x4){PKW(pB0,8),PKW(pB0,10),PKW(pB0,12),PKW(pB0,14)};pw2=(u32x4){PKW(pB1,0),PKW(pB1,2),PKW(pB1,4),PKW(pB1,6)};pw3=(u32x4){PKW(pB1,8),PKW(pB1,10),PKW(pB1,12),PKW(pB1,14)};
    SBAR(); pv(o,vb0+2*sl_cur,PAF(0),PAF(1),PAF(2),PAF(3)); }
  #undef PKW
  #undef PAF
  #undef VFR
  #undef PIN
  #undef MX3
  #undef GAPA
  #undef GAPB
  #undef EX
  #undef VRD
  #undef KRD
  #undef STEP
  #undef ENDW
  {auto rr=__builtin_amdgcn_permlane32_swap(__float_as_uint(l_reg),__float_as_uint(l_reg),false,false);l_reg=__uint_as_float(rr[0])+__uint_as_float(rr[1]);}
  if(hi==0)wsf[32+r32]=l_reg;asm volatile("s_waitcnt lgkmcnt(0)":::"memory");
  float rli[16];
  #pragma unroll
  for(int r=0;r<16;++r)rli[r]=__builtin_amdgcn_rcpf(wsf[32+crow(r,hi)]);
  bf16*Ow=O+(rowbase+q0+wid*QBLK)*DM+hh*VD;
  { bf16*stg=(bf16*)(shm+LDS_OST)+wid*4096;
    #pragma unroll
    for(int r=0;r<16;++r){const int orow=crow(r,hi);
      #pragma unroll
      for(int d0=0;d0<4;++d0)stg[orow*128+d0*32+r32]=__float2bfloat16(o[d0][r]*rli[r]);}
    asm volatile("s_waitcnt lgkmcnt(0)":::"memory");
    #pragma unroll
    for(int i=0;i<8;++i){const int row=i*4+(lane>>4),ch=lane&15; const u32x4 v=*(const u32x4*)(stg+row*128+ch*8); ATTN_STORE16(Ow+(long)row*DM+ch*8,v);} }
  asm volatile("s_waitcnt lgkmcnt(0)\n\ts_barrier":::"memory");
  #undef DMA_K
  #undef DMA_V
  #undef BINIT0
  #undef BINIT1
  #undef CMASK
  #undef START
  #undef RESC
  #undef ROT
}
constexpr int ATTN_LDS_BYTES=LDS_BYTES;
#undef SBAR
#undef WAIT_BAR
}
#define GAS __attribute__((address_space(1)))
#define LAS __attribute__((address_space(3)))
typedef unsigned short bf16;
typedef unsigned v4u __attribute__((ext_vector_type(4)));
typedef float f32x4 __attribute__((ext_vector_type(4)));
typedef short bf16x8 __attribute__((ext_vector_type(8)));
typedef GAS unsigned gu32;
typedef GAS unsigned long long gu64;
#define RLX_AGENT __ATOMIC_RELAXED, __HIP_MEMORY_SCOPE_AGENT
#define LDS_WAIT() asm volatile("s_waitcnt lgkmcnt(0)" ::: "memory")
#define VM_WAIT() asm volatile("s_waitcnt vmcnt(0)" ::: "memory")
__device__ __forceinline__ unsigned long long rt() { return __builtin_amdgcn_s_memrealtime(); }
__device__ __forceinline__ unsigned f2bf(float f) { unsigned u = __builtin_bit_cast(unsigned, f); return (u + 0x7fffu + ((u >> 16) & 1u)) >> 16; }
typedef float f32x2_pk __attribute__((ext_vector_type(2))); typedef __bf16 bf16x2_pk __attribute__((ext_vector_type(2)));
__device__ __forceinline__ unsigned pk2(float lo, float hi) { f32x2_pk v = {lo, hi}; bf16x2_pk b = __builtin_convertvector(v, bf16x2_pk); return __builtin_bit_cast(unsigned, b); }

#define XB_TMO      128
#define XB_XCNT(j)  (256  + 64 * (j))
#define XB_XSUB(j)  (1280 + 64 * (j))
#define XB_XGEN(j)  (2304 + 64 * (j))
#define XB_TOP      3328
#define XB_TOPGEN   3392
#define XCD_BAR_WORDS 3456
#define XB_SPIN_CAP (1u << 18)

__device__ __forceinline__ unsigned xb_ld(unsigned* p)              { return __hip_atomic_load(p, __ATOMIC_RELAXED, __HIP_MEMORY_SCOPE_AGENT); }
__device__ __forceinline__ unsigned xb_add(unsigned* p, unsigned v) { return __hip_atomic_fetch_add(p, v, __ATOMIC_RELAXED, __HIP_MEMORY_SCOPE_AGENT); }
__device__ __forceinline__ unsigned xb_xcc_id() { return (unsigned)__builtin_amdgcn_s_getreg((3 << 11) | 20) & 0xFu; }
#define XB_SPIN(cond, bar) do { unsigned _sp = 0; while (cond) { __builtin_amdgcn_s_sleep(1); \
    if ((++_sp & 255u) == 0u) { if (xb_ld(&(bar)[XB_TMO])) break; if (_sp > XB_SPIN_CAP) { atomicAdd(&(bar)[XB_TMO], 1u); break; } } } } while (0)

struct XcdBarrier {
    unsigned* bar; unsigned x;
    volatile LAS unsigned* st;
};

__device__ __forceinline__ XcdBarrier xcd_barrier_post(unsigned* bar, volatile LAS unsigned* st) {
    XcdBarrier b; b.bar = bar; b.x = xb_xcc_id(); b.st = st;
    if (threadIdx.x == 0) (void)xb_add(&bar[XB_XCNT(b.x)], 1u);
    return b;
}
__device__ __forceinline__ void xcd_barrier_complete(unsigned* bar, unsigned x, unsigned& nloc, unsigned& nx) {
    const unsigned G = gridDim.x * gridDim.y * gridDim.z;
    unsigned sum, cnt, mine, sp = 0u;
    for (;;) {
        sum = 0u; cnt = 0u; mine = 0u;
#pragma unroll
        for (unsigned j = 0; j < 16; ++j) { const unsigned c = xb_ld(&bar[XB_XCNT(j)]); sum += c; cnt += (c > 0u) ? 1u : 0u; mine = (j == x) ? c : mine; }
        if (sum == G) break;
        __builtin_amdgcn_s_sleep(1);
        if ((++sp & 255u) == 0u) { if (xb_ld(&bar[XB_TMO])) break; if (sp > XB_SPIN_CAP) { atomicAdd(&bar[XB_TMO], 1u); break; } }
    }
    nloc = mine > 0u ? mine : 1u; nx = cnt > 0u ? cnt : 1u;
}

__device__ __forceinline__ void xcd_barrier(const XcdBarrier& b) {
    asm volatile("s_waitcnt vmcnt(0)" ::: "memory");
    __syncthreads();
    if (threadIdx.x == 0) {
        unsigned* bar = b.bar;
        __builtin_amdgcn_s_waitcnt(0);
        unsigned nloc = b.st[0], nx = b.st[1];
        if (nloc == 0u) { xcd_barrier_complete(bar, b.x, nloc, nx); b.st[0] = nloc; b.st[1] = nx; }
        const unsigned old = xb_add(&bar[XB_XSUB(b.x)], 1u);
        const unsigned gen = old / nloc;
        if (old + 1u == (gen + 1u) * nloc) {
            __builtin_amdgcn_fence(__ATOMIC_RELEASE, "agent");
            asm volatile("s_waitcnt vmcnt(0)" ::: "memory");
            const unsigned og = xb_add(&bar[XB_TOP], 1u);
            const unsigned tg = og / nx;
            if (og + 1u == (tg + 1u) * nx) xb_add(&bar[XB_TOPGEN], 1u);
            else XB_SPIN(xb_ld(&bar[XB_TOPGEN]) == tg, bar);
            __builtin_amdgcn_fence(__ATOMIC_ACQUIRE, "agent");
            xb_add(&bar[XB_XGEN(b.x)], 1u);
            asm volatile("s_waitcnt vmcnt(0)" ::: "memory");
        } else {
            XB_SPIN(xb_ld(&bar[XB_XGEN(b.x)]) == gen, bar);
            __builtin_amdgcn_fence(__ATOMIC_ACQUIRE, "agent");
            asm volatile("s_waitcnt vmcnt(0)" ::: "memory");
        }
    }
    __syncthreads();
}
constexpr int NWAVES = 8;
constexpr int BATCH = 8, SEQ = 2048, DM = 2048, DEPTH = 2, M = BATCH * SEQ;
constexpr int HEADS = 8, IN_TOTAL = 10240, LRUW = 1024, NBLK = 8, BLKW = 128;
constexpr float LN_EPS = 1e-5f, SUBLN_EPS = 1e-5f, DN_ALPHA = 1.41421356237309515f, LOG2E = 1.4426950408889634f;

constexpr size_t MiB = 1u << 20;
constexpr size_t WS_CTL = 0, CTL_ZERO_BYTES = 1 * MiB;
constexpr size_t WS_GW = 1 * MiB;
constexpr int N_BF = 6144, N_F8 = 4096;
constexpr float W8_SCALE = 64.f;
constexpr size_t WS_WIN = 2 * MiB;
constexpr size_t WS_WG8 = 50 * MiB;
constexpr size_t WS_XQ8 = 66 * MiB;
constexpr size_t WS_WPAB = 98 * MiB;
constexpr size_t WS_WOUT = 114 * MiB;
constexpr size_t WS_XB16 = 130 * MiB;
constexpr size_t WS_O1 = 130 * MiB, WS_O2 = 162 * MiB, WS_MERGED = 130 * MiB;
constexpr size_t WS_P6 = 194 * MiB;
constexpr size_t WS_MA = 386 * MiB, WS_MB = 450 * MiB;
constexpr size_t WS_AR = 514 * MiB;
constexpr size_t WS_END = 578 * MiB;
constexpr int CW_TMO = 0, CW_BAR = 4096;

constexpr int RING_OFF = 0, RING_BYTES = 151552;
constexpr int LDSCTL_OFF = RING_BYTES, MISC_OFF = LDSCTL_OFF + 320;
constexpr int LDS_BYTES = 153600;
static_assert(MISC_OFF + 128 <= LDS_BYTES && attn_body::ATTN_LDS_BYTES <= RING_BYTES && pg8::STAGE_BYTES <= RING_BYTES, "LDS map");

struct Frame {
    LAS unsigned char* lds; volatile LAS unsigned* MISC; gu32* ctl;
    int tid, lane, wave, vcu, G;
};
__device__ __forceinline__ float wave_sum(float v, int lane) {
#pragma unroll
    for (int o = 1; o < 64; o <<= 1) v += __int_as_float(__builtin_amdgcn_ds_bpermute((lane ^ o) << 2, __float_as_int(v)));
    return v;
}
__device__ __forceinline__ void p0_transpose_item(const float* W, int ldw, int ncols, bf16* WT, int ldt, int koff, LAS float* scr, int item, int lane) {
    const int nblk = ncols / 32, kb = item / nblk, nb = item % nblk, k0 = 64 * kb, n0 = 32 * nb;
#pragma unroll 8
    for (int i = 0; i < 32; ++i) { const int kk = 2 * i + (lane >> 5); scr[kk * 33 + (lane & 31)] = W[(size_t)(k0 + kk) * ldw + n0 + (lane & 31)]; }
    LDS_WAIT(); asm volatile("" ::: "memory");
    const int c = lane & 7;
#pragma unroll
    for (int j = 0; j < 4; ++j) { const int n = (lane >> 3) + 8 * j; const LAS float* s = scr + (8 * c) * 33 + n;
        v4u o; o.x = pk2(s[0 * 33], s[1 * 33]); o.y = pk2(s[2 * 33], s[3 * 33]); o.z = pk2(s[4 * 33], s[5 * 33]); o.w = pk2(s[6 * 33], s[7 * 33]);
        *(GAS v4u*)(WT + (size_t)(n0 + n) * ldt + koff + k0 + 8 * c) = o; }
    LDS_WAIT(); asm volatile("" ::: "memory");
}
__device__ __forceinline__ unsigned pk4_fp8(float a, float b, float c, float d) { int w = __builtin_amdgcn_cvt_pk_fp8_f32(a, b, 0, false); w = __builtin_amdgcn_cvt_pk_fp8_f32(c, d, w, true); return (unsigned)w; }
__device__ __forceinline__ void p0_transpose_item8(const float* W, int ldw, int ncols, unsigned char* WT8, int ldt, float scale, LAS float* scr, int item, int lane) {
    const int nblk = ncols / 32, kb = item / nblk, nb = item % nblk, k0 = 64 * kb, n0 = 32 * nb;
#pragma unroll 8
    for (int i = 0; i < 32; ++i) { const int kk = 2 * i + (lane >> 5); scr[kk * 33 + (lane & 31)] = W[(size_t)(k0 + kk) * ldw + n0 + (lane & 31)] * scale; }
    LDS_WAIT(); asm volatile("" ::: "memory");
    const int c = lane & 3;
#pragma unroll
    for (int j = 0; j < 2; ++j) { const int n = (lane >> 2) + 16 * j; const LAS float* s = scr + (16 * c) * 33 + n;
        v4u o; o.x = pk4_fp8(s[0 * 33], s[1 * 33], s[2 * 33], s[3 * 33]); o.y = pk4_fp8(s[4 * 33], s[5 * 33], s[6 * 33], s[7 * 33]);
        o.z = pk4_fp8(s[8 * 33], s[9 * 33], s[10 * 33], s[11 * 33]); o.w = pk4_fp8(s[12 * 33], s[13 * 33], s[14 * 33], s[15 * 33]);
        *(GAS v4u*)(WT8 + (size_t)(n0 + n) * ldt + k0 + 16 * c) = o; }
    LDS_WAIT(); asm volatile("" ::: "memory");
}
struct Args { const float* in[19]; float* out; unsigned char* ws; int ph_lo, ph_hi; };

__device__ __forceinline__ void p0_prologue(Frame& F, const Args& a) {
    LAS float* scr = (LAS float*)(F.lds + RING_OFF + F.wave * 16384);
    const int gw = F.vcu * NWAVES + F.wave, NGW = F.G * NWAVES;
    constexpr int I_IN = (DM / 64) * (N_BF / 32), I_G8 = (DM / 64) * (N_F8 / 32), I_P = (1024 / 64) * (DM / 32), I_O = (DM / 64) * (DM / 32), I_L = I_IN + I_G8 + 2 * I_P + I_O;
    for (int it = gw; it < DEPTH * I_L; it += NGW) {
        const int l = it / I_L; int r = it % I_L;
        bf16* win = (bf16*)(a.ws + WS_WIN) + (size_t)l * N_BF * DM; bf16* wpab = (bf16*)(a.ws + WS_WPAB) + (size_t)l * DM * DM; bf16* wout = (bf16*)(a.ws + WS_WOUT) + (size_t)l * DM * DM;
        if (r < I_IN) { p0_transpose_item(a.in[1] + (size_t)l * DM * IN_TOTAL, IN_TOTAL, N_BF, win, DM, 0, scr, r, F.lane); continue; } r -= I_IN;
        if (r < I_G8) { p0_transpose_item8(a.in[1] + (size_t)l * DM * IN_TOTAL + N_BF, IN_TOTAL, N_F8, a.ws + WS_WG8 + (size_t)l * N_F8 * DM, DM, W8_SCALE, scr, r, F.lane); continue; } r -= I_G8;
        if (r < I_P) { p0_transpose_item(a.in[14] + (size_t)l * 1024 * DM, DM, DM, wpab, DM, 0, scr, r, F.lane); continue; } r -= I_P;
        if (r < I_P) { p0_transpose_item(a.in[15] + (size_t)l * 1024 * DM, DM, DM, wpab, DM, 1024, scr, r, F.lane); continue; } r -= I_P;
        p0_transpose_item(a.in[16] + (size_t)l * DM * DM, DM, DM, wout, DM, 0, scr, r, F.lane);
    }
    for (int it = gw; it < DEPTH * NBLK * 4 * 2 * 8; it += NGW) {
        const int s_ = it & 7, g_ = (it >> 3) & 1, jq = (it >> 4) & 3, n = (it >> 6) & 7, l = it >> 9;
        const float* w = a.in[g_ ? 6 : 4] + ((size_t)(l * NBLK + n) * BLKW + 16 * s_ + 8 * (F.lane >> 5)) * BLKW + jq * 32 + (F.lane & 31);
        v4u o; o.x = pk2(w[0], w[BLKW]); o.y = pk2(w[2 * BLKW], w[3 * BLKW]); o.z = pk2(w[4 * BLKW], w[5 * BLKW]); o.w = pk2(w[6 * BLKW], w[7 * BLKW]);
        *(GAS v4u*)((bf16*)(a.ws + WS_GW) + (size_t)it * 512 + F.lane * 8) = o; }
    bf16* xb = (bf16*)(a.ws + WS_XB16); const float* x = a.in[0];
    for (int m = gw; m < M; m += NGW) {
        const GAS f32x4* xr = (const GAS f32x4*)(x + (size_t)m * DM) + F.lane; GAS unsigned long long* o8 = (GAS unsigned long long*)(xb + (size_t)m * DM) + F.lane;
        GAS unsigned* q8 = (GAS unsigned*)(a.ws + WS_XQ8 + (size_t)m * DM) + F.lane;
#pragma unroll
        for (int j = 0; j < 8; ++j) { const f32x4 v = xr[64 * j]; o8[64 * j] = (unsigned long long)pk2(v.x, v.y) | ((unsigned long long)pk2(v.z, v.w) << 32); q8[64 * j] = pk4_fp8(v.x, v.y, v.z, v.w); }
    }
}
__device__ __forceinline__ void ln_phase(Frame& F, float* y, bf16* xb, unsigned char* xq8, const float* g, const float* bta) {
    const int gw = F.vcu * NWAVES + F.wave, NGW = F.G * NWAVES; int lane = F.lane; asm volatile("" : "+v"(lane));
    for (int m = gw; m < M; m += NGW) {
        GAS f32x4* yr = (GAS f32x4*)(y + (size_t)m * DM) + lane; f32x4 v[8]; float s = 0.f;
#pragma unroll
        for (int j = 0; j < 8; ++j) { v[j] = yr[64 * j]; s += (v[j].x + v[j].y) + (v[j].z + v[j].w); }
        const float mean = wave_sum(s, lane) * (1.f / DM); float s2 = 0.f;
#pragma unroll
        for (int j = 0; j < 8; ++j) { v[j] = v[j] - mean; s2 += (v[j].x * v[j].x + v[j].y * v[j].y) + (v[j].z * v[j].z + v[j].w * v[j].w); }
        const float rstd = 1.f / sqrtf(wave_sum(s2, lane) * (1.f / DM) + LN_EPS);
        GAS unsigned long long* o8 = (GAS unsigned long long*)(xb + (size_t)m * DM) + lane; GAS unsigned* q8 = (GAS unsigned*)(xq8 + (size_t)m * DM) + lane;
#pragma unroll
        for (int j = 0; j < 8; ++j) { const f32x4 gg = *((const GAS f32x4*)g + lane + 64 * j), bb = *((const GAS f32x4*)bta + lane + 64 * j);
            const f32x4 o = v[j] * rstd * gg + bb; yr[64 * j] = o; o8[64 * j] = (unsigned long long)pk2(o.x, o.y) | ((unsigned long long)pk2(o.z, o.w) << 32); q8[64 * j] = pk4_fp8(o.x, o.y, o.z, o.w); }
    }
}
__device__ __forceinline__ void combine_block(Frame& F, int b, int h, int qb, const bf16* O1, const bf16* O2, const bf16* GA, bf16* AR, const float* subln_g, float lam, float lam_init) {
    typedef short s16x8 __attribute__((ext_vector_type(8)));
    int tid = F.tid; asm volatile("" : "+v"(tid));
#pragma unroll 1
    for (int it = 0; it < 4; ++it) {
        const int idx = tid + 512 * it, row = b * SEQ + qb * 256 + (idx >> 3), c16 = idx & 7, col = h * 128 + c16 * 16;
        const size_t off = (size_t)row * 1024 + col;
        const s16x8 a0 = *(const GAS s16x8*)(O1 + off), a1 = *(const GAS s16x8*)(O1 + off + 8), b0 = *(const GAS s16x8*)(O2 + off), b1 = *(const GAS s16x8*)(O2 + off + 8);
        const s16x8 g0 = *(const GAS s16x8*)(GA + off), g1 = *(const GAS s16x8*)(GA + off + 8);
        float o[16]; float ss = 0.f;
#pragma unroll
        for (int j = 0; j < 8; ++j) { o[j] = pg8::bfbits2f(a0[j]) - lam * pg8::bfbits2f(b0[j]); o[8 + j] = pg8::bfbits2f(a1[j]) - lam * pg8::bfbits2f(b1[j]); }
#pragma unroll
        for (int j = 0; j < 16; ++j) ss += o[j] * o[j];
        ss += __int_as_float(__builtin_amdgcn_ds_swizzle(__float_as_int(ss), 0x041f)); ss += __int_as_float(__builtin_amdgcn_ds_swizzle(__float_as_int(ss), 0x081f)); ss += __int_as_float(__builtin_amdgcn_ds_swizzle(__float_as_int(ss), 0x101f));
        const float rn = (1.f / sqrtf(ss * (1.f / 128.f) + SUBLN_EPS)) * (1.f - lam_init);
        unsigned w[8];
#pragma unroll
        for (int j = 0; j < 8; ++j) {
            const float ga0 = pg8::bfbits2f(j < 4 ? g0[2 * j] : g1[2 * j - 8]), ga1 = pg8::bfbits2f(j < 4 ? g0[2 * j + 1] : g1[2 * j - 7]);
            const float v0 = o[2 * j] * rn * subln_g[c16 * 16 + 2 * j] * (ga0 / (1.f + __expf(-ga0))), v1 = o[2 * j + 1] * rn * subln_g[c16 * 16 + 2 * j + 1] * (ga1 / (1.f + __expf(-ga1)));
            w[j] = pk2(v0, v1); }
        bf16* op = AR + (size_t)row * 2048 + col;
        *(GAS v4u*)op = (v4u){w[0], w[1], w[2], w[3]}; *(GAS v4u*)(op + 8) = (v4u){w[4], w[5], w[6], w[7]};
    }
}
constexpr int LRU_TM = 256, XCS_PITCH = 272, LRU_XCS = 0, LRU_AS = LRU_XCS + LRU_TM * XCS_PITCH, LRU_US = LRU_AS + LRU_TM * 32 * 4, LRU_AH = LRU_US + LRU_TM * 32 * 4, LRU_CARRY = LRU_AH + 16 * 32 * 8, LRU_WI = LRU_CARRY + 2 * 32 * 4, LRU_CW = LRU_WI + 8 * 64 * 16, LRU_END = LRU_CW + 5 * 128 * 4;
static_assert(LRU_END <= RING_BYTES, "LRU LDS map");
constexpr size_t GW_ITEM = 2 * 8 * 64 * 8;
#define LBAR() asm volatile("s_waitcnt lgkmcnt(0)\n\ts_barrier" ::: "memory")
__device__ __forceinline__ void lru_item(Frame& F, int b, int n, int jq, const bf16* XB, const bf16* GB, bf16* AR, const float* conv_w, const float* conv_b, const bf16* gwf, const float* b_r,
                                         const float* b_i, const float* lam) {
    typedef short s16x8 __attribute__((ext_vector_type(8))); typedef float f32x16 __attribute__((ext_vector_type(16))); typedef float f32x2 __attribute__((ext_vector_type(2)));
    LAS unsigned char* L = F.lds + RING_OFF;
    int tid = F.tid; asm volatile("" : "+v"(tid));
    const int lane = tid & 63, wave = F.wave, r32 = lane & 31, hi = lane >> 5;
    const int ch8 = tid & 15, tq = tid >> 4;
    const int cch = n * BLKW + jq * 32 + r32;
    s16x8 wfr[8];
#pragma unroll
    for (int s = 0; s < 8; ++s) wfr[s] = *(const GAS s16x8*)(gwf + (size_t)(s * 64 + lane) * 8);
    *(LAS s16x8*)(L + LRU_WI + tid * 16) = *(const GAS s16x8*)(gwf + (size_t)(8 * 64 + tid) * 8);
    const float bias_r = b_r[cch], bias_i = b_i[cch], lc = -8.f * log1pf(__expf(-lam[cch])), lc2 = lc * LOG2E;
    if (tid < 64) ((LAS float*)(L + LRU_CARRY))[tid] = 0.f;
    const bf16* xbase = XB + (size_t)b * SEQ * 1024 + n * BLKW + ch8 * 8;
    if (tid < 128) { LAS float* cwl = (LAS float*)(L + LRU_CW); cwl[tid] = conv_b[n * BLKW + tid];
#pragma unroll
        for (int j = 0; j < 4; ++j) cwl[(1 + j) * 128 + tid] = conv_w[j * LRUW + n * BLKW + tid]; }
    s16x8 xq[2][7];
#define LRU_LOADX(t0_) do { _Pragma("unroll") for (int g = 0; g < 2; ++g) _Pragma("unroll") for (int rr = 0; rr < 7; ++rr) { const int t = (t0_) + (tq + 32 * g) * 4 - 3 + rr; \
        xq[g][rr] = (t >= 0) ? *(const GAS s16x8*)(xbase + (size_t)t * 1024) : (s16x8){0, 0, 0, 0, 0, 0, 0, 0}; } } while (0)
    LRU_LOADX(0);
    LBAR();
#pragma unroll 1
    for (int ms = 0; ms < SEQ / LRU_TM; ++ms) {
        const int t0 = ms * LRU_TM;
        {
            float cw[4][8], cb[8];
            { unsigned cwb = (unsigned)(LRU_CW + ch8 * 32); asm volatile("" : "+v"(cwb));
              const f32x4 b0 = *(const LAS f32x4*)(L + cwb), b1 = *(const LAS f32x4*)(L + cwb + 16);
              cb[0] = b0.x; cb[1] = b0.y; cb[2] = b0.z; cb[3] = b0.w; cb[4] = b1.x; cb[5] = b1.y; cb[6] = b1.z; cb[7] = b1.w;
#pragma unroll
              for (int j = 0; j < 4; ++j) { const f32x4 w0 = *(const LAS f32x4*)(L + cwb + (1 + j) * 512), w1 = *(const LAS f32x4*)(L + cwb + (1 + j) * 512 + 16);
                  cw[j][0] = w0.x; cw[j][1] = w0.y; cw[j][2] = w0.z; cw[j][3] = w0.w; cw[j][4] = w1.x; cw[j][5] = w1.y; cw[j][6] = w1.z; cw[j][7] = w1.w; } }
            unsigned s1b = (unsigned)(LRU_XCS + tq * 4 * XCS_PITCH + ch8 * 16); asm volatile("" : "+v"(s1b));
#pragma unroll
            for (int g = 0; g < 2; ++g) {
                unsigned w[4][4];
#pragma unroll
                for (int i2 = 0; i2 < 4; ++i2) {
                    float x0[7], x1[7];
#pragma unroll
                    for (int rr = 0; rr < 7; ++rr) { const unsigned d = ((const unsigned*)&xq[g][rr])[i2]; x0[rr] = __uint_as_float(d << 16); x1[rr] = __uint_as_float(d & 0xffff0000u); }
#pragma unroll
                    for (int q = 0; q < 4; ++q) {
                        const float v0 = cb[2 * i2] + cw[0][2 * i2] * x0[q] + cw[1][2 * i2] * x0[q + 1] + cw[2][2 * i2] * x0[q + 2] + cw[3][2 * i2] * x0[q + 3];
                        const float v1 = cb[2 * i2 + 1] + cw[0][2 * i2 + 1] * x1[q] + cw[1][2 * i2 + 1] * x1[q + 1] + cw[2][2 * i2 + 1] * x1[q + 2] + cw[3][2 * i2 + 1] * x1[q + 3];
                        w[q][i2] = pk2(v0, v1); }
                    asm volatile("" : "+v"(w[0][i2]), "+v"(w[1][i2]), "+v"(w[2][i2]), "+v"(w[3][i2]));
                }
#pragma unroll
                for (int q = 0; q < 4; ++q) *(LAS v4u*)(L + s1b + (32 * g * 4 + q) * XCS_PITCH) = (v4u){w[q][0], w[q][1], w[q][2], w[q][3]};
            }
        }
        if (ms + 1 < SEQ / LRU_TM) LRU_LOADX(t0 + LRU_TM);
        LBAR();
        {
            f32x16 ar, ai;
#pragma unroll
            for (int r = 0; r < 16; ++r) { ar[r] = bias_r; ai[r] = bias_i; }
            unsigned s2a = (unsigned)(LRU_XCS + (32 * wave + r32) * XCS_PITCH + hi * 16), s2i = (unsigned)(LRU_WI + lane * 16); asm volatile("" : "+v"(s2a), "+v"(s2i));
#pragma unroll
            for (int s = 0; s < 8; ++s) { const s16x8 af = *(const LAS s16x8*)(L + s2a + s * 32), wi = *(const LAS s16x8*)(L + s2i + s * 1024);
                ar = __builtin_amdgcn_mfma_f32_32x32x16_bf16(af, wfr[s], ar, 0, 0, 0); ai = __builtin_amdgcn_mfma_f32_32x32x16_bf16(af, wi, ai, 0, 0, 0); }
            unsigned s2x = (unsigned)(LRU_XCS + (32 * wave + 4 * hi) * XCS_PITCH + (jq * 32 + r32) * 2), s2w = (unsigned)((32 * wave + 4 * hi) * 128 + r32 * 4); asm volatile("" : "+v"(s2x), "+v"(s2w));
#pragma unroll
            for (int r = 0; r < 16; ++r) { const int cr = (r & 3) + 8 * (r >> 2);
                const float rg = __builtin_amdgcn_rcpf(1.f + __builtin_amdgcn_exp2f(-LOG2E * ar[r])), ig = __builtin_amdgcn_rcpf(1.f + __builtin_amdgcn_exp2f(-LOG2E * ai[r]));
                const float av = __builtin_amdgcn_exp2f(lc2 * rg), t = 2.f * lc * rg;
                const float ser = -t * (1.f + t * (0.5f + t * (0.16666667f + t * (0.041666668f + t * 0.0083333338f))));
                const float om = (t > -0.1f) ? ser : (1.f - av * av);
                const float xc = __uint_as_float(((unsigned)*(const LAS unsigned short*)(L + s2x + cr * XCS_PITCH)) << 16);
                const float uv = __builtin_amdgcn_sqrtf(om) * (ig * xc);
                *(LAS float*)(L + LRU_AS + s2w + cr * 128) = av; *(LAS float*)(L + LRU_US + s2w + cr * 128) = uv; }
        }
        LBAR();
        s16x8 gbv[2];
#pragma unroll
        for (int g = 0; g < 2; ++g) { const int idx = tid + 512 * g, tl = idx >> 2, c8 = idx & 3; gbv[g] = *(const GAS s16x8*)(GB + ((size_t)b * SEQ + t0 + tl) * 1024 + n * BLKW + jq * 32 + c8 * 8); }
        {
            const int sc = tid >> 5, o = tid & 31; unsigned s3b = (unsigned)(((sc * 16) * 32 + o) * 4); asm volatile("" : "+v"(s3b));
            LAS float* as = (LAS float*)(L + LRU_AS + s3b); LAS float* us = (LAS float*)(L + LRU_US + s3b);
            float a[16], u[16];
#pragma unroll
            for (int i = 0; i < 16; ++i) { a[i] = as[i * 32]; u[i] = us[i * 32]; }
            float A = 1.f, H = 0.f;
#pragma unroll
            for (int i = 0; i < 16; ++i) { H = a[i] * H + u[i]; A *= a[i]; }
            unsigned s3o = (unsigned)(LRU_AH + o * 8); asm volatile("" : "+v"(s3o));
            *(LAS f32x2*)(L + s3o + sc * 256) = (f32x2){A, H};
            LBAR();
            float h = ((LAS float*)(L + LRU_CARRY))[(ms & 1) * 32 + o];
            f32x2 p[15];
#pragma unroll
            for (int s2 = 0; s2 < 15; ++s2) p[s2] = *(const LAS f32x2*)(L + s3o + s2 * 256);
#pragma unroll
            for (int s2 = 0; s2 < 15; ++s2) h = (s2 < sc) ? p[s2].x * h + p[s2].y : h;
#pragma unroll
            for (int i = 0; i < 16; ++i) { h = a[i] * h + u[i]; us[i * 32] = h; }
            if (sc == 15) ((LAS float*)(L + LRU_CARRY))[((ms + 1) & 1) * 32 + o] = h;
        }
        LBAR();
#pragma unroll
        for (int g = 0; g < 2; ++g) { const int idx = tid + 512 * g, tl = idx >> 2, c8 = idx & 3; const size_t row = (size_t)b * SEQ + t0 + tl; const int col = n * BLKW + jq * 32 + c8 * 8;
            unsigned s4b = (unsigned)(LRU_US + (tl * 32 + c8 * 8) * 4); asm volatile("" : "+v"(s4b));
            const f32x4 h0 = *(const LAS f32x4*)(L + s4b), h1 = *(const LAS f32x4*)(L + s4b + 16);
            const s16x8 gv = gbv[g]; float hv[8] = {h0.x, h0.y, h0.z, h0.w, h1.x, h1.y, h1.z, h1.w}; unsigned w[4];
#pragma unroll
            for (int i2 = 0; i2 < 4; ++i2) { const float g0 = pg8::bfbits2f(gv[2 * i2]), g1 = pg8::bfbits2f(gv[2 * i2 + 1]);
                w[i2] = pk2(hv[2 * i2] * g0 * __builtin_amdgcn_rcpf(1.f + __builtin_amdgcn_exp2f(-LOG2E * g0)), hv[2 * i2 + 1] * g1 * __builtin_amdgcn_rcpf(1.f + __builtin_amdgcn_exp2f(-LOG2E * g1))); }
            *(GAS v4u*)(AR + row * 2048 + 1024 + col) = (v4u){w[0], w[1], w[2], w[3]}; }
    }
#undef LRU_LOADX
    LBAR();
}

#ifndef MK_DBL
#define MK_DBL 0
#endif
#define DBL(k) for (int rep_ = 0; rep_ < 1 + ((MK_DBL >> (k)) & 1); ++rep_)
constexpr int N_PH_LAYER = 5, N_PHASES = 1 + DEPTH * N_PH_LAYER;
__global__ void __launch_bounds__(NWAVES * 64, 2) mk_fwd(Args args) {
    extern __shared__ __attribute__((aligned(16))) unsigned char lds[];
    Frame F;
    F.lds = (LAS unsigned char*)lds; F.MISC = (volatile LAS unsigned*)(F.lds + MISC_OFF);
    F.tid = threadIdx.x; F.lane = F.tid & 63; F.wave = __builtin_amdgcn_readfirstlane(F.tid >> 6);
    F.G = gridDim.x; { const int bx = blockIdx.x; F.vcu = (F.G % 8 == 0) ? (bx % 8) * (F.G / 8) + bx / 8 : bx; }
    F.ctl = (gu32*)(args.ws + WS_CTL);
    for (int u = F.tid; u < (LDS_BYTES - LDSCTL_OFF) / 4; u += NWAVES * 64) ((LAS unsigned*)(F.lds + LDSCTL_OFF))[u] = 0u;
    __syncthreads();
    const int lo = args.ph_lo, hi = args.ph_hi;
    const bool use_bar = (hi - lo) > 1;
    XcdBarrier bar; bar.bar = (unsigned*)(F.ctl + CW_BAR); bar.x = 0; bar.st = nullptr;
    if (use_bar) bar = xcd_barrier_post((unsigned*)(F.ctl + CW_BAR), F.MISC + 8);
#define IN(k) (lo <= (k) && (k) < hi)
#define SEAM(k) do { if (IN(k) && IN((k) + 1)) xcd_barrier(bar); } while (0)
#define CAS __attribute__((address_space(4)))
    typedef unsigned char* ucp_t; typedef float* fp_t; typedef const float* cfp_t;
#define KARGS() CAS const char* ka_ = (CAS const char*)__builtin_amdgcn_kernarg_segment_ptr(); asm volatile("" : "+s"(ka_)); unsigned char* const ws = *(CAS const ucp_t*)(ka_ + 160); float* const outp = *(CAS const fp_t*)(ka_ + 152); (void)outp; (void)ws
#define KIN(k) (*(CAS const cfp_t*)(ka_ + 8 * (k)))
#define WSP(off) ((bf16*)(ws + (off)))
    if (IN(0)) { DBL(0) p0_prologue(F, args); } SEAM(0);
#pragma unroll 1
    for (int l = 0; l < DEPTH; ++l) {
        const int pb = 1 + l * N_PH_LAYER;
        const float lam_init = 0.8f - 0.6f * __expf(-0.3f * (float)l);
        if (IN(pb)) {
            KARGS(); bf16* const P6 = WSP(WS_P6); bf16* const MA = WSP(WS_MA); bf16* const MB = WSP(WS_MB);
            { pg8::Gemm g{WSP(WS_XB16), WSP(WS_WIN) + (size_t)l * N_BF * DM, M, N_BF, DM}; pg8::StaticOrder S; S.init(M, N_BF, F.G, (int)blockIdx.x);
              pg8::EpiProj E{P6, MA, MB, (size_t)M * 1024, attn_body::C2, 0, 1.f};
              DBL(1) pg8::gemm_phase<pg8::EpiProj, pg8::StaticOrder, PG8_ALIGN, PG8_SP2>(F.lds + RING_OFF, g, S, E); }
            { pg8::Gemm g{(const pg8::bf16_t*)(ws + WS_XQ8), (const pg8::bf16_t*)(ws + WS_WG8 + (size_t)l * N_F8 * DM), M, N_F8, DM / 2}; pg8::StaticOrder S; S.init(M, N_F8, F.G, (int)blockIdx.x);
              pg8::EpiProj E{P6, MA, MB, (size_t)M * 1024, attn_body::C2, 24, 1.f / W8_SCALE};
              DBL(1) pg8::gemm_phase<pg8::EpiProj, pg8::StaticOrder, PG8_ALIGN, PG8_SP2, true>(F.lds + RING_OFF, g, S, E); }
        }
        SEAM(pb);
        if (IN(pb + 1)) {
            KARGS(); bf16* const P6 = WSP(WS_P6); bf16* const O1 = WSP(WS_O1); bf16* const O2 = WSP(WS_O2); bf16* const AR = WSP(WS_AR);
            bf16* const Qb = P6; bf16* const Kb = P6 + (size_t)M * 1024; bf16* const Vb = P6 + (size_t)2 * M * 1024; bf16* const GA = P6 + (size_t)3 * M * 1024; bf16* const XBb = P6 + (size_t)4 * M * 1024; bf16* const GBb = P6 + (size_t)5 * M * 1024;
            int ln_ = F.lane; asm volatile("" : "+v"(ln_));
            float d1 = KIN(9)[l * 64 + ln_] * KIN(10)[l * 64 + ln_], d2 = KIN(11)[l * 64 + ln_] * KIN(12)[l * 64 + ln_];
            d1 = wave_sum(d1, ln_); d2 = wave_sum(d2, ln_);
            const float lam = __uint_as_float(__builtin_amdgcn_readfirstlane(__float_as_uint(__expf(d1) - __expf(d2) + lam_init)));
            const int bh = F.vcu >> 2, p = F.vcu & 3, b = bh >> 3, h = bh & 7;
            const float slope2 = exp2f(-(float)(h + 1)) * LOG2E;
            if (F.G == 256) {
#pragma unroll 1
                for (int i = 0; i < 2; ++i) {
                    const int qb = i ? (7 - p) : p;
#pragma unroll 1
                    DBL(2) for (int c = 0; c < 2; ++c) {
                        attn_body::attn_unit<8>(b, 2 * h + c, h, qb, slope2, (const attn_body::bf16*)Qb, (const attn_body::bf16*)Kb, (const attn_body::bf16*)Vb, (attn_body::bf16*)(c ? O2 : O1), (char*)lds + RING_OFF);
                    }
                    VM_WAIT(); __syncthreads();
                    DBL(6) combine_block(F, b, h, qb, O1, O2, GA, AR, KIN(13) + l * 128, lam, lam_init);
                }
                DBL(3) lru_item(F, F.vcu >> 5, (F.vcu >> 2) & 7, F.vcu & 3, XBb, GBb, AR, KIN(2) + (size_t)l * 4 * LRUW, KIN(3) + l * LRUW,
                         (const bf16*)(ws + WS_GW) + ((size_t)(l * NBLK + ((F.vcu >> 2) & 7)) * 4 + (F.vcu & 3)) * GW_ITEM, KIN(5) + l * LRUW, KIN(7) + l * LRUW, KIN(8) + l * LRUW);
            }
        }
        SEAM(pb + 1);
        if (IN(pb + 2)) {
            KARGS();
            pg8::Gemm g{WSP(WS_AR), WSP(WS_WPAB) + (size_t)l * DM * DM, M, DM, DM}; pg8::StaticOrder S; S.init(M, DM, F.G, (int)blockIdx.x);
            pg8::EpiMerge E{WSP(WS_MA), WSP(WS_MB), WSP(WS_MERGED)};
            DBL(4) pg8::gemm_phase<pg8::EpiMerge, pg8::StaticOrder, PG8_ALIGN, PG8_SP2>(F.lds + RING_OFF, g, S, E);
        }
        SEAM(pb + 2);
        if (IN(pb + 3)) {
            KARGS();
            pg8::Gemm g{WSP(WS_MERGED), WSP(WS_WOUT) + (size_t)l * DM * DM, M, DM, DM}; pg8::StaticOrder S; S.init(M, DM, F.G, (int)blockIdx.x);
            pg8::EpiRes E{l == 0 ? KIN(0) : outp, outp, DN_ALPHA};
            for (int rep_ = 0; rep_ < 1 + (((MK_DBL >> 5) & 1) && l == 0); ++rep_) pg8::gemm_phase<pg8::EpiRes, pg8::StaticOrder, PG8_ALIGN, PG8_SP2>(F.lds + RING_OFF, g, S, E);
        }
        SEAM(pb + 3);
        if (IN(pb + 4)) { KARGS(); ln_phase(F, outp, WSP(WS_XB16), ws + WS_XQ8, KIN(17) + l * DM, KIN(18) + l * DM); }
        SEAM(pb + 4);
    }
#undef IN
#undef SEAM
#undef KARGS
#undef KIN
#undef WSP
#undef CAS
}

#ifndef MK_PER_PHASE
#define MK_PER_PHASE 0
#endif
extern "C" void kernel_launch(void* const* d_in, const int* in_sizes, int n_in, void* d_out, int out_size, void* d_ws, size_t ws_size, hipStream_t stream) {
    static int grid = 0;
    if (grid == 0) {
        if (n_in != 19 || in_sizes[0] != M * DM || out_size != M * DM || ws_size < WS_END) { fprintf(stderr, "kernel_launch: unexpected shapes / workspace (n_in %d, ws %zu); nothing launched\n", n_in, ws_size); grid = -1; return; }
        int dev = 0, cus = 0;
        if (hipGetDevice(&dev) != hipSuccess || hipDeviceGetAttribute(&cus, hipDeviceAttributeMultiprocessorCount, dev) != hipSuccess) { grid = -1; return; }
        if (hipFuncSetAttribute((const void*)mk_fwd, hipFuncAttributeMaxDynamicSharedMemorySize, LDS_BYTES) != hipSuccess) { fprintf(stderr, "kernel_launch: hipFuncSetAttribute failed\n"); grid = -1; return; }
        int per_cu = 0;
        if (hipOccupancyMaxActiveBlocksPerMultiprocessor(&per_cu, (const void*)mk_fwd, NWAVES * 64, LDS_BYTES) != hipSuccess || per_cu < 1) fprintf(stderr, "kernel_launch: occupancy query reports %d blocks per CU\n", per_cu);
        (void)hipGetLastError();
        grid = cus;
        if (grid != 256) fprintf(stderr, "kernel_launch: %d CUs; the attention/LRU phase is built for 256\n", grid);
    }
    if (grid < 0) return;
    if (hipMemsetAsync((char*)d_ws + WS_CTL, 0, CTL_ZERO_BYTES, stream) != hipSuccess) return;
    Args a{};
    for (int i = 0; i < 19; ++i) a.in[i] = (const float*)d_in[i];
    a.out = (float*)d_out; a.ws = (unsigned char*)d_ws;
#if MK_PER_PHASE
    for (int p = 0; p < N_PHASES; ++p) { a.ph_lo = p; a.ph_hi = p + 1; hipLaunchKernelGGL(mk_fwd, dim3(grid), dim3(NWAVES * 64), LDS_BYTES, stream, a); }
#else
    a.ph_lo = 0; a.ph_hi = N_PHASES;
    hipLaunchKernelGGL(mk_fwd, dim3(grid), dim3(NWAVES * 64), LDS_BYTES, stream, a);
#endif
}
```

```cpp
#include <hip/hip_runtime.h>
#include <cstdio>
#include <cstdint>
namespace pg8 {
#define PG8_LAS __attribute__((address_space(3)))
typedef unsigned short bf16_t;
typedef short bf16x8 __attribute__((ext_vector_type(8)));
typedef float f32x4 __attribute__((ext_vector_type(4)));
typedef unsigned u32x4 __attribute__((ext_vector_type(4)));
constexpr int BM = 256, BK = 64, HALF = 128, HTB = HALF * BK * 2  , STAGE_BYTES = 8 * HTB, NXCD = 8, WGM = 8;

__host__ __device__ __forceinline__ int lds_byte(int r, int c) { const int st = (r >> 4) * 2 + (c >> 5), rr = r & 15, cc = c & 31, ob = rr * 64 + cc * 2; return st * 1024 + (ob ^ (((ob >> 9) & 1) << 5)); }
__host__ __device__ __forceinline__ void stage_rc(int b, int& R, int& C) { const int st = b / 1024, sb = b % 1024, swz = sb ^ (((sb >> 9) & 1) << 5); R = (st >> 1) * 16 + swz / 64; C = (st & 1) * 32 + (swz % 64) / 2; }
__host__ __device__ __forceinline__ int perm32(int rho) { const int n = rho >> 4, i = rho & 15; return 8 * (i >> 2) + 4 * n + (i & 3); }

struct Unit { int pm, pn; };
struct Gemm { const bf16_t* A; const bf16_t* Bt; int M, N, K; };

struct StaticOrder {
    int nM, nN, nwg, G, c;
    __host__ __device__ void init(int M, int N, int G_, int c_) { nM = M / BM; nN = N / BM; nwg = nM * nN; G = G_; c = c_; }
    __host__ __device__ bool next(int i, Unit& u) const {
        const long L = (long)i * G + c; if (L >= nwg) return false;
        int wgid = (int)L; { const int q = nwg / NXCD, r = nwg % NXCD, xcd = wgid % NXCD, off = wgid / NXCD; wgid = (xcd < r ? xcd * (q + 1) : r * (q + 1) + (xcd - r) * q) + off; }
        const int nig = WGM * nN, gid = wgid / nig, fm = gid * WGM, gsz = (nM - fm) < WGM ? (nM - fm) : WGM;
        u.pm = fm + ((wgid % nig) % gsz); u.pn = (wgid % nig) / gsz; return true;
    }
    __device__ __forceinline__ void a_ready(const Unit&) const {}
    __device__ __forceinline__ void done(const Unit&) const {}
};

__device__ __forceinline__ unsigned cvt_pk_bf16(float lo, float hi) { unsigned r; asm volatile("v_cvt_pk_bf16_f32 %0, %1, %2" : "=v"(r) : "v"(lo), "v"(hi)); return r; }
typedef short s16x8_t __attribute__((ext_vector_type(8)));
__device__ __forceinline__ float bfbits2f(short v) { return __uint_as_float(((unsigned)(unsigned short)v) << 16); }
struct EpiProj {
    static constexpr bool PERM = true, AFTER_DRAIN = false, HAS_MID = false;
    bf16_t* base6; bf16_t* ma; bf16_t* mb; size_t stride6; float qscale; int pn_off; float gscale;
    __device__ __forceinline__ void operator()(const f32x4 (&acc)[2][2][4][2], const Unit& u, int wr, int wc, int fr, int fq) const {
        const int pn = u.pn + pn_off; bf16_t* base; int ldc, colt; float sc = 1.f;
        float qs_ = qscale, gs_ = gscale; asm volatile("" : "+v"(qs_), "+v"(gs_));
        if (pn < 24) { const int t = pn >> 2; base = base6 + (size_t)t * stride6; ldc = 1024; colt = (pn & 3) * BM; sc = (t == 0) ? qs_ : gs_; }
        else if (pn < 32) { base = ma; ldc = 2048; colt = (pn - 24) * BM; sc = gs_; }
        else { base = mb; ldc = 2048; colt = (pn - 32) * BM; sc = gs_; }
        int t_ = threadIdx.x; asm volatile("" : "+v"(t_));
        const int lrow = (t_ >> 8) * 64 + (t_ & 15), lcol = ((t_ >> 6) & 3) * 32 + 8 * ((t_ >> 4) & 3);
        const int row0 = u.pm * BM + lrow, col0 = colt + lcol;
#pragma unroll
        for (int ai = 0; ai < 2; ++ai)
#pragma unroll
            for (int m = 0; m < 4; ++m) { bf16_t* rowp = base + (size_t)(row0 + ai * HALF + m * 16) * ldc + col0;
#pragma unroll
                for (int bj = 0; bj < 2; ++bj) { const f32x4 v0 = acc[ai][bj][m][0] * sc, v1 = acc[ai][bj][m][1] * sc;
                    u32x4 w; w.x = cvt_pk_bf16(v0[0], v0[1]); w.y = cvt_pk_bf16(v0[2], v0[3]); w.z = cvt_pk_bf16(v1[0], v1[1]); w.w = cvt_pk_bf16(v1[2], v1[3]);
                    *(u32x4*)(rowp + bj * HALF) = w; } }
    }
};
struct EpiMerge {
    static constexpr bool PERM = true, AFTER_DRAIN = false, HAS_MID = true;
    const bf16_t* ma; const bf16_t* mb; bf16_t* out;
    __device__ __forceinline__ void mid(f32x4 (&acc)[2][2][4][2], const Unit& u, int wr, int wc, int fr, int fq) const {
        unsigned lofs = (unsigned)((wr * 64 + fr) * 2048 + wc * 32 + 8 * fq); asm volatile("" : "+v"(lofs));
        const size_t tofs = (size_t)u.pm * BM * 2048 + (size_t)u.pn * BM;
#pragma unroll
        for (int ai = 0; ai < 2; ++ai)
#pragma unroll
            for (int m = 0; m < 4; ++m) { const size_t off = tofs + lofs + (size_t)(ai * HALF + m * 16) * 2048;
#pragma unroll
                for (int bj = 0; bj < 2; ++bj) { const s16x8_t a = *(const s16x8_t*)(ma + off + bj * HALF), b = *(const s16x8_t*)(mb + off + bj * HALF);
#pragma unroll
                    for (int j = 0; j < 8; ++j) { const float xa = bfbits2f(a[j]), xb = fmaxf(bfbits2f(b[j]), -30.f);
                        const float f = (1.f + __expf(-xb)) * __builtin_amdgcn_rcpf(1.f + __expf(-xa)); acc[ai][bj][m][j >> 2][j & 3] *= f; } }
                asm volatile("" ::: "memory"); }
    }
    __device__ __forceinline__ void operator()(const f32x4 (&acc)[2][2][4][2], const Unit& u, int wr, int wc, int fr, int fq) const {
        unsigned lofs = (unsigned)((wr * 64 + fr) * 2048 + wc * 32 + 8 * fq); asm volatile("" : "+v"(lofs));
        const size_t tofs = (size_t)u.pm * BM * 2048 + (size_t)u.pn * BM;
#pragma unroll
        for (int ai = 0; ai < 2; ++ai)
#pragma unroll
            for (int m = 0; m < 4; ++m) { const size_t off = tofs + lofs + (size_t)(ai * HALF + m * 16) * 2048;
#pragma unroll
                for (int bj = 0; bj < 2; ++bj) { const s16x8_t b = *(const s16x8_t*)(mb + off + bj * HALF); float v[8];
#pragma unroll
                    for (int j = 0; j < 8; ++j) { const float xb = fmaxf(bfbits2f(b[j]), -30.f); v[j] = acc[ai][bj][m][j >> 2][j & 3] * __builtin_amdgcn_rcpf(1.f + __expf(-xb)); }
                    u32x4 w; w.x = cvt_pk_bf16(v[0], v[1]); w.y = cvt_pk_bf16(v[2], v[3]); w.z = cvt_pk_bf16(v[4], v[5]); w.w = cvt_pk_bf16(v[6], v[7]);
                    *(u32x4*)(out + off + bj * HALF) = w; }
                asm volatile("" ::: "memory"); }
    }
};
struct EpiRes {
    static constexpr bool PERM = false, AFTER_DRAIN = false, HAS_MID = false;
    const float* base; float* out; float alpha;
    __device__ __forceinline__ void operator()(const f32x4 (&acc)[2][2][4][2], const Unit& u, int wr, int wc, int fr, int fq) const {
        const int row0 = u.pm * BM + wr * 64 + fr, col0 = u.pn * BM + wc * 32 + 4 * fq;
#pragma unroll
        for (int ai = 0; ai < 2; ++ai)
#pragma unroll
            for (int m = 0; m < 4; ++m) { const size_t off = (size_t)(row0 + ai * HALF + m * 16) * 2048 + col0;
#pragma unroll
                for (int bj = 0; bj < 2; ++bj)
#pragma unroll
                    for (int n = 0; n < 2; ++n) { const f32x4 bs = *(const f32x4*)(base + off + bj * HALF + n * 16); *(f32x4*)(out + off + bj * HALF + n * 16) = bs * alpha + acc[ai][bj][m][n]; }
                if (m & 1) asm volatile("" ::: "memory"); }
    }
};
typedef int pg8_v4i __attribute__((ext_vector_type(4))); typedef int pg8_v8i __attribute__((ext_vector_type(8)));
template <bool FP8> struct FragSel { struct type { bf16x8 k[2]; }; };
template <> struct FragSel<true> { typedef pg8_v8i type; };
template <bool FP8, class F> __device__ __forceinline__ void ld_frag(F& d, const PG8_LAS unsigned char* p) {
    if constexpr (FP8) { const pg8_v4i lo = *(const PG8_LAS pg8_v4i*)p, hi = *(const PG8_LAS pg8_v4i*)(p + 16); d = __builtin_shufflevector(lo, hi, 0, 1, 2, 3, 4, 5, 6, 7); }
    else { d.k[0] = *(const PG8_LAS bf16x8*)p; d.k[1] = *(const PG8_LAS bf16x8*)(p + 1024); }
}
template <bool FP8, class F> __device__ __forceinline__ void mma_frag(f32x4& c, const F& b, const F& a) {
    if constexpr (FP8) c = __builtin_amdgcn_mfma_scale_f32_16x16x128_f8f6f4(b, a, c, 0, 0, 0, 0, 0, 0);
    else { c = __builtin_amdgcn_mfma_f32_16x16x32_bf16(b.k[0], a.k[0], c, 0, 0, 0); c = __builtin_amdgcn_mfma_f32_16x16x32_bf16(b.k[1], a.k[1], c, 0, 0, 0); }
}
template <class Epi, class Sched, bool ALIGN_EPI = false, bool SP2 = false, bool FP8 = false>
__device__ __forceinline__ void gemm_phase(PG8_LAS unsigned char* lds, const Gemm g, const Sched& S, const Epi& E) {
    int tid_ = threadIdx.x; asm volatile("" : "+v"(tid_));
    const int tid = tid_, wid = __builtin_amdgcn_readfirstlane(tid >> 6), lane = tid & 63, wr = wid >> 2, wc = wid & 3, fr = lane & 15, fq = lane >> 4;
    const int K = g.K, nt = K / BK;
    unsigned voffA[2], voffB[2];
#pragma unroll
    for (int i = 0; i < 2; ++i) { int R, C; stage_rc(tid * 16 + i * 8192, R, C); const int Rb = Epi::PERM ? ((R & ~31) + perm32(R & 31)) : R;
        voffA[i] = (unsigned)(R * K + C) * 2u; voffB[i] = (unsigned)(Rb * K + C) * 2u; }
    const size_t kstep = (size_t)(BK * 2);
    const size_t hstep = (size_t)HALF * K * 2;
    const size_t tstep = 2 * hstep;
    const unsigned lds0 = (unsigned)(uintptr_t)lds;
    const unsigned ldsw = (unsigned)wid * 1024u;
    const int fcol = FP8 ? 32 * (fq >> 1) + 16 * (fq & 1) : fq * 8;
    const int aoff = lds_byte(wr * 64 + fr, fcol), boff = lds_byte(wc * 32 + fr, fcol);
#define PG8_SA(b, h) (((b) * 2 + (h)) * HTB)
#define PG8_SB(b, h) ((4 + (b) * 2 + (h)) * HTB)
#define PG8_STAGE(bufoff, gbase, voff) do { _Pragma("unroll") for (int _i = 0; _i < 2; ++_i) { unsigned keep_; \
        asm volatile("s_mov_b32 %0, m0\n\ts_mov_b32 m0, %3\n\ts_nop 4\n\tglobal_load_lds_dwordx4 %1, %2\n\ts_mov_b32 m0, %0" : "=&s"(keep_) : "v"((voff)[_i]), "s"((const char*)(gbase)), \
                     "s"((unsigned)__builtin_amdgcn_readfirstlane((int)(lds0 + (unsigned)(bufoff) + ldsw + (unsigned)(_i * 8192)))) : "memory"); } } while (0)
#define PG8_LDA(dst, b, h) do { _Pragma("unroll") for (int m = 0; m < 4; ++m) ld_frag<FP8>(dst[m], lds + PG8_SA(b, h) + aoff + m * 2048); } while (0)
#define PG8_LDB(dst, b, h) do { _Pragma("unroll") for (int n = 0; n < 2; ++n) ld_frag<FP8>(dst[n], lds + PG8_SB(b, h) + boff + n * 2048); } while (0)
#define PG8_MMA(ai, bj, At, Bt) do { __builtin_amdgcn_s_setprio(1); _Pragma("unroll") for (int m = 0; m < 4; ++m) _Pragma("unroll") for (int n = 0; n < 2; ++n) \
        mma_frag<FP8>(acc[ai][bj][m][n], Bt[n], At[m]); __builtin_amdgcn_s_setprio(0); } while (0)
#define PG8_WAIT_V(n) asm volatile("s_waitcnt vmcnt(" #n ")" ::: "memory")
#define PG8_WAIT_L(n) asm volatile("s_waitcnt lgkmcnt(" #n ")" ::: "memory")
#define PG8_BAR __builtin_amdgcn_s_barrier()
#define PG8_SCHED __builtin_amdgcn_sched_barrier(0)
    Unit cur, nxt; int ui = 0;
    if (!S.next(0, cur)) return;
    f32x4 acc[2][2][4][2];
#pragma unroll
    for (int a = 0; a < 2; ++a)
#pragma unroll
        for (int b = 0; b < 2; ++b)
#pragma unroll
            for (int m = 0; m < 4; ++m)
#pragma unroll
                for (int n = 0; n < 2; ++n) acc[a][b][m][n] = (f32x4){0.f, 0.f, 0.f, 0.f};
    typename FragSel<FP8>::type At[4], B0[2], B1[2];
    const char* cA = (const char*)g.A + (size_t)cur.pm * tstep; const char* cB = (const char*)g.Bt + (size_t)cur.pn * tstep;
    S.a_ready(cur);
    if constexpr (SP2) {
        PG8_STAGE(PG8_SB(0, 0), cB, voffB); PG8_STAGE(PG8_SB(0, 1), cB + hstep, voffB); PG8_STAGE(PG8_SA(0, 0), cA, voffA); PG8_STAGE(PG8_SA(0, 1), cA + hstep, voffA);
        if (wr == 1) PG8_BAR;
        PG8_WAIT_V(2); PG8_BAR;
        PG8_STAGE(PG8_SB(1, 0), cB + kstep, voffB); PG8_STAGE(PG8_SA(1, 0), cA + kstep, voffA); PG8_STAGE(PG8_SB(1, 1), cB + hstep + kstep, voffB);
        PG8_WAIT_V(6); PG8_BAR;
    } else {
        PG8_STAGE(PG8_SB(0, 0), cB, voffB); PG8_STAGE(PG8_SA(0, 0), cA, voffA); PG8_STAGE(PG8_SB(0, 1), cB + hstep, voffB); PG8_STAGE(PG8_SA(0, 1), cA + hstep, voffA);
        if (wr == 1) PG8_BAR;
        PG8_WAIT_V(4); PG8_BAR;
        PG8_STAGE(PG8_SB(1, 0), cB + kstep, voffB); PG8_STAGE(PG8_SA(1, 0), cA + kstep, voffA); PG8_STAGE(PG8_SB(1, 1), cB + hstep + kstep, voffB);
        PG8_WAIT_V(6); PG8_BAR;
    }
    for (;;) {
        const bool has_next = S.next(ui + 1, nxt);
        const char* nA = has_next ? (const char*)g.A + (size_t)nxt.pm * tstep : cA; const char* nB = has_next ? (const char*)g.Bt + (size_t)nxt.pn * tstep : cB;
        for (int t = 0; t < nt; t += 2) {
            const bool last = (t == nt - 2);
            if constexpr (Epi::HAS_MID) { if (t == nt / 2) E.mid(acc, cur, wr, wc, fr, fq); }
            const char* a1 = cA + (size_t)(t + 1) * kstep;
            const char* a2 = last ? nA : cA + (size_t)(t + 2) * kstep; const char* b2 = last ? nB : cB + (size_t)(t + 2) * kstep;
            const char* a3 = a2 + kstep; const char* b3 = b2 + kstep;
            if (last && has_next) S.a_ready(nxt);
            if constexpr (SP2) {
            PG8_LDB(B0, 0, 0); PG8_LDB(B1, 0, 1); PG8_SCHED; PG8_LDA(At, 0, 0); PG8_STAGE(PG8_SA(1, 1), a1 + hstep, voffA);
            PG8_WAIT_V(8); PG8_WAIT_L(0); PG8_BAR; PG8_MMA(0, 0, At, B0); PG8_MMA(0, 1, At, B1); PG8_BAR; PG8_SCHED;
            PG8_LDA(At, 0, 1); PG8_STAGE(PG8_SB(0, 0), b2, voffB); PG8_STAGE(PG8_SB(0, 1), b2 + hstep, voffB); PG8_STAGE(PG8_SA(0, 0), a2, voffA);
            PG8_WAIT_V(8); PG8_WAIT_L(0); PG8_BAR; PG8_MMA(1, 0, At, B0); PG8_MMA(1, 1, At, B1); PG8_BAR; PG8_SCHED;
            PG8_LDB(B0, 1, 0); PG8_LDB(B1, 1, 1); PG8_SCHED; PG8_LDA(At, 1, 0); PG8_STAGE(PG8_SA(0, 1), a2 + hstep, voffA);
            PG8_WAIT_V(8); PG8_WAIT_L(0); PG8_BAR; PG8_MMA(0, 0, At, B0); PG8_MMA(0, 1, At, B1); PG8_BAR; PG8_SCHED;
            PG8_LDA(At, 1, 1); PG8_STAGE(PG8_SB(1, 0), b3, voffB); PG8_STAGE(PG8_SB(1, 1), b3 + hstep, voffB); PG8_STAGE(PG8_SA(1, 0), a3, voffA);
            PG8_WAIT_V(8); PG8_WAIT_L(0); PG8_BAR; PG8_MMA(1, 0, At, B0); PG8_MMA(1, 1, At, B1); PG8_BAR; PG8_SCHED;
            } else {
            PG8_LDB(B0, 0, 0); PG8_SCHED; PG8_LDA(At, 0, 0); PG8_STAGE(PG8_SA(1, 1), a1 + hstep, voffA);
            PG8_WAIT_L(8); PG8_BAR; PG8_WAIT_L(0); PG8_MMA(0, 0, At, B0); PG8_BAR; PG8_SCHED;
            PG8_LDB(B1, 0, 1); PG8_STAGE(PG8_SB(0, 0), b2, voffB);
            PG8_BAR; PG8_WAIT_L(0); PG8_MMA(0, 1, At, B1); PG8_BAR;
            PG8_LDA(At, 0, 1); PG8_STAGE(PG8_SA(0, 0), a2, voffA);
            PG8_BAR; PG8_WAIT_L(0); PG8_MMA(1, 0, At, B0); PG8_BAR; PG8_SCHED;
            PG8_STAGE(PG8_SB(0, 1), b2 + hstep, voffB);
            PG8_WAIT_V(6); PG8_BAR; PG8_MMA(1, 1, At, B1); PG8_BAR;
            PG8_LDB(B0, 1, 0); PG8_SCHED; PG8_LDA(At, 1, 0); PG8_STAGE(PG8_SA(0, 1), a2 + hstep, voffA);
            PG8_WAIT_L(8); PG8_BAR; PG8_WAIT_L(0); PG8_MMA(0, 0, At, B0); PG8_BAR; PG8_SCHED;
            PG8_LDB(B1, 1, 1); PG8_STAGE(PG8_SB(1, 0), b3, voffB);
            PG8_BAR; PG8_WAIT_L(0); PG8_MMA(0, 1, At, B1); PG8_BAR;
            PG8_LDA(At, 1, 1); PG8_STAGE(PG8_SA(1, 0), a3, voffA);
            PG8_BAR; PG8_WAIT_L(0); PG8_MMA(1, 0, At, B0); PG8_BAR; PG8_SCHED;
            PG8_STAGE(PG8_SB(1, 1), b3 + hstep, voffB);
            PG8_WAIT_V(6); PG8_BAR; PG8_MMA(1, 1, At, B1); PG8_BAR;
            }
        }
        if constexpr (ALIGN_EPI) { if (wr == 0) PG8_BAR; }
        if constexpr (!Epi::AFTER_DRAIN) { E(acc, cur, wr, wc, fr, fq); S.done(cur); }
        if (!has_next) break;
#pragma unroll
        for (int a = 0; a < 2; ++a)
#pragma unroll
            for (int b = 0; b < 2; ++b)
#pragma unroll
                for (int m = 0; m < 4; ++m)
#pragma unroll
                    for (int n = 0; n < 2; ++n) acc[a][b][m][n] = (f32x4){0.f, 0.f, 0.f, 0.f};
        cur = nxt; cA = nA; cB = nB; ++ui;
        if constexpr (ALIGN_EPI) { if (wr == 1) PG8_BAR; }
    }
    PG8_WAIT_V(0);
    if constexpr (!ALIGN_EPI) { if (wr == 0) PG8_BAR; }
    PG8_BAR;
    if constexpr (Epi::AFTER_DRAIN) { E.fused(acc, cur, wr, wc, fr, fq, lds, wid, lane); S.done(cur); }
#undef PG8_SA
#undef PG8_SB
#undef PG8_STAGE
#undef PG8_LDA
#undef PG8_LDB
#undef PG8_MMA
#undef PG8_WAIT_V
#undef PG8_WAIT_L
#undef PG8_BAR
#undef PG8_SCHED
}
}

#ifndef PG8_SP2
#define PG8_SP2 true
#endif
#ifndef PG8_ALIGN
#define PG8_ALIGN true
#endif
#include <hip/hip_bf16.h>
#include <cmath>
namespace attn_body {
using bf16=__hip_bfloat16;
using bf16x8=__attribute__((ext_vector_type(8)))short;
using s16x4=__attribute__((ext_vector_type(4)))short;
using f32x16=__attribute__((ext_vector_type(16)))float;
using u32x4=__attribute__((ext_vector_type(4)))unsigned;
constexpr int BATCH=8,NHEAD=16,SEQ=2048,D=64,DM=NHEAD*D;
constexpr int NW=8,QBLK=32,QB=QBLK*NW,KVBLK=64,NQB=SEQ/QB;
constexpr int ATTN_PITCH=DM, ATTN_UNIT_ROWS=QB;
__device__ __forceinline__ int crow(int r,int hi){return (r&3)+8*(r>>2)+4*hi;}
#define SBAR() __builtin_amdgcn_sched_barrier(0)
__device__ __forceinline__ void cmask(f32x16&p0,f32x16&p1,int jb,int qrel,int hi){
  const float NEG=-INFINITY; int kb=64*jb+4*hi;
  #pragma unroll
  for(int r=0;r<16;++r){int kv=kb+(r&3)+8*(r>>2); if(kv>qrel)p0[r]=NEG; if(kv+32>qrel)p1[r]=NEG;}
}

constexpr int NSLOT=3, SLOTB=8192, VD=128;
constexpr int LDS_K=0, LDS_V=NSLOT*SLOTB, LDS_WS=3*NSLOT*SLOTB, LDS_OST=LDS_WS+NW*64*4, LDS_BYTES=LDS_OST+NW*8192;
constexpr float C2=0.125f*1.4426950408889634f;
__device__ __forceinline__ void glds16(const void*gsrc,unsigned lds_dst){unsigned keep;
  asm volatile("s_mov_b32 %0, m0\n\ts_mov_b32 m0, %2\n\ts_nop 0\n\tglobal_load_lds_dwordx4 %1, off\n\ts_mov_b32 m0, %0":"=&s"(keep):"v"(gsrc),"s"(lds_dst):"memory");}
__device__ __forceinline__ void glds16o(const void*sbase,unsigned voff,unsigned lds_dst){unsigned keep;
  asm volatile("s_mov_b32 %0, m0\n\ts_mov_b32 m0, %3\n\ts_nop 4\n\tglobal_load_lds_dwordx4 %1, %2\n\ts_mov_b32 m0, %0":"=&s"(keep):"v"(voff),"s"(sbase),"s"(lds_dst):"memory");}
__device__ __forceinline__ float max3f(float a,float b,float c){float r;asm("v_max3_f32 %0, %1, %2, %3":"=v"(r):"v"(a),"v"(b),"v"(c));return r;}
__device__ __forceinline__ float max2f(float a,float b){float r;asm("v_max_f32_e32 %0, %1, %2":"=v"(r):"v"(a),"v"(b));return r;}
__device__ __forceinline__ float fadd_s(float a,float b){float r;asm("v_add_f32_e32 %0, %1, %2":"=v"(r):"v"(a),"v"(b));return r;}
__device__ __forceinline__ float fsub_s(float a,float b){float r;asm("v_sub_f32_e32 %0, %1, %2":"=v"(r):"v"(a),"v"(b));return r;}
typedef float f32x2_t __attribute__((ext_vector_type(2))); typedef __bf16 bf16x2_t __attribute__((ext_vector_type(2)));
__device__ __forceinline__ unsigned cvtpk_s(float lo,float hi){f32x2_t v={lo,hi};bf16x2_t b=__builtin_convertvector(v,bf16x2_t);return __builtin_bit_cast(unsigned,b);}
#define WAIT_BAR(N) asm volatile("s_waitcnt vmcnt(" #N ") lgkmcnt(0)\n\ts_barrier":::"memory")

__device__ __forceinline__ void qkt(f32x16&p0,f32x16&p1,const char*Kslot,const bf16x8*qr,int r32,int hi){
  const char*kb=Kslot+hi*1024+r32*16;
  #pragma unroll
  for(int d0=0;d0<4;++d0){
    const bf16x8 b0=*reinterpret_cast<const bf16x8*>(kb+d0*2048);
    const bf16x8 b1=*reinterpret_cast<const bf16x8*>(kb+d0*2048+512);
    {p0=__builtin_amdgcn_mfma_f32_32x32x16_bf16(b0,qr[d0],p0,0,0,0);p1=__builtin_amdgcn_mfma_f32_32x32x16_bf16(b1,qr[d0],p1,0,0,0);}}
}
typedef __attribute__((address_space(3))) const char* lds_cptr;
typedef short v4i16_t __attribute__((ext_vector_type(4)));
__device__ __forceinline__ void kload8(bf16x8*kf,lds_cptr kp){
  kf[0]=*(const __attribute__((address_space(3))) bf16x8*)(kp);      kf[1]=*(const __attribute__((address_space(3))) bf16x8*)(kp+512);
  kf[2]=*(const __attribute__((address_space(3))) bf16x8*)(kp+2048); kf[3]=*(const __attribute__((address_space(3))) bf16x8*)(kp+2560);
  kf[4]=*(const __attribute__((address_space(3))) bf16x8*)(kp+4096); kf[5]=*(const __attribute__((address_space(3))) bf16x8*)(kp+4608);
  kf[6]=*(const __attribute__((address_space(3))) bf16x8*)(kp+6144); kf[7]=*(const __attribute__((address_space(3))) bf16x8*)(kp+6656);
}
__device__ __forceinline__ void kload2(bf16x8*kf,lds_cptr kp,int j){ kf[2*j]=*(const __attribute__((address_space(3))) bf16x8*)(kp+j*2048); kf[2*j+1]=*(const __attribute__((address_space(3))) bf16x8*)(kp+j*2048+512); }
__device__ __forceinline__ s16x4 vtr(lds_cptr p){ return __builtin_bit_cast(s16x4,__builtin_amdgcn_ds_read_tr16_b64_v4i16((__attribute__((address_space(3))) v4i16_t*)p)); }
__device__ __forceinline__ float rowmax(const f32x16&p0,const f32x16&p1){
  float a=max3f(p0[0],p0[1],p1[0]),b=max3f(p0[2],p0[3],p1[1]);a=max3f(a,p1[2],p1[3]);
  #pragma unroll
  for(int r=4;r<16;r+=4){a=max3f(a,p0[r],p0[r+1]);b=max3f(b,p0[r+2],p0[r+3]);a=max3f(a,p1[r],p1[r+1]);b=max3f(b,p1[r+2],p1[r+3]);}
  const float m=max2f(a,b);
  auto rr=__builtin_amdgcn_permlane32_swap(__float_as_uint(m),__float_as_uint(m),false,false);
  return max2f(__uint_as_float(rr[0]),__uint_as_float(rr[1]));
}
__device__ __forceinline__ void pv(f32x16*o,int vb,bf16x8 pa0,bf16x8 pa1,bf16x8 pa2,bf16x8 pa3){
  #pragma unroll
  for(int d0=0;d0<4;++d0){s16x4 lo[4],hi[4];
    #pragma unroll
    for(int ks=0;ks<4;++ks){
      asm volatile("ds_read_b64_tr_b16 %0,%1 offset:%c2":"=&v"(lo[ks]):"v"(vb),"i"(d0*4096+ks*1024):"memory");
      asm volatile("ds_read_b64_tr_b16 %0,%1 offset:%c2":"=&v"(hi[ks]):"v"(vb),"i"(d0*4096+ks*1024+512):"memory");}
    asm volatile("s_waitcnt lgkmcnt(0)":::"memory");SBAR();
    #define PK(k) (bf16x8){lo[k][0],lo[k][1],lo[k][2],lo[k][3],hi[k][0],hi[k][1],hi[k][2],hi[k][3]}
    o[d0]=__builtin_amdgcn_mfma_f32_32x32x16_bf16(pa0,PK(0),o[d0],0,0,0);
    o[d0]=__builtin_amdgcn_mfma_f32_32x32x16_bf16(pa1,PK(1),o[d0],0,0,0);
    o[d0]=__builtin_amdgcn_mfma_f32_32x32x16_bf16(pa2,PK(2),o[d0],0,0,0);
    o[d0]=__builtin_amdgcn_mfma_f32_32x32x16_bf16(pa3,PK(3),o[d0],0,0,0);
    #undef PK
  }
}

#ifndef ATTN_STORE16
#define ATTN_STORE16(p,v) (*(u32x4*)(p)=(v))
#endif
template<int THRL> __device__ __forceinline__ void attn_unit(int b,int hq,int hh,int qb,float slope2,const bf16*Q,const bf16*__restrict__ K,const bf16*__restrict__ V,bf16*O,char*shm){
  int tid_=threadIdx.x; asm volatile("":"+v"(tid_)); const int tid=tid_,lane=tid&63,r32=lane&31,hi=lane>>5; const int wid=__builtin_amdgcn_readfirstlane(tid>>6);
  const long rowbase=(long)b*SEQ; const int q0=qb*QB;
  const bf16*Qw=Q+(rowbase+q0+wid*QBLK)*DM+hq*D;
  const bf16*Kh=K+rowbase*DM+hq*D,*Vh=V+rowbase*DM+hh*VD;
  const unsigned lds0=(unsigned)(uintptr_t)shm;
  float*wsf=(float*)(shm+LDS_WS)+wid*64;
  const unsigned koff=(unsigned)((lane*DM+wid*8)*2);
  const unsigned voff=(unsigned)(((16*(wid&3)+(lane>>2))*DM+(wid>>2)*32+(lane&3)*8)*2);
  const unsigned kdst=lds0+LDS_K+wid*1024, vdst=lds0+LDS_V+wid*1024;
  #define DMA_K(t,slot) glds16o(Kh+(long)(t)*KVBLK*DM,koff,(unsigned)__builtin_amdgcn_readfirstlane(kdst+(slot)))
  #define DMA_V(t,slot) do{ glds16o(Vh+(long)(t)*KVBLK*DM,voff,(unsigned)__builtin_amdgcn_readfirstlane(vdst+2*(slot))); glds16o(Vh+(long)(t)*KVBLK*DM+64,voff,(unsigned)__builtin_amdgcn_readfirstlane(vdst+2*(slot)+8192)); }while(0)
  const int vb0=(int)(lds0+LDS_V)+((lane>>4)&1)*32+(lane&3)*8+(4*hi+((lane&15)>>2))*64;
  const char*Kbase=shm+LDS_K; bf16x8 kf[8];
  const lds_cptr shm3=(lds_cptr)shm; const lds_cptr kp0=shm3+LDS_K+hi*1024+r32*16; const lds_cptr vp0=shm3+LDS_V+((lane>>4)&1)*32+(lane&3)*8+(4*hi+((lane&15)>>2))*64;
  const int NT=(q0+QB)/KVBLK;
  DMA_K(0,0);DMA_V(0,0);DMA_K(1,SLOTB);
  bf16x8 qr[4];
  #pragma unroll
  for(int d0=0;d0<4;++d0)qr[d0]=*reinterpret_cast<const bf16x8*>(&Qw[(long)r32*DM+d0*16+hi*8]);
  float l_reg=0.f;f32x16 o[4];o[0]=f32x16{};o[1]=f32x16{};o[2]=f32x16{};o[3]=f32x16{};
  float nb=slope2*(float)(4*hi-q0-255); const float sl64=64.f*slope2;
  #define BINIT0(C0,t) do{ _Pragma("unroll") for(int r=0;r<16;++r)C0[r]=fmaf(slope2,(float)((r&3)+8*(r>>2)),nb); }while(0)
  #define BINIT1(C1,t) do{ _Pragma("unroll") for(int r=0;r<16;++r)C1[r]=fmaf(slope2,(float)((r&3)+8*(r>>2)+32),nb); nb+=sl64; }while(0)
  const int qrel=wid*QBLK+r32;
  #define CMASK(P0,P1,t) do{int jb_=(t)-(NT-4); if(jb_>=0)cmask(P0,P1,jb_,qrel,hi);}while(0)
  bool resc=false;
  #define START(P0,P1) do{ const float rm=rowmax(P0,P1); resc=false; \
    { const float dl=rm; nb=fsub_s(nb,dl); \
      _Pragma("unroll") for(int r=0;r<16;++r){P0[r]=fsub_s(P0[r],dl);P1[r]=fsub_s(P1[r],dl);} } \
    _Pragma("unroll") for(int r=0;r<16;++r)P0[r]=__builtin_amdgcn_exp2f(P0[r]); }while(0)
  #define RESC() do{ if(resc){ asm volatile("s_waitcnt lgkmcnt(0)":::"memory"); \
      _Pragma("unroll") for(int d_=0;d_<4;++d_) _Pragma("unroll") for(int r=0;r<16;++r)o[d_][r]*=wsf[crow(r,hi)]; } }while(0)
  f32x16 pA0,pA1,pB0,pB1;
  int sl_prev=0,sl_cur=0,sl_next=SLOTB;
  #define ROT() do{sl_prev=sl_cur;sl_cur=sl_next;sl_next=(sl_next==(NSLOT-1)*SLOTB)?0:sl_next+SLOTB;}while(0)
  DMA_K(2,2*SLOTB);
  WAIT_BAR(3);
  asm volatile("":"+v"(nb));
  BINIT0(pA0,0);BINIT1(pA1,0);qkt(pA0,pA1,Kbase,qr,r32,hi);asm volatile("s_nop 15\n\ts_nop 7":"+v"(pA0),"+v"(pA1));CMASK(pA0,pA1,0);
  START(pA0,pA1);
  _Pragma("unroll") for(int r=0;r<16;++r)pA1[r]=__builtin_amdgcn_exp2f(pA1[r]);
  WAIT_BAR(0);
  DMA_K(3,0);DMA_V(1,SLOTB);
  ROT();
  kload8(kf,kp0+sl_cur);
  WAIT_BAR(3);
  s16x4 vlo[16],vhi[16]; u32x4 pw0,pw1,pw2,pw3;
  #define PKW(P,B) cvtpk_s(P[B],P[B+1])
  #define PAF(k) __builtin_bit_cast(bf16x8,pw##k)
  #define VFR(i) (bf16x8){vlo[i][0],vlo[i][1],vlo[i][2],vlo[i][3],vhi[i][0],vhi[i][1],vhi[i][2],vhi[i][3]}
  #define PIN(x) asm volatile("":"+v"(x))
  #define MX3(a,b,c) __builtin_fmaxf(__builtin_fmaxf((a),(b)),(c))
  #define GAPA(MF,A0,A1,A2,A3,W0,W1,PW) do{ MF; sacc+=A0; sacc+=A1; sacc+=A2; sacc+=A3; PIN(sacc); W0; W1; PIN(PW); SBAR(); }while(0)
  #define EX(v) __builtin_amdgcn_exp2f(v)
  #define VRD(j) do{ vlo[j]=vtr(vp_+(((j)&3)*4096+((j)>>2)*1024)); vhi[j]=vtr(vp_+(((j)&3)*4096+((j)>>2)*1024+512)); }while(0)
  #define GAPB(j,k,X,B) do{ asm volatile("s_waitcnt lgkmcnt(0)":::"memory"); SBAR(); o[(j)&3]=__builtin_amdgcn_mfma_f32_32x32x16_bf16(PAF(k),VFR(j),o[(j)&3],0,0,0); X[B]=EX(X[B]); X[B+1]=EX(X[B+1]); PIN(X); if((j)+4<16){VRD(((j)+4)&15);} SBAR(); }while(0)
  #define KRD(G,j) do{ if(G){ kload2(kf,kp0+sl_next,j); SBAR(); } }while(0)
  #define STEP(C0,C1,P0,P1,t,GK,GV,GL) do{ SBAR(); \
    const lds_cptr vp_=vp0+2*sl_prev; \
    BINIT0(C0,t); PIN(C0); SBAR(); float sacc=(P0[0]+P0[1]); \
    GAPA(C0=__builtin_amdgcn_mfma_f32_32x32x16_bf16(kf[0],qr[0],C0,0,0,0), P0[2],P0[3],P0[4],P0[5],     pw0[0]=PKW(P0,0), pw0[1]=PKW(P0,2), pw0); \
    BINIT1(C1,t); PIN(C1); SBAR(); GAPA(C1=__builtin_amdgcn_mfma_f32_32x32x16_bf16(kf[1],qr[0],C1,0,0,0), P0[6],P0[7],P0[8],P0[9],     pw0[2]=PKW(P0,4), pw0[3]=PKW(P0,6), pw0); \
    GAPA(C0=__builtin_amdgcn_mfma_f32_32x32x16_bf16(kf[2],qr[1],C0,0,0,0),   P0[10],P0[11],P0[12],P0[13], pw1[0]=PKW(P0,8), pw1[1]=PKW(P0,10), pw1); \
    GAPA(C1=__builtin_amdgcn_mfma_f32_32x32x16_bf16(kf[3],qr[1],C1,0,0,0),   P0[14],P0[15],P1[0],P1[1],   pw1[2]=PKW(P0,12),pw1[3]=PKW(P0,14), pw1); \
    VRD(0); SBAR(); GAPA(C0=__builtin_amdgcn_mfma_f32_32x32x16_bf16(kf[4],qr[2],C0,0,0,0),   P1[2],P1[3],P1[4],P1[5],     pw2[0]=PKW(P1,0), pw2[1]=PKW(P1,2), pw2); \
    VRD(1); SBAR(); GAPA(C1=__builtin_amdgcn_mfma_f32_32x32x16_bf16(kf[5],qr[2],C1,0,0,0),   P1[6],P1[7],P1[8],P1[9],     pw2[2]=PKW(P1,4), pw2[3]=PKW(P1,6), pw2); \
    VRD(2); SBAR(); GAPA(C0=__builtin_amdgcn_mfma_f32_32x32x16_bf16(kf[6],qr[3],C0,0,0,0),   P1[10],P1[11],P1[12],P1[13], pw3[0]=PKW(P1,8), pw3[1]=PKW(P1,10), pw3); \
    VRD(3); SBAR(); GAPA(C1=__builtin_amdgcn_mfma_f32_32x32x16_bf16(kf[7],qr[3],C1,0,0,0),   P1[14],P1[15],0.f,0.f,       pw3[2]=PKW(P1,12),pw3[3]=PKW(P1,14), pw3); \
    l_reg+=sacc; \
    if(GK){DMA_K((t)+3,sl_cur);} if(GV){DMA_V((t)+1,sl_next);} \
    CMASK(C0,C1,t); \
    { float a=MX3(C0[0],C0[1],C1[0]),b=MX3(C0[2],C0[3],C1[1]); a=MX3(a,C1[2],C1[3]); \
      _Pragma("unroll") for(int r=4;r<16;r+=4){a=MX3(a,C0[r],C0[r+1]);b=MX3(b,C0[r+2],C0[r+3]);a=MX3(a,C1[r],C1[r+1]);b=MX3(b,C1[r+2],C1[r+3]);} \
      float rm=__builtin_fmaxf(a,b); { auto rr=__builtin_amdgcn_permlane32_swap(__float_as_uint(rm),__float_as_uint(rm),false,false); rm=__builtin_fmaxf(__uint_as_float(rr[0]),__uint_as_float(rr[1])); } \
      resc=false; \
      if(__builtin_expect(__any(rm>(float)THRL),0)){ const float dl=__builtin_fmaxf(rm,0.f); nb-=dl; \
        _Pragma("unroll") for(int r=0;r<16;++r){C0[r]-=dl;C1[r]-=dl;} \
        const float f=__builtin_amdgcn_exp2f(-dl); l_reg*=f; if(hi==0)wsf[r32]=f; resc=true; } } \
    SBAR(); \
    GAPB(0,0,C0,0); GAPB(1,0,C0,2); GAPB(2,0,C0,4); GAPB(3,0,C0,6); \
    GAPB(4,1,C0,8); GAPB(5,1,C0,10); KRD(GL,0); GAPB(6,1,C0,12); GAPB(7,1,C0,14); \
    KRD(GL,1); GAPB(8,2,C1,0); GAPB(9,2,C1,2); KRD(GL,2); GAPB(10,2,C1,4); GAPB(11,2,C1,6); \
    KRD(GL,3); GAPB(12,3,C1,8); GAPB(13,3,C1,10); GAPB(14,3,C1,12); GAPB(15,3,C1,14); \
    }while(0)
  int t=1;
  #undef CMASK
  #define CMASK(P0,P1,t) do{}while(0)
  for(;t+5<NT;t+=2){
    STEP(pB0,pB1,pA0,pA1,t,true,true,true);     WAIT_BAR(3); RESC(); ROT();
    STEP(pA0,pA1,pB0,pB1,t+1,true,true,true);   WAIT_BAR(3); RESC(); ROT();
  }
  #undef CMASK
  #define CMASK(P0,P1,t) do{int jb_=(t)-(NT-4); if(jb_>=0)cmask(P0,P1,jb_,qrel,hi);}while(0)
  #define ENDW(tt) do{ if((tt)+3<NT){WAIT_BAR(3);} else if((tt)+2<NT){WAIT_BAR(2);} else {WAIT_BAR(0);} }while(0)
  for(;t+1<NT;t+=2){
    STEP(pB0,pB1,pA0,pA1,t,(t+3<NT),(t+1<NT),(t+1<NT));       ENDW(t);   RESC(); ROT();
    STEP(pA0,pA1,pB0,pB1,t+1,(t+4<NT),(t+2<NT),(t+2<NT));     ENDW(t+1); RESC(); ROT();
  }
  STEP(pB0,pB1,pA0,pA1,NT-1,false,false,false); RESC();
  { float sacc=pB0[0]+pB0[1]; _Pragma("unroll") for(int r=2;r<16;++r)sacc+=pB0[r]; _Pragma("unroll") for(int r=0;r<16;++r)sacc+=pB1[r]; l_reg+=sacc;
    pw0=(u32x4){PKW(pB0,0),PKW(pB0,2),PKW(pB0,4),PKW(pB0,6)};pw1=(u32x4){PKW(pB0,8),PKW(pB0,10),PKW(pB0,12),PKW(pB0,14)};pw2=(u32x4){PKW(pB1,0),PKW(pB1,2),PKW(pB1,4),PKW(pB1,6)};pw3=(u32x4){PKW(pB1,8),PKW(pB1,10),PKW(pB1,12),PKW(pB1,14)};
    SBAR(); pv(o,vb0+2*sl_cur,PAF(0),PAF(1),PAF(2),PAF(3)); }
  #undef PKW
  #undef PAF
  #undef VFR
  #undef PIN
  #undef MX3
  #undef GAPA
  #undef GAPB
  #undef EX
  #undef VRD
  #undef KRD
  #undef STEP
  #undef ENDW
  {auto rr=__builtin_amdgcn_permlane32_swap(__float_as_uint(l_reg),__float_as_uint(l_reg),false,false);l_reg=__uint_as_float(rr[0])+__uint_as_float(rr[1]);}
  if(hi==0)wsf[32+r32]=l_reg;asm volatile("s_waitcnt lgkmcnt(0)":::"memory");
  float rli[16];
  #pragma unroll
  for(int r=0;r<16;++r)rli[r]=__builtin_amdgcn_rcpf(wsf[32+crow(r,hi)]);
  bf16*Ow=O+(rowbase+q0+wid*QBLK)*DM+hh*VD;
  { bf16*stg=(bf16*)(shm+LDS_OST)+wid*4096;
    #pragma unroll
    for(int r=0;r<16;++r){const int orow=crow(r,hi);
      #pragma unroll
      for(int d0=0;d0<4;++d0)stg[orow*128+d0*32+r32]=__float2bfloat16(o[d0][r]*rli[r]);}
    asm volatile("s_waitcnt lgkmcnt(0)":::"memory");
    #pragma unroll
    for(int i=0;i<8;++i){const int row=i*4+(lane>>4),ch=lane&15; const u32x4 v=*(const u32x4*)(stg+row*128+ch*8); ATTN_STORE16(Ow+(long)row*DM+ch*8,v);} }
  asm volatile("s_waitcnt lgkmcnt(0)\n\ts_barrier":::"memory");
  #undef DMA_K
  #undef DMA_V
  #undef BINIT0
  #undef BINIT1
  #undef CMASK
  #undef START
  #undef RESC
  #undef ROT
}
constexpr int ATTN_LDS_BYTES=LDS_BYTES;
#undef SBAR
#undef WAIT_BAR
}
#define GAS __attribute__((address_space(1)))
#define LAS __attribute__((address_space(3)))
typedef unsigned short bf16;
typedef unsigned v4u __attribute__((ext_vector_type(4)));
typedef float f32x4 __attribute__((ext_vector_type(4)));
typedef short bf16x8 __attribute__((ext_vector_type(8)));
typedef GAS unsigned gu32;
typedef GAS unsigned long long gu64;
#define RLX_AGENT __ATOMIC_RELAXED, __HIP_MEMORY_SCOPE_AGENT
#define LDS_WAIT() asm volatile("s_waitcnt lgkmcnt(0)" ::: "memory")
#define VM_WAIT() asm volatile("s_waitcnt vmcnt(0)" ::: "memory")
__device__ __forceinline__ unsigned long long rt() { return __builtin_amdgcn_s_memrealtime(); }
__device__ __forceinline__ unsigned f2bf(float f) { unsigned u = __builtin_bit_cast(unsigned, f); return (u + 0x7fffu + ((u >> 16) & 1u)) >> 16; }
typedef float f32x2_pk __attribute__((ext_vector_type(2))); typedef __bf16 bf16x2_pk __attribute__((ext_vector_type(2)));
__device__ __forceinline__ unsigned pk2(float lo, float hi) { f32x2_pk v = {lo, hi}; bf16x2_pk b = __builtin_convertvector(v, bf16x2_pk); return __builtin_bit_cast(unsigned, b); }

#define XB_TMO      128
#define XB_XCNT(j)  (256  + 64 * (j))
#define XB_XSUB(j)  (1280 + 64 * (j))
#define XB_XGEN(j)  (2304 + 64 * (j))
#define XB_TOP      3328
#define XB_TOPGEN   3392
#define XCD_BAR_WORDS 3456
#define XB_SPIN_CAP (1u << 18)

__device__ __forceinline__ unsigned xb_ld(unsigned* p)              { return __hip_atomic_load(p, __ATOMIC_RELAXED, __HIP_MEMORY_SCOPE_AGENT); }
__device__ __forceinline__ unsigned xb_add(unsigned* p, unsigned v) { return __hip_atomic_fetch_add(p, v, __ATOMIC_RELAXED, __HIP_MEMORY_SCOPE_AGENT); }
__device__ __forceinline__ unsigned xb_xcc_id() { return (unsigned)__builtin_amdgcn_s_getreg((3 << 11) | 20) & 0xFu; }
#define XB_SPIN(cond, bar) do { unsigned _sp = 0; while (cond) { __builtin_amdgcn_s_sleep(1); \
    if ((++_sp & 255u) == 0u) { if (xb_ld(&(bar)[XB_TMO])) break; if (_sp > XB_SPIN_CAP) { atomicAdd(&(bar)[XB_TMO], 1u); break; } } } } while (0)

struct XcdBarrier {
    unsigned* bar; unsigned x;
    volatile LAS unsigned* st;
};

__device__ __forceinline__ XcdBarrier xcd_barrier_post(unsigned* bar, volatile LAS unsigned* st) {
    XcdBarrier b; b.bar = bar; b.x = xb_xcc_id(); b.st = st;
    if (threadIdx.x == 0) (void)xb_add(&bar[XB_XCNT(b.x)], 1u);
    return b;
}
__device__ __forceinline__ void xcd_barrier_complete(unsigned* bar, unsigned x, unsigned& nloc, unsigned& nx) {
    const unsigned G = gridDim.x * gridDim.y * gridDim.z;
    unsigned sum, cnt, mine, sp = 0u;
    for (;;) {
        sum = 0u; cnt = 0u; mine = 0u;
#pragma unroll
        for (unsigned j = 0; j < 16; ++j) { const unsigned c = xb_ld(&bar[XB_XCNT(j)]); sum += c; cnt += (c > 0u) ? 1u : 0u; mine = (j == x) ? c : mine; }
        if (sum == G) break;
        __builtin_amdgcn_s_sleep(1);
        if ((++sp & 255u) == 0u) { if (xb_ld(&bar[XB_TMO])) break; if (sp > XB_SPIN_CAP) { atomicAdd(&bar[XB_TMO], 1u); break; } }
    }
    nloc = mine > 0u ? mine : 1u; nx = cnt > 0u ? cnt : 1u;
}

__device__ __forceinline__ void xcd_barrier(const XcdBarrier& b) {
    asm volatile("s_waitcnt vmcnt(0)" ::: "memory");
    __syncthreads();
    if (threadIdx.x == 0) {
        unsigned* bar = b.bar;
        __builtin_amdgcn_s_waitcnt(0);
        unsigned nloc = b.st[0], nx = b.st[1];
        if (nloc == 0u) { xcd_barrier_complete(bar, b.x, nloc, nx); b.st[0] = nloc; b.st[1] = nx; }
        const unsigned old = xb_add(&bar[XB_XSUB(b.x)], 1u);
        const unsigned gen = old / nloc;
        if (old + 1u == (gen + 1u) * nloc) {
            __builtin_amdgcn_fence(__ATOMIC_RELEASE, "agent");
            asm volatile("s_waitcnt vmcnt(0)" ::: "memory");
            const unsigned og = xb_add(&bar[XB_TOP], 1u);
            const unsigned tg = og / nx;
            if (og + 1u == (tg + 1u) * nx) xb_add(&bar[XB_TOPGEN], 1u);
            else XB_SPIN(xb_ld(&bar[XB_TOPGEN]) == tg, bar);
            __builtin_amdgcn_fence(__ATOMIC_ACQUIRE, "agent");
            xb_add(&bar[XB_XGEN(b.x)], 1u);
            asm volatile("s_waitcnt vmcnt(0)" ::: "memory");
        } else {
            XB_SPIN(xb_ld(&bar[XB_XGEN(b.x)]) == gen, bar);
            __builtin_amdgcn_fence(__ATOMIC_ACQUIRE, "agent");
            asm volatile("s_waitcnt vmcnt(0)" ::: "memory");
        }
    }
    __syncthreads();
}
constexpr int NWAVES = 8;
constexpr int BATCH = 8, SEQ = 2048, DM = 2048, DEPTH = 2, M = BATCH * SEQ;
constexpr int HEADS = 8, IN_TOTAL = 10240, LRUW = 1024, NBLK = 8, BLKW = 128;
constexpr float LN_EPS = 1e-5f, SUBLN_EPS = 1e-5f, DN_ALPHA = 1.41421356237309515f, LOG2E = 1.4426950408889634f;

constexpr size_t MiB = 1u << 20;
constexpr size_t WS_CTL = 0, CTL_ZERO_BYTES = 1 * MiB;
constexpr size_t WS_GW = 1 * MiB;
constexpr int N_BF = 4096, N_F8 = 6144;
constexpr float W8_SCALE = 64.f;
constexpr size_t WS_WIN = 2 * MiB;
constexpr size_t WS_WG8 = 34 * MiB;
constexpr size_t WS_XQ8 = 66 * MiB;
constexpr size_t WS_WPAB = 98 * MiB;
constexpr size_t WS_WOUT = 114 * MiB;
constexpr size_t WS_XB16 = 130 * MiB;
constexpr size_t WS_O1 = 130 * MiB, WS_O2 = 162 * MiB, WS_MERGED = 130 * MiB;
constexpr size_t WS_P6 = 194 * MiB;
constexpr size_t WS_MA = 386 * MiB, WS_MB = 450 * MiB;
constexpr size_t WS_AR = 514 * MiB;
constexpr size_t WS_END = 578 * MiB;
constexpr int CW_TMO = 0, CW_BAR = 4096;

constexpr int RING_OFF = 0, RING_BYTES = 151552;
constexpr int LDSCTL_OFF = RING_BYTES, MISC_OFF = LDSCTL_OFF + 320;
constexpr int LDS_BYTES = 153600;
static_assert(MISC_OFF + 128 <= LDS_BYTES && attn_body::ATTN_LDS_BYTES <= RING_BYTES && pg8::STAGE_BYTES <= RING_BYTES, "LDS map");

struct Frame {
    LAS unsigned char* lds; volatile LAS unsigned* MISC; gu32* ctl;
    int tid, lane, wave, vcu, G;
};
__device__ __forceinline__ float wave_sum(float v, int lane) {
#pragma unroll
    for (int o = 1; o < 64; o <<= 1) v += __int_as_float(__builtin_amdgcn_ds_bpermute((lane ^ o) << 2, __float_as_int(v)));
    return v;
}
__device__ __forceinline__ void p0_transpose_item(const float* W, int ldw, int ncols, bf16* WT, int ldt, int koff, LAS float* scr, int item, int lane) {
    const int nblk = ncols / 32, kb = item / nblk, nb = item % nblk, k0 = 64 * kb, n0 = 32 * nb;
#pragma unroll 8
    for (int i = 0; i < 32; ++i) { const int kk = 2 * i + (lane >> 5); scr[kk * 33 + (lane & 31)] = W[(size_t)(k0 + kk) * ldw + n0 + (lane & 31)]; }
    LDS_WAIT(); asm volatile("" ::: "memory");
    const int c = lane & 7;
#pragma unroll
    for (int j = 0; j < 4; ++j) { const int n = (lane >> 3) + 8 * j; const LAS float* s = scr + (8 * c) * 33 + n;
        v4u o; o.x = pk2(s[0 * 33], s[1 * 33]); o.y = pk2(s[2 * 33], s[3 * 33]); o.z = pk2(s[4 * 33], s[5 * 33]); o.w = pk2(s[6 * 33], s[7 * 33]);
        *(GAS v4u*)(WT + (size_t)(n0 + n) * ldt + koff + k0 + 8 * c) = o; }
    LDS_WAIT(); asm volatile("" ::: "memory");
}
__device__ __forceinline__ unsigned pk4_fp8(float a, float b, float c, float d) { int w = __builtin_amdgcn_cvt_pk_fp8_f32(a, b, 0, false); w = __builtin_amdgcn_cvt_pk_fp8_f32(c, d, w, true); return (unsigned)w; }
__device__ __forceinline__ void p0_transpose_item8(const float* W, int ldw, int ncols, unsigned char* WT8, int ldt, float scale, LAS float* scr, int item, int lane) {
    const int nblk = ncols / 32, kb = item / nblk, nb = item % nblk, k0 = 64 * kb, n0 = 32 * nb;
#pragma unroll 8
    for (int i = 0; i < 32; ++i) { const int kk = 2 * i + (lane >> 5); scr[kk * 33 + (lane & 31)] = W[(size_t)(k0 + kk) * ldw + n0 + (lane & 31)] * scale; }
    LDS_WAIT(); asm volatile("" ::: "memory");
    const int c = lane & 3;
#pragma unroll
    for (int j = 0; j < 2; ++j) { const int n = (lane >> 2) + 16 * j; const LAS float* s = scr + (16 * c) * 33 + n;
        v4u o; o.x = pk4_fp8(s[0 * 33], s[1 * 33], s[2 * 33], s[3 * 33]); o.y = pk4_fp8(s[4 * 33], s[5 * 33], s[6 * 33], s[7 * 33]);
        o.z = pk4_fp8(s[8 * 33], s[9 * 33], s[10 * 33], s[11 * 33]); o.w = pk4_fp8(s[12 * 33], s[13 * 33], s[14 * 33], s[15 * 33]);
        *(GAS v4u*)(WT8 + (size_t)(n0 + n) * ldt + k0 + 16 * c) = o; }
    LDS_WAIT(); asm volatile("" ::: "memory");
}
struct Args { const float* in[19]; float* out; unsigned char* ws; int ph_lo, ph_hi; };

__device__ __forceinline__ void p0_prologue(Frame& F, const Args& a) {
    LAS float* scr = (LAS float*)(F.lds + RING_OFF + F.wave * 16384);
    const int gw = F.vcu * NWAVES + F.wave, NGW = F.G * NWAVES;
    constexpr int I_IN = (DM / 64) * (N_BF / 32), I_G8 = (DM / 64) * (N_F8 / 32), I_P = (1024 / 64) * (DM / 32), I_O = (DM / 64) * (DM / 32), I_L = I_IN + I_G8 + 2 * I_P + I_O;
    for (int it = gw; it < DEPTH * I_L; it += NGW) {
        const int l = it / I_L; int r = it % I_L;
        bf16* win = (bf16*)(a.ws + WS_WIN) + (size_t)l * N_BF * DM; bf16* wpab = (bf16*)(a.ws + WS_WPAB) + (size_t)l * DM * DM; bf16* wout = (bf16*)(a.ws + WS_WOUT) + (size_t)l * DM * DM;
        if (r < I_IN) { p0_transpose_item(a.in[1] + (size_t)l * DM * IN_TOTAL, IN_TOTAL, N_BF, win, DM, 0, scr, r, F.lane); continue; } r -= I_IN;
        if (r < I_G8) { p0_transpose_item8(a.in[1] + (size_t)l * DM * IN_TOTAL + N_BF, IN_TOTAL, N_F8, a.ws + WS_WG8 + (size_t)l * N_F8 * DM, DM, W8_SCALE, scr, r, F.lane); continue; } r -= I_G8;
        if (r < I_P) { p0_transpose_item(a.in[14] + (size_t)l * 1024 * DM, DM, DM, wpab, DM, 0, scr, r, F.lane); continue; } r -= I_P;
        if (r < I_P) { p0_transpose_item(a.in[15] + (size_t)l * 1024 * DM, DM, DM, wpab, DM, 1024, scr, r, F.lane); continue; } r -= I_P;
        p0_transpose_item(a.in[16] + (size_t)l * DM * DM, DM, DM, wout, DM, 0, scr, r, F.lane);
    }
    for (int it = gw; it < DEPTH * NBLK * 4 * 2 * 8; it += NGW) {
        const int s_ = it & 7, g_ = (it >> 3) & 1, jq = (it >> 4) & 3, n = (it >> 6) & 7, l = it >> 9;
        const float* w = a.in[g_ ? 6 : 4] + ((size_t)(l * NBLK + n) * BLKW + 16 * s_ + 8 * (F.lane >> 5)) * BLKW + jq * 32 + (F.lane & 31);
        v4u o; o.x = pk2(w[0], w[BLKW]); o.y = pk2(w[2 * BLKW], w[3 * BLKW]); o.z = pk2(w[4 * BLKW], w[5 * BLKW]); o.w = pk2(w[6 * BLKW], w[7 * BLKW]);
        *(GAS v4u*)((bf16*)(a.ws + WS_GW) + (size_t)it * 512 + F.lane * 8) = o; }
    bf16* xb = (bf16*)(a.ws + WS_XB16); const float* x = a.in[0];
    for (int m = gw; m < M; m += NGW) {
        const GAS f32x4* xr = (const GAS f32x4*)(x + (size_t)m * DM) + F.lane; GAS unsigned long long* o8 = (GAS unsigned long long*)(xb + (size_t)m * DM) + F.lane;
        GAS unsigned* q8 = (GAS unsigned*)(a.ws + WS_XQ8 + (size_t)m * DM) + F.lane;
#pragma unroll
        for (int j = 0; j < 8; ++j) { const f32x4 v = xr[64 * j]; o8[64 * j] = (unsigned long long)pk2(v.x, v.y) | ((unsigned long long)pk2(v.z, v.w) << 32); q8[64 * j] = pk4_fp8(v.x, v.y, v.z, v.w); }
    }
}
__device__ __forceinline__ void ln_phase(Frame& F, float* y, bf16* xb, unsigned char* xq8, const float* g, const float* bta) {
    const int gw = F.vcu * NWAVES + F.wave, NGW = F.G * NWAVES; int lane = F.lane; asm volatile("" : "+v"(lane));
    for (int m = gw; m < M; m += NGW) {
        GAS f32x4* yr = (GAS f32x4*)(y + (size_t)m * DM) + lane; f32x4 v[8]; float s = 0.f;
#pragma unroll
        for (int j = 0; j < 8; ++j) { v[j] = yr[64 * j]; s += (v[j].x + v[j].y) + (v[j].z + v[j].w); }
        const float mean = wave_sum(s, lane) * (1.f / DM); float s2 = 0.f;
#pragma unroll
        for (int j = 0; j < 8; ++j) { v[j] = v[j] - mean; s2 += (v[j].x * v[j].x + v[j].y * v[j].y) + (v[j].z * v[j].z + v[j].w * v[j].w); }
        const float rstd = 1.f / sqrtf(wave_sum(s2, lane) * (1.f / DM) + LN_EPS);
        GAS unsigned long long* o8 = (GAS unsigned long long*)(xb + (size_t)m * DM) + lane; GAS unsigned* q8 = (GAS unsigned*)(xq8 + (size_t)m * DM) + lane;
#pragma unroll
        for (int j = 0; j < 8; ++j) { const f32x4 gg = *((const GAS f32x4*)g + lane + 64 * j), bb = *((const GAS f32x4*)bta + lane + 64 * j);
            const f32x4 o = v[j] * rstd * gg + bb; yr[64 * j] = o; o8[64 * j] = (unsigned long long)pk2(o.x, o.y) | ((unsigned long long)pk2(o.z, o.w) << 32); q8[64 * j] = pk4_fp8(o.x, o.y, o.z, o.w); }
    }
}
__device__ __forceinline__ void combine_block(Frame& F, int b, int h, int qb, const bf16* O1, const bf16* O2, const bf16* GA, bf16* AR, const float* subln_g, float lam, float lam_init) {
    typedef short s16x8 __attribute__((ext_vector_type(8)));
    int tid = F.tid; asm volatile("" : "+v"(tid));
#pragma unroll 1
    for (int it = 0; it < 4; ++it) {
        const int idx = tid + 512 * it, row = b * SEQ + qb * 256 + (idx >> 3), c16 = idx & 7, col = h * 128 + c16 * 16;
        const size_t off = (size_t)row * 1024 + col;
        const s16x8 a0 = *(const GAS s16x8*)(O1 + off), a1 = *(const GAS s16x8*)(O1 + off + 8), b0 = *(const GAS s16x8*)(O2 + off), b1 = *(const GAS s16x8*)(O2 + off + 8);
        const s16x8 g0 = *(const GAS s16x8*)(GA + off), g1 = *(const GAS s16x8*)(GA + off + 8);
        float o[16]; float ss = 0.f;
#pragma unroll
        for (int j = 0; j < 8; ++j) { o[j] = pg8::bfbits2f(a0[j]) - lam * pg8::bfbits2f(b0[j]); o[8 + j] = pg8::bfbits2f(a1[j]) - lam * pg8::bfbits2f(b1[j]); }
#pragma unroll
        for (int j = 0; j < 16; ++j) ss += o[j] * o[j];
        ss += __int_as_float(__builtin_amdgcn_ds_swizzle(__float_as_int(ss), 0x041f)); ss += __int_as_float(__builtin_amdgcn_ds_swizzle(__float_as_int(ss), 0x081f)); ss += __int_as_float(__builtin_amdgcn_ds_swizzle(__float_as_int(ss), 0x101f));
        const float rn = (1.f / sqrtf(ss * (1.f / 128.f) + SUBLN_EPS)) * (1.f - lam_init);
        unsigned w[8];
#pragma unroll
        for (int j = 0; j < 8; ++j) {
            const float ga0 = pg8::bfbits2f(j < 4 ? g0[2 * j] : g1[2 * j - 8]), ga1 = pg8::bfbits2f(j < 4 ? g0[2 * j + 1] : g1[2 * j - 7]);
            const float v0 = o[2 * j] * rn * subln_g[c16 * 16 + 2 * j] * (ga0 / (1.f + __expf(-ga0))), v1 = o[2 * j + 1] * rn * subln_g[c16 * 16 + 2 * j + 1] * (ga1 / (1.f + __expf(-ga1)));
            w[j] = pk2(v0, v1); }
        bf16* op = AR + (size_t)row * 2048 + col;
        *(GAS v4u*)op = (v4u){w[0], w[1], w[2], w[3]}; *(GAS v4u*)(op + 8) = (v4u){w[4], w[5], w[6], w[7]};
    }
}
constexpr int LRU_TM = 256, XCS_PITCH = 272, LRU_XCS = 0, LRU_AS = LRU_XCS + LRU_TM * XCS_PITCH, LRU_US = LRU_AS + LRU_TM * 32 * 4, LRU_AH = LRU_US + LRU_TM * 32 * 4, LRU_CARRY = LRU_AH + 16 * 32 * 8, LRU_WI = LRU_CARRY + 2 * 32 * 4, LRU_CW = LRU_WI + 8 * 64 * 16, LRU_END = LRU_CW + 5 * 128 * 4;
static_assert(LRU_END <= RING_BYTES, "LRU LDS map");
constexpr size_t GW_ITEM = 2 * 8 * 64 * 8;
#define LBAR() asm volatile("s_waitcnt lgkmcnt(0)\n\ts_barrier" ::: "memory")
__device__ __forceinline__ void lru_item(Frame& F, int b, int n, int jq, const bf16* XB, const bf16* GB, bf16* AR, const float* conv_w, const float* conv_b, const bf16* gwf, const float* b_r,
                                         const float* b_i, const float* lam) {
    typedef short s16x8 __attribute__((ext_vector_type(8))); typedef float f32x16 __attribute__((ext_vector_type(16))); typedef float f32x2 __attribute__((ext_vector_type(2)));
    LAS unsigned char* L = F.lds + RING_OFF;
    int tid = F.tid; asm volatile("" : "+v"(tid));
    const int lane = tid & 63, wave = F.wave, r32 = lane & 31, hi = lane >> 5;
    const int ch8 = tid & 15, tq = tid >> 4;
    const int cch = n * BLKW + jq * 32 + r32;
    s16x8 wfr[8];
#pragma unroll
    for (int s = 0; s < 8; ++s) wfr[s] = *(const GAS s16x8*)(gwf + (size_t)(s * 64 + lane) * 8);
    *(LAS s16x8*)(L + LRU_WI + tid * 16) = *(const GAS s16x8*)(gwf + (size_t)(8 * 64 + tid) * 8);
    const float bias_r = b_r[cch], bias_i = b_i[cch], lc = -8.f * log1pf(__expf(-lam[cch])), lc2 = lc * LOG2E;
    if (tid < 64) ((LAS float*)(L + LRU_CARRY))[tid] = 0.f;
    const bf16* xbase = XB + (size_t)b * SEQ * 1024 + n * BLKW + ch8 * 8;
    if (tid < 128) { LAS float* cwl = (LAS float*)(L + LRU_CW); cwl[tid] = conv_b[n * BLKW + tid];
#pragma unroll
        for (int j = 0; j < 4; ++j) cwl[(1 + j) * 128 + tid] = conv_w[j * LRUW + n * BLKW + tid]; }
    s16x8 xq[2][7];
#define LRU_LOADX(t0_) do { _Pragma("unroll") for (int g = 0; g < 2; ++g) _Pragma("unroll") for (int rr = 0; rr < 7; ++rr) { const int t = (t0_) + (tq + 32 * g) * 4 - 3 + rr; \
        xq[g][rr] = (t >= 0) ? *(const GAS s16x8*)(xbase + (size_t)t * 1024) : (s16x8){0, 0, 0, 0, 0, 0, 0, 0}; } } while (0)
    LRU_LOADX(0);
    LBAR();
#pragma unroll 1
    for (int ms = 0; ms < SEQ / LRU_TM; ++ms) {
        const int t0 = ms * LRU_TM;
        {
            float cw[4][8], cb[8];
            { unsigned cwb = (unsigned)(LRU_CW + ch8 * 32); asm volatile("" : "+v"(cwb));
              const f32x4 b0 = *(const LAS f32x4*)(L + cwb), b1 = *(const LAS f32x4*)(L + cwb + 16);
              cb[0] = b0.x; cb[1] = b0.y; cb[2] = b0.z; cb[3] = b0.w; cb[4] = b1.x; cb[5] = b1.y; cb[6] = b1.z; cb[7] = b1.w;
#pragma unroll
              for (int j = 0; j < 4; ++j) { const f32x4 w0 = *(const LAS f32x4*)(L + cwb + (1 + j) * 512), w1 = *(const LAS f32x4*)(L + cwb + (1 + j) * 512 + 16);
                  cw[j][0] = w0.x; cw[j][1] = w0.y; cw[j][2] = w0.z; cw[j][3] = w0.w; cw[j][4] = w1.x; cw[j][5] = w1.y; cw[j][6] = w1.z; cw[j][7] = w1.w; } }
            unsigned s1b = (unsigned)(LRU_XCS + tq * 4 * XCS_PITCH + ch8 * 16); asm volatile("" : "+v"(s1b));
#pragma unroll
            for (int g = 0; g < 2; ++g) {
                unsigned w[4][4];
#pragma unroll
                for (int i2 = 0; i2 < 4; ++i2) {
                    float x0[7], x1[7];
#pragma unroll
                    for (int rr = 0; rr < 7; ++rr) { const unsigned d = ((const unsigned*)&xq[g][rr])[i2]; x0[rr] = __uint_as_float(d << 16); x1[rr] = __uint_as_float(d & 0xffff0000u); }
#pragma unroll
                    for (int q = 0; q < 4; ++q) {
                        const float v0 = cb[2 * i2] + cw[0][2 * i2] * x0[q] + cw[1][2 * i2] * x0[q + 1] + cw[2][2 * i2] * x0[q + 2] + cw[3][2 * i2] * x0[q + 3];
                        const float v1 = cb[2 * i2 + 1] + cw[0][2 * i2 + 1] * x1[q] + cw[1][2 * i2 + 1] * x1[q + 1] + cw[2][2 * i2 + 1] * x1[q + 2] + cw[3][2 * i2 + 1] * x1[q + 3];
                        w[q][i2] = pk2(v0, v1); }
                    asm volatile("" : "+v"(w[0][i2]), "+v"(w[1][i2]), "+v"(w[2][i2]), "+v"(w[3][i2]));
                }
#pragma unroll
                for (int q = 0; q < 4; ++q) *(LAS v4u*)(L + s1b + (32 * g * 4 + q) * XCS_PITCH) = (v4u){w[q][0], w[q][1], w[q][2], w[q][3]};
            }
        }
        if (ms + 1 < SEQ / LRU_TM) LRU_LOADX(t0 + LRU_TM);
        LBAR();
        {
            f32x16 ar, ai;
#pragma unroll
            for (int r = 0; r < 16; ++r) { ar[r] = bias_r; ai[r] = bias_i; }
            unsigned s2a = (unsigned)(LRU_XCS + (32 * wave + r32) * XCS_PITCH + hi * 16), s2i = (unsigned)(LRU_WI + lane * 16); asm volatile("" : "+v"(s2a), "+v"(s2i));
#pragma unroll
            for (int s = 0; s < 8; ++s) { const s16x8 af = *(const LAS s16x8*)(L + s2a + s * 32), wi = *(const LAS s16x8*)(L + s2i + s * 1024);
                ar = __builtin_amdgcn_mfma_f32_32x32x16_bf16(af, wfr[s], ar, 0, 0, 0); ai = __builtin_amdgcn_mfma_f32_32x32x16_bf16(af, wi, ai, 0, 0, 0); }
            unsigned s2x = (unsigned)(LRU_XCS + (32 * wave + 4 * hi) * XCS_PITCH + (jq * 32 + r32) * 2), s2w = (unsigned)((32 * wave + 4 * hi) * 128 + r32 * 4); asm volatile("" : "+v"(s2x), "+v"(s2w));
#pragma unroll
            for (int r = 0; r < 16; ++r) { const int cr = (r & 3) + 8 * (r >> 2);
                const float rg = __builtin_amdgcn_rcpf(1.f + __builtin_amdgcn_exp2f(-LOG2E * ar[r])), ig = __builtin_amdgcn_rcpf(1.f + __builtin_amdgcn_exp2f(-LOG2E * ai[r]));
                const float av = __builtin_amdgcn_exp2f(lc2 * rg), t = 2.f * lc * rg;
                const float ser = -t * (1.f + t * (0.5f + t * (0.16666667f + t * (0.041666668f + t * 0.0083333338f))));
                const float om = (t > -0.1f) ? ser : (1.f - av * av);
                const float xc = __uint_as_float(((unsigned)*(const LAS unsigned short*)(L + s2x + cr * XCS_PITCH)) << 16);
                const float uv = __builtin_amdgcn_sqrtf(om) * (ig * xc);
                *(LAS float*)(L + LRU_AS + s2w + cr * 128) = av; *(LAS float*)(L + LRU_US + s2w + cr * 128) = uv; }
        }
        LBAR();
        s16x8 gbv[2];
#pragma unroll
        for (int g = 0; g < 2; ++g) { const int idx = tid + 512 * g, tl = idx >> 2, c8 = idx & 3; gbv[g] = *(const GAS s16x8*)(GB + ((size_t)b * SEQ + t0 + tl) * 1024 + n * BLKW + jq * 32 + c8 * 8); }
        {
            const int sc = tid >> 5, o = tid & 31; unsigned s3b = (unsigned)(((sc * 16) * 32 + o) * 4); asm volatile("" : "+v"(s3b));
            LAS float* as = (LAS float*)(L + LRU_AS + s3b); LAS float* us = (LAS float*)(L + LRU_US + s3b);
            float a[16], u[16];
#pragma unroll
            for (int i = 0; i < 16; ++i) { a[i] = as[i * 32]; u[i] = us[i * 32]; }
            float A = 1.f, H = 0.f;
#pragma unroll
            for (int i = 0; i < 16; ++i) { H = a[i] * H + u[i]; A *= a[i]; }
            unsigned s3o = (unsigned)(LRU_AH + o * 8); asm volatile("" : "+v"(s3o));
            *(LAS f32x2*)(L + s3o + sc * 256) = (f32x2){A, H};
            LBAR();
            float h = ((LAS float*)(L + LRU_CARRY))[(ms & 1) * 32 + o];
            f32x2 p[15];
#pragma unroll
            for (int s2 = 0; s2 < 15; ++s2) p[s2] = *(const LAS f32x2*)(L + s3o + s2 * 256);
#pragma unroll
            for (int s2 = 0; s2 < 15; ++s2) h = (s2 < sc) ? p[s2].x * h + p[s2].y : h;
#pragma unroll
            for (int i = 0; i < 16; ++i) { h = a[i] * h + u[i]; us[i * 32] = h; }
            if (sc == 15) ((LAS float*)(L + LRU_CARRY))[((ms + 1) & 1) * 32 + o] = h;
        }
        LBAR();
#pragma unroll
        for (int g = 0; g < 2; ++g) { const int idx = tid + 512 * g, tl = idx >> 2, c8 = idx & 3; const size_t row = (size_t)b * SEQ + t0 + tl; const int col = n * BLKW + jq * 32 + c8 * 8;
            unsigned s4b = (unsigned)(LRU_US + (tl * 32 + c8 * 8) * 4); asm volatile("" : "+v"(s4b));
            const f32x4 h0 = *(const LAS f32x4*)(L + s4b), h1 = *(const LAS f32x4*)(L + s4b + 16);
            const s16x8 gv = gbv[g]; float hv[8] = {h0.x, h0.y, h0.z, h0.w, h1.x, h1.y, h1.z, h1.w}; unsigned w[4];
#pragma unroll
            for (int i2 = 0; i2 < 4; ++i2) { const float g0 = pg8::bfbits2f(gv[2 * i2]), g1 = pg8::bfbits2f(gv[2 * i2 + 1]);
                w[i2] = pk2(hv[2 * i2] * g0 * __builtin_amdgcn_rcpf(1.f + __builtin_amdgcn_exp2f(-LOG2E * g0)), hv[2 * i2 + 1] * g1 * __builtin_amdgcn_rcpf(1.f + __builtin_amdgcn_exp2f(-LOG2E * g1))); }
            *(GAS v4u*)(AR + row * 2048 + 1024 + col) = (v4u){w[0], w[1], w[2], w[3]}; }
    }
#undef LRU_LOADX
    LBAR();
}

#ifndef MK_DBL
#define MK_DBL 0
#endif
#define DBL(k) for (int rep_ = 0; rep_ < 1 + ((MK_DBL >> (k)) & 1); ++rep_)
constexpr int N_PH_LAYER = 5, N_PHASES = 1 + DEPTH * N_PH_LAYER;
__global__ void __launch_bounds__(NWAVES * 64, 2) mk_fwd(Args args) {
    extern __shared__ __attribute__((aligned(16))) unsigned char lds[];
    Frame F;
    F.lds = (LAS unsigned char*)lds; F.MISC = (volatile LAS unsigned*)(F.lds + MISC_OFF);
    F.tid = threadIdx.x; F.lane = F.tid & 63; F.wave = __builtin_amdgcn_readfirstlane(F.tid >> 6);
    F.G = gridDim.x; { const int bx = blockIdx.x; F.vcu = (F.G % 8 == 0) ? (bx % 8) * (F.G / 8) + bx / 8 : bx; }
    F.ctl = (gu32*)(args.ws + WS_CTL);
    for (int u = F.tid; u < (LDS_BYTES - LDSCTL_OFF) / 4; u += NWAVES * 64) ((LAS unsigned*)(F.lds + LDSCTL_OFF))[u] = 0u;
    __syncthreads();
    const int lo = args.ph_lo, hi = args.ph_hi;
    const bool use_bar = (hi - lo) > 1;
    XcdBarrier bar; bar.bar = (unsigned*)(F.ctl + CW_BAR); bar.x = 0; bar.st = nullptr;
    if (use_bar) bar = xcd_barrier_post((unsigned*)(F.ctl + CW_BAR), F.MISC + 8);
#define IN(k) (lo <= (k) && (k) < hi)
#define SEAM(k) do { if (IN(k) && IN((k) + 1)) xcd_barrier(bar); } while (0)
#define CAS __attribute__((address_space(4)))
    typedef unsigned char* ucp_t; typedef float* fp_t; typedef const float* cfp_t;
#define KARGS() CAS const char* ka_ = (CAS const char*)__builtin_amdgcn_kernarg_segment_ptr(); asm volatile("" : "+s"(ka_)); unsigned char* const ws = *(CAS const ucp_t*)(ka_ + 160); float* const outp = *(CAS const fp_t*)(ka_ + 152); (void)outp; (void)ws
#define KIN(k) (*(CAS const cfp_t*)(ka_ + 8 * (k)))
#define WSP(off) ((bf16*)(ws + (off)))
    if (IN(0)) { DBL(0) p0_prologue(F, args); } SEAM(0);
#pragma unroll 1
    for (int l = 0; l < DEPTH; ++l) {
        const int pb = 1 + l * N_PH_LAYER;
        const float lam_init = 0.8f - 0.6f * __expf(-0.3f * (float)l);
        if (IN(pb)) {
            KARGS(); bf16* const P6 = WSP(WS_P6); bf16* const MA = WSP(WS_MA); bf16* const MB = WSP(WS_MB);
            { pg8::Gemm g{WSP(WS_XB16), WSP(WS_WIN) + (size_t)l * N_BF * DM, M, N_BF, DM}; pg8::StaticOrder S; S.init(M, N_BF, F.G, (int)blockIdx.x);
              pg8::EpiProj E{P6, MA, MB, (size_t)M * 1024, attn_body::C2, 0, 1.f};
              DBL(1) pg8::gemm_phase<pg8::EpiProj, pg8::StaticOrder, PG8_ALIGN, PG8_SP2>(F.lds + RING_OFF, g, S, E); }
            { pg8::Gemm g{(const pg8::bf16_t*)(ws + WS_XQ8), (const pg8::bf16_t*)(ws + WS_WG8 + (size_t)l * N_F8 * DM), M, N_F8, DM / 2}; pg8::StaticOrder S; S.init(M, N_F8, F.G, (int)blockIdx.x);
              pg8::EpiProj E{P6, MA, MB, (size_t)M * 1024, attn_body::C2, N_BF / 256, 1.f / W8_SCALE};
              DBL(1) pg8::gemm_phase<pg8::EpiProj, pg8::StaticOrder, PG8_ALIGN, PG8_SP2, true>(F.lds + RING_OFF, g, S, E); }
        }
        SEAM(pb);
        if (IN(pb + 1)) {
            KARGS(); bf16* const P6 = WSP(WS_P6); bf16* const O1 = WSP(WS_O1); bf16* const O2 = WSP(WS_O2); bf16* const AR = WSP(WS_AR);
            bf16* const Qb = P6; bf16* const Kb = P6 + (size_t)M * 1024; bf16* const Vb = P6 + (size_t)2 * M * 1024; bf16* const GA = P6 + (size_t)3 * M * 1024; bf16* const XBb = P6 + (size_t)4 * M * 1024; bf16* const GBb = P6 + (size_t)5 * M * 1024;
            int ln_ = F.lane; asm volatile("" : "+v"(ln_));
            float d1 = KIN(9)[l * 64 + ln_] * KIN(10)[l * 64 + ln_], d2 = KIN(11)[l * 64 + ln_] * KIN(12)[l * 64 + ln_];
            d1 = wave_sum(d1, ln_); d2 = wave_sum(d2, ln_);
            const float lam = __uint_as_float(__builtin_amdgcn_readfirstlane(__float_as_uint(__expf(d1) - __expf(d2) + lam_init)));
            const int bh = F.vcu >> 2, p = F.vcu & 3, b = bh >> 3, h = bh & 7;
            const float slope2 = exp2f(-(float)(h + 1)) * LOG2E;
            if (F.G == 256) {
#pragma unroll 1
                for (int i = 0; i < 2; ++i) {
                    const int qb = i ? (7 - p) : p;
#pragma unroll 1
                    DBL(2) for (int c = 0; c < 2; ++c) {
                        attn_body::attn_unit<8>(b, 2 * h + c, h, qb, slope2, (const attn_body::bf16*)Qb, (const attn_body::bf16*)Kb, (const attn_body::bf16*)Vb, (attn_body::bf16*)(c ? O2 : O1), (char*)lds + RING_OFF);
                    }
                    VM_WAIT(); __syncthreads();
                    DBL(6) combine_block(F, b, h, qb, O1, O2, GA, AR, KIN(13) + l * 128, lam, lam_init);
                }
                DBL(3) lru_item(F, F.vcu >> 5, (F.vcu >> 2) & 7, F.vcu & 3, XBb, GBb, AR, KIN(2) + (size_t)l * 4 * LRUW, KIN(3) + l * LRUW,
                         (const bf16*)(ws + WS_GW) + ((size_t)(l * NBLK + ((F.vcu >> 2) & 7)) * 4 + (F.vcu & 3)) * GW_ITEM, KIN(5) + l * LRUW, KIN(7) + l * LRUW, KIN(8) + l * LRUW);
            }
        }
        SEAM(pb + 1);
        if (IN(pb + 2)) {
            KARGS();
            pg8::Gemm g{WSP(WS_AR), WSP(WS_WPAB) + (size_t)l * DM * DM, M, DM, DM}; pg8::StaticOrder S; S.init(M, DM, F.G, (int)blockIdx.x);
            pg8::EpiMerge E{WSP(WS_MA), WSP(WS_MB), WSP(WS_MERGED)};
            DBL(4) pg8::gemm_phase<pg8::EpiMerge, pg8::StaticOrder, PG8_ALIGN, PG8_SP2>(F.lds + RING_OFF, g, S, E);
        }
        SEAM(pb + 2);
        if (IN(pb + 3)) {
            KARGS();
            pg8::Gemm g{WSP(WS_MERGED), WSP(WS_WOUT) + (size_t)l * DM * DM, M, DM, DM}; pg8::StaticOrder S; S.init(M, DM, F.G, (int)blockIdx.x);
            pg8::EpiRes E{l == 0 ? KIN(0) : outp, outp, DN_ALPHA};
            for (int rep_ = 0; rep_ < 1 + (((MK_DBL >> 5) & 1) && l == 0); ++rep_) pg8::gemm_phase<pg8::EpiRes, pg8::StaticOrder, PG8_ALIGN, PG8_SP2>(F.lds + RING_OFF, g, S, E);
        }
        SEAM(pb + 3);
        if (IN(pb + 4)) { KARGS(); ln_phase(F, outp, WSP(WS_XB16), ws + WS_XQ8, KIN(17) + l * DM, KIN(18) + l * DM); }
        SEAM(pb + 4);
    }
#undef IN
#undef SEAM
#undef KARGS
#undef KIN
#undef WSP
#undef CAS
}

#ifndef MK_PER_PHASE
#define MK_PER_PHASE 0
#endif
extern "C" void kernel_launch(void* const* d_in, const int* in_sizes, int n_in, void* d_out, int out_size, void* d_ws, size_t ws_size, hipStream_t stream) {
    static int grid = 0;
    if (grid == 0) {
        if (n_in != 19 || in_sizes[0] != M * DM || out_size != M * DM || ws_size < WS_END) { fprintf(stderr, "kernel_launch: unexpected shapes / workspace (n_in %d, ws %zu); nothing launched\n", n_in, ws_size); grid = -1; return; }
        int dev = 0, cus = 0;
        if (hipGetDevice(&dev) != hipSuccess || hipDeviceGetAttribute(&cus, hipDeviceAttributeMultiprocessorCount, dev) != hipSuccess) { grid = -1; return; }
        if (hipFuncSetAttribute((const void*)mk_fwd, hipFuncAttributeMaxDynamicSharedMemorySize, LDS_BYTES) != hipSuccess) { fprintf(stderr, "kernel_launch: hipFuncSetAttribute failed\n"); grid = -1; return; }
        int per_cu = 0;
        if (hipOccupancyMaxActiveBlocksPerMultiprocessor(&per_cu, (const void*)mk_fwd, NWAVES * 64, LDS_BYTES) != hipSuccess || per_cu < 1) fprintf(stderr, "kernel_launch: occupancy query reports %d blocks per CU\n", per_cu);
        (void)hipGetLastError();
        grid = cus;
        if (grid != 256) fprintf(stderr, "kernel_launch: %d CUs; the attention/LRU phase is built for 256\n", grid);
    }
    if (grid < 0) return;
    if (hipMemsetAsync((char*)d_ws + WS_CTL, 0, CTL_ZERO_BYTES, stream) != hipSuccess) return;
    Args a{};
    for (int i = 0; i < 19; ++i) a.in[i] = (const float*)d_in[i];
    a.out = (float*)d_out; a.ws = (unsigned char*)d_ws;
#if MK_PER_PHASE
    for (int p = 0; p < N_PHASES; ++p) { a.ph_lo = p; a.ph_hi = p + 1; hipLaunchKernelGGL(mk_fwd, dim3(grid), dim3(NWAVES * 64), LDS_BYTES, stream, a); }
#else
    a.ph_lo = 0; a.ph_hi = N_PHASES;
    hipLaunchKernelGGL(mk_fwd, dim3(grid), dim3(NWAVES * 64), LDS_BYTES, stream, a);
#endif
}
```

```cpp
#include <hip/hip_runtime.h>
#include <cstdio>
#include <cstdint>
namespace pg8 {
#define PG8_LAS __attribute__((address_space(3)))
typedef unsigned short bf16_t;
typedef short bf16x8 __attribute__((ext_vector_type(8)));
typedef float f32x4 __attribute__((ext_vector_type(4)));
typedef unsigned u32x4 __attribute__((ext_vector_type(4)));
constexpr int BM = 256, BK = 64, HALF = 128, HTB = HALF * BK * 2  , STAGE_BYTES = 8 * HTB, NXCD = 8, WGM = 8;

__host__ __device__ __forceinline__ int lds_byte(int r, int c) { const int st = (r >> 4) * 2 + (c >> 5), rr = r & 15, cc = c & 31, ob = rr * 64 + cc * 2; return st * 1024 + (ob ^ (((ob >> 9) & 1) << 5)); }
__host__ __device__ __forceinline__ void stage_rc(int b, int& R, int& C) { const int st = b / 1024, sb = b % 1024, swz = sb ^ (((sb >> 9) & 1) << 5); R = (st >> 1) * 16 + swz / 64; C = (st & 1) * 32 + (swz % 64) / 2; }
__host__ __device__ __forceinline__ int perm32(int rho) { const int n = rho >> 4, i = rho & 15; return 8 * (i >> 2) + 4 * n + (i & 3); }

struct Unit { int pm, pn; };
struct Gemm { const bf16_t* A; const bf16_t* Bt; int M, N, K; };

struct StaticOrder {
    int nM, nN, nwg, G, c;
    __host__ __device__ void init(int M, int N, int G_, int c_) { nM = M / BM; nN = N / BM; nwg = nM * nN; G = G_; c = c_; }
    __host__ __device__ bool next(int i, Unit& u) const {
        const long L = (long)i * G + c; if (L >= nwg) return false;
        int wgid = (int)L; { const int q = nwg / NXCD, r = nwg % NXCD, xcd = wgid % NXCD, off = wgid / NXCD; wgid = (xcd < r ? xcd * (q + 1) : r * (q + 1) + (xcd - r) * q) + off; }
        const int nig = WGM * nN, gid = wgid / nig, fm = gid * WGM, gsz = (nM - fm) < WGM ? (nM - fm) : WGM;
        u.pm = fm + ((wgid % nig) % gsz); u.pn = (wgid % nig) / gsz; return true;
    }
    __device__ __forceinline__ void a_ready(const Unit&) const {}
    __device__ __forceinline__ void done(const Unit&) const {}
};

__device__ __forceinline__ unsigned cvt_pk_bf16(float lo, float hi) { unsigned r; asm volatile("v_cvt_pk_bf16_f32 %0, %1, %2" : "=v"(r) : "v"(lo), "v"(hi)); return r; }
typedef short s16x8_t __attribute__((ext_vector_type(8)));
__device__ __forceinline__ float bfbits2f(short v) { return __uint_as_float(((unsigned)(unsigned short)v) << 16); }
struct EpiProj {
    static constexpr bool PERM = true, AFTER_DRAIN = false, HAS_MID = false;
    bf16_t* base6; bf16_t* ma; bf16_t* mb; size_t stride6; float qscale; int pn_off; float gscale;
    __device__ __forceinline__ void operator()(const f32x4 (&acc)[2][2][4][2], const Unit& u, int wr, int wc, int fr, int fq) const {
        const int pn = u.pn + pn_off; bf16_t* base; int ldc, colt; float sc = 1.f;
        float qs_ = qscale, gs_ = gscale; asm volatile("" : "+v"(qs_), "+v"(gs_));
        if (pn < 24) { const int t = pn >> 2; base = base6 + (size_t)t * stride6; ldc = 1024; colt = (pn & 3) * BM; sc = (t == 0) ? qs_ : gs_; }
        else if (pn < 32) { base = ma; ldc = 2048; colt = (pn - 24) * BM; sc = gs_; }
        else { base = mb; ldc = 2048; colt = (pn - 32) * BM; sc = gs_; }
        int t_ = threadIdx.x; asm volatile("" : "+v"(t_));
        const int lrow = (t_ >> 8) * 64 + (t_ & 15), lcol = ((t_ >> 6) & 3) * 32 + 8 * ((t_ >> 4) & 3);
        const int row0 = u.pm * BM + lrow, col0 = colt + lcol;
#pragma unroll
        for (int ai = 0; ai < 2; ++ai)
#pragma unroll
            for (int m = 0; m < 4; ++m) { bf16_t* rowp = base + (size_t)(row0 + ai * HALF + m * 16) * ldc + col0;
#pragma unroll
                for (int bj = 0; bj < 2; ++bj) { const f32x4 v0 = acc[ai][bj][m][0] * sc, v1 = acc[ai][bj][m][1] * sc;
                    u32x4 w; w.x = cvt_pk_bf16(v0[0], v0[1]); w.y = cvt_pk_bf16(v0[2], v0[3]); w.z = cvt_pk_bf16(v1[0], v1[1]); w.w = cvt_pk_bf16(v1[2], v1[3]);
                    *(u32x4*)(rowp + bj * HALF) = w; } }
    }
};
struct EpiMerge {
    static constexpr bool PERM = true, AFTER_DRAIN = false, HAS_MID = true;
    const bf16_t* ma; const bf16_t* mb; bf16_t* out;
    __device__ __forceinline__ void mid(f32x4 (&acc)[2][2][4][2], const Unit& u, int wr, int wc, int fr, int fq) const {
        unsigned lofs = (unsigned)((wr * 64 + fr) * 2048 + wc * 32 + 8 * fq); asm volatile("" : "+v"(lofs));
        const size_t tofs = (size_t)u.pm * BM * 2048 + (size_t)u.pn * BM;
#pragma unroll
        for (int ai = 0; ai < 2; ++ai)
#pragma unroll
            for (int m = 0; m < 4; ++m) { const size_t off = tofs + lofs + (size_t)(ai * HALF + m * 16) * 2048;
#pragma unroll
                for (int bj = 0; bj < 2; ++bj) { const s16x8_t a = *(const s16x8_t*)(ma + off + bj * HALF), b = *(const s16x8_t*)(mb + off + bj * HALF);
#pragma unroll
                    for (int j = 0; j < 8; ++j) { const float xa = bfbits2f(a[j]), xb = fmaxf(bfbits2f(b[j]), -30.f);
                        const float f = (1.f + __expf(-xb)) * __builtin_amdgcn_rcpf(1.f + __expf(-xa)); acc[ai][bj][m][j >> 2][j & 3] *= f; } }
                asm volatile("" ::: "memory"); }
    }
    __device__ __forceinline__ void operator()(const f32x4 (&acc)[2][2][4][2], const Unit& u, int wr, int wc, int fr, int fq) const {
        unsigned lofs = (unsigned)((wr * 64 + fr) * 2048 + wc * 32 + 8 * fq); asm volatile("" : "+v"(lofs));
        const size_t tofs = (size_t)u.pm * BM * 2048 + (size_t)u.pn * BM;
#pragma unroll
        for (int ai = 0; ai < 2; ++ai)
#pragma unroll
            for (int m = 0; m < 4; ++m) { const size_t off = tofs + lofs + (size_t)(ai * HALF + m * 16) * 2048;
#pragma unroll
                for (int bj = 0; bj < 2; ++bj) { const s16x8_t b = *(const s16x8_t*)(mb + off + bj * HALF); float v[8];
#pragma unroll
                    for (int j = 0; j < 8; ++j) { const float xb = fmaxf(bfbits2f(b[j]), -30.f); v[j] = acc[ai][bj][m][j >> 2][j & 3] * __builtin_amdgcn_rcpf(1.f + __expf(-xb)); }
                    u32x4 w; w.x = cvt_pk_bf16(v[0], v[1]); w.y = cvt_pk_bf16(v[2], v[3]); w.z = cvt_pk_bf16(v[4], v[5]); w.w = cvt_pk_bf16(v[6], v[7]);
                    *(u32x4*)(out + off + bj * HALF) = w; }
                asm volatile("" ::: "memory"); }
    }
};
struct EpiRes {
    static constexpr bool PERM = false, AFTER_DRAIN = false, HAS_MID = false;
    const float* base; float* out; float alpha;
    __device__ __forceinline__ void operator()(const f32x4 (&acc)[2][2][4][2], const Unit& u, int wr, int wc, int fr, int fq) const {
        const int row0 = u.pm * BM + wr * 64 + fr, col0 = u.pn * BM + wc * 32 + 4 * fq;
#pragma unroll
        for (int ai = 0; ai < 2; ++ai)
#pragma unroll
            for (int m = 0; m < 4; ++m) { const size_t off = (size_t)(row0 + ai * HALF + m * 16) * 2048 + col0;
#pragma unroll
                for (int bj = 0; bj < 2; ++bj)
#pragma unroll
                    for (int n = 0; n < 2; ++n) { const f32x4 bs = *(const f32x4*)(base + off + bj * HALF + n * 16); *(f32x4*)(out + off + bj * HALF + n * 16) = bs * alpha + acc[ai][bj][m][n]; }
                if (m & 1) asm volatile("" ::: "memory"); }
    }
};
typedef int pg8_v4i __attribute__((ext_vector_type(4))); typedef int pg8_v8i __attribute__((ext_vector_type(8)));
template <bool FP8> struct FragSel { struct type { bf16x8 k[2]; }; };
template <> struct FragSel<true> { typedef pg8_v8i type; };
template <bool FP8, class F> __device__ __forceinline__ void ld_frag(F& d, const PG8_LAS unsigned char* p) {
    if constexpr (FP8) { const pg8_v4i lo = *(const PG8_LAS pg8_v4i*)p, hi = *(const PG8_LAS pg8_v4i*)(p + 16); d = __builtin_shufflevector(lo, hi, 0, 1, 2, 3, 4, 5, 6, 7); }
    else { d.k[0] = *(const PG8_LAS bf16x8*)p; d.k[1] = *(const PG8_LAS bf16x8*)(p + 1024); }
}
template <bool FP8, class F> __device__ __forceinline__ void mma_frag(f32x4& c, const F& b, const F& a) {
    if constexpr (FP8) c = __builtin_amdgcn_mfma_scale_f32_16x16x128_f8f6f4(b, a, c, 0, 0, 0, 0, 0, 0);
    else { c = __builtin_amdgcn_mfma_f32_16x16x32_bf16(b.k[0], a.k[0], c, 0, 0, 0); c = __builtin_amdgcn_mfma_f32_16x16x32_bf16(b.k[1], a.k[1], c, 0, 0, 0); }
}
template <class Epi, class Sched, bool ALIGN_EPI = false, bool SP2 = false, bool FP8 = false>
__device__ __forceinline__ void gemm_phase(PG8_LAS unsigned char* lds, const Gemm g, const Sched& S, const Epi& E) {
    int tid_ = threadIdx.x; asm volatile("" : "+v"(tid_));
    const int tid = tid_, wid = __builtin_amdgcn_readfirstlane(tid >> 6), lane = tid & 63, wr = wid >> 2, wc = wid & 3, fr = lane & 15, fq = lane >> 4;
    const int K = g.K, nt = K / BK;
    unsigned voffA[2], voffB[2];
#pragma unroll
    for (int i = 0; i < 2; ++i) { int R, C; stage_rc(tid * 16 + i * 8192, R, C); const int Rb = Epi::PERM ? ((R & ~31) + perm32(R & 31)) : R;
        voffA[i] = (unsigned)(R * K + C) * 2u; voffB[i] = (unsigned)(Rb * K + C) * 2u; }
    const size_t kstep = (size_t)(BK * 2);
    const size_t hstep = (size_t)HALF * K * 2;
    const size_t tstep = 2 * hstep;
    const unsigned lds0 = (unsigned)(uintptr_t)lds;
    const unsigned ldsw = (unsigned)wid * 1024u;
    const int fcol = FP8 ? 32 * (fq >> 1) + 16 * (fq & 1) : fq * 8;
    const int aoff = lds_byte(wr * 64 + fr, fcol), boff = lds_byte(wc * 32 + fr, fcol);
#define PG8_SA(b, h) (((b) * 2 + (h)) * HTB)
#define PG8_SB(b, h) ((4 + (b) * 2 + (h)) * HTB)
#define PG8_STAGE(bufoff, gbase, voff) do { _Pragma("unroll") for (int _i = 0; _i < 2; ++_i) { unsigned keep_; \
        asm volatile("s_mov_b32 %0, m0\n\ts_mov_b32 m0, %3\n\ts_nop 4\n\tglobal_load_lds_dwordx4 %1, %2\n\ts_mov_b32 m0, %0" : "=&s"(keep_) : "v"((voff)[_i]), "s"((const char*)(gbase)), \
                     "s"((unsigned)__builtin_amdgcn_readfirstlane((int)(lds0 + (unsigned)(bufoff) + ldsw + (unsigned)(_i * 8192)))) : "memory"); } } while (0)
#define PG8_LDA(dst, b, h) do { _Pragma("unroll") for (int m = 0; m < 4; ++m) ld_frag<FP8>(dst[m], lds + PG8_SA(b, h) + aoff + m * 2048); } while (0)
#define PG8_LDB(dst, b, h) do { _Pragma("unroll") for (int n = 0; n < 2; ++n) ld_frag<FP8>(dst[n], lds + PG8_SB(b, h) + boff + n * 2048); } while (0)
#define PG8_MMA(ai, bj, At, Bt) do { __builtin_amdgcn_s_setprio(1); _Pragma("unroll") for (int m = 0; m < 4; ++m) _Pragma("unroll") for (int n = 0; n < 2; ++n) \
        mma_frag<FP8>(acc[ai][bj][m][n], Bt[n], At[m]); __builtin_amdgcn_s_setprio(0); } while (0)
#define PG8_WAIT_V(n) asm volatile("s_waitcnt vmcnt(" #n ")" ::: "memory")
#define PG8_WAIT_L(n) asm volatile("s_waitcnt lgkmcnt(" #n ")" ::: "memory")
#define PG8_BAR __builtin_amdgcn_s_barrier()
#define PG8_SCHED __builtin_amdgcn_sched_barrier(0)
    Unit cur, nxt; int ui = 0;
    if (!S.next(0, cur)) return;
    f32x4 acc[2][2][4][2];
#pragma unroll
    for (int a = 0; a < 2; ++a)
#pragma unroll
        for (int b = 0; b < 2; ++b)
#pragma unroll
            for (int m = 0; m < 4; ++m)
#pragma unroll
                for (int n = 0; n < 2; ++n) acc[a][b][m][n] = (f32x4){0.f, 0.f, 0.f, 0.f};
    typename FragSel<FP8>::type At[4], B0[2], B1[2];
    const char* cA = (const char*)g.A + (size_t)cur.pm * tstep; const char* cB = (const char*)g.Bt + (size_t)cur.pn * tstep;
    S.a_ready(cur);
    if constexpr (SP2) {
        PG8_STAGE(PG8_SB(0, 0), cB, voffB); PG8_STAGE(PG8_SB(0, 1), cB + hstep, voffB); PG8_STAGE(PG8_SA(0, 0), cA, voffA); PG8_STAGE(PG8_SA(0, 1), cA + hstep, voffA);
        if (wr == 1) PG8_BAR;
        PG8_WAIT_V(2); PG8_BAR;
        PG8_STAGE(PG8_SB(1, 0), cB + kstep, voffB); PG8_STAGE(PG8_SA(1, 0), cA + kstep, voffA); PG8_STAGE(PG8_SB(1, 1), cB + hstep + kstep, voffB);
        PG8_WAIT_V(6); PG8_BAR;
    } else {
        PG8_STAGE(PG8_SB(0, 0), cB, voffB); PG8_STAGE(PG8_SA(0, 0), cA, voffA); PG8_STAGE(PG8_SB(0, 1), cB + hstep, voffB); PG8_STAGE(PG8_SA(0, 1), cA + hstep, voffA);
        if (wr == 1) PG8_BAR;
        PG8_WAIT_V(4); PG8_BAR;
        PG8_STAGE(PG8_SB(1, 0), cB + kstep, voffB); PG8_STAGE(PG8_SA(1, 0), cA + kstep, voffA); PG8_STAGE(PG8_SB(1, 1), cB + hstep + kstep, voffB);
        PG8_WAIT_V(6); PG8_BAR;
    }
    for (;;) {
        const bool has_next = S.next(ui + 1, nxt);
        const char* nA = has_next ? (const char*)g.A + (size_t)nxt.pm * tstep : cA; const char* nB = has_next ? (const char*)g.Bt + (size_t)nxt.pn * tstep : cB;
        for (int t = 0; t < nt; t += 2) {
            const bool last = (t == nt - 2);
            if constexpr (Epi::HAS_MID) { if (t == nt / 2) E.mid(acc, cur, wr, wc, fr, fq); }
            const char* a1 = cA + (size_t)(t + 1) * kstep;
            const char* a2 = last ? nA : cA + (size_t)(t + 2) * kstep; const char* b2 = last ? nB : cB + (size_t)(t + 2) * kstep;
            const char* a3 = a2 + kstep; const char* b3 = b2 + kstep;
            if (last && has_next) S.a_ready(nxt);
            if constexpr (SP2) {
            PG8_LDB(B0, 0, 0); PG8_LDB(B1, 0, 1); PG8_SCHED; PG8_LDA(At, 0, 0); PG8_STAGE(PG8_SA(1, 1), a1 + hstep, voffA);
            PG8_WAIT_V(8); PG8_WAIT_L(0); PG8_BAR; PG8_MMA(0, 0, At, B0); PG8_MMA(0, 1, At, B1); PG8_BAR; PG8_SCHED;
            PG8_LDA(At, 0, 1); PG8_STAGE(PG8_SB(0, 0), b2, voffB); PG8_STAGE(PG8_SB(0, 1), b2 + hstep, voffB); PG8_STAGE(PG8_SA(0, 0), a2, voffA);
            PG8_WAIT_V(8); PG8_WAIT_L(0); PG8_BAR; PG8_MMA(1, 0, At, B0); PG8_MMA(1, 1, At, B1); PG8_BAR; PG8_SCHED;
            PG8_LDB(B0, 1, 0); PG8_LDB(B1, 1, 1); PG8_SCHED; PG8_LDA(At, 1, 0); PG8_STAGE(PG8_SA(0, 1), a2 + hstep, voffA);
            PG8_WAIT_V(8); PG8_WAIT_L(0); PG8_BAR; PG8_MMA(0, 0, At, B0); PG8_MMA(0, 1, At, B1); PG8_BAR; PG8_SCHED;
            PG8_LDA(At, 1, 1); PG8_STAGE(PG8_SB(1, 0), b3, voffB); PG8_STAGE(PG8_SB(1, 1), b3 + hstep, voffB); PG8_STAGE(PG8_SA(1, 0), a3, voffA);
            PG8_WAIT_V(8); PG8_WAIT_L(0); PG8_BAR; PG8_MMA(1, 0, At, B0); PG8_MMA(1, 1, At, B1); PG8_BAR; PG8_SCHED;
            } else {
            PG8_LDB(B0, 0, 0); PG8_SCHED; PG8_LDA(At, 0, 0); PG8_STAGE(PG8_SA(1, 1), a1 + hstep, voffA);
            PG8_WAIT_L(8); PG8_BAR; PG8_WAIT_L(0); PG8_MMA(0, 0, At, B0); PG8_BAR; PG8_SCHED;
            PG8_LDB(B1, 0, 1); PG8_STAGE(PG8_SB(0, 0), b2, voffB);
            PG8_BAR; PG8_WAIT_L(0); PG8_MMA(0, 1, At, B1); PG8_BAR;
            PG8_LDA(At, 0, 1); PG8_STAGE(PG8_SA(0, 0), a2, voffA);
            PG8_BAR; PG8_WAIT_L(0); PG8_MMA(1, 0, At, B0); PG8_BAR; PG8_SCHED;
            PG8_STAGE(PG8_SB(0, 1), b2 + hstep, voffB);
            PG8_WAIT_V(6); PG8_BAR; PG8_MMA(1, 1, At, B1); PG8_BAR;
            PG8_LDB(B0, 1, 0); PG8_SCHED; PG8_LDA(At, 1, 0); PG8_STAGE(PG8_SA(0, 1), a2 + hstep, voffA);
            PG8_WAIT_L(8); PG8_BAR; PG8_WAIT_L(0); PG8_MMA(0, 0, At, B0); PG8_BAR; PG8_SCHED;
            PG8_LDB(B1, 1, 1); PG8_STAGE(PG8_SB(1, 0), b3, voffB);
            PG8_BAR; PG8_WAIT_L(0); PG8_MMA(0, 1, At, B1); PG8_BAR;
            PG8_LDA(At, 1, 1); PG8_STAGE(PG8_SA(1, 0), a3, voffA);
            PG8_BAR; PG8_WAIT_L(0); PG8_MMA(1, 0, At, B0); PG8_BAR; PG8_SCHED;
            PG8_STAGE(PG8_SB(1, 1), b3 + hstep, voffB);
            PG8_WAIT_V(6); PG8_BAR; PG8_MMA(1, 1, At, B1); PG8_BAR;
            }
        }
        if constexpr (ALIGN_EPI) { if (wr == 0) PG8_BAR; }
        if constexpr (!Epi::AFTER_DRAIN) { E(acc, cur, wr, wc, fr, fq); S.done(cur); }
        if (!has_next) break;
#pragma unroll
        for (int a = 0; a < 2; ++a)
#pragma unroll
            for (int b = 0; b < 2; ++b)
#pragma unroll
                for (int m = 0; m < 4; ++m)
#pragma unroll
                    for (int n = 0; n < 2; ++n) acc[a][b][m][n] = (f32x4){0.f, 0.f, 0.f, 0.f};
        cur = nxt; cA = nA; cB = nB; ++ui;
        if constexpr (ALIGN_EPI) { if (wr == 1) PG8_BAR; }
    }
    PG8_WAIT_V(0);
    if constexpr (!ALIGN_EPI) { if (wr == 0) PG8_BAR; }
    PG8_BAR;
    if constexpr (Epi::AFTER_DRAIN) { E.fused(acc, cur, wr, wc, fr, fq, lds, wid, lane); S.done(cur); }
#undef PG8_SA
#undef PG8_SB
#undef PG8_STAGE
#undef PG8_LDA
#undef PG8_LDB
#undef PG8_MMA
#undef PG8_WAIT_V
#undef PG8_WAIT_L
#undef PG8_BAR
#undef PG8_SCHED
}
}

#ifndef PG8_SP2
#define PG8_SP2 true
#endif
#ifndef PG8_ALIGN
#define PG8_ALIGN true
#endif
#include <hip/hip_bf16.h>
#include <cmath>
namespace attn_body {
using bf16=__hip_bfloat16;
using bf16x8=__attribute__((ext_vector_type(8)))short;
using s16x4=__attribute__((ext_vector_type(4)))short;
using f32x16=__attribute__((ext_vector_type(16)))float;
using u32x4=__attribute__((ext_vector_type(4)))unsigned;
constexpr int BATCH=8,NHEAD=16,SEQ=2048,D=64,DM=NHEAD*D;
constexpr int NW=8,QBLK=32,QB=QBLK*NW,KVBLK=64,NQB=SEQ/QB;
constexpr int ATTN_PITCH=DM, ATTN_UNIT_ROWS=QB;
__device__ __forceinline__ int crow(int r,int hi){return (r&3)+8*(r>>2)+4*hi;}
#define SBAR() __builtin_amdgcn_sched_barrier(0)
__device__ __forceinline__ void cmask(f32x16&p0,f32x16&p1,int jb,int qrel,int hi){
  const float NEG=-INFINITY; int kb=64*jb+4*hi;
  #pragma unroll
  for(int r=0;r<16;++r){int kv=kb+(r&3)+8*(r>>2); if(kv>qrel)p0[r]=NEG; if(kv+32>qrel)p1[r]=NEG;}
}

constexpr int NSLOT=3, SLOTB=8192, VD=128;
constexpr int LDS_K=0, LDS_V=NSLOT*SLOTB, LDS_WS=3*NSLOT*SLOTB, LDS_OST=LDS_WS+NW*64*4, LDS_BYTES=LDS_OST+NW*8192;
constexpr float C2=0.125f*1.4426950408889634f;
__device__ __forceinline__ void glds16(const void*gsrc,unsigned lds_dst){unsigned keep;
  asm volatile("s_mov_b32 %0, m0\n\ts_mov_b32 m0, %2\n\ts_nop 0\n\tglobal_load_lds_dwordx4 %1, off\n\ts_mov_b32 m0, %0":"=&s"(keep):"v"(gsrc),"s"(lds_dst):"memory");}
__device__ __forceinline__ void glds16o(const void*sbase,unsigned voff,unsigned lds_dst){unsigned keep;
  asm volatile("s_mov_b32 %0, m0\n\ts_mov_b32 m0, %3\n\ts_nop 4\n\tglobal_load_lds_dwordx4 %1, %2\n\ts_mov_b32 m0, %0":"=&s"(keep):"v"(voff),"s"(sbase),"s"(lds_dst):"memory");}
__device__ __forceinline__ float max3f(float a,float b,float c){float r;asm("v_max3_f32 %0, %1, %2, %3":"=v"(r):"v"(a),"v"(b),"v"(c));return r;}
__device__ __forceinline__ float max2f(float a,float b){float r;asm("v_max_f32_e32 %0, %1, %2":"=v"(r):"v"(a),"v"(b));return r;}
__device__ __forceinline__ float fadd_s(float a,float b){float r;asm("v_add_f32_e32 %0, %1, %2":"=v"(r):"v"(a),"v"(b));return r;}
__device__ __forceinline__ float fsub_s(float a,float b){float r;asm("v_sub_f32_e32 %0, %1, %2":"=v"(r):"v"(a),"v"(b));return r;}
typedef float f32x2_t __attribute__((ext_vector_type(2))); typedef __bf16 bf16x2_t __attribute__((ext_vector_type(2)));
__device__ __forceinline__ unsigned cvtpk_s(float lo,float hi){f32x2_t v={lo,hi};bf16x2_t b=__builtin_convertvector(v,bf16x2_t);return __builtin_bit_cast(unsigned,b);}
#define WAIT_BAR(N) asm volatile("s_waitcnt vmcnt(" #N ") lgkmcnt(0)\n\ts_barrier":::"memory")

__device__ __forceinline__ void qkt(f32x16&p0,f32x16&p1,const char*Kslot,const bf16x8*qr,int r32,int hi){
  const char*kb=Kslot+hi*1024+r32*16;
  #pragma unroll
  for(int d0=0;d0<4;++d0){
    const bf16x8 b0=*reinterpret_cast<const bf16x8*>(kb+d0*2048);
    const bf16x8 b1=*reinterpret_cast<const bf16x8*>(kb+d0*2048+512);
    {p0=__builtin_amdgcn_mfma_f32_32x32x16_bf16(b0,qr[d0],p0,0,0,0);p1=__builtin_amdgcn_mfma_f32_32x32x16_bf16(b1,qr[d0],p1,0,0,0);}}
}
typedef __attribute__((address_space(3))) const char* lds_cptr;
typedef short v4i16_t __attribute__((ext_vector_type(4)));
__device__ __forceinline__ void kload8(bf16x8*kf,lds_cptr kp){
  kf[0]=*(const __attribute__((address_space(3))) bf16x8*)(kp);      kf[1]=*(const __attribute__((address_space(3))) bf16x8*)(kp+512);
  kf[2]=*(const __attribute__((address_space(3))) bf16x8*)(kp+2048); kf[3]=*(const __attribute__((address_space(3))) bf16x8*)(kp+2560);
  kf[4]=*(const __attribute__((address_space(3))) bf16x8*)(kp+4096); kf[5]=*(const __attribute__((address_space(3))) bf16x8*)(kp+4608);
  kf[6]=*(const __attribute__((address_space(3))) bf16x8*)(kp+6144); kf[7]=*(const __attribute__((address_space(3))) bf16x8*)(kp+6656);
}
__device__ __forceinline__ void kload2(bf16x8*kf,lds_cptr kp,int j){ kf[2*j]=*(const __attribute__((address_space(3))) bf16x8*)(kp+j*2048); kf[2*j+1]=*(const __attribute__((address_space(3))) bf16x8*)(kp+j*2048+512); }
__device__ __forceinline__ s16x4 vtr(lds_cptr p){ return __builtin_bit_cast(s16x4,__builtin_amdgcn_ds_read_tr16_b64_v4i16((__attribute__((address_space(3))) v4i16_t*)p)); }
__device__ __forceinline__ float rowmax(const f32x16&p0,const f32x16&p1){
  float a=max3f(p0[0],p0[1],p1[0]),b=max3f(p0[2],p0[3],p1[1]);a=max3f(a,p1[2],p1[3]);
  #pragma unroll
  for(int r=4;r<16;r+=4){a=max3f(a,p0[r],p0[r+1]);b=max3f(b,p0[r+2],p0[r+3]);a=max3f(a,p1[r],p1[r+1]);b=max3f(b,p1[r+2],p1[r+3]);}
  const float m=max2f(a,b);
  auto rr=__builtin_amdgcn_permlane32_swap(__float_as_uint(m),__float_as_uint(m),false,false);
  return max2f(__uint_as_float(rr[0]),__uint_as_float(rr[1]));
}
__device__ __forceinline__ void pv(f32x16*o,int vb,bf16x8 pa0,bf16x8 pa1,bf16x8 pa2,bf16x8 pa3){
  #pragma unroll
  for(int d0=0;d0<4;++d0){s16x4 lo[4],hi[4];
    #pragma unroll
    for(int ks=0;ks<4;++ks){
      asm volatile("ds_read_b64_tr_b16 %0,%1 offset:%c2":"=&v"(lo[ks]):"v"(vb),"i"(d0*4096+ks*1024):"memory");
      asm volatile("ds_read_b64_tr_b16 %0,%1 offset:%c2":"=&v"(hi[ks]):"v"(vb),"i"(d0*4096+ks*1024+512):"memory");}
    asm volatile("s_waitcnt lgkmcnt(0)":::"memory");SBAR();
    #define PK(k) (bf16x8){lo[k][0],lo[k][1],lo[k][2],lo[k][3],hi[k][0],hi[k][1],hi[k][2],hi[k][3]}
    o[d0]=__builtin_amdgcn_mfma_f32_32x32x16_bf16(pa0,PK(0),o[d0],0,0,0);
    o[d0]=__builtin_amdgcn_mfma_f32_32x32x16_bf16(pa1,PK(1),o[d0],0,0,0);
    o[d0]=__builtin_amdgcn_mfma_f32_32x32x16_bf16(pa2,PK(2),o[d0],0,0,0);
    o[d0]=__builtin_amdgcn_mfma_f32_32x32x16_bf16(pa3,PK(3),o[d0],0,0,0);
    #undef PK
  }
}

#ifndef ATTN_STORE16
#define ATTN_STORE16(p,v) (*(u32x4*)(p)=(v))
#endif
template<int THRL> __device__ __forceinline__ void attn_unit(int b,int hq,int hh,int qb,float slope2,const bf16*Q,const bf16*__restrict__ K,const bf16*__restrict__ V,bf16*O,char*shm){
  int tid_=threadIdx.x; asm volatile("":"+v"(tid_)); const int tid=tid_,lane=tid&63,r32=lane&31,hi=lane>>5; const int wid=__builtin_amdgcn_readfirstlane(tid>>6);
  const long rowbase=(long)b*SEQ; const int q0=qb*QB;
  const bf16*Qw=Q+(rowbase+q0+wid*QBLK)*DM+hq*D;
  const bf16*Kh=K+rowbase*DM+hq*D,*Vh=V+rowbase*DM+hh*VD;
  const unsigned lds0=(unsigned)(uintptr_t)shm;
  float*wsf=(float*)(shm+LDS_WS)+wid*64;
  const unsigned koff=(unsigned)((lane*DM+wid*8)*2);
  const unsigned voff=(unsigned)(((16*(wid&3)+(lane>>2))*DM+(wid>>2)*32+(lane&3)*8)*2);
  const unsigned kdst=lds0+LDS_K+wid*1024, vdst=lds0+LDS_V+wid*1024;
  #define DMA_K(t,slot) glds16o(Kh+(long)(t)*KVBLK*DM,koff,(unsigned)__builtin_amdgcn_readfirstlane(kdst+(slot)))
  #define DMA_V(t,slot) do{ glds16o(Vh+(long)(t)*KVBLK*DM,voff,(unsigned)__builtin_amdgcn_readfirstlane(vdst+2*(slot))); glds16o(Vh+(long)(t)*KVBLK*DM+64,voff,(unsigned)__builtin_amdgcn_readfirstlane(vdst+2*(slot)+8192)); }while(0)
  const int vb0=(int)(lds0+LDS_V)+((lane>>4)&1)*32+(lane&3)*8+(4*hi+((lane&15)>>2))*64;
  const char*Kbase=shm+LDS_K; bf16x8 kf[8];
  const lds_cptr shm3=(lds_cptr)shm; const lds_cptr kp0=shm3+LDS_K+hi*1024+r32*16; const lds_cptr vp0=shm3+LDS_V+((lane>>4)&1)*32+(lane&3)*8+(4*hi+((lane&15)>>2))*64;
  const int NT=(q0+QB)/KVBLK;
  DMA_K(0,0);DMA_V(0,0);DMA_K(1,SLOTB);
  bf16x8 qr[4];
  #pragma unroll
  for(int d0=0;d0<4;++d0)qr[d0]=*reinterpret_cast<const bf16x8*>(&Qw[(long)r32*DM+d0*16+hi*8]);
  float l_reg=0.f;f32x16 o[4];o[0]=f32x16{};o[1]=f32x16{};o[2]=f32x16{};o[3]=f32x16{};
  float nb=slope2*(float)(4*hi-q0-255); const float sl64=64.f*slope2;
  #define BINIT0(C0,t) do{ _Pragma("unroll") for(int r=0;r<16;++r)C0[r]=fmaf(slope2,(float)((r&3)+8*(r>>2)),nb); }while(0)
  #define BINIT1(C1,t) do{ _Pragma("unroll") for(int r=0;r<16;++r)C1[r]=fmaf(slope2,(float)((r&3)+8*(r>>2)+32),nb); nb+=sl64; }while(0)
  const int qrel=wid*QBLK+r32;
  #define CMASK(P0,P1,t) do{int jb_=(t)-(NT-4); if(jb_>=0)cmask(P0,P1,jb_,qrel,hi);}while(0)
  bool resc=false;
  #define START(P0,P1) do{ const float rm=rowmax(P0,P1); resc=false; \
    { const float dl=rm; nb=fsub_s(nb,dl); \
      _Pragma("unroll") for(int r=0;r<16;++r){P0[r]=fsub_s(P0[r],dl);P1[r]=fsub_s(P1[r],dl);} } \
    _Pragma("unroll") for(int r=0;r<16;++r)P0[r]=__builtin_amdgcn_exp2f(P0[r]); }while(0)
  #define RESC() do{ if(resc){ asm volatile("s_waitcnt lgkmcnt(0)":::"memory"); \
      _Pragma("unroll") for(int d_=0;d_<4;++d_) _Pragma("unroll") for(int r=0;r<16;++r)o[d_][r]*=wsf[crow(r,hi)]; } }while(0)
  f32x16 pA0,pA1,pB0,pB1;
  int sl_prev=0,sl_cur=0,sl_next=SLOTB;
  #define ROT() do{sl_prev=sl_cur;sl_cur=sl_next;sl_next=(sl_next==(NSLOT-1)*SLOTB)?0:sl_next+SLOTB;}while(0)
  DMA_K(2,2*SLOTB);
  WAIT_BAR(3);
  asm volatile("":"+v"(nb));
  BINIT0(pA0,0);BINIT1(pA1,0);qkt(pA0,pA1,Kbase,qr,r32,hi);asm volatile("s_nop 15\n\ts_nop 7":"+v"(pA0),"+v"(pA1));CMASK(pA0,pA1,0);
  START(pA0,pA1);
  _Pragma("unroll") for(int r=0;r<16;++r)pA1[r]=__builtin_amdgcn_exp2f(pA1[r]);
  WAIT_BAR(0);
  DMA_K(3,0);DMA_V(1,SLOTB);
  ROT();
  kload8(kf,kp0+sl_cur);
  WAIT_BAR(3);
  s16x4 vlo[16],vhi[16]; u32x4 pw0,pw1,pw2,pw3;
  #define PKW(P,B) cvtpk_s(P[B],P[B+1])
  #define PAF(k) __builtin_bit_cast(bf16x8,pw##k)
  #define VFR(i) (bf16x8){vlo[i][0],vlo[i][1],vlo[i][2],vlo[i][3],vhi[i][0],vhi[i][1],vhi[i][2],vhi[i][3]}
  #define PIN(x) asm volatile("":"+v"(x))
  #define MX3(a,b,c) __builtin_fmaxf(__builtin_fmaxf((a),(b)),(c))
  #define GAPA(MF,A0,A1,A2,A3,W0,W1,PW) do{ MF; sacc+=A0; sacc+=A1; sacc+=A2; sacc+=A3; PIN(sacc); W0; W1; PIN(PW); SBAR(); }while(0)
  #define EX(v) __builtin_amdgcn_exp2f(v)
  #define VRD(j) do{ vlo[j]=vtr(vp_+(((j)&3)*4096+((j)>>2)*1024)); vhi[j]=vtr(vp_+(((j)&3)*4096+((j)>>2)*1024+512)); }while(0)
  #define GAPB(j,k,X,B) do{ asm volatile("s_waitcnt lgkmcnt(0)":::"memory"); SBAR(); o[(j)&3]=__builtin_amdgcn_mfma_f32_32x32x16_bf16(PAF(k),VFR(j),o[(j)&3],0,0,0); X[B]=EX(X[B]); X[B+1]=EX(X[B+1]); PIN(X); if((j)+4<16){VRD(((j)+4)&15);} SBAR(); }while(0)
  #define KRD(G,j) do{ if(G){ kload2(kf,kp0+sl_next,j); SBAR(); } }while(0)
  #define STEP(C0,C1,P0,P1,t,GK,GV,GL) do{ SBAR(); \
    const lds_cptr vp_=vp0+2*sl_prev; \
    BINIT0(C0,t); PIN(C0); SBAR(); float sacc=(P0[0]+P0[1]); \
    GAPA(C0=__builtin_amdgcn_mfma_f32_32x32x16_bf16(kf[0],qr[0],C0,0,0,0), P0[2],P0[3],P0[4],P0[5],     pw0[0]=PKW(P0,0), pw0[1]=PKW(P0,2), pw0); \
    BINIT1(C1,t); PIN(C1); SBAR(); GAPA(C1=__builtin_amdgcn_mfma_f32_32x32x16_bf16(kf[1],qr[0],C1,0,0,0), P0[6],P0[7],P0[8],P0[9],     pw0[2]=PKW(P0,4), pw0[3]=PKW(P0,6), pw0); \
    GAPA(C0=__builtin_amdgcn_mfma_f32_32x32x16_bf16(kf[2],qr[1],C0,0,0,0),   P0[10],P0[11],P0[12],P0[13], pw1[0]=PKW(P0,8), pw1[1]=PKW(P0,10), pw1); \
    GAPA(C1=__builtin_amdgcn_mfma_f32_32x32x16_bf16(kf[3],qr[1],C1,0,0,0),   P0[14],P0[15],P1[0],P1[1],   pw1[2]=PKW(P0,12),pw1[3]=PKW(P0,14), pw1); \
    VRD(0); SBAR(); GAPA(C0=__builtin_amdgcn_mfma_f32_32x32x16_bf16(kf[4],qr[2],C0,0,0,0),   P1[2],P1[3],P1[4],P1[5],     pw2[0]=PKW(P1,0), pw2[1]=PKW(P1,2), pw2); \
    VRD(1); SBAR(); GAPA(C1=__builtin_amdgcn_mfma_f32_32x32x16_bf16(kf[5],qr[2],C1,0,0,0),   P1[6],P1[7],P1[8],P1[9],     pw2[2]=PKW(P1,4), pw2[3]=PKW(P1,6), pw2); \
    VRD(2); SBAR(); GAPA(C0=__builtin_amdgcn_mfma_f32_32x32x16_bf16(kf[6],qr[3],C0,0,0,0),   P1[10],P1[11],P1[12],P1[13], pw3[0]=PKW(P1,8), pw3[1]=PKW(P1,10), pw3); \
    VRD(3); SBAR(); GAPA(C1=__builtin_amdgcn_mfma_f32_32x32x16_bf16(kf[7],qr[3],C1,0,0,0),   P1[14],P1[15],0.f,0.f,       pw3[2]=PKW(P1,12),pw3[3]=PKW(P1,14), pw3); \
    l_reg+=sacc; \
    if(GK){DMA_K((t)+3,sl_cur);} if(GV){DMA_V((t)+1,sl_next);} \
    CMASK(C0,C1,t); \
    { float a=MX3(C0[0],C0[1],C1[0]),b=MX3(C0[2],C0[3],C1[1]); a=MX3(a,C1[2],C1[3]); \
      _Pragma("unroll") for(int r=4;r<16;r+=4){a=MX3(a,C0[r],C0[r+1]);b=MX3(b,C0[r+2],C0[r+3]);a=MX3(a,C1[r],C1[r+1]);b=MX3(b,C1[r+2],C1[r+3]);} \
      float rm=__builtin_fmaxf(a,b); { auto rr=__builtin_amdgcn_permlane32_swap(__float_as_uint(rm),__float_as_uint(rm),false,false); rm=__builtin_fmaxf(__uint_as_float(rr[0]),__uint_as_float(rr[1])); } \
      resc=false; \
      if(__builtin_expect(__any(rm>(float)THRL),0)){ const float dl=__builtin_fmaxf(rm,0.f); nb-=dl; \
        _Pragma("unroll") for(int r=0;r<16;++r){C0[r]-=dl;C1[r]-=dl;} \
        const float f=__builtin_amdgcn_exp2f(-dl); l_reg*=f; if(hi==0)wsf[r32]=f; resc=true; } } \
    SBAR(); \
    GAPB(0,0,C0,0); GAPB(1,0,C0,2); GAPB(2,0,C0,4); GAPB(3,0,C0,6); \
    GAPB(4,1,C0,8); GAPB(5,1,C0,10); KRD(GL,0); GAPB(6,1,C0,12); GAPB(7,1,C0,14); \
    KRD(GL,1); GAPB(8,2,C1,0); GAPB(9,2,C1,2); KRD(GL,2); GAPB(10,2,C1,4); GAPB(11,2,C1,6); \
    KRD(GL,3); GAPB(12,3,C1,8); GAPB(13,3,C1,10); GAPB(14,3,C1,12); GAPB(15,3,C1,14); \
    }while(0)
  int t=1;
  #undef CMASK
  #define CMASK(P0,P1,t) do{}while(0)
  for(;t+5<NT;t+=2){
    STEP(pB0,pB1,pA0,pA1,t,true,true,true);     WAIT_BAR(3); RESC(); ROT();
    STEP(pA0,pA1,pB0,pB1,t+1,true,true,true);   WAIT_BAR(3); RESC(); ROT();
  }
  #undef CMASK
  #define CMASK(P0,P1,t) do{int jb_=(t)-(NT-4); if(jb_>=0)cmask(P0,P1,jb_,qrel,hi);}while(0)
  #define ENDW(tt) do{ if((tt)+3<NT){WAIT_BAR(3);} else if((tt)+2<NT){WAIT_BAR(2);} else {WAIT_BAR(0);} }while(0)
  for(;t+1<NT;t+=2){
    STEP(pB0,pB1,pA0,pA1,t,(t+3<NT),(t+1<NT),(t+1<NT));       ENDW(t);   RESC(); ROT();
    STEP(pA0,pA1,pB0,pB1,t+1,(t+4<NT),(t+2<NT),(t+2<NT));     ENDW(t+1); RESC(); ROT();
  }
  STEP(pB0,pB1,pA0,pA1,NT-1,false,false,false); RESC();
  { float sacc=pB0[0]+pB0[1]; _Pragma("unroll") for(int r=2;r<16;++r)sacc+=pB0[r]; _Pragma("unroll") for(int r=0;r<16;++r)sacc+=pB1[r]; l_reg+=sacc;
    pw0=(u32x4){PKW(pB0,0),PKW(pB0,2),PKW(pB0,4),PKW(pB0,6)};pw1=(u32x4){PKW(pB0,8),PKW(pB0,10),PKW(pB0,12),PKW(pB0,14)};pw2=(u32x4){PKW(pB1,0),PKW(pB1,2),PKW(pB1,4),PKW(pB1,6)};pw3=(u32x4){PKW(pB1,8),PKW(pB1,10),PKW(pB1,12),PKW(pB1,14)};
    SBAR(); pv(o,vb0+2*sl_cur,PAF(0),PAF(1),PAF(2),PAF(3)); }
  #undef PKW
  #undef PAF
  #undef VFR
  #undef PIN
  #undef MX3
  #undef GAPA
  #undef GAPB
  #undef EX
  #undef VRD
  #undef KRD
  #undef STEP
  #undef ENDW
  {auto rr=__builtin_amdgcn_permlane32_swap(__float_as_uint(l_reg),__float_as_uint(l_reg),false,false);l_reg=__uint_as_float(rr[0])+__uint_as_float(rr[1]);}
  if(hi==0)wsf[32+r32]=l_reg;asm volatile("s_waitcnt lgkmcnt(0)":::"memory");
  float rli[16];
  #pragma unroll
  for(int r=0;r<16;++r)rli[r]=__builtin_amdgcn_rcpf(wsf[32+crow(r,hi)]);
  bf16*Ow=O+(rowbase+q0+wid*QBLK)*DM+hh*VD;
  { bf16*stg=(bf16*)(shm+LDS_OST)+wid*4096;
    #pragma unroll
    for(int r=0;r<16;++r){const int orow=crow(r,hi);
      #pragma unroll
      for(int d0=0;d0<4;++d0)stg[orow*128+d0*32+r32]=__float2bfloat16(o[d0][r]*rli[r]);}
    asm volatile("s_waitcnt lgkmcnt(0)":::"memory");
    #pragma unroll
    for(int i=0;i<8;++i){const int row=i*4+(lane>>4),ch=lane&15; const u32x4 v=*(const u32x4*)(stg+row*128+ch*8); ATTN_STORE16(Ow+(long)row*DM+ch*8,v);} }
  asm volatile("s_waitcnt lgkmcnt(0)\n\ts_barrier":::"memory");
  #undef DMA_K
  #undef DMA_V
  #undef BINIT0
  #undef BINIT1
  #undef CMASK
  #undef START
  #undef RESC
  #undef ROT
}
constexpr int ATTN_LDS_BYTES=LDS_BYTES;
#undef SBAR
#undef WAIT_BAR
}
#define GAS __attribute__((address_space(1)))
#define LAS __attribute__((address_space(3)))
typedef unsigned short bf16;
typedef unsigned v4u __attribute__((ext_vector_type(4)));
typedef float f32x4 __attribute__((ext_vector_type(4)));
typedef short bf16x8 __attribute__((ext_vector_type(8)));
typedef GAS unsigned gu32;
typedef GAS unsigned long long gu64;
#define RLX_AGENT __ATOMIC_RELAXED, __HIP_MEMORY_SCOPE_AGENT
#define LDS_WAIT() asm volatile("s_waitcnt lgkmcnt(0)" ::: "memory")
#define VM_WAIT() asm volatile("s_waitcnt vmcnt(0)" ::: "memory")
__device__ __forceinline__ unsigned long long rt() { return __builtin_amdgcn_s_memrealtime(); }
__device__ __forceinline__ unsigned f2bf(float f) { unsigned u = __builtin_bit_cast(unsigned, f); return (u + 0x7fffu + ((u >> 16) & 1u)) >> 16; }
typedef float f32x2_pk __attribute__((ext_vector_type(2))); typedef __bf16 bf16x2_pk __attribute__((ext_vector_type(2)));
__device__ __forceinline__ unsigned pk2(float lo, float hi) { f32x2_pk v = {lo, hi}; bf16x2_pk b = __builtin_convertvector(v, bf16x2_pk); return __builtin_bit_cast(unsigned, b); }

#define XB_TMO      128
#define XB_XCNT(j)  (256  + 64 * (j))
#define XB_XSUB(j)  (1280 + 64 * (j))
#define XB_XGEN(j)  (2304 + 64 * (j))
#define XB_TOP      3328
#define XB_TOPGEN   3392
#define XCD_BAR_WORDS 3456
#define XB_SPIN_CAP (1u << 18)

__device__ __forceinline__ unsigned xb_ld(unsigned* p)              { return __hip_atomic_load(p, __ATOMIC_RELAXED, __HIP_MEMORY_SCOPE_AGENT); }
__device__ __forceinline__ unsigned xb_add(unsigned* p, unsigned v) { return __hip_atomic_fetch_add(p, v, __ATOMIC_RELAXED, __HIP_MEMORY_SCOPE_AGENT); }
__device__ __forceinline__ unsigned xb_xcc_id() { return (unsigned)__builtin_amdgcn_s_getreg((3 << 11) | 20) & 0xFu; }
#define XB_SPIN(cond, bar) do { unsigned _sp = 0; while (cond) { __builtin_amdgcn_s_sleep(1); \
    if ((++_sp & 255u) == 0u) { if (xb_ld(&(bar)[XB_TMO])) break; if (_sp > XB_SPIN_CAP) { atomicAdd(&(bar)[XB_TMO], 1u); break; } } } } while (0)

struct XcdBarrier {
    unsigned* bar; unsigned x;
    volatile LAS unsigned* st;
};

__device__ __forceinline__ XcdBarrier xcd_barrier_post(unsigned* bar, volatile LAS unsigned* st) {
    XcdBarrier b; b.bar = bar; b.x = xb_xcc_id(); b.st = st;
    if (threadIdx.x == 0) (void)xb_add(&bar[XB_XCNT(b.x)], 1u);
    return b;
}
__device__ __forceinline__ void xcd_barrier_complete(unsigned* bar, unsigned x, unsigned& nloc, unsigned& nx) {
    const unsigned G = gridDim.x * gridDim.y * gridDim.z;
    unsigned sum, cnt, mine, sp = 0u;
    for (;;) {
        sum = 0u; cnt = 0u; mine = 0u;
#pragma unroll
        for (unsigned j = 0; j < 16; ++j) { const unsigned c = xb_ld(&bar[XB_XCNT(j)]); sum += c; cnt += (c > 0u) ? 1u : 0u; mine = (j == x) ? c : mine; }
        if (sum == G) break;
        __builtin_amdgcn_s_sleep(1);
        if ((++sp & 255u) == 0u) { if (xb_ld(&bar[XB_TMO])) break; if (sp > XB_SPIN_CAP) { atomicAdd(&bar[XB_TMO], 1u); break; } }
    }
    nloc = mine > 0u ? mine : 1u; nx = cnt > 0u ? cnt : 1u;
}

__device__ __forceinline__ void xcd_barrier(const XcdBarrier& b) {
    asm volatile("s_waitcnt vmcnt(0)" ::: "memory");
    __syncthreads();
    if (threadIdx.x == 0) {
        unsigned* bar = b.bar;
        __builtin_amdgcn_s_waitcnt(0);
        unsigned nloc = b.st[0], nx = b.st[1];
        if (nloc == 0u) { xcd_barrier_complete(bar, b.x, nloc, nx); b.st[0] = nloc; b.st[1] = nx; }
        const unsigned old = xb_add(&bar[XB_XSUB(b.x)], 1u);
        const unsigned gen = old / nloc;
        if (old + 1u == (gen + 1u) * nloc) {
            __builtin_amdgcn_fence(__ATOMIC_RELEASE, "agent");
            asm volatile("s_waitcnt vmcnt(0)" ::: "memory");
            const unsigned og = xb_add(&bar[XB_TOP], 1u);
            const unsigned tg = og / nx;
            if (og + 1u == (tg + 1u) * nx) xb_add(&bar[XB_TOPGEN], 1u);
            else XB_SPIN(xb_ld(&bar[XB_TOPGEN]) == tg, bar);
            __builtin_amdgcn_fence(__ATOMIC_ACQUIRE, "agent");
            xb_add(&bar[XB_XGEN(b.x)], 1u);
            asm volatile("s_waitcnt vmcnt(0)" ::: "memory");
        } else {
            XB_SPIN(xb_ld(&bar[XB_XGEN(b.x)]) == gen, bar);
            __builtin_amdgcn_fence(__ATOMIC_ACQUIRE, "agent");
            asm volatile("s_waitcnt vmcnt(0)" ::: "memory");
        }
    }
    __syncthreads();
}
constexpr int NWAVES = 8;
constexpr int BATCH = 8, SEQ = 2048, DM = 2048, DEPTH = 2, M = BATCH * SEQ;
constexpr int HEADS = 8, IN_TOTAL = 10240, LRUW = 1024, NBLK = 8, BLKW = 128;
constexpr float LN_EPS = 1e-5f, SUBLN_EPS = 1e-5f, DN_ALPHA = 1.41421356237309515f, LOG2E = 1.4426950408889634f;

constexpr size_t MiB = 1u << 20;
constexpr size_t WS_CTL = 0, CTL_ZERO_BYTES = 1 * MiB;
constexpr size_t WS_GW = 1 * MiB;
constexpr int N_BF = 4096, N_F8 = 6144;
constexpr float W8_SCALE = 64.f;
constexpr size_t WS_WIN = 2 * MiB;
constexpr size_t WS_WG8 = 34 * MiB;
constexpr size_t WS_XQ8 = 66 * MiB;
constexpr size_t WS_WPAB = 98 * MiB;
constexpr size_t WS_WOUT = 114 * MiB;
constexpr size_t WS_XB16 = 130 * MiB;
constexpr size_t WS_O1 = 130 * MiB, WS_O2 = 162 * MiB, WS_MERGED = 130 * MiB;
constexpr size_t WS_P6 = 194 * MiB;
constexpr size_t WS_MA = 386 * MiB, WS_MB = 450 * MiB;
constexpr size_t WS_AR = 514 * MiB;
constexpr size_t WS_END = 578 * MiB;
constexpr int CW_TMO = 0, CW_BAR = 4096;

constexpr int RING_OFF = 0, RING_BYTES = 151552;
constexpr int LDSCTL_OFF = RING_BYTES, MISC_OFF = LDSCTL_OFF + 320;
constexpr int LDS_BYTES = 153600;
static_assert(MISC_OFF + 128 <= LDS_BYTES && attn_body::ATTN_LDS_BYTES <= RING_BYTES && pg8::STAGE_BYTES <= RING_BYTES, "LDS map");

struct Frame {
    LAS unsigned char* lds; volatile LAS unsigned* MISC; gu32* ctl;
    int tid, lane, wave, vcu, G;
};
__device__ __forceinline__ float wave_sum(float v, int lane) {
#pragma unroll
    for (int o = 1; o < 64; o <<= 1) v += __int_as_float(__builtin_amdgcn_ds_bpermute((lane ^ o) << 2, __float_as_int(v)));
    return v;
}
__device__ __forceinline__ void p0_transpose_item(const float* W, int ldw, int ncols, bf16* WT, int ldt, int koff, LAS float* scr, int item, int lane) {
    const int nblk = ncols / 32, kb = item / nblk, nb = item % nblk, k0 = 64 * kb, n0 = 32 * nb;
#pragma unroll 8
    for (int i = 0; i < 32; ++i) { const int kk = 2 * i + (lane >> 5); scr[kk * 33 + (lane & 31)] = W[(size_t)(k0 + kk) * ldw + n0 + (lane & 31)]; }
    LDS_WAIT(); asm volatile("" ::: "memory");
    const int c = lane & 7;
#pragma unroll
    for (int j = 0; j < 4; ++j) { const int n = (lane >> 3) + 8 * j; const LAS float* s = scr + (8 * c) * 33 + n;
        v4u o; o.x = pk2(s[0 * 33], s[1 * 33]); o.y = pk2(s[2 * 33], s[3 * 33]); o.z = pk2(s[4 * 33], s[5 * 33]); o.w = pk2(s[6 * 33], s[7 * 33]);
        *(GAS v4u*)(WT + (size_t)(n0 + n) * ldt + koff + k0 + 8 * c) = o; }
    LDS_WAIT(); asm volatile("" ::: "memory");
}
__device__ __forceinline__ unsigned pk4_fp8(float a, float b, float c, float d) { int w = __builtin_amdgcn_cvt_pk_fp8_f32(a, b, 0, false); w = __builtin_amdgcn_cvt_pk_fp8_f32(c, d, w, true); return (unsigned)w; }
__device__ __forceinline__ void p0_transpose_item8(const float* W, int ldw, int ncols, unsigned char* WT8, int ldt, float scale, LAS float* scr, int item, int lane) {
    const int nblk = ncols / 32, kb = item / nblk, nb = item % nblk, k0 = 64 * kb, n0 = 32 * nb;
#pragma unroll 8
    for (int i = 0; i < 32; ++i) { const int kk = 2 * i + (lane >> 5); scr[kk * 33 + (lane & 31)] = W[(size_t)(k0 + kk) * ldw + n0 + (lane & 31)] * scale; }
    LDS_WAIT(); asm volatile("" ::: "memory");
    const int c = lane & 3;
#pragma unroll
    for (int j = 0; j < 2; ++j) { const int n = (lane >> 2) + 16 * j; const LAS float* s = scr + (16 * c) * 33 + n;
        v4u o; o.x = pk4_fp8(s[0 * 33], s[1 * 33], s[2 * 33], s[3 * 33]); o.y = pk4_fp8(s[4 * 33], s[5 * 33], s[6 * 33], s[7 * 33]);
        o.z = pk4_fp8(s[8 * 33], s[9 * 33], s[10 * 33], s[11 * 33]); o.w = pk4_fp8(s[12 * 33], s[13 * 33], s[14 * 33], s[15 * 33]);
        *(GAS v4u*)(WT8 + (size_t)(n0 + n) * ldt + k0 + 16 * c) = o; }
    LDS_WAIT(); asm volatile("" ::: "memory");
}
struct Args { const float* in[19]; float* out; unsigned char* ws; int ph_lo, ph_hi; };

__device__ __forceinline__ void p0_prologue(Frame& F, const Args& a) {
    LAS float* scr = (LAS float*)(F.lds + RING_OFF + F.wave * 16384);
    const int gw = F.vcu * NWAVES + F.wave, NGW = F.G * NWAVES;
    constexpr int I_IN = (DM / 64) * (N_BF / 32), I_G8 = (DM / 64) * (N_F8 / 32), I_P = (1024 / 64) * (DM / 32), I_O = (DM / 64) * (DM / 32), I_L = I_IN + I_G8 + 2 * I_P + I_O;
    for (int it = gw; it < DEPTH * I_L; it += NGW) {
        const int l = it / I_L; int r = it % I_L;
        bf16* win = (bf16*)(a.ws + WS_WIN) + (size_t)l * N_BF * DM; bf16* wpab = (bf16*)(a.ws + WS_WPAB) + (size_t)l * DM * DM; bf16* wout = (bf16*)(a.ws + WS_WOUT) + (size_t)l * DM * DM;
        if (r < I_IN) { p0_transpose_item(a.in[1] + (size_t)l * DM * IN_TOTAL, IN_TOTAL, N_BF, win, DM, 0, scr, r, F.lane); continue; } r -= I_IN;
        if (r < I_G8) { p0_transpose_item8(a.in[1] + (size_t)l * DM * IN_TOTAL + N_BF, IN_TOTAL, N_F8, a.ws + WS_WG8 + (size_t)l * N_F8 * DM, DM, W8_SCALE, scr, r, F.lane); continue; } r -= I_G8;
        if (r < I_P) { p0_transpose_item(a.in[14] + (size_t)l * 1024 * DM, DM, DM, wpab, DM, 0, scr, r, F.lane); continue; } r -= I_P;
        if (r < I_P) { p0_transpose_item(a.in[15] + (size_t)l * 1024 * DM, DM, DM, wpab, DM, 1024, scr, r, F.lane); continue; } r -= I_P;
        p0_transpose_item(a.in[16] + (size_t)l * DM * DM, DM, DM, wout, DM, 0, scr, r, F.lane);
    }
    for (int it = gw; it < DEPTH * NBLK * 4 * 2 * 8; it += NGW) {
        const int s_ = it & 7, g_ = (it >> 3) & 1, jq = (it >> 4) & 3, n = (it >> 6) & 7, l = it >> 9;
        const float* w = a.in[g_ ? 6 : 4] + ((size_t)(l * NBLK + n) * BLKW + 16 * s_ + 8 * (F.lane >> 5)) * BLKW + jq * 32 + (F.lane & 31);
        v4u o; o.x = pk2(w[0], w[BLKW]); o.y = pk2(w[2 * BLKW], w[3 * BLKW]); o.z = pk2(w[4 * BLKW], w[5 * BLKW]); o.w = pk2(w[6 * BLKW], w[7 * BLKW]);
        *(GAS v4u*)((bf16*)(a.ws + WS_GW) + (size_t)it * 512 + F.lane * 8) = o; }
    bf16* xb = (bf16*)(a.ws + WS_XB16); const float* x = a.in[0];
    for (int m = gw; m < M; m += NGW) {
        const GAS f32x4* xr = (const GAS f32x4*)(x + (size_t)m * DM) + F.lane; GAS unsigned long long* o8 = (GAS unsigned long long*)(xb + (size_t)m * DM) + F.lane;
        GAS unsigned* q8 = (GAS unsigned*)(a.ws + WS_XQ8 + (size_t)m * DM) + F.lane;
#pragma unroll
        for (int j = 0; j < 8; ++j) { const f32x4 v = xr[64 * j]; o8[64 * j] = (unsigned long long)pk2(v.x, v.y) | ((unsigned long long)pk2(v.z, v.w) << 32); q8[64 * j] = pk4_fp8(v.x, v.y, v.z, v.w); }
    }
}
__device__ __forceinline__ void ln_phase(Frame& F, float* y, bf16* xb, unsigned char* xq8, const float* g, const float* bta, bool copies) {
    const int gw = F.vcu * NWAVES + F.wave, NGW = F.G * NWAVES; int lane = F.lane; asm volatile("" : "+v"(lane));
    for (int m = gw; m < M; m += NGW) {
        GAS f32x4* yr = (GAS f32x4*)(y + (size_t)m * DM) + lane; f32x4 v[8]; float s = 0.f;
#pragma unroll
        for (int j = 0; j < 8; ++j) { v[j] = yr[64 * j]; s += (v[j].x + v[j].y) + (v[j].z + v[j].w); }
        const float mean = wave_sum(s, lane) * (1.f / DM); float s2 = 0.f;
#pragma unroll
        for (int j = 0; j < 8; ++j) { v[j] = v[j] - mean; s2 += (v[j].x * v[j].x + v[j].y * v[j].y) + (v[j].z * v[j].z + v[j].w * v[j].w); }
        const float rstd = 1.f / sqrtf(wave_sum(s2, lane) * (1.f / DM) + LN_EPS);
        GAS unsigned long long* o8 = (GAS unsigned long long*)(xb + (size_t)m * DM) + lane; GAS unsigned* q8 = (GAS unsigned*)(xq8 + (size_t)m * DM) + lane;
#pragma unroll
        for (int j = 0; j < 8; ++j) { const f32x4 gg = *((const GAS f32x4*)g + lane + 64 * j), bb = *((const GAS f32x4*)bta + lane + 64 * j);
            const f32x4 o = v[j] * rstd * gg + bb; yr[64 * j] = o; if (copies) { o8[64 * j] = (unsigned long long)pk2(o.x, o.y) | ((unsigned long long)pk2(o.z, o.w) << 32); q8[64 * j] = pk4_fp8(o.x, o.y, o.z, o.w); } }
    }
}
__device__ __forceinline__ void combine_block(Frame& F, int b, int h, int qb, const bf16* O1, const bf16* O2, const bf16* GA, bf16* AR, const float* subln_g, float lam, float lam_init) {
    typedef short s16x8 __attribute__((ext_vector_type(8)));
    int tid = F.tid; asm volatile("" : "+v"(tid));
#pragma unroll 1
    for (int it = 0; it < 4; ++it) {
        const int idx = tid + 512 * it, row = b * SEQ + qb * 256 + (idx >> 3), c16 = idx & 7, col = h * 128 + c16 * 16;
        const size_t off = (size_t)row * 1024 + col;
        const s16x8 a0 = *(const GAS s16x8*)(O1 + off), a1 = *(const GAS s16x8*)(O1 + off + 8), b0 = *(const GAS s16x8*)(O2 + off), b1 = *(const GAS s16x8*)(O2 + off + 8);
        const s16x8 g0 = *(const GAS s16x8*)(GA + off), g1 = *(const GAS s16x8*)(GA + off + 8);
        float o[16]; float ss = 0.f;
#pragma unroll
        for (int j = 0; j < 8; ++j) { o[j] = pg8::bfbits2f(a0[j]) - lam * pg8::bfbits2f(b0[j]); o[8 + j] = pg8::bfbits2f(a1[j]) - lam * pg8::bfbits2f(b1[j]); }
#pragma unroll
        for (int j = 0; j < 16; ++j) ss += o[j] * o[j];
        ss += __int_as_float(__builtin_amdgcn_ds_swizzle(__float_as_int(ss), 0x041f)); ss += __int_as_float(__builtin_amdgcn_ds_swizzle(__float_as_int(ss), 0x081f)); ss += __int_as_float(__builtin_amdgcn_ds_swizzle(__float_as_int(ss), 0x101f));
        const float rn = (1.f / sqrtf(ss * (1.f / 128.f) + SUBLN_EPS)) * (1.f - lam_init);
        unsigned w[8];
#pragma unroll
        for (int j = 0; j < 8; ++j) {
            const float ga0 = pg8::bfbits2f(j < 4 ? g0[2 * j] : g1[2 * j - 8]), ga1 = pg8::bfbits2f(j < 4 ? g0[2 * j + 1] : g1[2 * j - 7]);
            const float v0 = o[2 * j] * rn * subln_g[c16 * 16 + 2 * j] * (ga0 / (1.f + __expf(-ga0))), v1 = o[2 * j + 1] * rn * subln_g[c16 * 16 + 2 * j + 1] * (ga1 / (1.f + __expf(-ga1)));
            w[j] = pk2(v0, v1); }
        bf16* op = AR + (size_t)row * 2048 + col;
        *(GAS v4u*)op = (v4u){w[0], w[1], w[2], w[3]}; *(GAS v4u*)(op + 8) = (v4u){w[4], w[5], w[6], w[7]};
    }
}
constexpr int LRU_TM = 256, XCS_PITCH = 272, LRU_XCS = 0, LRU_AS = LRU_XCS + LRU_TM * XCS_PITCH, LRU_US = LRU_AS + LRU_TM * 32 * 4, LRU_AH = LRU_US + LRU_TM * 32 * 4, LRU_CARRY = LRU_AH + 16 * 32 * 8, LRU_WI = LRU_CARRY + 2 * 32 * 4, LRU_CW = LRU_WI + 8 * 64 * 16, LRU_END = LRU_CW + 5 * 128 * 4;
static_assert(LRU_END <= RING_BYTES, "LRU LDS map");
constexpr size_t GW_ITEM = 2 * 8 * 64 * 8;
#define LBAR() asm volatile("s_waitcnt lgkmcnt(0)\n\ts_barrier" ::: "memory")
__device__ __forceinline__ void lru_item(Frame& F, int b, int n, int jq, const bf16* XB, const bf16* GB, bf16* AR, const float* conv_w, const float* conv_b, const bf16* gwf, const float* b_r,
                                         const float* b_i, const float* lam) {
    typedef short s16x8 __attribute__((ext_vector_type(8))); typedef float f32x16 __attribute__((ext_vector_type(16))); typedef float f32x2 __attribute__((ext_vector_type(2)));
    LAS unsigned char* L = F.lds + RING_OFF;
    int tid = F.tid; asm volatile("" : "+v"(tid));
    const int lane = tid & 63, wave = F.wave, r32 = lane & 31, hi = lane >> 5;
    const int ch8 = tid & 15, tq = tid >> 4;
    const int cch = n * BLKW + jq * 32 + r32;
    s16x8 wfr[8];
#pragma unroll
    for (int s = 0; s < 8; ++s) wfr[s] = *(const GAS s16x8*)(gwf + (size_t)(s * 64 + lane) * 8);
    *(LAS s16x8*)(L + LRU_WI + tid * 16) = *(const GAS s16x8*)(gwf + (size_t)(8 * 64 + tid) * 8);
    const float bias_r = b_r[cch], bias_i = b_i[cch], lc = -8.f * log1pf(__expf(-lam[cch])), lc2 = lc * LOG2E;
    if (tid < 64) ((LAS float*)(L + LRU_CARRY))[tid] = 0.f;
    const bf16* xbase = XB + (size_t)b * SEQ * 1024 + n * BLKW + ch8 * 8;
    if (tid < 128) { LAS float* cwl = (LAS float*)(L + LRU_CW); cwl[tid] = conv_b[n * BLKW + tid];
#pragma unroll
        for (int j = 0; j < 4; ++j) cwl[(1 + j) * 128 + tid] = conv_w[j * LRUW + n * BLKW + tid]; }
    s16x8 xq[2][7];
#define LRU_LOADX(t0_) do { _Pragma("unroll") for (int g = 0; g < 2; ++g) _Pragma("unroll") for (int rr = 0; rr < 7; ++rr) { const int t = (t0_) + (tq + 32 * g) * 4 - 3 + rr; \
        xq[g][rr] = (t >= 0) ? *(const GAS s16x8*)(xbase + (size_t)t * 1024) : (s16x8){0, 0, 0, 0, 0, 0, 0, 0}; } } while (0)
    LRU_LOADX(0);
    LBAR();
#pragma unroll 1
    for (int ms = 0; ms < SEQ / LRU_TM; ++ms) {
        const int t0 = ms * LRU_TM;
        {
            float cw[4][8], cb[8];
            { unsigned cwb = (unsigned)(LRU_CW + ch8 * 32); asm volatile("" : "+v"(cwb));
              const f32x4 b0 = *(const LAS f32x4*)(L + cwb), b1 = *(const LAS f32x4*)(L + cwb + 16);
              cb[0] = b0.x; cb[1] = b0.y; cb[2] = b0.z; cb[3] = b0.w; cb[4] = b1.x; cb[5] = b1.y; cb[6] = b1.z; cb[7] = b1.w;
#pragma unroll
              for (int j = 0; j < 4; ++j) { const f32x4 w0 = *(const LAS f32x4*)(L + cwb + (1 + j) * 512), w1 = *(const LAS f32x4*)(L + cwb + (1 + j) * 512 + 16);
                  cw[j][0] = w0.x; cw[j][1] = w0.y; cw[j][2] = w0.z; cw[j][3] = w0.w; cw[j][4] = w1.x; cw[j][5] = w1.y; cw[j][6] = w1.z; cw[j][7] = w1.w; } }
            unsigned s1b = (unsigned)(LRU_XCS + tq * 4 * XCS_PITCH + ch8 * 16); asm volatile("" : "+v"(s1b));
#pragma unroll
            for (int g = 0; g < 2; ++g) {
                unsigned w[4][4];
#pragma unroll
                for (int i2 = 0; i2 < 4; ++i2) {
                    float x0[7], x1[7];
#pragma unroll
                    for (int rr = 0; rr < 7; ++rr) { const unsigned d = ((const unsigned*)&xq[g][rr])[i2]; x0[rr] = __uint_as_float(d << 16); x1[rr] = __uint_as_float(d & 0xffff0000u); }
#pragma unroll
                    for (int q = 0; q < 4; ++q) {
                        const float v0 = cb[2 * i2] + cw[0][2 * i2] * x0[q] + cw[1][2 * i2] * x0[q + 1] + cw[2][2 * i2] * x0[q + 2] + cw[3][2 * i2] * x0[q + 3];
                        const float v1 = cb[2 * i2 + 1] + cw[0][2 * i2 + 1] * x1[q] + cw[1][2 * i2 + 1] * x1[q + 1] + cw[2][2 * i2 + 1] * x1[q + 2] + cw[3][2 * i2 + 1] * x1[q + 3];
                        w[q][i2] = pk2(v0, v1); }
                    asm volatile("" : "+v"(w[0][i2]), "+v"(w[1][i2]), "+v"(w[2][i2]), "+v"(w[3][i2]));
                }
#pragma unroll
                for (int q = 0; q < 4; ++q) *(LAS v4u*)(L + s1b + (32 * g * 4 + q) * XCS_PITCH) = (v4u){w[q][0], w[q][1], w[q][2], w[q][3]};
            }
        }
        if (ms + 1 < SEQ / LRU_TM) LRU_LOADX(t0 + LRU_TM);
        LBAR();
        {
            f32x16 ar, ai;
#pragma unroll
            for (int r = 0; r < 16; ++r) { ar[r] = bias_r; ai[r] = bias_i; }
            unsigned s2a = (unsigned)(LRU_XCS + (32 * wave + r32) * XCS_PITCH + hi * 16), s2i = (unsigned)(LRU_WI + lane * 16); asm volatile("" : "+v"(s2a), "+v"(s2i));
#pragma unroll
            for (int s = 0; s < 8; ++s) { const s16x8 af = *(const LAS s16x8*)(L + s2a + s * 32), wi = *(const LAS s16x8*)(L + s2i + s * 1024);
                ar = __builtin_amdgcn_mfma_f32_32x32x16_bf16(af, wfr[s], ar, 0, 0, 0); ai = __builtin_amdgcn_mfma_f32_32x32x16_bf16(af, wi, ai, 0, 0, 0); }
            unsigned s2x = (unsigned)(LRU_XCS + (32 * wave + 4 * hi) * XCS_PITCH + (jq * 32 + r32) * 2), s2w = (unsigned)((32 * wave + 4 * hi) * 128 + r32 * 4); asm volatile("" : "+v"(s2x), "+v"(s2w));
#pragma unroll
            for (int r = 0; r < 16; ++r) { const int cr = (r & 3) + 8 * (r >> 2);
                const float rg = __builtin_amdgcn_rcpf(1.f + __builtin_amdgcn_exp2f(-LOG2E * ar[r])), ig = __builtin_amdgcn_rcpf(1.f + __builtin_amdgcn_exp2f(-LOG2E * ai[r]));
                const float av = __builtin_amdgcn_exp2f(lc2 * rg), t = 2.f * lc * rg;
                const float ser = -t * (1.f + t * (0.5f + t * (0.16666667f + t * (0.041666668f + t * 0.0083333338f))));
                const float om = (t > -0.1f) ? ser : (1.f - av * av);
                const float xc = __uint_as_float(((unsigned)*(const LAS unsigned short*)(L + s2x + cr * XCS_PITCH)) << 16);
                const float uv = __builtin_amdgcn_sqrtf(om) * (ig * xc);
                *(LAS float*)(L + LRU_AS + s2w + cr * 128) = av; *(LAS float*)(L + LRU_US + s2w + cr * 128) = uv; }
        }
        LBAR();
        s16x8 gbv[2];
#pragma unroll
        for (int g = 0; g < 2; ++g) { const int idx = tid + 512 * g, tl = idx >> 2, c8 = idx & 3; gbv[g] = *(const GAS s16x8*)(GB + ((size_t)b * SEQ + t0 + tl) * 1024 + n * BLKW + jq * 32 + c8 * 8); }
        {
            const int sc = tid >> 5, o = tid & 31; unsigned s3b = (unsigned)(((sc * 16) * 32 + o) * 4); asm volatile("" : "+v"(s3b));
            LAS float* as = (LAS float*)(L + LRU_AS + s3b); LAS float* us = (LAS float*)(L + LRU_US + s3b);
            float a[16], u[16];
#pragma unroll
            for (int i = 0; i < 16; ++i) { a[i] = as[i * 32]; u[i] = us[i * 32]; }
            float A = 1.f, H = 0.f;
#pragma unroll
            for (int i = 0; i < 16; ++i) { H = a[i] * H + u[i]; A *= a[i]; }
            unsigned s3o = (unsigned)(LRU_AH + o * 8); asm volatile("" : "+v"(s3o));
            *(LAS f32x2*)(L + s3o + sc * 256) = (f32x2){A, H};
            LBAR();
            float h = ((LAS float*)(L + LRU_CARRY))[(ms & 1) * 32 + o];
            f32x2 p[15];
#pragma unroll
            for (int s2 = 0; s2 < 15; ++s2) p[s2] = *(const LAS f32x2*)(L + s3o + s2 * 256);
#pragma unroll
            for (int s2 = 0; s2 < 15; ++s2) h = (s2 < sc) ? p[s2].x * h + p[s2].y : h;
#pragma unroll
            for (int i = 0; i < 16; ++i) { h = a[i] * h + u[i]; us[i * 32] = h; }
            if (sc == 15) ((LAS float*)(L + LRU_CARRY))[((ms + 1) & 1) * 32 + o] = h;
        }
        LBAR();
#pragma unroll
        for (int g = 0; g < 2; ++g) { const int idx = tid + 512 * g, tl = idx >> 2, c8 = idx & 3; const size_t row = (size_t)b * SEQ + t0 + tl; const int col = n * BLKW + jq * 32 + c8 * 8;
            unsigned s4b = (unsigned)(LRU_US + (tl * 32 + c8 * 8) * 4); asm volatile("" : "+v"(s4b));
            const f32x4 h0 = *(const LAS f32x4*)(L + s4b), h1 = *(const LAS f32x4*)(L + s4b + 16);
            const s16x8 gv = gbv[g]; float hv[8] = {h0.x, h0.y, h0.z, h0.w, h1.x, h1.y, h1.z, h1.w}; unsigned w[4];
#pragma unroll
            for (int i2 = 0; i2 < 4; ++i2) { const float g0 = pg8::bfbits2f(gv[2 * i2]), g1 = pg8::bfbits2f(gv[2 * i2 + 1]);
                w[i2] = pk2(hv[2 * i2] * g0 * __builtin_amdgcn_rcpf(1.f + __builtin_amdgcn_exp2f(-LOG2E * g0)), hv[2 * i2 + 1] * g1 * __builtin_amdgcn_rcpf(1.f + __builtin_amdgcn_exp2f(-LOG2E * g1))); }
            *(GAS v4u*)(AR + row * 2048 + 1024 + col) = (v4u){w[0], w[1], w[2], w[3]}; }
    }
#undef LRU_LOADX
    LBAR();
}

#ifndef MK_DBL
#define MK_DBL 0
#endif
#define DBL(k) for (int rep_ = 0; rep_ < 1 + ((MK_DBL >> (k)) & 1); ++rep_)
constexpr int N_PH_LAYER = 5, N_PHASES = 1 + DEPTH * N_PH_LAYER;
__global__ void __launch_bounds__(NWAVES * 64, 2) mk_fwd(Args args) {
    extern __shared__ __attribute__((aligned(16))) unsigned char lds[];
    Frame F;
    F.lds = (LAS unsigned char*)lds; F.MISC = (volatile LAS unsigned*)(F.lds + MISC_OFF);
    F.tid = threadIdx.x; F.lane = F.tid & 63; F.wave = __builtin_amdgcn_readfirstlane(F.tid >> 6);
    F.G = gridDim.x; { const int bx = blockIdx.x; F.vcu = (F.G % 8 == 0) ? (bx % 8) * (F.G / 8) + bx / 8 : bx; }
    F.ctl = (gu32*)(args.ws + WS_CTL);
    for (int u = F.tid; u < (LDS_BYTES - LDSCTL_OFF) / 4; u += NWAVES * 64) ((LAS unsigned*)(F.lds + LDSCTL_OFF))[u] = 0u;
    __syncthreads();
    const int lo = args.ph_lo, hi = args.ph_hi;
    const bool use_bar = (hi - lo) > 1;
    XcdBarrier bar; bar.bar = (unsigned*)(F.ctl + CW_BAR); bar.x = 0; bar.st = nullptr;
    if (use_bar) bar = xcd_barrier_post((unsigned*)(F.ctl + CW_BAR), F.MISC + 8);
#define IN(k) (lo <= (k) && (k) < hi)
#define SEAM(k) do { if (IN(k) && IN((k) + 1)) xcd_barrier(bar); } while (0)
#define CAS __attribute__((address_space(4)))
    typedef unsigned char* ucp_t; typedef float* fp_t; typedef const float* cfp_t;
#define KARGS() CAS const char* ka_ = (CAS const char*)__builtin_amdgcn_kernarg_segment_ptr(); asm volatile("" : "+s"(ka_)); unsigned char* const ws = *(CAS const ucp_t*)(ka_ + 160); float* const outp = *(CAS const fp_t*)(ka_ + 152); (void)outp; (void)ws
#define KIN(k) (*(CAS const cfp_t*)(ka_ + 8 * (k)))
#define WSP(off) ((bf16*)(ws + (off)))
    if (IN(0)) { DBL(0) p0_prologue(F, args); } SEAM(0);
#pragma unroll 1
    for (int l = 0; l < DEPTH; ++l) {
        const int pb = 1 + l * N_PH_LAYER;
        const float lam_init = 0.8f - 0.6f * __expf(-0.3f * (float)l);
        if (IN(pb)) {
            KARGS(); bf16* const P6 = WSP(WS_P6); bf16* const MA = WSP(WS_MA); bf16* const MB = WSP(WS_MB);
            { pg8::Gemm g{WSP(WS_XB16), WSP(WS_WIN) + (size_t)l * N_BF * DM, M, N_BF, DM}; pg8::StaticOrder S; S.init(M, N_BF, F.G, (int)blockIdx.x);
              pg8::EpiProj E{P6, MA, MB, (size_t)M * 1024, attn_body::C2, 0, 1.f};
              DBL(1) pg8::gemm_phase<pg8::EpiProj, pg8::StaticOrder, PG8_ALIGN, PG8_SP2>(F.lds + RING_OFF, g, S, E); }
            { pg8::Gemm g{(const pg8::bf16_t*)(ws + WS_XQ8), (const pg8::bf16_t*)(ws + WS_WG8 + (size_t)l * N_F8 * DM), M, N_F8, DM / 2}; pg8::StaticOrder S; S.init(M, N_F8, F.G, (int)blockIdx.x);
              pg8::EpiProj E{P6, MA, MB, (size_t)M * 1024, attn_body::C2, N_BF / 256, 1.f / W8_SCALE};
              DBL(1) pg8::gemm_phase<pg8::EpiProj, pg8::StaticOrder, PG8_ALIGN, PG8_SP2, true>(F.lds + RING_OFF, g, S, E); }
        }
        SEAM(pb);
        if (IN(pb + 1)) {
            KARGS(); bf16* const P6 = WSP(WS_P6); bf16* const O1 = WSP(WS_O1); bf16* const O2 = WSP(WS_O2); bf16* const AR = WSP(WS_AR);
            bf16* const Qb = P6; bf16* const Kb = P6 + (size_t)M * 1024; bf16* const Vb = P6 + (size_t)2 * M * 1024; bf16* const GA = P6 + (size_t)3 * M * 1024; bf16* const XBb = P6 + (size_t)4 * M * 1024; bf16* const GBb = P6 + (size_t)5 * M * 1024;
            int ln_ = F.lane; asm volatile("" : "+v"(ln_));
            float d1 = KIN(9)[l * 64 + ln_] * KIN(10)[l * 64 + ln_], d2 = KIN(11)[l * 64 + ln_] * KIN(12)[l * 64 + ln_];
            d1 = wave_sum(d1, ln_); d2 = wave_sum(d2, ln_);
            const float lam = __uint_as_float(__builtin_amdgcn_readfirstlane(__float_as_uint(__expf(d1) - __expf(d2) + lam_init)));
            const int bh = F.vcu >> 2, p = F.vcu & 3, b = bh >> 3, h = bh & 7;
            const float slope2 = exp2f(-(float)(h + 1)) * LOG2E;
            if (F.G == 256) {
#pragma unroll 1
                for (int i = 0; i < 2; ++i) {
                    const int qb = i ? (7 - p) : p;
#pragma unroll 1
                    DBL(2) for (int c = 0; c < 2; ++c) {
                        attn_body::attn_unit<8>(b, 2 * h + c, h, qb, slope2, (const attn_body::bf16*)Qb, (const attn_body::bf16*)Kb, (const attn_body::bf16*)Vb, (attn_body::bf16*)(c ? O2 : O1), (char*)lds + RING_OFF);
                    }
                    VM_WAIT(); __syncthreads();
                    DBL(6) combine_block(F, b, h, qb, O1, O2, GA, AR, KIN(13) + l * 128, lam, lam_init);
                }
                DBL(3) lru_item(F, F.vcu >> 5, (F.vcu >> 2) & 7, F.vcu & 3, XBb, GBb, AR, KIN(2) + (size_t)l * 4 * LRUW, KIN(3) + l * LRUW,
                         (const bf16*)(ws + WS_GW) + ((size_t)(l * NBLK + ((F.vcu >> 2) & 7)) * 4 + (F.vcu & 3)) * GW_ITEM, KIN(5) + l * LRUW, KIN(7) + l * LRUW, KIN(8) + l * LRUW);
            }
        }
        SEAM(pb + 1);
        if (IN(pb + 2)) {
            KARGS();
            pg8::Gemm g{WSP(WS_AR), WSP(WS_WPAB) + (size_t)l * DM * DM, M, DM, DM}; pg8::StaticOrder S; S.init(M, DM, F.G, (int)blockIdx.x);
            pg8::EpiMerge E{WSP(WS_MA), WSP(WS_MB), WSP(WS_MERGED)};
            DBL(4) pg8::gemm_phase<pg8::EpiMerge, pg8::StaticOrder, PG8_ALIGN, PG8_SP2>(F.lds + RING_OFF, g, S, E);
        }
        SEAM(pb + 2);
        if (IN(pb + 3)) {
            KARGS();
            pg8::Gemm g{WSP(WS_MERGED), WSP(WS_WOUT) + (size_t)l * DM * DM, M, DM, DM}; pg8::StaticOrder S; S.init(M, DM, F.G, (int)blockIdx.x);
            pg8::EpiRes E{l == 0 ? KIN(0) : outp, outp, DN_ALPHA};
            for (int rep_ = 0; rep_ < 1 + (((MK_DBL >> 5) & 1) && l == 0); ++rep_) pg8::gemm_phase<pg8::EpiRes, pg8::StaticOrder, PG8_ALIGN, PG8_SP2>(F.lds + RING_OFF, g, S, E);
        }
        SEAM(pb + 3);
        if (IN(pb + 4)) { KARGS(); ln_phase(F, outp, WSP(WS_XB16), ws + WS_XQ8, KIN(17) + l * DM, KIN(18) + l * DM, l + 1 < DEPTH); }
        SEAM(pb + 4);
    }
#undef IN
#undef SEAM
#undef KARGS
#undef KIN
#undef WSP
#undef CAS
}

#ifndef MK_PER_PHASE
#define MK_PER_PHASE 0
#endif
extern "C" void kernel_launch(void* const* d_in, const int* in_sizes, int n_in, void* d_out, int out_size, void* d_ws, size_t ws_size, hipStream_t stream) {
    static int grid = 0;
    if (grid == 0) {
        if (n_in != 19 || in_sizes[0] != M * DM || out_size != M * DM || ws_size < WS_END) { fprintf(stderr, "kernel_launch: unexpected shapes / workspace (n_in %d, ws %zu); nothing launched\n", n_in, ws_size); grid = -1; return; }
        int dev = 0, cus = 0;
        if (hipGetDevice(&dev) != hipSuccess || hipDeviceGetAttribute(&cus, hipDeviceAttributeMultiprocessorCount, dev) != hipSuccess) { grid = -1; return; }
        if (hipFuncSetAttribute((const void*)mk_fwd, hipFuncAttributeMaxDynamicSharedMemorySize, LDS_BYTES) != hipSuccess) { fprintf(stderr, "kernel_launch: hipFuncSetAttribute failed\n"); grid = -1; return; }
        int per_cu = 0;
        if (hipOccupancyMaxActiveBlocksPerMultiprocessor(&per_cu, (const void*)mk_fwd, NWAVES * 64, LDS_BYTES) != hipSuccess || per_cu < 1) fprintf(stderr, "kernel_launch: occupancy query reports %d blocks per CU\n", per_cu);
        (void)hipGetLastError();
        grid = cus;
        if (grid != 256) fprintf(stderr, "kernel_launch: %d CUs; the attention/LRU phase is built for 256\n", grid);
    }
    if (grid < 0) return;
    if (hipMemsetAsync((char*)d_ws + WS_CTL, 0, CTL_ZERO_BYTES, stream) != hipSuccess) return;
    Args a{};
    for (int i = 0; i < 19; ++i) a.in[i] = (const float*)d_in[i];
    a.out = (float*)d_out; a.ws = (unsigned char*)d_ws;
#if MK_PER_PHASE
    for (int p = 0; p < N_PHASES; ++p) { a.ph_lo = p; a.ph_hi = p + 1; hipLaunchKernelGGL(mk_fwd, dim3(grid), dim3(NWAVES * 64), LDS_BYTES, stream, a); }
#else
    a.ph_lo = 0; a.ph_hi = N_PHASES;
    hipLaunchKernelGGL(mk_fwd, dim3(grid), dim3(NWAVES * 64), LDS_BYTES, stream, a);
#endif
}
```

```cpp
#include <hip/hip_runtime.h>
#include <cstdio>
#include <cstdint>
namespace pg8 {
#define PG8_LAS __attribute__((address_space(3)))
typedef unsigned short bf16_t;
typedef short bf16x8 __attribute__((ext_vector_type(8)));
typedef float f32x4 __attribute__((ext_vector_type(4)));
typedef unsigned u32x4 __attribute__((ext_vector_type(4)));
constexpr int BM = 256, BK = 64, HALF = 128, HTB = HALF * BK * 2  , STAGE_BYTES = 8 * HTB, NXCD = 8, WGM = 8;

__host__ __device__ __forceinline__ int lds_byte(int r, int c) { const int st = (r >> 4) * 2 + (c >> 5), rr = r & 15, cc = c & 31, ob = rr * 64 + cc * 2; return st * 1024 + (ob ^ (((ob >> 9) & 1) << 5)); }
__host__ __device__ __forceinline__ void stage_rc(int b, int& R, int& C) { const int st = b / 1024, sb = b % 1024, swz = sb ^ (((sb >> 9) & 1) << 5); R = (st >> 1) * 16 + swz / 64; C = (st & 1) * 32 + (swz % 64) / 2; }
__host__ __device__ __forceinline__ int perm32(int rho) { const int n = rho >> 4, i = rho & 15; return 8 * (i >> 2) + 4 * n + (i & 3); }

struct Unit { int pm, pn; };
struct Gemm { const bf16_t* A; const bf16_t* Bt; int M, N, K; };

struct StaticOrder {
    int nM, nN, nwg, G, c;
    __host__ __device__ void init(int M, int N, int G_, int c_) { nM = M / BM; nN = N / BM; nwg = nM * nN; G = G_; c = c_; }
    __host__ __device__ bool next(int i, Unit& u) const {
        const long L = (long)i * G + c; if (L >= nwg) return false;
        int wgid = (int)L; { const int q = nwg / NXCD, r = nwg % NXCD, xcd = wgid % NXCD, off = wgid / NXCD; wgid = (xcd < r ? xcd * (q + 1) : r * (q + 1) + (xcd - r) * q) + off; }
        const int nig = WGM * nN, gid = wgid / nig, fm = gid * WGM, gsz = (nM - fm) < WGM ? (nM - fm) : WGM;
        u.pm = fm + ((wgid % nig) % gsz); u.pn = (wgid % nig) / gsz; return true;
    }
    __device__ __forceinline__ void a_ready(const Unit&) const {}
    __device__ __forceinline__ void done(const Unit&) const {}
};

__device__ __forceinline__ unsigned cvt_pk_bf16(float lo, float hi) { unsigned r; asm volatile("v_cvt_pk_bf16_f32 %0, %1, %2" : "=v"(r) : "v"(lo), "v"(hi)); return r; }
typedef short s16x8_t __attribute__((ext_vector_type(8)));
__device__ __forceinline__ float bfbits2f(short v) { return __uint_as_float(((unsigned)(unsigned short)v) << 16); }
struct EpiProj {
    static constexpr bool PERM = true, AFTER_DRAIN = false, HAS_MID = false;
    bf16_t* base6; bf16_t* ma; bf16_t* mb; size_t stride6; float qscale; int pn_off; float gscale;
    __device__ __forceinline__ void operator()(const f32x4 (&acc)[2][2][4][2], const Unit& u, int wr, int wc, int fr, int fq) const {
        const int pn = u.pn + pn_off; bf16_t* base; int ldc, colt; float sc = 1.f;
        float qs_ = qscale, gs_ = gscale; asm volatile("" : "+v"(qs_), "+v"(gs_));
        if (pn < 24) { const int t = pn >> 2; base = base6 + (size_t)t * stride6; ldc = 1024; colt = (pn & 3) * BM; sc = (t == 0) ? qs_ : gs_; }
        else if (pn < 32) { base = ma; ldc = 2048; colt = (pn - 24) * BM; sc = gs_; }
        else { base = mb; ldc = 2048; colt = (pn - 32) * BM; sc = gs_; }
        int t_ = threadIdx.x; asm volatile("" : "+v"(t_));
        const int lrow = (t_ >> 8) * 64 + (t_ & 15), lcol = ((t_ >> 6) & 3) * 32 + 8 * ((t_ >> 4) & 3);
        const int row0 = u.pm * BM + lrow, col0 = colt + lcol;
#pragma unroll
        for (int ai = 0; ai < 2; ++ai)
#pragma unroll
            for (int m = 0; m < 4; ++m) { bf16_t* rowp = base + (size_t)(row0 + ai * HALF + m * 16) * ldc + col0;
#pragma unroll
                for (int bj = 0; bj < 2; ++bj) { const f32x4 v0 = acc[ai][bj][m][0] * sc, v1 = acc[ai][bj][m][1] * sc;
                    u32x4 w; w.x = cvt_pk_bf16(v0[0], v0[1]); w.y = cvt_pk_bf16(v0[2], v0[3]); w.z = cvt_pk_bf16(v1[0], v1[1]); w.w = cvt_pk_bf16(v1[2], v1[3]);
                    *(u32x4*)(rowp + bj * HALF) = w; } }
    }
};
struct EpiMerge {
    static constexpr bool PERM = true, AFTER_DRAIN = false, HAS_MID = true;
    const bf16_t* ma; const bf16_t* mb; bf16_t* out;
    __device__ __forceinline__ void mid(f32x4 (&acc)[2][2][4][2], const Unit& u, int wr, int wc, int fr, int fq) const {
        unsigned lofs = (unsigned)((wr * 64 + fr) * 2048 + wc * 32 + 8 * fq); asm volatile("" : "+v"(lofs));
        const size_t tofs = (size_t)u.pm * BM * 2048 + (size_t)u.pn * BM;
#pragma unroll
        for (int ai = 0; ai < 2; ++ai)
#pragma unroll
            for (int m = 0; m < 4; ++m) { const size_t off = tofs + lofs + (size_t)(ai * HALF + m * 16) * 2048;
#pragma unroll
                for (int bj = 0; bj < 2; ++bj) { const s16x8_t a = *(const s16x8_t*)(ma + off + bj * HALF), b = *(const s16x8_t*)(mb + off + bj * HALF);
#pragma unroll
                    for (int j = 0; j < 8; ++j) { const float xa = bfbits2f(a[j]), xb = fmaxf(bfbits2f(b[j]), -30.f);
                        const float f = (1.f + __expf(-xb)) * __builtin_amdgcn_rcpf(1.f + __expf(-xa)); acc[ai][bj][m][j >> 2][j & 3] *= f; } }
                asm volatile("" ::: "memory"); }
    }
    __device__ __forceinline__ void operator()(const f32x4 (&acc)[2][2][4][2], const Unit& u, int wr, int wc, int fr, int fq) const {
        unsigned lofs = (unsigned)((wr * 64 + fr) * 2048 + wc * 32 + 8 * fq); asm volatile("" : "+v"(lofs));
        const size_t tofs = (size_t)u.pm * BM * 2048 + (size_t)u.pn * BM;
#pragma unroll
        for (int ai = 0; ai < 2; ++ai)
#pragma unroll
            for (int m = 0; m < 4; ++m) { const size_t off = tofs + lofs + (size_t)(ai * HALF + m * 16) * 2048;
#pragma unroll
                for (int bj = 0; bj < 2; ++bj) { const s16x8_t b = *(const s16x8_t*)(mb + off + bj * HALF); float v[8];
#pragma unroll
                    for (int j = 0; j < 8; ++j) { const float xb = fmaxf(bfbits2f(b[j]), -30.f); v[j] = acc[ai][bj][m][j >> 2][j & 3] * __builtin_amdgcn_rcpf(1.f + __expf(-xb)); }
                    u32x4 w; w.x = cvt_pk_bf16(v[0], v[1]); w.y = cvt_pk_bf16(v[2], v[3]); w.z = cvt_pk_bf16(v[4], v[5]); w.w = cvt_pk_bf16(v[6], v[7]);
                    *(u32x4*)(out + off + bj * HALF) = w; }
                asm volatile("" ::: "memory"); }
    }
};
struct EpiRes {
    static constexpr bool PERM = false, AFTER_DRAIN = false, HAS_MID = false;
    const float* base; float* out; float alpha;
    __device__ __forceinline__ void operator()(const f32x4 (&acc)[2][2][4][2], const Unit& u, int wr, int wc, int fr, int fq) const {
        const int row0 = u.pm * BM + wr * 64 + fr, col0 = u.pn * BM + wc * 32 + 4 * fq;
#pragma unroll
        for (int ai = 0; ai < 2; ++ai)
#pragma unroll
            for (int m = 0; m < 4; ++m) { const size_t off = (size_t)(row0 + ai * HALF + m * 16) * 2048 + col0;
#pragma unroll
                for (int bj = 0; bj < 2; ++bj)
#pragma unroll
                    for (int n = 0; n < 2; ++n) { const f32x4 bs = *(const f32x4*)(base + off + bj * HALF + n * 16); *(f32x4*)(out + off + bj * HALF + n * 16) = bs * alpha + acc[ai][bj][m][n]; }
                if (m & 1) asm volatile("" ::: "memory"); }
    }
};
typedef int pg8_v4i __attribute__((ext_vector_type(4))); typedef int pg8_v8i __attribute__((ext_vector_type(8)));
template <bool FP8> struct FragSel { struct type { bf16x8 k[2]; }; };
template <> struct FragSel<true> { typedef pg8_v8i type; };
template <bool FP8, class F> __device__ __forceinline__ void ld_frag(F& d, const PG8_LAS unsigned char* p) {
    if constexpr (FP8) { const pg8_v4i lo = *(const PG8_LAS pg8_v4i*)p, hi = *(const PG8_LAS pg8_v4i*)(p + 16); d = __builtin_shufflevector(lo, hi, 0, 1, 2, 3, 4, 5, 6, 7); }
    else { d.k[0] = *(const PG8_LAS bf16x8*)p; d.k[1] = *(const PG8_LAS bf16x8*)(p + 1024); }
}
template <bool FP8, class F> __device__ __forceinline__ void mma_frag(f32x4& c, const F& b, const F& a) {
    if constexpr (FP8) c = __builtin_amdgcn_mfma_scale_f32_16x16x128_f8f6f4(b, a, c, 0, 0, 0, 0, 0, 0);
    else { c = __builtin_amdgcn_mfma_f32_16x16x32_bf16(b.k[0], a.k[0], c, 0, 0, 0); c = __builtin_amdgcn_mfma_f32_16x16x32_bf16(b.k[1], a.k[1], c, 0, 0, 0); }
}
template <class Epi, class Sched, bool ALIGN_EPI = false, bool SP2 = false, bool FP8 = false>
__device__ __forceinline__ void gemm_phase(PG8_LAS unsigned char* lds, const Gemm g, const Sched& S, const Epi& E) {
    int tid_ = threadIdx.x; asm volatile("" : "+v"(tid_));
    const int tid = tid_, wid = __builtin_amdgcn_readfirstlane(tid >> 6), lane = tid & 63, wr = wid >> 2, wc = wid & 3, fr = lane & 15, fq = lane >> 4;
    const int K = g.K, nt = K / BK;
    unsigned voffA[2], voffB[2];
#pragma unroll
    for (int i = 0; i < 2; ++i) { int R, C; stage_rc(tid * 16 + i * 8192, R, C); const int Rb = Epi::PERM ? ((R & ~31) + perm32(R & 31)) : R;
        voffA[i] = (unsigned)(R * K + C) * 2u; voffB[i] = (unsigned)(Rb * K + C) * 2u; }
    const size_t kstep = (size_t)(BK * 2);
    const size_t hstep = (size_t)HALF * K * 2;
    const size_t tstep = 2 * hstep;
    const unsigned lds0 = (unsigned)(uintptr_t)lds;
    const unsigned ldsw = (unsigned)wid * 1024u;
    const int fcol = FP8 ? 32 * (fq >> 1) + 16 * (fq & 1) : fq * 8;
    const int aoff = lds_byte(wr * 64 + fr, fcol), boff = lds_byte(wc * 32 + fr, fcol);
#define PG8_SA(b, h) (((b) * 2 + (h)) * HTB)
#define PG8_SB(b, h) ((4 + (b) * 2 + (h)) * HTB)
#define PG8_STAGE(bufoff, gbase, voff) do { _Pragma("unroll") for (int _i = 0; _i < 2; ++_i) { unsigned keep_; \
        asm volatile("s_mov_b32 %0, m0\n\ts_mov_b32 m0, %3\n\ts_nop 4\n\tglobal_load_lds_dwordx4 %1, %2\n\ts_mov_b32 m0, %0" : "=&s"(keep_) : "v"((voff)[_i]), "s"((const char*)(gbase)), \
                     "s"((unsigned)__builtin_amdgcn_readfirstlane((int)(lds0 + (unsigned)(bufoff) + ldsw + (unsigned)(_i * 8192)))) : "memory"); } } while (0)
#define PG8_LDA(dst, b, h) do { _Pragma("unroll") for (int m = 0; m < 4; ++m) ld_frag<FP8>(dst[m], lds + PG8_SA(b, h) + aoff + m * 2048); } while (0)
#define PG8_LDB(dst, b, h) do { _Pragma("unroll") for (int n = 0; n < 2; ++n) ld_frag<FP8>(dst[n], lds + PG8_SB(b, h) + boff + n * 2048); } while (0)
#define PG8_MMA(ai, bj, At, Bt) do { __builtin_amdgcn_s_setprio(1); _Pragma("unroll") for (int m = 0; m < 4; ++m) _Pragma("unroll") for (int n = 0; n < 2; ++n) \
        mma_frag<FP8>(acc[ai][bj][m][n], Bt[n], At[m]); __builtin_amdgcn_s_setprio(0); } while (0)
#define PG8_WAIT_V(n) asm volatile("s_waitcnt vmcnt(" #n ")" ::: "memory")
#define PG8_WAIT_L(n) asm volatile("s_waitcnt lgkmcnt(" #n ")" ::: "memory")
#define PG8_BAR __builtin_amdgcn_s_barrier()
#define PG8_SCHED __builtin_amdgcn_sched_barrier(0)
    Unit cur, nxt; int ui = 0;
    if (!S.next(0, cur)) return;
    f32x4 acc[2][2][4][2];
#pragma unroll
    for (int a = 0; a < 2; ++a)
#pragma unroll
        for (int b = 0; b < 2; ++b)
#pragma unroll
            for (int m = 0; m < 4; ++m)
#pragma unroll
                for (int n = 0; n < 2; ++n) acc[a][b][m][n] = (f32x4){0.f, 0.f, 0.f, 0.f};
    typename FragSel<FP8>::type At[4], B0[2], B1[2];
    const char* cA = (const char*)g.A + (size_t)cur.pm * tstep; const char* cB = (const char*)g.Bt + (size_t)cur.pn * tstep;
    S.a_ready(cur);
    if constexpr (SP2) {
        PG8_STAGE(PG8_SB(0, 0), cB, voffB); PG8_STAGE(PG8_SB(0, 1), cB + hstep, voffB); PG8_STAGE(PG8_SA(0, 0), cA, voffA); PG8_STAGE(PG8_SA(0, 1), cA + hstep, voffA);
        if (wr == 1) PG8_BAR;
        PG8_WAIT_V(2); PG8_BAR;
        PG8_STAGE(PG8_SB(1, 0), cB + kstep, voffB); PG8_STAGE(PG8_SA(1, 0), cA + kstep, voffA); PG8_STAGE(PG8_SB(1, 1), cB + hstep + kstep, voffB);
        PG8_WAIT_V(6); PG8_BAR;
    } else {
        PG8_STAGE(PG8_SB(0, 0), cB, voffB); PG8_STAGE(PG8_SA(0, 0), cA, voffA); PG8_STAGE(PG8_SB(0, 1), cB + hstep, voffB); PG8_STAGE(PG8_SA(0, 1), cA + hstep, voffA);
        if (wr == 1) PG8_BAR;
        PG8_WAIT_V(4); PG8_BAR;
        PG8_STAGE(PG8_SB(1, 0), cB + kstep, voffB); PG8_STAGE(PG8_SA(1, 0), cA + kstep, voffA); PG8_STAGE(PG8_SB(1, 1), cB + hstep + kstep, voffB);
        PG8_WAIT_V(6); PG8_BAR;
    }
    for (;;) {
        const bool has_next = S.next(ui + 1, nxt);
        const char* nA = has_next ? (const char*)g.A + (size_t)nxt.pm * tstep : cA; const char* nB = has_next ? (const char*)g.Bt + (size_t)nxt.pn * tstep : cB;
        for (int t = 0; t < nt; t += 2) {
            const bool last = (t == nt - 2);
            if constexpr (Epi::HAS_MID) { if (t == nt / 2) E.mid(acc, cur, wr, wc, fr, fq); }
            const char* a1 = cA + (size_t)(t + 1) * kstep;
            const char* a2 = last ? nA : cA + (size_t)(t + 2) * kstep; const char* b2 = last ? nB : cB + (size_t)(t + 2) * kstep;
            const char* a3 = a2 + kstep; const char* b3 = b2 + kstep;
            if (last && has_next) S.a_ready(nxt);
            if constexpr (SP2) {
            PG8_LDB(B0, 0, 0); PG8_LDB(B1, 0, 1); PG8_SCHED; PG8_LDA(At, 0, 0); PG8_STAGE(PG8_SA(1, 1), a1 + hstep, voffA);
            PG8_WAIT_V(8); PG8_WAIT_L(0); PG8_BAR; PG8_MMA(0, 0, At, B0); PG8_MMA(0, 1, At, B1); PG8_BAR; PG8_SCHED;
            PG8_LDA(At, 0, 1); PG8_STAGE(PG8_SB(0, 0), b2, voffB); PG8_STAGE(PG8_SB(0, 1), b2 + hstep, voffB); PG8_STAGE(PG8_SA(0, 0), a2, voffA);
            PG8_WAIT_V(8); PG8_WAIT_L(0); PG8_BAR; PG8_MMA(1, 0, At, B0); PG8_MMA(1, 1, At, B1); PG8_BAR; PG8_SCHED;
            PG8_LDB(B0, 1, 0); PG8_LDB(B1, 1, 1); PG8_SCHED; PG8_LDA(At, 1, 0); PG8_STAGE(PG8_SA(0, 1), a2 + hstep, voffA);
            PG8_WAIT_V(8); PG8_WAIT_L(0); PG8_BAR; PG8_MMA(0, 0, At, B0); PG8_MMA(0, 1, At, B1); PG8_BAR; PG8_SCHED;
            PG8_LDA(At, 1, 1); PG8_STAGE(PG8_SB(1, 0), b3, voffB); PG8_STAGE(PG8_SB(1, 1), b3 + hstep, voffB); PG8_STAGE(PG8_SA(1, 0), a3, voffA);
            PG8_WAIT_V(8); PG8_WAIT_L(0); PG8_BAR; PG8_MMA(1, 0, At, B0); PG8_MMA(1, 1, At, B1); PG8_BAR; PG8_SCHED;
            } else {
            PG8_LDB(B0, 0, 0); PG8_SCHED; PG8_LDA(At, 0, 0); PG8_STAGE(PG8_SA(1, 1), a1 + hstep, voffA);
            PG8_WAIT_L(8); PG8_BAR; PG8_WAIT_L(0); PG8_MMA(0, 0, At, B0); PG8_BAR; PG8_SCHED;
            PG8_LDB(B1, 0, 1); PG8_STAGE(PG8_SB(0, 0), b2, voffB);
            PG8_BAR; PG8_WAIT_L(0); PG8_MMA(0, 1, At, B1); PG8_BAR;
            PG8_LDA(At, 0, 1); PG8_STAGE(PG8_SA(0, 0), a2, voffA);
            PG8_BAR; PG8_WAIT_L(0); PG8_MMA(1, 0, At, B0); PG8_BAR; PG8_SCHED;
            PG8_STAGE(PG8_SB(0, 1), b2 + hstep, voffB);
            PG8_WAIT_V(6); PG8_BAR; PG8_MMA(1, 1, At, B1); PG8_BAR;
            PG8_LDB(B0, 1, 0); PG8_SCHED; PG8_LDA(At, 1, 0); PG8_STAGE(PG8_SA(0, 1), a2 + hstep, voffA);
            PG8_WAIT_L(8); PG8_BAR; PG8_WAIT_L(0); PG8_MMA(0, 0, At, B0); PG8_BAR; PG8_SCHED;
            PG8_LDB(B1, 1, 1); PG8_STAGE(PG8_SB(1, 0), b3, voffB);
            PG8_BAR; PG8_WAIT_L(0); PG8_MMA(0, 1, At, B1); PG8_BAR;
            PG8_LDA(At, 1, 1); PG8_STAGE(PG8_SA(1, 0), a3, voffA);
            PG8_BAR; PG8_WAIT_L(0); PG8_MMA(1, 0, At, B0); PG8_BAR; PG8_SCHED;
            PG8_STAGE(PG8_SB(1, 1), b3 + hstep, voffB);
            PG8_WAIT_V(6); PG8_BAR; PG8_MMA(1, 1, At, B1); PG8_BAR;
            }
        }
        if constexpr (ALIGN_EPI) { if (wr == 0) PG8_BAR; }
        if constexpr (!Epi::AFTER_DRAIN) { E(acc, cur, wr, wc, fr, fq); S.done(cur); }
        if (!has_next) break;
#pragma unroll
        for (int a = 0; a < 2; ++a)
#pragma unroll
            for (int b = 0; b < 2; ++b)
#pragma unroll
                for (int m = 0; m < 4; ++m)
#pragma unroll
                    for (int n = 0; n < 2; ++n) acc[a][b][m][n] = (f32x4){0.f, 0.f, 0.f, 0.f};
        cur = nxt; cA = nA; cB = nB; ++ui;
        if constexpr (ALIGN_EPI) { if (wr == 1) PG8_BAR; }
    }
    PG8_WAIT_V(0);
    if constexpr (!ALIGN_EPI) { if (wr == 0) PG8_BAR; }
    PG8_BAR;
    if constexpr (Epi::AFTER_DRAIN) { E.fused(acc, cur, wr, wc, fr, fq, lds, wid, lane); S.done(cur); }
#undef PG8_SA
#undef PG8_SB
#undef PG8_STAGE
#undef PG8_LDA
#undef PG8_LDB
#undef PG8_MMA
#undef PG8_WAIT_V
#undef PG8_WAIT_L
#undef PG8_BAR
#undef PG8_SCHED
}
}

#ifndef PG8_SP2
#define PG8_SP2 true
#endif
#ifndef PG8_ALIGN
#define PG8_ALIGN true
#endif
#include <hip/hip_bf16.h>
#include <cmath>
namespace attn_body {
using bf16=__hip_bfloat16;
using bf16x8=__attribute__((ext_vector_type(8)))short;
using s16x4=__attribute__((ext_vector_type(4)))short;
using f32x16=__attribute__((ext_vector_type(16)))float;
using u32x4=__attribute__((ext_vector_type(4)))unsigned;
constexpr int BATCH=8,NHEAD=16,SEQ=2048,D=64,DM=NHEAD*D;
constexpr int NW=8,QBLK=32,QB=QBLK*NW,KVBLK=64,NQB=SEQ/QB;
constexpr int ATTN_PITCH=DM, ATTN_UNIT_ROWS=QB;
__device__ __forceinline__ int crow(int r,int hi){return (r&3)+8*(r>>2)+4*hi;}
#define SBAR() __builtin_amdgcn_sched_barrier(0)
__device__ __forceinline__ void cmask(f32x16&p0,f32x16&p1,int jb,int qrel,int hi){
  const float NEG=-INFINITY; int kb=64*jb+4*hi;
  #pragma unroll
  for(int r=0;r<16;++r){int kv=kb+(r&3)+8*(r>>2); if(kv>qrel)p0[r]=NEG; if(kv+32>qrel)p1[r]=NEG;}
}

constexpr int NSLOT=3, SLOTB=8192, VD=128;
constexpr int LDS_K=0, LDS_V=NSLOT*SLOTB, LDS_WS=3*NSLOT*SLOTB, LDS_OST=LDS_WS+NW*64*4, LDS_BYTES=LDS_OST+NW*8192;
constexpr float C2=0.125f*1.4426950408889634f;
__device__ __forceinline__ void glds16(const void*gsrc,unsigned lds_dst){unsigned keep;
  asm volatile("s_mov_b32 %0, m0\n\ts_mov_b32 m0, %2\n\ts_nop 0\n\tglobal_load_lds_dwordx4 %1, off\n\ts_mov_b32 m0, %0":"=&s"(keep):"v"(gsrc),"s"(lds_dst):"memory");}
__device__ __forceinline__ void glds16o(const void*sbase,unsigned voff,unsigned lds_dst){unsigned keep;
  asm volatile("s_mov_b32 %0, m0\n\ts_mov_b32 m0, %3\n\ts_nop 4\n\tglobal_load_lds_dwordx4 %1, %2\n\ts_mov_b32 m0, %0":"=&s"(keep):"v"(voff),"s"(sbase),"s"(lds_dst):"memory");}
__device__ __forceinline__ float max3f(float a,float b,float c){float r;asm("v_max3_f32 %0, %1, %2, %3":"=v"(r):"v"(a),"v"(b),"v"(c));return r;}
__device__ __forceinline__ float max2f(float a,float b){float r;asm("v_max_f32_e32 %0, %1, %2":"=v"(r):"v"(a),"v"(b));return r;}
__device__ __forceinline__ float fadd_s(float a,float b){float r;asm("v_add_f32_e32 %0, %1, %2":"=v"(r):"v"(a),"v"(b));return r;}
__device__ __forceinline__ float fsub_s(float a,float b){float r;asm("v_sub_f32_e32 %0, %1, %2":"=v"(r):"v"(a),"v"(b));return r;}
typedef float f32x2_t __attribute__((ext_vector_type(2))); typedef __bf16 bf16x2_t __attribute__((ext_vector_type(2)));
__device__ __forceinline__ unsigned cvtpk_s(float lo,float hi){f32x2_t v={lo,hi};bf16x2_t b=__builtin_convertvector(v,bf16x2_t);return __builtin_bit_cast(unsigned,b);}
#define WAIT_BAR(N) asm volatile("s_waitcnt vmcnt(" #N ") lgkmcnt(0)\n\ts_barrier":::"memory")

__device__ __forceinline__ void qkt(f32x16&p0,f32x16&p1,const char*Kslot,const bf16x8*qr,int r32,int hi){
  const char*kb=Kslot+hi*1024+r32*16;
  #pragma unroll
  for(int d0=0;d0<4;++d0){
    const bf16x8 b0=*reinterpret_cast<const bf16x8*>(kb+d0*2048);
    const bf16x8 b1=*reinterpret_cast<const bf16x8*>(kb+d0*2048+512);
    {p0=__builtin_amdgcn_mfma_f32_32x32x16_bf16(b0,qr[d0],p0,0,0,0);p1=__builtin_amdgcn_mfma_f32_32x32x16_bf16(b1,qr[d0],p1,0,0,0);}}
}
typedef __attribute__((address_space(3))) const char* lds_cptr;
typedef short v4i16_t __attribute__((ext_vector_type(4)));
__device__ __forceinline__ void kload8(bf16x8*kf,lds_cptr kp){
  kf[0]=*(const __attribute__((address_space(3))) bf16x8*)(kp);      kf[1]=*(const __attribute__((address_space(3))) bf16x8*)(kp+512);
  kf[2]=*(const __attribute__((address_space(3))) bf16x8*)(kp+2048); kf[3]=*(const __attribute__((address_space(3))) bf16x8*)(kp+2560);
  kf[4]=*(const __attribute__((address_space(3))) bf16x8*)(kp+4096); kf[5]=*(const __attribute__((address_space(3))) bf16x8*)(kp+4608);
  kf[6]=*(const __attribute__((address_space(3))) bf16x8*)(kp+6144); kf[7]=*(const __attribute__((address_space(3))) bf16x8*)(kp+6656);
}
__device__ __forceinline__ void kload2(bf16x8*kf,lds_cptr kp,int j){ kf[2*j]=*(const __attribute__((address_space(3))) bf16x8*)(kp+j*2048); kf[2*j+1]=*(const __attribute__((address_space(3))) bf16x8*)(kp+j*2048+512); }
__device__ __forceinline__ s16x4 vtr(lds_cptr p){ return __builtin_bit_cast(s16x4,__builtin_amdgcn_ds_read_tr16_b64_v4i16((__attribute__((address_space(3))) v4i16_t*)p)); }
__device__ __forceinline__ float rowmax(const f32x16&p0,const f32x16&p1){
  float a=max3f(p0[0],p0[1],p1[0]),b=max3f(p0[2],p0[3],p1[1]);a=max3f(a,p1[2],p1[3]);
  #pragma unroll
  for(int r=4;r<16;r+=4){a=max3f(a,p0[r],p0[r+1]);b=max3f(b,p0[r+2],p0[r+3]);a=max3f(a,p1[r],p1[r+1]);b=max3f(b,p1[r+2],p1[r+3]);}
  const float m=max2f(a,b);
  auto rr=__builtin_amdgcn_permlane32_swap(__float_as_uint(m),__float_as_uint(m),false,false);
  return max2f(__uint_as_float(rr[0]),__uint_as_float(rr[1]));
}
__device__ __forceinline__ void pv(f32x16*o,int vb,bf16x8 pa0,bf16x8 pa1,bf16x8 pa2,bf16x8 pa3){
  #pragma unroll
  for(int d0=0;d0<4;++d0){s16x4 lo[4],hi[4];
    #pragma unroll
    for(int ks=0;ks<4;++ks){
      asm volatile("ds_read_b64_tr_b16 %0,%1 offset:%c2":"=&v"(lo[ks]):"v"(vb),"i"(d0*4096+ks*1024):"memory");
      asm volatile("ds_read_b64_tr_b16 %0,%1 offset:%c2":"=&v"(hi[ks]):"v"(vb),"i"(d0*4096+ks*1024+512):"memory");}
    asm volatile("s_waitcnt lgkmcnt(0)":::"memory");SBAR();
    #define PK(k) (bf16x8){lo[k][0],lo[k][1],lo[k][2],lo[k][3],hi[k][0],hi[k][1],hi[k][2],hi[k][3]}
    o[d0]=__builtin_amdgcn_mfma_f32_32x32x16_bf16(pa0,PK(0),o[d0],0,0,0);
    o[d0]=__builtin_amdgcn_mfma_f32_32x32x16_bf16(pa1,PK(1),o[d0],0,0,0);
    o[d0]=__builtin_amdgcn_mfma_f32_32x32x16_bf16(pa2,PK(2),o[d0],0,0,0);
    o[d0]=__builtin_amdgcn_mfma_f32_32x32x16_bf16(pa3,PK(3),o[d0],0,0,0);
    #undef PK
  }
}

#ifndef ATTN_STORE16
#define ATTN_STORE16(p,v) (*(u32x4*)(p)=(v))
#endif
template<int THRL> __device__ __forceinline__ void attn_unit(int b,int hq,int hh,int qb,float slope2,const bf16*Q,const bf16*__restrict__ K,const bf16*__restrict__ V,bf16*O,char*shm,
    bool fuse,float lam,float osc,const bf16*GA,const float*sg,bf16*AR){
  int tid_=threadIdx.x; asm volatile("":"+v"(tid_)); const int tid=tid_,lane=tid&63,r32=lane&31,hi=lane>>5; const int wid=__builtin_amdgcn_readfirstlane(tid>>6);
  const long rowbase=(long)b*SEQ; const int q0=qb*QB;
  const bf16*Qw=Q+(rowbase+q0+wid*QBLK)*DM+hq*D;
  const bf16*Kh=K+rowbase*DM+hq*D,*Vh=V+rowbase*DM+hh*VD;
  const unsigned lds0=(unsigned)(uintptr_t)shm;
  float*wsf=(float*)(shm+LDS_WS)+wid*64;
  const unsigned koff=(unsigned)((lane*DM+wid*8)*2);
  const unsigned voff=(unsigned)(((16*(wid&3)+(lane>>2))*DM+(wid>>2)*32+(lane&3)*8)*2);
  const unsigned kdst=lds0+LDS_K+wid*1024, vdst=lds0+LDS_V+wid*1024;
  #define DMA_K(t,slot) glds16o(Kh+(long)(t)*KVBLK*DM,koff,(unsigned)__builtin_amdgcn_readfirstlane(kdst+(slot)))
  #define DMA_V(t,slot) do{ glds16o(Vh+(long)(t)*KVBLK*DM,voff,(unsigned)__builtin_amdgcn_readfirstlane(vdst+2*(slot))); glds16o(Vh+(long)(t)*KVBLK*DM+64,voff,(unsigned)__builtin_amdgcn_readfirstlane(vdst+2*(slot)+8192)); }while(0)
  const int vb0=(int)(lds0+LDS_V)+((lane>>4)&1)*32+(lane&3)*8+(4*hi+((lane&15)>>2))*64;
  const char*Kbase=shm+LDS_K; bf16x8 kf[8];
  const lds_cptr shm3=(lds_cptr)shm; const lds_cptr kp0=shm3+LDS_K+hi*1024+r32*16; const lds_cptr vp0=shm3+LDS_V+((lane>>4)&1)*32+(lane&3)*8+(4*hi+((lane&15)>>2))*64;
  const int NT=(q0+QB)/KVBLK;
  DMA_K(0,0);DMA_V(0,0);DMA_K(1,SLOTB);
  bf16x8 qr[4];
  #pragma unroll
  for(int d0=0;d0<4;++d0)qr[d0]=*reinterpret_cast<const bf16x8*>(&Qw[(long)r32*DM+d0*16+hi*8]);
  float l_reg=0.f;f32x16 o[4];o[0]=f32x16{};o[1]=f32x16{};o[2]=f32x16{};o[3]=f32x16{};
  float nb=slope2*(float)(4*hi-q0-255); const float sl64=64.f*slope2;
  #define BINIT0(C0,t) do{ _Pragma("unroll") for(int r=0;r<16;++r)C0[r]=fmaf(slope2,(float)((r&3)+8*(r>>2)),nb); }while(0)
  #define BINIT1(C1,t) do{ _Pragma("unroll") for(int r=0;r<16;++r)C1[r]=fmaf(slope2,(float)((r&3)+8*(r>>2)+32),nb); nb+=sl64; }while(0)
  const int qrel=wid*QBLK+r32;
  #define CMASK(P0,P1,t) do{int jb_=(t)-(NT-4); if(jb_>=0)cmask(P0,P1,jb_,qrel,hi);}while(0)
  bool resc=false;
  #define START(P0,P1) do{ const float rm=rowmax(P0,P1); resc=false; \
    { const float dl=rm; nb=fsub_s(nb,dl); \
      _Pragma("unroll") for(int r=0;r<16;++r){P0[r]=fsub_s(P0[r],dl);P1[r]=fsub_s(P1[r],dl);} } \
    _Pragma("unroll") for(int r=0;r<16;++r)P0[r]=__builtin_amdgcn_exp2f(P0[r]); }while(0)
  #define RESC() do{ if(resc){ asm volatile("s_waitcnt lgkmcnt(0)":::"memory"); \
      _Pragma("unroll") for(int d_=0;d_<4;++d_) _Pragma("unroll") for(int r=0;r<16;++r)o[d_][r]*=wsf[crow(r,hi)]; } }while(0)
  f32x16 pA0,pA1,pB0,pB1;
  int sl_prev=0,sl_cur=0,sl_next=SLOTB;
  #define ROT() do{sl_prev=sl_cur;sl_cur=sl_next;sl_next=(sl_next==(NSLOT-1)*SLOTB)?0:sl_next+SLOTB;}while(0)
  DMA_K(2,2*SLOTB);
  WAIT_BAR(3);
  asm volatile("":"+v"(nb));
  BINIT0(pA0,0);BINIT1(pA1,0);qkt(pA0,pA1,Kbase,qr,r32,hi);asm volatile("s_nop 15\n\ts_nop 7":"+v"(pA0),"+v"(pA1));CMASK(pA0,pA1,0);
  START(pA0,pA1);
  _Pragma("unroll") for(int r=0;r<16;++r)pA1[r]=__builtin_amdgcn_exp2f(pA1[r]);
  WAIT_BAR(0);
  DMA_K(3,0);DMA_V(1,SLOTB);
  ROT();
  kload8(kf,kp0+sl_cur);
  WAIT_BAR(3);
  s16x4 vlo[16],vhi[16]; u32x4 pw0,pw1,pw2,pw3;
  #define PKW(P,B) cvtpk_s(P[B],P[B+1])
  #define PAF(k) __builtin_bit_cast(bf16x8,pw##k)
  #define VFR(i) (bf16x8){vlo[i][0],vlo[i][1],vlo[i][2],vlo[i][3],vhi[i][0],vhi[i][1],vhi[i][2],vhi[i][3]}
  #define PIN(x) asm volatile("":"+v"(x))
  #define MX3(a,b,c) __builtin_fmaxf(__builtin_fmaxf((a),(b)),(c))
  #define GAPA(MF,A0,A1,A2,A3,W0,W1,PW) do{ MF; sacc+=A0; sacc+=A1; sacc+=A2; sacc+=A3; PIN(sacc); W0; W1; PIN(PW); SBAR(); }while(0)
  #define EX(v) __builtin_amdgcn_exp2f(v)
  #define VRD(j) do{ vlo[j]=vtr(vp_+(((j)&3)*4096+((j)>>2)*1024)); vhi[j]=vtr(vp_+(((j)&3)*4096+((j)>>2)*1024+512)); }while(0)
  #define GAPB(j,k,X,B) do{ asm volatile("s_waitcnt lgkmcnt(0)":::"memory"); SBAR(); o[(j)&3]=__builtin_amdgcn_mfma_f32_32x32x16_bf16(PAF(k),VFR(j),o[(j)&3],0,0,0); X[B]=EX(X[B]); X[B+1]=EX(X[B+1]); PIN(X); if((j)+4<16){VRD(((j)+4)&15);} SBAR(); }while(0)
  #define GAPB1(j,k,X,B) do{ asm volatile("s_waitcnt lgkmcnt(0)":::"memory"); SBAR(); o[(j)&3]=__builtin_amdgcn_mfma_f32_32x32x16_bf16(PAF(k),VFR(j),o[(j)&3],0,0,0); X[B]=EX(X[B]); X[B+1]=EX(X[B+1]); X[B+2]=EX(X[B+2]); X[B+3]=EX(X[B+3]); PIN(X); if((j)+4<8){VRD(((j)+4)&15);} SBAR(); }while(0)
  #define GAPB2(j,k) do{ o[(j)&3]=__builtin_amdgcn_mfma_f32_32x32x16_bf16(PAF(k),VFR(j),o[(j)&3],0,0,0); if((j)+4<16){VRD(((j)+4)&15);} SBAR(); }while(0)
  #define KRD(G,j) do{ if(G){ kload2(kf,kp0+sl_next,j); SBAR(); } }while(0)
  #define STEP(C0,C1,P0,P1,t,GK,GV,GL) do{ SBAR(); \
    const lds_cptr vp_=vp0+2*sl_prev; \
    BINIT0(C0,t); PIN(C0); SBAR(); float sacc=(P0[0]+P0[1]); \
    GAPA(C0=__builtin_amdgcn_mfma_f32_32x32x16_bf16(kf[0],qr[0],C0,0,0,0), P0[2],P0[3],P0[4],P0[5],     pw0[0]=PKW(P0,0), pw0[1]=PKW(P0,2), pw0); \
    BINIT1(C1,t); PIN(C1); SBAR(); GAPA(C1=__builtin_amdgcn_mfma_f32_32x32x16_bf16(kf[1],qr[0],C1,0,0,0), P0[6],P0[7],P0[8],P0[9],     pw0[2]=PKW(P0,4), pw0[3]=PKW(P0,6), pw0); \
    GAPA(C0=__builtin_amdgcn_mfma_f32_32x32x16_bf16(kf[2],qr[1],C0,0,0,0),   P0[10],P0[11],P0[12],P0[13], pw1[0]=PKW(P0,8), pw1[1]=PKW(P0,10), pw1); \
    GAPA(C1=__builtin_amdgcn_mfma_f32_32x32x16_bf16(kf[3],qr[1],C1,0,0,0),   P0[14],P0[15],P1[0],P1[1],   pw1[2]=PKW(P0,12),pw1[3]=PKW(P0,14), pw1); \
    VRD(0); SBAR(); GAPA(C0=__builtin_amdgcn_mfma_f32_32x32x16_bf16(kf[4],qr[2],C0,0,0,0),   P1[2],P1[3],P1[4],P1[5],     pw2[0]=PKW(P1,0), pw2[1]=PKW(P1,2), pw2); \
    VRD(1); SBAR(); GAPA(C1=__builtin_amdgcn_mfma_f32_32x32x16_bf16(kf[5],qr[2],C1,0,0,0),   P1[6],P1[7],P1[8],P1[9],     pw2[2]=PKW(P1,4), pw2[3]=PKW(P1,6), pw2); \
    VRD(2); SBAR(); GAPA(C0=__builtin_amdgcn_mfma_f32_32x32x16_bf16(kf[6],qr[3],C0,0,0,0),   P1[10],P1[11],P1[12],P1[13], pw3[0]=PKW(P1,8), pw3[1]=PKW(P1,10), pw3); \
    VRD(3); SBAR(); GAPA(C1=__builtin_amdgcn_mfma_f32_32x32x16_bf16(kf[7],qr[3],C1,0,0,0),   P1[14],P1[15],0.f,0.f,       pw3[2]=PKW(P1,12),pw3[3]=PKW(P1,14), pw3); \
    l_reg+=sacc; \
    if(GK){DMA_K((t)+3,sl_cur);} if(GV){DMA_V((t)+1,sl_next);} \
    CMASK(C0,C1,t); \
    { float a=MX3(C0[0],C0[1],C1[0]),b=MX3(C0[2],C0[3],C1[1]); a=MX3(a,C1[2],C1[3]); \
      _Pragma("unroll") for(int r=4;r<16;r+=4){a=MX3(a,C0[r],C0[r+1]);b=MX3(b,C0[r+2],C0[r+3]);a=MX3(a,C1[r],C1[r+1]);b=MX3(b,C1[r+2],C1[r+3]);} \
      float rm=__builtin_fmaxf(a,b); { auto rr=__builtin_amdgcn_permlane32_swap(__float_as_uint(rm),__float_as_uint(rm),false,false); rm=__builtin_fmaxf(__uint_as_float(rr[0]),__uint_as_float(rr[1])); } \
      resc=false; \
      if(__builtin_expect(__any(rm>(float)THRL),0)){ const float dl=__builtin_fmaxf(rm,0.f); nb-=dl; \
        _Pragma("unroll") for(int r=0;r<16;++r){C0[r]-=dl;C1[r]-=dl;} \
        const float f=__builtin_amdgcn_exp2f(-dl); l_reg*=f; if(hi==0)wsf[r32]=f; resc=true; } } \
    SBAR(); \
    GAPB1(0,0,C0,0); GAPB1(1,0,C0,4); GAPB1(2,0,C0,8); GAPB1(3,0,C0,12); \
    GAPB1(4,1,C1,0); GAPB1(5,1,C1,4); GAPB1(6,1,C1,8); GAPB1(7,1,C1,12); \
    asm volatile("s_waitcnt lgkmcnt(0)":::"memory"); SBAR(); VRD(8); VRD(9); VRD(10); VRD(11); SBAR(); \
    KRD(GL,0); GAPB2(8,2); GAPB2(9,2); KRD(GL,1); GAPB2(10,2); GAPB2(11,2); \
    KRD(GL,2); GAPB2(12,3); GAPB2(13,3); KRD(GL,3); GAPB2(14,3); GAPB2(15,3); \
    }while(0)
  int t=1;
  #undef CMASK
  #define CMASK(P0,P1,t) do{}while(0)
  for(;t+5<NT;t+=2){
    STEP(pB0,pB1,pA0,pA1,t,true,true,true);     WAIT_BAR(3); RESC(); ROT();
    STEP(pA0,pA1,pB0,pB1,t+1,true,true,true);   WAIT_BAR(3); RESC(); ROT();
  }
  #undef CMASK
  #define CMASK(P0,P1,t) do{int jb_=(t)-(NT-4); if(jb_>=0)cmask(P0,P1,jb_,qrel,hi);}while(0)
  #define ENDW(tt) do{ if((tt)+3<NT){WAIT_BAR(3);} else if((tt)+2<NT){WAIT_BAR(2);} else {WAIT_BAR(0);} }while(0)
  for(;t+1<NT;t+=2){
    STEP(pB0,pB1,pA0,pA1,t,(t+3<NT),(t+1<NT),(t+1<NT));       ENDW(t);   RESC(); ROT();
    STEP(pA0,pA1,pB0,pB1,t+1,(t+4<NT),(t+2<NT),(t+2<NT));     ENDW(t+1); RESC(); ROT();
  }
  STEP(pB0,pB1,pA0,pA1,NT-1,false,false,false); RESC();
  { float sacc=pB0[0]+pB0[1]; _Pragma("unroll") for(int r=2;r<16;++r)sacc+=pB0[r]; _Pragma("unroll") for(int r=0;r<16;++r)sacc+=pB1[r]; l_reg+=sacc;
    pw0=(u32x4){PKW(pB0,0),PKW(pB0,2),PKW(pB0,4),PKW(pB0,6)};pw1=(u32x4){PKW(pB0,8),PKW(pB0,10),PKW(pB0,12),PKW(pB0,14)};pw2=(u32x4){PKW(pB1,0),PKW(pB1,2),PKW(pB1,4),PKW(pB1,6)};pw3=(u32x4){PKW(pB1,8),PKW(pB1,10),PKW(pB1,12),PKW(pB1,14)};
    SBAR(); pv(o,vb0+2*sl_cur,PAF(0),PAF(1),PAF(2),PAF(3)); }
  #undef PKW
  #undef PAF
  #undef VFR
  #undef PIN
  #undef MX3
  #undef GAPA
  #undef GAPB
  #undef EX
  #undef VRD
  #undef KRD
  #undef STEP
  #undef ENDW
  {auto rr=__builtin_amdgcn_permlane32_swap(__float_as_uint(l_reg),__float_as_uint(l_reg),false,false);l_reg=__uint_as_float(rr[0])+__uint_as_float(rr[1]);}
  if(hi==0)wsf[32+r32]=l_reg;asm volatile("s_waitcnt lgkmcnt(0)":::"memory");
  float rli[16];
  #pragma unroll
  for(int r=0;r<16;++r)rli[r]=__builtin_amdgcn_rcpf(wsf[32+crow(r,hi)]);
  bf16*Ow=O+(rowbase+q0+wid*QBLK)*DM+hh*VD;
  { bf16*stg=(bf16*)(shm+LDS_OST)+wid*4096;
    #pragma unroll
    for(int r=0;r<16;++r){const int orow=crow(r,hi);
      #pragma unroll
      for(int d0=0;d0<4;++d0)stg[orow*128+d0*32+r32]=__float2bfloat16(o[d0][r]*rli[r]);}
    asm volatile("s_waitcnt lgkmcnt(0)":::"memory");
    if(!fuse){
    #pragma unroll
    for(int i=0;i<8;++i){const int row=i*4+(lane>>4),ch=lane&15; const u32x4 v=*(const u32x4*)(stg+row*128+ch*8); ATTN_STORE16(Ow+(long)row*DM+ch*8,v);} }
    else{
      asm volatile("s_waitcnt vmcnt(0)":::"memory");
      const bf16*GAw=GA+(rowbase+q0+wid*QBLK)*DM+hh*VD; bf16*ARw=AR+(rowbase+q0+wid*QBLK)*(2*DM)+hh*VD; const int ch=lane&15;
      float sgv[8];
      #pragma unroll
      for(int j=0;j<8;++j)sgv[j]=sg[ch*8+j]*osc;
      #pragma unroll 2
      for(int i=0;i<8;++i){const int row=i*4+(lane>>4);
        const bf16x8 o2=*(const bf16x8*)(stg+row*128+ch*8), o1=*(const bf16x8*)(Ow+(long)row*DM+ch*8), ga=*(const bf16x8*)(GAw+(long)row*DM+ch*8);
        float d[8]; float ss=0.f;
        #pragma unroll
        for(int j=0;j<8;++j){ d[j]=__uint_as_float(((unsigned)(unsigned short)o1[j])<<16)-lam*__uint_as_float(((unsigned)(unsigned short)o2[j])<<16); ss+=d[j]*d[j]; }
        ss+=__int_as_float(__builtin_amdgcn_ds_swizzle(__float_as_int(ss),0x041f)); ss+=__int_as_float(__builtin_amdgcn_ds_swizzle(__float_as_int(ss),0x081f));
        ss+=__int_as_float(__builtin_amdgcn_ds_swizzle(__float_as_int(ss),0x101f)); ss+=__int_as_float(__builtin_amdgcn_ds_swizzle(__float_as_int(ss),0x201f));
        const float rn=1.0f/sqrtf(ss*(1.f/128.f)+1e-5f);
        u32x4 w;
        #pragma unroll
        for(int j2=0;j2<4;++j2){ const float g0=__uint_as_float(((unsigned)(unsigned short)ga[2*j2])<<16), g1=__uint_as_float(((unsigned)(unsigned short)ga[2*j2+1])<<16);
          w[j2]=cvtpk_s(d[2*j2]*rn*sgv[2*j2]*(g0/(1.f+__expf(-g0))), d[2*j2+1]*rn*sgv[2*j2+1]*(g1/(1.f+__expf(-g1)))); }
        *(u32x4*)(ARw+(long)row*(2*DM)+ch*8)=w; } } }
  asm volatile("s_waitcnt lgkmcnt(0)\n\ts_barrier":::"memory");
  #undef DMA_K
  #undef DMA_V
  #undef BINIT0
  #undef BINIT1
  #undef CMASK
  #undef START
  #undef RESC
  #undef ROT
}
constexpr int ATTN_LDS_BYTES=LDS_BYTES;
#undef SBAR
#undef WAIT_BAR
}
#define GAS __attribute__((address_space(1)))
#define LAS __attribute__((address_space(3)))
typedef unsigned short bf16;
typedef unsigned v4u __attribute__((ext_vector_type(4)));
typedef float f32x4 __attribute__((ext_vector_type(4)));
typedef short bf16x8 __attribute__((ext_vector_type(8)));
typedef GAS unsigned gu32;
typedef GAS unsigned long long gu64;
#define RLX_AGENT __ATOMIC_RELAXED, __HIP_MEMORY_SCOPE_AGENT
#define LDS_WAIT() asm volatile("s_waitcnt lgkmcnt(0)" ::: "memory")
#define VM_WAIT() asm volatile("s_waitcnt vmcnt(0)" ::: "memory")
__device__ __forceinline__ unsigned long long rt() { return __builtin_amdgcn_s_memrealtime(); }
__device__ __forceinline__ unsigned f2bf(float f) { unsigned u = __builtin_bit_cast(unsigned, f); return (u + 0x7fffu + ((u >> 16) & 1u)) >> 16; }
typedef float f32x2_pk __attribute__((ext_vector_type(2))); typedef __bf16 bf16x2_pk __attribute__((ext_vector_type(2)));
__device__ __forceinline__ unsigned pk2(float lo, float hi) { f32x2_pk v = {lo, hi}; bf16x2_pk b = __builtin_convertvector(v, bf16x2_pk); return __builtin_bit_cast(unsigned, b); }

#define XB_TMO      128
#define XB_XCNT(j)  (256  + 64 * (j))
#define XB_XSUB(j)  (1280 + 64 * (j))
#define XB_XGEN(j)  (2304 + 64 * (j))
#define XB_TOP      3328
#define XB_TOPGEN   3392
#define XCD_BAR_WORDS 3456
#define XB_SPIN_CAP (1u << 18)

__device__ __forceinline__ unsigned xb_ld(unsigned* p)              { return __hip_atomic_load(p, __ATOMIC_RELAXED, __HIP_MEMORY_SCOPE_AGENT); }
__device__ __forceinline__ unsigned xb_add(unsigned* p, unsigned v) { return __hip_atomic_fetch_add(p, v, __ATOMIC_RELAXED, __HIP_MEMORY_SCOPE_AGENT); }
__device__ __forceinline__ unsigned xb_xcc_id() { return (unsigned)__builtin_amdgcn_s_getreg((3 << 11) | 20) & 0xFu; }
#define XB_SPIN(cond, bar) do { unsigned _sp = 0; while (cond) { __builtin_amdgcn_s_sleep(1); \
    if ((++_sp & 255u) == 0u) { if (xb_ld(&(bar)[XB_TMO])) break; if (_sp > XB_SPIN_CAP) { atomicAdd(&(bar)[XB_TMO], 1u); break; } } } } while (0)

struct XcdBarrier {
    unsigned* bar; unsigned x;
    volatile LAS unsigned* st;
};

__device__ __forceinline__ XcdBarrier xcd_barrier_post(unsigned* bar, volatile LAS unsigned* st) {
    XcdBarrier b; b.bar = bar; b.x = xb_xcc_id(); b.st = st;
    if (threadIdx.x == 0) (void)xb_add(&bar[XB_XCNT(b.x)], 1u);
    return b;
}
__device__ __forceinline__ void xcd_barrier_complete(unsigned* bar, unsigned x, unsigned& nloc, unsigned& nx) {
    const unsigned G = gridDim.x * gridDim.y * gridDim.z;
    unsigned sum, cnt, mine, sp = 0u;
    for (;;) {
        sum = 0u; cnt = 0u; mine = 0u;
#pragma unroll
        for (unsigned j = 0; j < 16; ++j) { const unsigned c = xb_ld(&bar[XB_XCNT(j)]); sum += c; cnt += (c > 0u) ? 1u : 0u; mine = (j == x) ? c : mine; }
        if (sum == G) break;
        __builtin_amdgcn_s_sleep(1);
        if ((++sp & 255u) == 0u) { if (xb_ld(&bar[XB_TMO])) break; if (sp > XB_SPIN_CAP) { atomicAdd(&bar[XB_TMO], 1u); break; } }
    }
    nloc = mine > 0u ? mine : 1u; nx = cnt > 0u ? cnt : 1u;
}

__device__ __forceinline__ void xcd_barrier(const XcdBarrier& b) {
    asm volatile("s_waitcnt vmcnt(0)" ::: "memory");
    __syncthreads();
    if (threadIdx.x == 0) {
        unsigned* bar = b.bar;
        __builtin_amdgcn_s_waitcnt(0);
        unsigned nloc = b.st[0], nx = b.st[1];
        if (nloc == 0u) { xcd_barrier_complete(bar, b.x, nloc, nx); b.st[0] = nloc; b.st[1] = nx; }
        const unsigned old = xb_add(&bar[XB_XSUB(b.x)], 1u);
        const unsigned gen = old / nloc;
        if (old + 1u == (gen + 1u) * nloc) {
            __builtin_amdgcn_fence(__ATOMIC_RELEASE, "agent");
            asm volatile("s_waitcnt vmcnt(0)" ::: "memory");
            const unsigned og = xb_add(&bar[XB_TOP], 1u);
            const unsigned tg = og / nx;
            if (og + 1u == (tg + 1u) * nx) xb_add(&bar[XB_TOPGEN], 1u);
            else XB_SPIN(xb_ld(&bar[XB_TOPGEN]) == tg, bar);
            __builtin_amdgcn_fence(__ATOMIC_ACQUIRE, "agent");
            xb_add(&bar[XB_XGEN(b.x)], 1u);
            asm volatile("s_waitcnt vmcnt(0)" ::: "memory");
        } else {
            XB_SPIN(xb_ld(&bar[XB_XGEN(b.x)]) == gen, bar);
            __builtin_amdgcn_fence(__ATOMIC_ACQUIRE, "agent");
            asm volatile("s_waitcnt vmcnt(0)" ::: "memory");
        }
    }
    __syncthreads();
}
constexpr int NWAVES = 8;
constexpr int BATCH = 8, SEQ = 2048, DM = 2048, DEPTH = 2, M = BATCH * SEQ;
constexpr int HEADS = 8, IN_TOTAL = 10240, LRUW = 1024, NBLK = 8, BLKW = 128;
constexpr float LN_EPS = 1e-5f, SUBLN_EPS = 1e-5f, DN_ALPHA = 1.41421356237309515f, LOG2E = 1.4426950408889634f;

constexpr size_t MiB = 1u << 20;
constexpr size_t WS_CTL = 0, CTL_ZERO_BYTES = 1 * MiB;
constexpr size_t WS_GW = 1 * MiB;
constexpr int N_BF = 4096, N_F8 = 6144;
constexpr float W8_SCALE = 64.f;
constexpr size_t WS_WIN = 2 * MiB;
constexpr size_t WS_WG8 = 34 * MiB;
constexpr size_t WS_XQ8 = 66 * MiB;
constexpr size_t WS_WPAB = 98 * MiB;
constexpr size_t WS_WOUT = 114 * MiB;
constexpr size_t WS_XB16 = 130 * MiB;
constexpr size_t WS_O1 = 130 * MiB, WS_O2 = 162 * MiB, WS_MERGED = 130 * MiB;
constexpr size_t WS_P6 = 194 * MiB;
constexpr size_t WS_MA = 386 * MiB, WS_MB = 450 * MiB;
constexpr size_t WS_AR = 514 * MiB;
constexpr size_t WS_END = 578 * MiB;
constexpr int CW_TMO = 0, CW_BAR = 4096;

constexpr int RING_OFF = 0, RING_BYTES = 151552;
constexpr int LDSCTL_OFF = RING_BYTES, MISC_OFF = LDSCTL_OFF + 320;
constexpr int LDS_BYTES = 153600;
static_assert(MISC_OFF + 128 <= LDS_BYTES && attn_body::ATTN_LDS_BYTES <= RING_BYTES && pg8::STAGE_BYTES <= RING_BYTES, "LDS map");

struct Frame {
    LAS unsigned char* lds; volatile LAS unsigned* MISC; gu32* ctl;
    int tid, lane, wave, vcu, G;
};
__device__ __forceinline__ float wave_sum(float v, int lane) {
#pragma unroll
    for (int o = 1; o < 64; o <<= 1) v += __int_as_float(__builtin_amdgcn_ds_bpermute((lane ^ o) << 2, __float_as_int(v)));
    return v;
}
__device__ __forceinline__ void p0_transpose_item(const float* W, int ldw, int ncols, bf16* WT, int ldt, int koff, LAS float* scr, int item, int lane) {
    const int nblk = ncols / 32, kb = item / nblk, nb = item % nblk, k0 = 64 * kb, n0 = 32 * nb;
#pragma unroll 8
    for (int i = 0; i < 32; ++i) { const int kk = 2 * i + (lane >> 5); scr[kk * 33 + (lane & 31)] = W[(size_t)(k0 + kk) * ldw + n0 + (lane & 31)]; }
    LDS_WAIT(); asm volatile("" ::: "memory");
    const int c = lane & 7;
#pragma unroll
    for (int j = 0; j < 4; ++j) { const int n = (lane >> 3) + 8 * j; const LAS float* s = scr + (8 * c) * 33 + n;
        v4u o; o.x = pk2(s[0 * 33], s[1 * 33]); o.y = pk2(s[2 * 33], s[3 * 33]); o.z = pk2(s[4 * 33], s[5 * 33]); o.w = pk2(s[6 * 33], s[7 * 33]);
        *(GAS v4u*)(WT + (size_t)(n0 + n) * ldt + koff + k0 + 8 * c) = o; }
    LDS_WAIT(); asm volatile("" ::: "memory");
}
__device__ __forceinline__ unsigned pk4_fp8(float a, float b, float c, float d) { int w = __builtin_amdgcn_cvt_pk_fp8_f32(a, b, 0, false); w = __builtin_amdgcn_cvt_pk_fp8_f32(c, d, w, true); return (unsigned)w; }
__device__ __forceinline__ void p0_transpose_item8(const float* W, int ldw, int ncols, unsigned char* WT8, int ldt, float scale, LAS float* scr, int item, int lane) {
    const int nblk = ncols / 32, kb = item / nblk, nb = item % nblk, k0 = 64 * kb, n0 = 32 * nb;
#pragma unroll 8
    for (int i = 0; i < 32; ++i) { const int kk = 2 * i + (lane >> 5); scr[kk * 33 + (lane & 31)] = W[(size_t)(k0 + kk) * ldw + n0 + (lane & 31)] * scale; }
    LDS_WAIT(); asm volatile("" ::: "memory");
    const int c = lane & 3;
#pragma unroll
    for (int j = 0; j < 2; ++j) { const int n = (lane >> 2) + 16 * j; const LAS float* s = scr + (16 * c) * 33 + n;
        v4u o; o.x = pk4_fp8(s[0 * 33], s[1 * 33], s[2 * 33], s[3 * 33]); o.y = pk4_fp8(s[4 * 33], s[5 * 33], s[6 * 33], s[7 * 33]);
        o.z = pk4_fp8(s[8 * 33], s[9 * 33], s[10 * 33], s[11 * 33]); o.w = pk4_fp8(s[12 * 33], s[13 * 33], s[14 * 33], s[15 * 33]);
        *(GAS v4u*)(WT8 + (size_t)(n0 + n) * ldt + k0 + 16 * c) = o; }
    LDS_WAIT(); asm volatile("" ::: "memory");
}
struct Args { const float* in[19]; float* out; unsigned char* ws; int ph_lo, ph_hi; };

__device__ __forceinline__ void p0_prologue(Frame& F, const Args& a) {
    LAS float* scr = (LAS float*)(F.lds + RING_OFF + F.wave * 16384);
    const int gw = F.vcu * NWAVES + F.wave, NGW = F.G * NWAVES;
    constexpr int I_IN = (DM / 64) * (N_BF / 32), I_G8 = (DM / 64) * (N_F8 / 32), I_P = (1024 / 64) * (DM / 32), I_O = (DM / 64) * (DM / 32), I_L = I_IN + I_G8 + 2 * I_P + I_O;
    for (int it = gw; it < DEPTH * I_L; it += NGW) {
        const int l = it / I_L; int r = it % I_L;
        bf16* win = (bf16*)(a.ws + WS_WIN) + (size_t)l * N_BF * DM; bf16* wpab = (bf16*)(a.ws + WS_WPAB) + (size_t)l * DM * DM; bf16* wout = (bf16*)(a.ws + WS_WOUT) + (size_t)l * DM * DM;
        if (r < I_IN) { p0_transpose_item(a.in[1] + (size_t)l * DM * IN_TOTAL, IN_TOTAL, N_BF, win, DM, 0, scr, r, F.lane); continue; } r -= I_IN;
        if (r < I_G8) { p0_transpose_item8(a.in[1] + (size_t)l * DM * IN_TOTAL + N_BF, IN_TOTAL, N_F8, a.ws + WS_WG8 + (size_t)l * N_F8 * DM, DM, W8_SCALE, scr, r, F.lane); continue; } r -= I_G8;
        if (r < I_P) { p0_transpose_item(a.in[14] + (size_t)l * 1024 * DM, DM, DM, wpab, DM, 0, scr, r, F.lane); continue; } r -= I_P;
        if (r < I_P) { p0_transpose_item(a.in[15] + (size_t)l * 1024 * DM, DM, DM, wpab, DM, 1024, scr, r, F.lane); continue; } r -= I_P;
        p0_transpose_item(a.in[16] + (size_t)l * DM * DM, DM, DM, wout, DM, 0, scr, r, F.lane);
    }
    for (int it = gw; it < DEPTH * NBLK * 4 * 2 * 8; it += NGW) {
        const int s_ = it & 7, g_ = (it >> 3) & 1, jq = (it >> 4) & 3, n = (it >> 6) & 7, l = it >> 9;
        const float* w = a.in[g_ ? 6 : 4] + ((size_t)(l * NBLK + n) * BLKW + 16 * s_ + 8 * (F.lane >> 5)) * BLKW + jq * 32 + (F.lane & 31);
        v4u o; o.x = pk2(w[0], w[BLKW]); o.y = pk2(w[2 * BLKW], w[3 * BLKW]); o.z = pk2(w[4 * BLKW], w[5 * BLKW]); o.w = pk2(w[6 * BLKW], w[7 * BLKW]);
        *(GAS v4u*)((bf16*)(a.ws + WS_GW) + (size_t)it * 512 + F.lane * 8) = o; }
    bf16* xb = (bf16*)(a.ws + WS_XB16); const float* x = a.in[0];
    for (int m = gw; m < M; m += NGW) {
        const GAS f32x4* xr = (const GAS f32x4*)(x + (size_t)m * DM) + F.lane; GAS unsigned long long* o8 = (GAS unsigned long long*)(xb + (size_t)m * DM) + F.lane;
        GAS unsigned* q8 = (GAS unsigned*)(a.ws + WS_XQ8 + (size_t)m * DM) + F.lane;
#pragma unroll
        for (int j = 0; j < 8; ++j) { const f32x4 v = xr[64 * j]; o8[64 * j] = (unsigned long long)pk2(v.x, v.y) | ((unsigned long long)pk2(v.z, v.w) << 32); q8[64 * j] = pk4_fp8(v.x, v.y, v.z, v.w); }
    }
}
__device__ __forceinline__ void ln_phase(Frame& F, float* y, bf16* xb, unsigned char* xq8, const float* g, const float* bta, bool copies) {
    const int gw = F.vcu * NWAVES + F.wave, NGW = F.G * NWAVES; int lane = F.lane; asm volatile("" : "+v"(lane));
    for (int m = gw; m < M; m += NGW) {
        GAS f32x4* yr = (GAS f32x4*)(y + (size_t)m * DM) + lane; f32x4 v[8]; float s = 0.f;
#pragma unroll
        for (int j = 0; j < 8; ++j) { v[j] = yr[64 * j]; s += (v[j].x + v[j].y) + (v[j].z + v[j].w); }
        const float mean = wave_sum(s, lane) * (1.f / DM); float s2 = 0.f;
#pragma unroll
        for (int j = 0; j < 8; ++j) { v[j] = v[j] - mean; s2 += (v[j].x * v[j].x + v[j].y * v[j].y) + (v[j].z * v[j].z + v[j].w * v[j].w); }
        const float rstd = 1.f / sqrtf(wave_sum(s2, lane) * (1.f / DM) + LN_EPS);
        GAS unsigned long long* o8 = (GAS unsigned long long*)(xb + (size_t)m * DM) + lane; GAS unsigned* q8 = (GAS unsigned*)(xq8 + (size_t)m * DM) + lane;
#pragma unroll
        for (int j = 0; j < 8; ++j) { const f32x4 gg = *((const GAS f32x4*)g + lane + 64 * j), bb = *((const GAS f32x4*)bta + lane + 64 * j);
            const f32x4 o = v[j] * rstd * gg + bb; yr[64 * j] = o; if (copies) { o8[64 * j] = (unsigned long long)pk2(o.x, o.y) | ((unsigned long long)pk2(o.z, o.w) << 32); q8[64 * j] = pk4_fp8(o.x, o.y, o.z, o.w); } }
    }
}
__device__ __forceinline__ void combine_block(Frame& F, int b, int h, int qb, const bf16* O1, const bf16* O2, const bf16* GA, bf16* AR, const float* subln_g, float lam, float lam_init) {
    typedef short s16x8 __attribute__((ext_vector_type(8)));
    int tid = F.tid; asm volatile("" : "+v"(tid));
#pragma unroll 1
    for (int it = 0; it < 4; ++it) {
        const int idx = tid + 512 * it, row = b * SEQ + qb * 256 + (idx >> 3), c16 = idx & 7, col = h * 128 + c16 * 16;
        const size_t off = (size_t)row * 1024 + col;
        const s16x8 a0 = *(const GAS s16x8*)(O1 + off), a1 = *(const GAS s16x8*)(O1 + off + 8), b0 = *(const GAS s16x8*)(O2 + off), b1 = *(const GAS s16x8*)(O2 + off + 8);
        const s16x8 g0 = *(const GAS s16x8*)(GA + off), g1 = *(const GAS s16x8*)(GA + off + 8);
        float o[16]; float ss = 0.f;
#pragma unroll
        for (int j = 0; j < 8; ++j) { o[j] = pg8::bfbits2f(a0[j]) - lam * pg8::bfbits2f(b0[j]); o[8 + j] = pg8::bfbits2f(a1[j]) - lam * pg8::bfbits2f(b1[j]); }
#pragma unroll
        for (int j = 0; j < 16; ++j) ss += o[j] * o[j];
        ss += __int_as_float(__builtin_amdgcn_ds_swizzle(__float_as_int(ss), 0x041f)); ss += __int_as_float(__builtin_amdgcn_ds_swizzle(__float_as_int(ss), 0x081f)); ss += __int_as_float(__builtin_amdgcn_ds_swizzle(__float_as_int(ss), 0x101f));
        const float rn = (1.f / sqrtf(ss * (1.f / 128.f) + SUBLN_EPS)) * (1.f - lam_init);
        unsigned w[8];
#pragma unroll
        for (int j = 0; j < 8; ++j) {
            const float ga0 = pg8::bfbits2f(j < 4 ? g0[2 * j] : g1[2 * j - 8]), ga1 = pg8::bfbits2f(j < 4 ? g0[2 * j + 1] : g1[2 * j - 7]);
            const float v0 = o[2 * j] * rn * subln_g[c16 * 16 + 2 * j] * (ga0 / (1.f + __expf(-ga0))), v1 = o[2 * j + 1] * rn * subln_g[c16 * 16 + 2 * j + 1] * (ga1 / (1.f + __expf(-ga1)));
            w[j] = pk2(v0, v1); }
        bf16* op = AR + (size_t)row * 2048 + col;
        *(GAS v4u*)op = (v4u){w[0], w[1], w[2], w[3]}; *(GAS v4u*)(op + 8) = (v4u){w[4], w[5], w[6], w[7]};
    }
}
constexpr int LRU_TM = 256, XCS_PITCH = 272, LRU_XCS = 0, LRU_AS = LRU_XCS + LRU_TM * XCS_PITCH, LRU_US = LRU_AS + LRU_TM * 32 * 4, LRU_AH = LRU_US + LRU_TM * 32 * 4, LRU_CARRY = LRU_AH + 16 * 32 * 8, LRU_WI = LRU_CARRY + 2 * 32 * 4, LRU_CW = LRU_WI + 8 * 64 * 16, LRU_END = LRU_CW + 5 * 128 * 4;
static_assert(LRU_END <= RING_BYTES, "LRU LDS map");
constexpr size_t GW_ITEM = 2 * 8 * 64 * 8;
#define LBAR() asm volatile("s_waitcnt lgkmcnt(0)\n\ts_barrier" ::: "memory")
__device__ __forceinline__ void lru_item(Frame& F, int b, int n, int jq, const bf16* XB, const bf16* GB, bf16* AR, const float* conv_w, const float* conv_b, const bf16* gwf, const float* b_r,
                                         const float* b_i, const float* lam) {
    typedef short s16x8 __attribute__((ext_vector_type(8))); typedef float f32x16 __attribute__((ext_vector_type(16))); typedef float f32x2 __attribute__((ext_vector_type(2)));
    LAS unsigned char* L = F.lds + RING_OFF;
    int tid = F.tid; asm volatile("" : "+v"(tid));
    const int lane = tid & 63, wave = F.wave, r32 = lane & 31, hi = lane >> 5;
    const int ch8 = tid & 15, tq = tid >> 4;
    const int cch = n * BLKW + jq * 32 + r32;
    s16x8 wfr[8];
#pragma unroll
    for (int s = 0; s < 8; ++s) wfr[s] = *(const GAS s16x8*)(gwf + (size_t)(s * 64 + lane) * 8);
    *(LAS s16x8*)(L + LRU_WI + tid * 16) = *(const GAS s16x8*)(gwf + (size_t)(8 * 64 + tid) * 8);
    const float bias_r = b_r[cch], bias_i = b_i[cch], lc = -8.f * log1pf(__expf(-lam[cch])), lc2 = lc * LOG2E;
    if (tid < 64) ((LAS float*)(L + LRU_CARRY))[tid] = 0.f;
    const bf16* xbase = XB + (size_t)b * SEQ * 1024 + n * BLKW + ch8 * 8;
    if (tid < 128) { LAS float* cwl = (LAS float*)(L + LRU_CW); cwl[tid] = conv_b[n * BLKW + tid];
#pragma unroll
        for (int j = 0; j < 4; ++j) cwl[(1 + j) * 128 + tid] = conv_w[j * LRUW + n * BLKW + tid]; }
    s16x8 xq[2][7];
#define LRU_LOADX(t0_) do { _Pragma("unroll") for (int g = 0; g < 2; ++g) _Pragma("unroll") for (int rr = 0; rr < 7; ++rr) { const int t = (t0_) + (tq + 32 * g) * 4 - 3 + rr; \
        xq[g][rr] = (t >= 0) ? *(const GAS s16x8*)(xbase + (size_t)t * 1024) : (s16x8){0, 0, 0, 0, 0, 0, 0, 0}; } } while (0)
    LRU_LOADX(0);
    LBAR();
#pragma unroll 1
    for (int ms = 0; ms < SEQ / LRU_TM; ++ms) {
        const int t0 = ms * LRU_TM;
        {
            float cw[4][8], cb[8];
            { unsigned cwb = (unsigned)(LRU_CW + ch8 * 32); asm volatile("" : "+v"(cwb));
              const f32x4 b0 = *(const LAS f32x4*)(L + cwb), b1 = *(const LAS f32x4*)(L + cwb + 16);
              cb[0] = b0.x; cb[1] = b0.y; cb[2] = b0.z; cb[3] = b0.w; cb[4] = b1.x; cb[5] = b1.y; cb[6] = b1.z; cb[7] = b1.w;
#pragma unroll
              for (int j = 0; j < 4; ++j) { const f32x4 w0 = *(const LAS f32x4*)(L + cwb + (1 + j) * 512), w1 = *(const LAS f32x4*)(L + cwb + (1 + j) * 512 + 16);
                  cw[j][0] = w0.x; cw[j][1] = w0.y; cw[j][2] = w0.z; cw[j][3] = w0.w; cw[j][4] = w1.x; cw[j][5] = w1.y; cw[j][6] = w1.z; cw[j][7] = w1.w; } }
            unsigned s1b = (unsigned)(LRU_XCS + tq * 4 * XCS_PITCH + ch8 * 16); asm volatile("" : "+v"(s1b));
#pragma unroll
            for (int g = 0; g < 2; ++g) {
                unsigned w[4][4];
#pragma unroll
                for (int i2 = 0; i2 < 4; ++i2) {
                    float x0[7], x1[7];
#pragma unroll
                    for (int rr = 0; rr < 7; ++rr) { const unsigned d = ((const unsigned*)&xq[g][rr])[i2]; x0[rr] = __uint_as_float(d << 16); x1[rr] = __uint_as_float(d & 0xffff0000u); }
#pragma unroll
                    for (int q = 0; q < 4; ++q) {
                        const float v0 = cb[2 * i2] + cw[0][2 * i2] * x0[q] + cw[1][2 * i2] * x0[q + 1] + cw[2][2 * i2] * x0[q + 2] + cw[3][2 * i2] * x0[q + 3];
                        const float v1 = cb[2 * i2 + 1] + cw[0][2 * i2 + 1] * x1[q] + cw[1][2 * i2 + 1] * x1[q + 1] + cw[2][2 * i2 + 1] * x1[q + 2] + cw[3][2 * i2 + 1] * x1[q + 3];
                        w[q][i2] = pk2(v0, v1); }
                    asm volatile("" : "+v"(w[0][i2]), "+v"(w[1][i2]), "+v"(w[2][i2]), "+v"(w[3][i2]));
                }
#pragma unroll
                for (int q = 0; q < 4; ++q) *(LAS v4u*)(L + s1b + (32 * g * 4 + q) * XCS_PITCH) = (v4u){w[q][0], w[q][1], w[q][2], w[q][3]};
            }
        }
        if (ms + 1 < SEQ / LRU_TM) LRU_LOADX(t0 + LRU_TM);
        LBAR();
        {
            f32x16 ar, ai;
#pragma unroll
            for (int r = 0; r < 16; ++r) { ar[r] = bias_r; ai[r] = bias_i; }
            unsigned s2a = (unsigned)(LRU_XCS + (32 * wave + r32) * XCS_PITCH + hi * 16), s2i = (unsigned)(LRU_WI + lane * 16); asm volatile("" : "+v"(s2a), "+v"(s2i));
#pragma unroll
            for (int s = 0; s < 8; ++s) { const s16x8 af = *(const LAS s16x8*)(L + s2a + s * 32), wi = *(const LAS s16x8*)(L + s2i + s * 1024);
                ar = __builtin_amdgcn_mfma_f32_32x32x16_bf16(af, wfr[s], ar, 0, 0, 0); ai = __builtin_amdgcn_mfma_f32_32x32x16_bf16(af, wi, ai, 0, 0, 0); }
            unsigned s2x = (unsigned)(LRU_XCS + (32 * wave + 4 * hi) * XCS_PITCH + (jq * 32 + r32) * 2), s2w = (unsigned)((32 * wave + 4 * hi) * 128 + r32 * 4); asm volatile("" : "+v"(s2x), "+v"(s2w));
#pragma unroll
            for (int r = 0; r < 16; ++r) { const int cr = (r & 3) + 8 * (r >> 2);
                const float rg = __builtin_amdgcn_rcpf(1.f + __builtin_amdgcn_exp2f(-LOG2E * ar[r])), ig = __builtin_amdgcn_rcpf(1.f + __builtin_amdgcn_exp2f(-LOG2E * ai[r]));
                const float av = __builtin_amdgcn_exp2f(lc2 * rg), t = 2.f * lc * rg;
                const float ser = -t * (1.f + t * (0.5f + t * (0.16666667f + t * (0.041666668f + t * 0.0083333338f))));
                const float om = (t > -0.1f) ? ser : (1.f - av * av);
                const float xc = __uint_as_float(((unsigned)*(const LAS unsigned short*)(L + s2x + cr * XCS_PITCH)) << 16);
                const float uv = __builtin_amdgcn_sqrtf(om) * (ig * xc);
                *(LAS float*)(L + LRU_AS + s2w + cr * 128) = av; *(LAS float*)(L + LRU_US + s2w + cr * 128) = uv; }
        }
        LBAR();
        s16x8 gbv[2];
#pragma unroll
        for (int g = 0; g < 2; ++g) { const int idx = tid + 512 * g, tl = idx >> 2, c8 = idx & 3; gbv[g] = *(const GAS s16x8*)(GB + ((size_t)b * SEQ + t0 + tl) * 1024 + n * BLKW + jq * 32 + c8 * 8); }
        {
            const int sc = tid >> 5, o = tid & 31; unsigned s3b = (unsigned)(((sc * 16) * 32 + o) * 4); asm volatile("" : "+v"(s3b));
            LAS float* as = (LAS float*)(L + LRU_AS + s3b); LAS float* us = (LAS float*)(L + LRU_US + s3b);
            float a[16], u[16];
#pragma unroll
            for (int i = 0; i < 16; ++i) { a[i] = as[i * 32]; u[i] = us[i * 32]; }
            float A = 1.f, H = 0.f;
#pragma unroll
            for (int i = 0; i < 16; ++i) { H = a[i] * H + u[i]; A *= a[i]; }
            unsigned s3o = (unsigned)(LRU_AH + o * 8); asm volatile("" : "+v"(s3o));
            *(LAS f32x2*)(L + s3o + sc * 256) = (f32x2){A, H};
            LBAR();
            float h = ((LAS float*)(L + LRU_CARRY))[(ms & 1) * 32 + o];
            f32x2 p[15];
#pragma unroll
            for (int s2 = 0; s2 < 15; ++s2) p[s2] = *(const LAS f32x2*)(L + s3o + s2 * 256);
#pragma unroll
            for (int s2 = 0; s2 < 15; ++s2) h = (s2 < sc) ? p[s2].x * h + p[s2].y : h;
#pragma unroll
            for (int i = 0; i < 16; ++i) { h = a[i] * h + u[i]; us[i * 32] = h; }
            if (sc == 15) ((LAS float*)(L + LRU_CARRY))[((ms + 1) & 1) * 32 + o] = h;
        }
        LBAR();
#pragma unroll
        for (int g = 0; g < 2; ++g) { const int idx = tid + 512 * g, tl = idx >> 2, c8 = idx & 3; const size_t row = (size_t)b * SEQ + t0 + tl; const int col = n * BLKW + jq * 32 + c8 * 8;
            unsigned s4b = (unsigned)(LRU_US + (tl * 32 + c8 * 8) * 4); asm volatile("" : "+v"(s4b));
            const f32x4 h0 = *(const LAS f32x4*)(L + s4b), h1 = *(const LAS f32x4*)(L + s4b + 16);
            const s16x8 gv = gbv[g]; float hv[8] = {h0.x, h0.y, h0.z, h0.w, h1.x, h1.y, h1.z, h1.w}; unsigned w[4];
#pragma unroll
            for (int i2 = 0; i2 < 4; ++i2) { const float g0 = pg8::bfbits2f(gv[2 * i2]), g1 = pg8::bfbits2f(gv[2 * i2 + 1]);
                w[i2] = pk2(hv[2 * i2] * g0 * __builtin_amdgcn_rcpf(1.f + __builtin_amdgcn_exp2f(-LOG2E * g0)), hv[2 * i2 + 1] * g1 * __builtin_amdgcn_rcpf(1.f + __builtin_amdgcn_exp2f(-LOG2E * g1))); }
            *(GAS v4u*)(AR + row * 2048 + 1024 + col) = (v4u){w[0], w[1], w[2], w[3]}; }
    }
#undef LRU_LOADX
    LBAR();
}

#ifndef MK_DBL
#define MK_DBL 0
#endif
#define DBL(k) for (int rep_ = 0; rep_ < 1 + ((MK_DBL >> (k)) & 1); ++rep_)
constexpr int N_PH_LAYER = 5, N_PHASES = 1 + DEPTH * N_PH_LAYER;
__global__ void __launch_bounds__(NWAVES * 64, 2) mk_fwd(Args args) {
    extern __shared__ __attribute__((aligned(16))) unsigned char lds[];
    Frame F;
    F.lds = (LAS unsigned char*)lds; F.MISC = (volatile LAS unsigned*)(F.lds + MISC_OFF);
    F.tid = threadIdx.x; F.lane = F.tid & 63; F.wave = __builtin_amdgcn_readfirstlane(F.tid >> 6);
    F.G = gridDim.x; { const int bx = blockIdx.x; F.vcu = (F.G % 8 == 0) ? (bx % 8) * (F.G / 8) + bx / 8 : bx; }
    F.ctl = (gu32*)(args.ws + WS_CTL);
    for (int u = F.tid; u < (LDS_BYTES - LDSCTL_OFF) / 4; u += NWAVES * 64) ((LAS unsigned*)(F.lds + LDSCTL_OFF))[u] = 0u;
    __syncthreads();
    const int lo = args.ph_lo, hi = args.ph_hi;
    const bool use_bar = (hi - lo) > 1;
    XcdBarrier bar; bar.bar = (unsigned*)(F.ctl + CW_BAR); bar.x = 0; bar.st = nullptr;
    if (use_bar) bar = xcd_barrier_post((unsigned*)(F.ctl + CW_BAR), F.MISC + 8);
#define IN(k) (lo <= (k) && (k) < hi)
#define SEAM(k) do { if (IN(k) && IN((k) + 1)) xcd_barrier(bar); } while (0)
#define CAS __attribute__((address_space(4)))
    typedef unsigned char* ucp_t; typedef float* fp_t; typedef const float* cfp_t;
#define KARGS() CAS const char* ka_ = (CAS const char*)__builtin_amdgcn_kernarg_segment_ptr(); asm volatile("" : "+s"(ka_)); unsigned char* const ws = *(CAS const ucp_t*)(ka_ + 160); float* const outp = *(CAS const fp_t*)(ka_ + 152); (void)outp; (void)ws
#define KIN(k) (*(CAS const cfp_t*)(ka_ + 8 * (k)))
#define WSP(off) ((bf16*)(ws + (off)))
    if (IN(0)) { DBL(0) p0_prologue(F, args); } SEAM(0);
#pragma unroll 1
    for (int l = 0; l < DEPTH; ++l) {
        const int pb = 1 + l * N_PH_LAYER;
        const float lam_init = 0.8f - 0.6f * __expf(-0.3f * (float)l);
        if (IN(pb)) {
            KARGS(); bf16* const P6 = WSP(WS_P6); bf16* const MA = WSP(WS_MA); bf16* const MB = WSP(WS_MB);
            { pg8::Gemm g{WSP(WS_XB16), WSP(WS_WIN) + (size_t)l * N_BF * DM, M, N_BF, DM}; pg8::StaticOrder S; S.init(M, N_BF, F.G, (int)blockIdx.x);
              pg8::EpiProj E{P6, MA, MB, (size_t)M * 1024, attn_body::C2, 0, 1.f};
              DBL(1) pg8::gemm_phase<pg8::EpiProj, pg8::StaticOrder, PG8_ALIGN, PG8_SP2>(F.lds + RING_OFF, g, S, E); }
            { pg8::Gemm g{(const pg8::bf16_t*)(ws + WS_XQ8), (const pg8::bf16_t*)(ws + WS_WG8 + (size_t)l * N_F8 * DM), M, N_F8, DM / 2}; pg8::StaticOrder S; S.init(M, N_F8, F.G, (int)blockIdx.x);
              pg8::EpiProj E{P6, MA, MB, (size_t)M * 1024, attn_body::C2, N_BF / 256, 1.f / W8_SCALE};
              DBL(1) pg8::gemm_phase<pg8::EpiProj, pg8::StaticOrder, PG8_ALIGN, PG8_SP2, true>(F.lds + RING_OFF, g, S, E); }
        }
        SEAM(pb);
        if (IN(pb + 1)) {
            KARGS(); bf16* const P6 = WSP(WS_P6); bf16* const O1 = WSP(WS_O1); bf16* const O2 = WSP(WS_O2); bf16* const AR = WSP(WS_AR);
            bf16* const Qb = P6; bf16* const Kb = P6 + (size_t)M * 1024; bf16* const Vb = P6 + (size_t)2 * M * 1024; bf16* const GA = P6 + (size_t)3 * M * 1024; bf16* const XBb = P6 + (size_t)4 * M * 1024; bf16* const GBb = P6 + (size_t)5 * M * 1024;
            int ln_ = F.lane; asm volatile("" : "+v"(ln_));
            float d1 = KIN(9)[l * 64 + ln_] * KIN(10)[l * 64 + ln_], d2 = KIN(11)[l * 64 + ln_] * KIN(12)[l * 64 + ln_];
            d1 = wave_sum(d1, ln_); d2 = wave_sum(d2, ln_);
            const float lam = __uint_as_float(__builtin_amdgcn_readfirstlane(__float_as_uint(__expf(d1) - __expf(d2) + lam_init)));
            const int bh = F.vcu >> 2, p = F.vcu & 3, b = bh >> 3, h = bh & 7;
            const float slope2 = exp2f(-(float)(h + 1)) * LOG2E;
            if (F.G == 256) {
#pragma unroll 1
                for (int i = 0; i < 2; ++i) {
                    const int qb = i ? (7 - p) : p;
#pragma unroll 1
                    DBL(2) for (int c = 0; c < 2; ++c) {
                        attn_body::attn_unit<8>(b, 2 * h + c, h, qb, slope2, (const attn_body::bf16*)Qb, (const attn_body::bf16*)Kb, (const attn_body::bf16*)Vb, (attn_body::bf16*)O1, (char*)lds + RING_OFF,
                                                c != 0, lam, 1.f - lam_init, (const attn_body::bf16*)GA, KIN(13) + l * 128, (attn_body::bf16*)AR);
                    }
                }
                DBL(3) lru_item(F, F.vcu >> 5, (F.vcu >> 2) & 7, F.vcu & 3, XBb, GBb, AR, KIN(2) + (size_t)l * 4 * LRUW, KIN(3) + l * LRUW,
                         (const bf16*)(ws + WS_GW) + ((size_t)(l * NBLK + ((F.vcu >> 2) & 7)) * 4 + (F.vcu & 3)) * GW_ITEM, KIN(5) + l * LRUW, KIN(7) + l * LRUW, KIN(8) + l * LRUW);
            }
        }
        SEAM(pb + 1);
        if (IN(pb + 2)) {
            KARGS();
            pg8::Gemm g{WSP(WS_AR), WSP(WS_WPAB) + (size_t)l * DM * DM, M, DM, DM}; pg8::StaticOrder S; S.init(M, DM, F.G, (int)blockIdx.x);
            pg8::EpiMerge E{WSP(WS_MA), WSP(WS_MB), WSP(WS_MERGED)};
            DBL(4) pg8::gemm_phase<pg8::EpiMerge, pg8::StaticOrder, PG8_ALIGN, PG8_SP2>(F.lds + RING_OFF, g, S, E);
        }
        SEAM(pb + 2);
        if (IN(pb + 3)) {
            KARGS();
            pg8::Gemm g{WSP(WS_MERGED), WSP(WS_WOUT) + (size_t)l * DM * DM, M, DM, DM}; pg8::StaticOrder S; S.init(M, DM, F.G, (int)blockIdx.x);
            pg8::EpiRes E{l == 0 ? KIN(0) : outp, outp, DN_ALPHA};
            for (int rep_ = 0; rep_ < 1 + (((MK_DBL >> 5) & 1) && l == 0); ++rep_) pg8::gemm_phase<pg8::EpiRes, pg8::StaticOrder, PG8_ALIGN, PG8_SP2>(F.lds + RING_OFF, g, S, E);
        }
        SEAM(pb + 3);
        if (IN(pb + 4)) { KARGS(); ln_phase(F, outp, WSP(WS_XB16), ws + WS_XQ8, KIN(17) + l * DM, KIN(18) + l * DM, l + 1 < DEPTH); }
        SEAM(pb + 4);
    }
#undef IN
#undef SEAM
#undef KARGS
#undef KIN
#undef WSP
#undef CAS
}

#ifndef MK_PER_PHASE
#define MK_PER_PHASE 0
#endif
extern "C" void kernel_launch(void* const* d_in, const int* in_sizes, int n_in, void* d_out, int out_size, void* d_ws, size_t ws_size, hipStream_t stream) {
    static int grid = 0;
    if (grid == 0) {
        if (n_in != 19 || in_sizes[0] != M * DM || out_size != M * DM || ws_size < WS_END) { fprintf(stderr, "kernel_launch: unexpected shapes / workspace (n_in %d, ws %zu); nothing launched\n", n_in, ws_size); grid = -1; return; }
        int dev = 0, cus = 0;
        if (hipGetDevice(&dev) != hipSuccess || hipDeviceGetAttribute(&cus, hipDeviceAttributeMultiprocessorCount, dev) != hipSuccess) { grid = -1; return; }
        if (hipFuncSetAttribute((const void*)mk_fwd, hipFuncAttributeMaxDynamicSharedMemorySize, LDS_BYTES) != hipSuccess) { fprintf(stderr, "kernel_launch: hipFuncSetAttribute failed\n"); grid = -1; return; }
        int per_cu = 0;
        if (hipOccupancyMaxActiveBlocksPerMultiprocessor(&per_cu, (const void*)mk_fwd, NWAVES * 64, LDS_BYTES) != hipSuccess || per_cu < 1) fprintf(stderr, "kernel_launch: occupancy query reports %d blocks per CU\n", per_cu);
        (void)hipGetLastError();
        grid = cus;
        if (grid != 256) fprintf(stderr, "kernel_launch: %d CUs; the attention/LRU phase is built for 256\n", grid);
    }
    if (grid < 0) return;
    if (hipMemsetAsync((char*)d_ws + WS_CTL, 0, CTL_ZERO_BYTES, stream) != hipSuccess) return;
    Args a{};
    for (int i = 0; i < 19; ++i) a.in[i] = (const float*)d_in[i];
    a.out = (float*)d_out; a.ws = (unsigned char*)d_ws;
#if MK_PER_PHASE
    for (int p = 0; p < N_PHASES; ++p) { a.ph_lo = p; a.ph_hi = p + 1; hipLaunchKernelGGL(mk_fwd, dim3(grid), dim3(NWAVES * 64), LDS_BYTES, stream, a); }
#else
    a.ph_lo = 0; a.ph_hi = N_PHASES;
    hipLaunchKernelGGL(mk_fwd, dim3(grid), dim3(NWAVES * 64), LDS_BYTES, stream, a);
#endif
}
```

```cpp
#include <hip/hip_runtime.h>
#include <cstdio>
#include <cstdint>
namespace pg8 {
#define PG8_LAS __attribute__((address_space(3)))
typedef unsigned short bf16_t;
typedef short bf16x8 __attribute__((ext_vector_type(8)));
typedef float f32x4 __attribute__((ext_vector_type(4)));
typedef unsigned u32x4 __attribute__((ext_vector_type(4)));
constexpr int BM = 256, BK = 64, HALF = 128, HTB = HALF * BK * 2  , STAGE_BYTES = 8 * HTB, NXCD = 8, WGM = 8;

__host__ __device__ __forceinline__ int lds_byte(int r, int c) { const int st = (r >> 4) * 2 + (c >> 5), rr = r & 15, cc = c & 31, ob = rr * 64 + cc * 2; return st * 1024 + (ob ^ (((ob >> 9) & 1) << 5)); }
__host__ __device__ __forceinline__ void stage_rc(int b, int& R, int& C) { const int st = b / 1024, sb = b % 1024, swz = sb ^ (((sb >> 9) & 1) << 5); R = (st >> 1) * 16 + swz / 64; C = (st & 1) * 32 + (swz % 64) / 2; }
__host__ __device__ __forceinline__ int perm32(int rho) { const int n = rho >> 4, i = rho & 15; return 8 * (i >> 2) + 4 * n + (i & 3); }

struct Unit { int pm, pn; };
struct Gemm { const bf16_t* A; const bf16_t* Bt; int M, N, K; };

struct StaticOrder {
    int nM, nN, nwg, G, c;
    __host__ __device__ void init(int M, int N, int G_, int c_) { nM = M / BM; nN = N / BM; nwg = nM * nN; G = G_; c = c_; }
    __host__ __device__ bool next(int i, Unit& u) const {
        const long L = (long)i * G + c; if (L >= nwg) return false;
        int wgid = (int)L; { const int q = nwg / NXCD, r = nwg % NXCD, xcd = wgid % NXCD, off = wgid / NXCD; wgid = (xcd < r ? xcd * (q + 1) : r * (q + 1) + (xcd - r) * q) + off; }
        const int nig = WGM * nN, gid = wgid / nig, fm = gid * WGM, gsz = (nM - fm) < WGM ? (nM - fm) : WGM;
        u.pm = fm + ((wgid % nig) % gsz); u.pn = (wgid % nig) / gsz; return true;
    }
    __device__ __forceinline__ void a_ready(const Unit&) const {}
    __device__ __forceinline__ void done(const Unit&) const {}
};

__device__ __forceinline__ unsigned cvt_pk_bf16(float lo, float hi) { unsigned r; asm volatile("v_cvt_pk_bf16_f32 %0, %1, %2" : "=v"(r) : "v"(lo), "v"(hi)); return r; }
typedef short s16x8_t __attribute__((ext_vector_type(8)));
typedef float f32x2 __attribute__((ext_vector_type(2)));
__device__ __forceinline__ float bfbits2f(short v) { return __uint_as_float(((unsigned)(unsigned short)v) << 16); }
struct EpiProj {
    static constexpr bool PERM = true, AFTER_DRAIN = false, HAS_MID = false;
    bf16_t* base6; bf16_t* ma; bf16_t* mb; size_t stride6; float qscale; int pn_off; float gscale;
    __device__ __forceinline__ void operator()(const f32x4 (&acc)[2][2][4][2], const Unit& u, int wr, int wc, int fr, int fq) const {
        const int pn = u.pn + pn_off; bf16_t* base; int ldc, colt; float sc = 1.f;
        float qs_ = qscale, gs_ = gscale; asm volatile("" : "+v"(qs_), "+v"(gs_));
        if (pn < 24) { const int t = pn >> 2; base = base6 + (size_t)t * stride6; ldc = 1024; colt = (pn & 3) * BM; sc = (t == 0) ? qs_ : gs_; }
        else if (pn < 32) { base = ma; ldc = 2048; colt = (pn - 24) * BM; sc = gs_; }
        else { base = mb; ldc = 2048; colt = (pn - 32) * BM; sc = gs_; }
        int t_ = threadIdx.x; asm volatile("" : "+v"(t_));
        const int lrow = (t_ >> 8) * 64 + (t_ & 15), lcol = ((t_ >> 6) & 3) * 32 + 8 * ((t_ >> 4) & 3);
        const int row0 = u.pm * BM + lrow, col0 = colt + lcol;
#pragma unroll
        for (int ai = 0; ai < 2; ++ai)
#pragma unroll
            for (int m = 0; m < 4; ++m) { bf16_t* rowp = base + (size_t)(row0 + ai * HALF + m * 16) * ldc + col0;
#pragma unroll
                for (int bj = 0; bj < 2; ++bj) { const f32x4 v0 = acc[ai][bj][m][0] * sc, v1 = acc[ai][bj][m][1] * sc;
                    u32x4 w; w.x = cvt_pk_bf16(v0[0], v0[1]); w.y = cvt_pk_bf16(v0[2], v0[3]); w.z = cvt_pk_bf16(v1[0], v1[1]); w.w = cvt_pk_bf16(v1[2], v1[3]);
                    *(u32x4*)(rowp + bj * HALF) = w; } }
    }
};
struct EpiMerge {
    static constexpr bool PERM = true, AFTER_DRAIN = false, HAS_MID = true;
    const bf16_t* ma; const bf16_t* mb; bf16_t* out;
    __device__ __forceinline__ void mid(f32x4 (&acc)[2][2][4][2], const Unit& u, int wr, int wc, int fr, int fq) const {
        unsigned lofs = (unsigned)((wr * 64 + fr) * 2048 + wc * 32 + 8 * fq); asm volatile("" : "+v"(lofs));
        const size_t tofs = (size_t)u.pm * BM * 2048 + (size_t)u.pn * BM;
#pragma unroll
        for (int ai = 0; ai < 2; ++ai)
#pragma unroll
            for (int m = 0; m < 4; ++m) { const size_t off = tofs + lofs + (size_t)(ai * HALF + m * 16) * 2048;
#pragma unroll
                for (int bj = 0; bj < 2; ++bj) { const s16x8_t a = *(const s16x8_t*)(ma + off + bj * HALF), b = *(const s16x8_t*)(mb + off + bj * HALF);
#pragma unroll
                    for (int j = 0; j < 8; ++j) { const float xa = bfbits2f(a[j]), xb = fmaxf(bfbits2f(b[j]), -30.f);
                        const float f = (1.f + __expf(-xb)) * __builtin_amdgcn_rcpf(1.f + __expf(-xa)); acc[ai][bj][m][j >> 2][j & 3] *= f; } }
                asm volatile("" ::: "memory"); }
    }
    __device__ __forceinline__ void operator()(const f32x4 (&acc)[2][2][4][2], const Unit& u, int wr, int wc, int fr, int fq) const {
        unsigned lofs = (unsigned)((wr * 64 + fr) * 2048 + wc * 32 + 8 * fq); asm volatile("" : "+v"(lofs));
        const size_t tofs = (size_t)u.pm * BM * 2048 + (size_t)u.pn * BM;
#pragma unroll
        for (int ai = 0; ai < 2; ++ai)
#pragma unroll
            for (int m = 0; m < 4; ++m) { const size_t off = tofs + lofs + (size_t)(ai * HALF + m * 16) * 2048;
#pragma unroll
                for (int bj = 0; bj < 2; ++bj) { const s16x8_t b = *(const s16x8_t*)(mb + off + bj * HALF); float v[8];
#pragma unroll
                    for (int j = 0; j < 8; ++j) { const float xb = fmaxf(bfbits2f(b[j]), -30.f); v[j] = acc[ai][bj][m][j >> 2][j & 3] * __builtin_amdgcn_rcpf(1.f + __expf(-xb)); }
                    u32x4 w; w.x = cvt_pk_bf16(v[0], v[1]); w.y = cvt_pk_bf16(v[2], v[3]); w.z = cvt_pk_bf16(v[4], v[5]); w.w = cvt_pk_bf16(v[6], v[7]);
                    *(u32x4*)(out + off + bj * HALF) = w; }
                asm volatile("" ::: "memory"); }
    }
};
struct EpiRes {
    static constexpr bool PERM = false, AFTER_DRAIN = false, HAS_MID = false;
    const float* base; float* out; float alpha;
    __device__ __forceinline__ void operator()(const f32x4 (&acc)[2][2][4][2], const Unit& u, int wr, int wc, int fr, int fq) const {
        const int row0 = u.pm * BM + wr * 64 + fr, col0 = u.pn * BM + wc * 32 + 4 * fq;
#pragma unroll
        for (int ai = 0; ai < 2; ++ai)
#pragma unroll
            for (int m = 0; m < 4; ++m) { const size_t off = (size_t)(row0 + ai * HALF + m * 16) * 2048 + col0;
#pragma unroll
                for (int bj = 0; bj < 2; ++bj)
#pragma unroll
                    for (int n = 0; n < 2; ++n) { const f32x4 bs = *(const f32x4*)(base + off + bj * HALF + n * 16); *(f32x4*)(out + off + bj * HALF + n * 16) = bs * alpha + acc[ai][bj][m][n]; }
                if (m & 1) asm volatile("" ::: "memory"); }
    }
};

struct EpiResFromY {
    static constexpr bool PERM = false, AFTER_DRAIN = false, HAS_MID = false;
    float* out; const float* st; const float* g; const float* b;
    static constexpr float alpha = 1.41421356237309515f;
    __device__ __forceinline__ void operator()(const f32x4 (&acc)[2][2][4][2], const Unit& u, int wr, int wc, int fr, int fq) const {
        int t_ = threadIdx.x; asm volatile("" : "+v"(t_));
        const int lrow = (t_ >> 8) * 64 + (t_ & 15), lcol = ((t_ >> 6) & 3) * 32 + 4 * ((t_ >> 4) & 3);
        const int row0 = u.pm * BM + lrow, col0 = u.pn * BM + lcol;
        f32x4 gv[2][2], bv[2][2];
#pragma unroll
        for (int bj = 0; bj < 2; ++bj)
#pragma unroll
            for (int n = 0; n < 2; ++n) { gv[bj][n] = *(const f32x4*)(g + col0 + bj * HALF + n * 16); bv[bj][n] = *(const f32x4*)(b + col0 + bj * HALF + n * 16); }
#pragma unroll
        for (int ai = 0; ai < 2; ++ai)
#pragma unroll
            for (int m = 0; m < 4; ++m) { const int row = row0 + ai * HALF + m * 16; const size_t off = (size_t)row * 2048 + col0;
                const f32x2 ms = *(const f32x2*)(st + 2 * (size_t)row);
#pragma unroll
                for (int bj = 0; bj < 2; ++bj)
#pragma unroll
                    for (int n = 0; n < 2; ++n) { const f32x4 y = *(const f32x4*)(out + off + bj * HALF + n * 16); const f32x4 x = (y - ms.x) * ms.y * gv[bj][n] + bv[bj][n];
                        *(f32x4*)(out + off + bj * HALF + n * 16) = x * alpha + acc[ai][bj][m][n]; }
                if (m & 1) asm volatile("" ::: "memory"); }
    }
};
typedef int pg8_v4i __attribute__((ext_vector_type(4))); typedef int pg8_v8i __attribute__((ext_vector_type(8)));
template <bool FP8> struct FragSel { struct type { bf16x8 k[2]; }; };
template <> struct FragSel<true> { typedef pg8_v8i type; };
template <bool FP8, class F> __device__ __forceinline__ void ld_frag(F& d, const PG8_LAS unsigned char* p) {
    if constexpr (FP8) { const pg8_v4i lo = *(const PG8_LAS pg8_v4i*)p, hi = *(const PG8_LAS pg8_v4i*)(p + 16); d = __builtin_shufflevector(lo, hi, 0, 1, 2, 3, 4, 5, 6, 7); }
    else { d.k[0] = *(const PG8_LAS bf16x8*)p; d.k[1] = *(const PG8_LAS bf16x8*)(p + 1024); }
}
template <bool FP8, class F> __device__ __forceinline__ void mma_frag(f32x4& c, const F& b, const F& a) {
    if constexpr (FP8) c = __builtin_amdgcn_mfma_scale_f32_16x16x128_f8f6f4(b, a, c, 0, 0, 0, 0, 0, 0);
    else { c = __builtin_amdgcn_mfma_f32_16x16x32_bf16(b.k[0], a.k[0], c, 0, 0, 0); c = __builtin_amdgcn_mfma_f32_16x16x32_bf16(b.k[1], a.k[1], c, 0, 0, 0); }
}
template <class Epi, class Sched, bool ALIGN_EPI = false, bool SP2 = false, bool FP8 = false>
__device__ __forceinline__ void gemm_phase(PG8_LAS unsigned char* lds, const Gemm g, const Sched& S, const Epi& E) {
    int tid_ = threadIdx.x; asm volatile("" : "+v"(tid_));
    const int tid = tid_, wid = __builtin_amdgcn_readfirstlane(tid >> 6), lane = tid & 63, wr = wid >> 2, wc = wid & 3, fr = lane & 15, fq = lane >> 4;
    const int K = g.K, nt = K / BK;
    unsigned voffA[2], voffB[2];
#pragma unroll
    for (int i = 0; i < 2; ++i) { int R, C; stage_rc(tid * 16 + i * 8192, R, C); const int Rb = Epi::PERM ? ((R & ~31) + perm32(R & 31)) : R;
        voffA[i] = (unsigned)(R * K + C) * 2u; voffB[i] = (unsigned)(Rb * K + C) * 2u; }
    const size_t kstep = (size_t)(BK * 2);
    const size_t hstep = (size_t)HALF * K * 2;
    const size_t tstep = 2 * hstep;
    const unsigned lds0 = (unsigned)(uintptr_t)lds;
    const unsigned ldsw = (unsigned)wid * 1024u;
    const int fcol = FP8 ? 32 * (fq >> 1) + 16 * (fq & 1) : fq * 8;
    const int aoff = lds_byte(wr * 64 + fr, fcol), boff = lds_byte(wc * 32 + fr, fcol);
#define PG8_SA(b, h) (((b) * 2 + (h)) * HTB)
#define PG8_SB(b, h) ((4 + (b) * 2 + (h)) * HTB)
#define PG8_STAGE(bufoff, gbase, voff) do { _Pragma("unroll") for (int _i = 0; _i < 2; ++_i) { unsigned keep_; \
        asm volatile("s_mov_b32 %0, m0\n\ts_mov_b32 m0, %3\n\ts_nop 4\n\tglobal_load_lds_dwordx4 %1, %2\n\ts_mov_b32 m0, %0" : "=&s"(keep_) : "v"((voff)[_i]), "s"((const char*)(gbase)), \
                     "s"((unsigned)__builtin_amdgcn_readfirstlane((int)(lds0 + (unsigned)(bufoff) + ldsw + (unsigned)(_i * 8192)))) : "memory"); } } while (0)
#define PG8_LDA(dst, b, h) do { _Pragma("unroll") for (int m = 0; m < 4; ++m) ld_frag<FP8>(dst[m], lds + PG8_SA(b, h) + aoff + m * 2048); } while (0)
#define PG8_LDB(dst, b, h) do { _Pragma("unroll") for (int n = 0; n < 2; ++n) ld_frag<FP8>(dst[n], lds + PG8_SB(b, h) + boff + n * 2048); } while (0)
#define PG8_MMA(ai, bj, At, Bt) do { __builtin_amdgcn_s_setprio(1); _Pragma("unroll") for (int m = 0; m < 4; ++m) _Pragma("unroll") for (int n = 0; n < 2; ++n) \
        mma_frag<FP8>(acc[ai][bj][m][n], Bt[n], At[m]); __builtin_amdgcn_s_setprio(0); } while (0)
#define PG8_WAIT_V(n) asm volatile("s_waitcnt vmcnt(" #n ")" ::: "memory")
#define PG8_WAIT_L(n) asm volatile("s_waitcnt lgkmcnt(" #n ")" ::: "memory")
#define PG8_BAR __builtin_amdgcn_s_barrier()
#define PG8_SCHED __builtin_amdgcn_sched_barrier(0)
    Unit cur, nxt; int ui = 0;
    if (!S.next(0, cur)) return;
    f32x4 acc[2][2][4][2];
#pragma unroll
    for (int a = 0; a < 2; ++a)
#pragma unroll
        for (int b = 0; b < 2; ++b)
#pragma unroll
            for (int m = 0; m < 4; ++m)
#pragma unroll
                for (int n = 0; n < 2; ++n) acc[a][b][m][n] = (f32x4){0.f, 0.f, 0.f, 0.f};
    typename FragSel<FP8>::type At[4], B0[2], B1[2];
    const char* cA = (const char*)g.A + (size_t)cur.pm * tstep; const char* cB = (const char*)g.Bt + (size_t)cur.pn * tstep;
    S.a_ready(cur);
    if constexpr (SP2) {
        PG8_STAGE(PG8_SB(0, 0), cB, voffB); PG8_STAGE(PG8_SB(0, 1), cB + hstep, voffB); PG8_STAGE(PG8_SA(0, 0), cA, voffA); PG8_STAGE(PG8_SA(0, 1), cA + hstep, voffA);
        if (wr == 1) PG8_BAR;
        PG8_WAIT_V(2); PG8_BAR;
        PG8_STAGE(PG8_SB(1, 0), cB + kstep, voffB); PG8_STAGE(PG8_SA(1, 0), cA + kstep, voffA); PG8_STAGE(PG8_SB(1, 1), cB + hstep + kstep, voffB);
        PG8_WAIT_V(6); PG8_BAR;
    } else {
        PG8_STAGE(PG8_SB(0, 0), cB, voffB); PG8_STAGE(PG8_SA(0, 0), cA, voffA); PG8_STAGE(PG8_SB(0, 1), cB + hstep, voffB); PG8_STAGE(PG8_SA(0, 1), cA + hstep, voffA);
        if (wr == 1) PG8_BAR;
        PG8_WAIT_V(4); PG8_BAR;
        PG8_STAGE(PG8_SB(1, 0), cB + kstep, voffB); PG8_STAGE(PG8_SA(1, 0), cA + kstep, voffA); PG8_STAGE(PG8_SB(1, 1), cB + hstep + kstep, voffB);
        PG8_WAIT_V(6); PG8_BAR;
    }
    for (;;) {
        const bool has_next = S.next(ui + 1, nxt);
        const char* nA = has_next ? (const char*)g.A + (size_t)nxt.pm * tstep : cA; const char* nB = has_next ? (const char*)g.Bt + (size_t)nxt.pn * tstep : cB;
        for (int t = 0; t < nt; t += 2) {
            const bool last = (t == nt - 2);
            if constexpr (Epi::HAS_MID) { if (t == nt / 2) E.mid(acc, cur, wr, wc, fr, fq); }
            const char* a1 = cA + (size_t)(t + 1) * kstep;
            const char* a2 = last ? nA : cA + (size_t)(t + 2) * kstep; const char* b2 = last ? nB : cB + (size_t)(t + 2) * kstep;
            const char* a3 = a2 + kstep; const char* b3 = b2 + kstep;
            if (last && has_next) S.a_ready(nxt);
            if constexpr (SP2) {
            PG8_LDB(B0, 0, 0); PG8_LDB(B1, 0, 1); PG8_SCHED; PG8_LDA(At, 0, 0); PG8_STAGE(PG8_SA(1, 1), a1 + hstep, voffA);
            PG8_WAIT_V(8); PG8_WAIT_L(0); PG8_BAR; PG8_MMA(0, 0, At, B0); PG8_MMA(0, 1, At, B1); PG8_BAR; PG8_SCHED;
            PG8_LDA(At, 0, 1); PG8_STAGE(PG8_SB(0, 0), b2, voffB); PG8_STAGE(PG8_SB(0, 1), b2 + hstep, voffB); PG8_STAGE(PG8_SA(0, 0), a2, voffA);
            PG8_WAIT_V(8); PG8_WAIT_L(0); PG8_BAR; PG8_MMA(1, 0, At, B0); PG8_MMA(1, 1, At, B1); PG8_BAR; PG8_SCHED;
            PG8_LDB(B0, 1, 0); PG8_LDB(B1, 1, 1); PG8_SCHED; PG8_LDA(At, 1, 0); PG8_STAGE(PG8_SA(0, 1), a2 + hstep, voffA);
            PG8_WAIT_V(8); PG8_WAIT_L(0); PG8_BAR; PG8_MMA(0, 0, At, B0); PG8_MMA(0, 1, At, B1); PG8_BAR; PG8_SCHED;
            PG8_LDA(At, 1, 1); PG8_STAGE(PG8_SB(1, 0), b3, voffB); PG8_STAGE(PG8_SB(1, 1), b3 + hstep, voffB); PG8_STAGE(PG8_SA(1, 0), a3, voffA);
            PG8_WAIT_V(8); PG8_WAIT_L(0); PG8_BAR; PG8_MMA(1, 0, At, B0); PG8_MMA(1, 1, At, B1); PG8_BAR; PG8_SCHED;
            } else {
            PG8_LDB(B0, 0, 0); PG8_SCHED; PG8_LDA(At, 0, 0); PG8_STAGE(PG8_SA(1, 1), a1 + hstep, voffA);
            PG8_WAIT_L(8); PG8_BAR; PG8_WAIT_L(0); PG8_MMA(0, 0, At, B0); PG8_BAR; PG8_SCHED;
            PG8_LDB(B1, 0, 1); PG8_STAGE(PG8_SB(0, 0), b2, voffB);
            PG8_BAR; PG8_WAIT_L(0); PG8_MMA(0, 1, At, B1); PG8_BAR;
            PG8_LDA(At, 0, 1); PG8_STAGE(PG8_SA(0, 0), a2, voffA);
            PG8_BAR; PG8_WAIT_L(0); PG8_MMA(1, 0, At, B0); PG8_BAR; PG8_SCHED;
            PG8_STAGE(PG8_SB(0, 1), b2 + hstep, voffB);
            PG8_WAIT_V(6); PG8_BAR; PG8_MMA(1, 1, At, B1); PG8_BAR;
            PG8_LDB(B0, 1, 0); PG8_SCHED; PG8_LDA(At, 1, 0); PG8_STAGE(PG8_SA(0, 1), a2 + hstep, voffA);
            PG8_WAIT_L(8); PG8_BAR; PG8_WAIT_L(0); PG8_MMA(0, 0, At, B0); PG8_BAR; PG8_SCHED;
            PG8_LDB(B1, 1, 1); PG8_STAGE(PG8_SB(1, 0), b3, voffB);
            PG8_BAR; PG8_WAIT_L(0); PG8_MMA(0, 1, At, B1); PG8_BAR;
            PG8_LDA(At, 1, 1); PG8_STAGE(PG8_SA(1, 0), a3, voffA);
            PG8_BAR; PG8_WAIT_L(0); PG8_MMA(1, 0, At, B0); PG8_BAR; PG8_SCHED;
            PG8_STAGE(PG8_SB(1, 1), b3 + hstep, voffB);
            PG8_WAIT_V(6); PG8_BAR; PG8_MMA(1, 1, At, B1); PG8_BAR;
            }
        }
        if constexpr (ALIGN_EPI) { if (wr == 0) PG8_BAR; }
        if constexpr (!Epi::AFTER_DRAIN) { E(acc, cur, wr, wc, fr, fq); S.done(cur); }
        if (!has_next) break;
#pragma unroll
        for (int a = 0; a < 2; ++a)
#pragma unroll
            for (int b = 0; b < 2; ++b)
#pragma unroll
                for (int m = 0; m < 4; ++m)
#pragma unroll
                    for (int n = 0; n < 2; ++n) acc[a][b][m][n] = (f32x4){0.f, 0.f, 0.f, 0.f};
        cur = nxt; cA = nA; cB = nB; ++ui;
        if constexpr (ALIGN_EPI) { if (wr == 1) PG8_BAR; }
    }
    PG8_WAIT_V(0);
    if constexpr (!ALIGN_EPI) { if (wr == 0) PG8_BAR; }
    PG8_BAR;
    if constexpr (Epi::AFTER_DRAIN) { E.fused(acc, cur, wr, wc, fr, fq, lds, wid, lane); S.done(cur); }
#undef PG8_SA
#undef PG8_SB
#undef PG8_STAGE
#undef PG8_LDA
#undef PG8_LDB
#undef PG8_MMA
#undef PG8_WAIT_V
#undef PG8_WAIT_L
#undef PG8_BAR
#undef PG8_SCHED
}
}

#ifndef PG8_SP2
#define PG8_SP2 true
#endif
#ifndef PG8_ALIGN
#define PG8_ALIGN true
#endif
#include <hip/hip_bf16.h>
#include <cmath>
namespace attn_body {
using bf16=__hip_bfloat16;
using bf16x8=__attribute__((ext_vector_type(8)))short;
using s16x4=__attribute__((ext_vector_type(4)))short;
using f32x16=__attribute__((ext_vector_type(16)))float;
using u32x4=__attribute__((ext_vector_type(4)))unsigned;
constexpr int BATCH=8,NHEAD=16,SEQ=2048,D=64,DM=NHEAD*D;
constexpr int NW=8,QBLK=32,QB=QBLK*NW,KVBLK=64,NQB=SEQ/QB;
constexpr int ATTN_PITCH=DM, ATTN_UNIT_ROWS=QB;
__device__ __forceinline__ int crow(int r,int hi){return (r&3)+8*(r>>2)+4*hi;}
#define SBAR() __builtin_amdgcn_sched_barrier(0)
__device__ __forceinline__ void cmask(f32x16&p0,f32x16&p1,int jb,int qrel,int hi){
  const float NEG=-INFINITY; int kb=64*jb+4*hi;
  #pragma unroll
  for(int r=0;r<16;++r){int kv=kb+(r&3)+8*(r>>2); if(kv>qrel)p0[r]=NEG; if(kv+32>qrel)p1[r]=NEG;}
}

constexpr int NSLOT=3, SLOTB=8192, VD=128;
constexpr int LDS_K=0, LDS_V=NSLOT*SLOTB, LDS_WS=3*NSLOT*SLOTB, LDS_OST=LDS_WS+NW*64*4, LDS_BYTES=LDS_OST+NW*8192;
constexpr float C2=0.125f*1.4426950408889634f;
__device__ __forceinline__ void glds16(const void*gsrc,unsigned lds_dst){unsigned keep;
  asm volatile("s_mov_b32 %0, m0\n\ts_mov_b32 m0, %2\n\ts_nop 0\n\tglobal_load_lds_dwordx4 %1, off\n\ts_mov_b32 m0, %0":"=&s"(keep):"v"(gsrc),"s"(lds_dst):"memory");}
__device__ __forceinline__ void glds16o(const void*sbase,unsigned voff,unsigned lds_dst){unsigned keep;
  asm volatile("s_mov_b32 %0, m0\n\ts_mov_b32 m0, %3\n\ts_nop 4\n\tglobal_load_lds_dwordx4 %1, %2\n\ts_mov_b32 m0, %0":"=&s"(keep):"v"(voff),"s"(sbase),"s"(lds_dst):"memory");}
__device__ __forceinline__ float max3f(float a,float b,float c){float r;asm("v_max3_f32 %0, %1, %2, %3":"=v"(r):"v"(a),"v"(b),"v"(c));return r;}
__device__ __forceinline__ float max2f(float a,float b){float r;asm("v_max_f32_e32 %0, %1, %2":"=v"(r):"v"(a),"v"(b));return r;}
__device__ __forceinline__ float fadd_s(float a,float b){float r;asm("v_add_f32_e32 %0, %1, %2":"=v"(r):"v"(a),"v"(b));return r;}
__device__ __forceinline__ float fsub_s(float a,float b){float r;asm("v_sub_f32_e32 %0, %1, %2":"=v"(r):"v"(a),"v"(b));return r;}
typedef float f32x2_t __attribute__((ext_vector_type(2))); typedef __bf16 bf16x2_t __attribute__((ext_vector_type(2)));
__device__ __forceinline__ unsigned cvtpk_s(float lo,float hi){f32x2_t v={lo,hi};bf16x2_t b=__builtin_convertvector(v,bf16x2_t);return __builtin_bit_cast(unsigned,b);}
#define WAIT_BAR(N) asm volatile("s_waitcnt vmcnt(" #N ") lgkmcnt(0)\n\ts_barrier":::"memory")

__device__ __forceinline__ void qkt(f32x16&p0,f32x16&p1,const char*Kslot,const bf16x8*qr,int r32,int hi){
  const char*kb=Kslot+hi*1024+r32*16;
  #pragma unroll
  for(int d0=0;d0<4;++d0){
    const bf16x8 b0=*reinterpret_cast<const bf16x8*>(kb+d0*2048);
    const bf16x8 b1=*reinterpret_cast<const bf16x8*>(kb+d0*2048+512);
    {p0=__builtin_amdgcn_mfma_f32_32x32x16_bf16(b0,qr[d0],p0,0,0,0);p1=__builtin_amdgcn_mfma_f32_32x32x16_bf16(b1,qr[d0],p1,0,0,0);}}
}
typedef __attribute__((address_space(3))) const char* lds_cptr;
typedef short v4i16_t __attribute__((ext_vector_type(4)));
__device__ __forceinline__ void kload8(bf16x8*kf,lds_cptr kp){
  kf[0]=*(const __attribute__((address_space(3))) bf16x8*)(kp);      kf[1]=*(const __attribute__((address_space(3))) bf16x8*)(kp+512);
  kf[2]=*(const __attribute__((address_space(3))) bf16x8*)(kp+2048); kf[3]=*(const __attribute__((address_space(3))) bf16x8*)(kp+2560);
  kf[4]=*(const __attribute__((address_space(3))) bf16x8*)(kp+4096); kf[5]=*(const __attribute__((address_space(3))) bf16x8*)(kp+4608);
  kf[6]=*(const __attribute__((address_space(3))) bf16x8*)(kp+6144); kf[7]=*(const __attribute__((address_space(3))) bf16x8*)(kp+6656);
}
__device__ __forceinline__ void kload2(bf16x8*kf,lds_cptr kp,int j){ kf[2*j]=*(const __attribute__((address_space(3))) bf16x8*)(kp+j*2048); kf[2*j+1]=*(const __attribute__((address_space(3))) bf16x8*)(kp+j*2048+512); }
__device__ __forceinline__ s16x4 vtr(lds_cptr p){ return __builtin_bit_cast(s16x4,__builtin_amdgcn_ds_read_tr16_b64_v4i16((__attribute__((address_space(3))) v4i16_t*)p)); }
__device__ __forceinline__ float rowmax(const f32x16&p0,const f32x16&p1){
  float a=max3f(p0[0],p0[1],p1[0]),b=max3f(p0[2],p0[3],p1[1]);a=max3f(a,p1[2],p1[3]);
  #pragma unroll
  for(int r=4;r<16;r+=4){a=max3f(a,p0[r],p0[r+1]);b=max3f(b,p0[r+2],p0[r+3]);a=max3f(a,p1[r],p1[r+1]);b=max3f(b,p1[r+2],p1[r+3]);}
  const float m=max2f(a,b);
  auto rr=__builtin_amdgcn_permlane32_swap(__float_as_uint(m),__float_as_uint(m),false,false);
  return max2f(__uint_as_float(rr[0]),__uint_as_float(rr[1]));
}
__device__ __forceinline__ void pv(f32x16*o,int vb,bf16x8 pa0,bf16x8 pa1,bf16x8 pa2,bf16x8 pa3){
  #pragma unroll
  for(int d0=0;d0<4;++d0){s16x4 lo[4],hi[4];
    #pragma unroll
    for(int ks=0;ks<4;++ks){
      asm volatile("ds_read_b64_tr_b16 %0,%1 offset:%c2":"=&v"(lo[ks]):"v"(vb),"i"(d0*4096+ks*1024):"memory");
      asm volatile("ds_read_b64_tr_b16 %0,%1 offset:%c2":"=&v"(hi[ks]):"v"(vb),"i"(d0*4096+ks*1024+512):"memory");}
    asm volatile("s_waitcnt lgkmcnt(0)":::"memory");SBAR();
    #define PK(k) (bf16x8){lo[k][0],lo[k][1],lo[k][2],lo[k][3],hi[k][0],hi[k][1],hi[k][2],hi[k][3]}
    o[d0]=__builtin_amdgcn_mfma_f32_32x32x16_bf16(pa0,PK(0),o[d0],0,0,0);
    o[d0]=__builtin_amdgcn_mfma_f32_32x32x16_bf16(pa1,PK(1),o[d0],0,0,0);
    o[d0]=__builtin_amdgcn_mfma_f32_32x32x16_bf16(pa2,PK(2),o[d0],0,0,0);
    o[d0]=__builtin_amdgcn_mfma_f32_32x32x16_bf16(pa3,PK(3),o[d0],0,0,0);
    #undef PK
  }
}

#ifndef ATTN_STORE16
#define ATTN_STORE16(p,v) (*(u32x4*)(p)=(v))
#endif
template<int THRL> __device__ __forceinline__ void attn_unit(int b,int hq,int hh,int qb,float slope2,const bf16*Q,const bf16*__restrict__ K,const bf16*__restrict__ V,bf16*O,char*shm,
    bool fuse,float lam,float osc,const bf16*GA,const float*sg,bf16*AR){
  int tid_=threadIdx.x; asm volatile("":"+v"(tid_)); const int tid=tid_,lane=tid&63,r32=lane&31,hi=lane>>5; const int wid=__builtin_amdgcn_readfirstlane(tid>>6);
  const long rowbase=(long)b*SEQ; const int q0=qb*QB;
  const bf16*Qw=Q+(rowbase+q0+wid*QBLK)*DM+hq*D;
  const bf16*Kh=K+rowbase*DM+hq*D,*Vh=V+rowbase*DM+hh*VD;
  const unsigned lds0=(unsigned)(uintptr_t)shm;
  float*wsf=(float*)(shm+LDS_WS)+wid*64;
  const unsigned koff=(unsigned)((lane*DM+wid*8)*2);
  const unsigned voff=(unsigned)(((16*(wid&3)+(lane>>2))*DM+(wid>>2)*32+(lane&3)*8)*2);
  const unsigned kdst=lds0+LDS_K+wid*1024, vdst=lds0+LDS_V+wid*1024;
  #define DMA_K(t,slot) glds16o(Kh+(long)(t)*KVBLK*DM,koff,(unsigned)__builtin_amdgcn_readfirstlane(kdst+(slot)))
  #define DMA_V(t,slot) do{ glds16o(Vh+(long)(t)*KVBLK*DM,voff,(unsigned)__builtin_amdgcn_readfirstlane(vdst+2*(slot))); glds16o(Vh+(long)(t)*KVBLK*DM+64,voff,(unsigned)__builtin_amdgcn_readfirstlane(vdst+2*(slot)+8192)); }while(0)
  const int vb0=(int)(lds0+LDS_V)+((lane>>4)&1)*32+(lane&3)*8+(4*hi+((lane&15)>>2))*64;
  const char*Kbase=shm+LDS_K; bf16x8 kf[8];
  const lds_cptr shm3=(lds_cptr)shm; const lds_cptr kp0=shm3+LDS_K+hi*1024+r32*16; const lds_cptr vp0=shm3+LDS_V+((lane>>4)&1)*32+(lane&3)*8+(4*hi+((lane&15)>>2))*64;
  const int NT=(q0+QB)/KVBLK;
  DMA_K(0,0);DMA_V(0,0);DMA_K(1,SLOTB);
  bf16x8 qr[4];
  #pragma unroll
  for(int d0=0;d0<4;++d0)qr[d0]=*reinterpret_cast<const bf16x8*>(&Qw[(long)r32*DM+d0*16+hi*8]);
  float l_reg=0.f;f32x16 o[4];o[0]=f32x16{};o[1]=f32x16{};o[2]=f32x16{};o[3]=f32x16{};
  float nb=slope2*(float)(4*hi-q0-255); const float sl64=64.f*slope2;
  #define BINIT0(C0,t) do{ _Pragma("unroll") for(int r=0;r<16;++r)C0[r]=fmaf(slope2,(float)((r&3)+8*(r>>2)),nb); }while(0)
  #define BINIT1(C1,t) do{ _Pragma("unroll") for(int r=0;r<16;++r)C1[r]=fmaf(slope2,(float)((r&3)+8*(r>>2)+32),nb); nb+=sl64; }while(0)
  const int qrel=wid*QBLK+r32;
  #define CMASK(P0,P1,t) do{int jb_=(t)-(NT-4); if(jb_>=0)cmask(P0,P1,jb_,qrel,hi);}while(0)
  bool resc=false;
  #define START(P0,P1) do{ const float rm=rowmax(P0,P1); resc=false; \
    { const float dl=rm; nb=fsub_s(nb,dl); \
      _Pragma("unroll") for(int r=0;r<16;++r){P0[r]=fsub_s(P0[r],dl);P1[r]=fsub_s(P1[r],dl);} } \
    _Pragma("unroll") for(int r=0;r<16;++r)P0[r]=__builtin_amdgcn_exp2f(P0[r]); }while(0)
  #define RESC() do{ if(resc){ asm volatile("s_waitcnt lgkmcnt(0)":::"memory"); \
      _Pragma("unroll") for(int d_=0;d_<4;++d_) _Pragma("unroll") for(int r=0;r<16;++r)o[d_][r]*=wsf[crow(r,hi)]; } }while(0)
  f32x16 pA0,pA1,pB0,pB1;
  int sl_prev=0,sl_cur=0,sl_next=SLOTB;
  #define ROT() do{sl_prev=sl_cur;sl_cur=sl_next;sl_next=(sl_next==(NSLOT-1)*SLOTB)?0:sl_next+SLOTB;}while(0)
  DMA_K(2,2*SLOTB);
  WAIT_BAR(3);
  asm volatile("":"+v"(nb));
  BINIT0(pA0,0);BINIT1(pA1,0);qkt(pA0,pA1,Kbase,qr,r32,hi);asm volatile("s_nop 15\n\ts_nop 7":"+v"(pA0),"+v"(pA1));CMASK(pA0,pA1,0);
  START(pA0,pA1);
  _Pragma("unroll") for(int r=0;r<16;++r)pA1[r]=__builtin_amdgcn_exp2f(pA1[r]);
  WAIT_BAR(0);
  DMA_K(3,0);DMA_V(1,SLOTB);
  ROT();
  kload8(kf,kp0+sl_cur);
  WAIT_BAR(3);
  s16x4 vlo[16],vhi[16]; u32x4 pw0,pw1,pw2,pw3;
  #define PKW(P,B) cvtpk_s(P[B],P[B+1])
  #define PAF(k) __builtin_bit_cast(bf16x8,pw##k)
  #define VFR(i) (bf16x8){vlo[i][0],vlo[i][1],vlo[i][2],vlo[i][3],vhi[i][0],vhi[i][1],vhi[i][2],vhi[i][3]}
  #define PIN(x) asm volatile("":"+v"(x))
  #define MX3(a,b,c) __builtin_fmaxf(__builtin_fmaxf((a),(b)),(c))
  #define GAPA(MF,A0,A1,A2,A3,W0,W1,PW) do{ MF; sacc+=A0; sacc+=A1; sacc+=A2; sacc+=A3; PIN(sacc); W0; W1; PIN(PW); SBAR(); }while(0)
  #define EX(v) __builtin_amdgcn_exp2f(v)
  #define VRD(j) do{ vlo[j]=vtr(vp_+(((j)&3)*4096+((j)>>2)*1024)); vhi[j]=vtr(vp_+(((j)&3)*4096+((j)>>2)*1024+512)); }while(0)
  #define GAPB(j,k,X,B) do{ asm volatile("s_waitcnt lgkmcnt(0)":::"memory"); SBAR(); o[(j)&3]=__builtin_amdgcn_mfma_f32_32x32x16_bf16(PAF(k),VFR(j),o[(j)&3],0,0,0); X[B]=EX(X[B]); X[B+1]=EX(X[B+1]); PIN(X); if((j)+4<16){VRD(((j)+4)&15);} SBAR(); }while(0)
  #define GAPB1(j,k,X,B) do{ asm volatile("s_waitcnt lgkmcnt(0)":::"memory"); SBAR(); o[(j)&3]=__builtin_amdgcn_mfma_f32_32x32x16_bf16(PAF(k),VFR(j),o[(j)&3],0,0,0); X[B]=EX(X[B]); X[B+1]=EX(X[B+1]); X[B+2]=EX(X[B+2]); X[B+3]=EX(X[B+3]); PIN(X); if((j)+4<8){VRD(((j)+4)&15);} SBAR(); }while(0)
  #define GAPB2(j,k) do{ o[(j)&3]=__builtin_amdgcn_mfma_f32_32x32x16_bf16(PAF(k),VFR(j),o[(j)&3],0,0,0); if((j)+4<16){VRD(((j)+4)&15);} SBAR(); }while(0)
  #define KRD(G,j) do{ if(G){ kload2(kf,kp0+sl_next,j); SBAR(); } }while(0)
  #define STEP(C0,C1,P0,P1,t,GK,GV,GL) do{ SBAR(); \
    const lds_cptr vp_=vp0+2*sl_prev; \
    BINIT0(C0,t); PIN(C0); SBAR(); float sacc=(P0[0]+P0[1]); \
    GAPA(C0=__builtin_amdgcn_mfma_f32_32x32x16_bf16(kf[0],qr[0],C0,0,0,0), P0[2],P0[3],P0[4],P0[5],     pw0[0]=PKW(P0,0), pw0[1]=PKW(P0,2), pw0); \
    BINIT1(C1,t); PIN(C1); SBAR(); GAPA(C1=__builtin_amdgcn_mfma_f32_32x32x16_bf16(kf[1],qr[0],C1,0,0,0), P0[6],P0[7],P0[8],P0[9],     pw0[2]=PKW(P0,4), pw0[3]=PKW(P0,6), pw0); \
    GAPA(C0=__builtin_amdgcn_mfma_f32_32x32x16_bf16(kf[2],qr[1],C0,0,0,0),   P0[10],P0[11],P0[12],P0[13], pw1[0]=PKW(P0,8), pw1[1]=PKW(P0,10), pw1); \
    GAPA(C1=__builtin_amdgcn_mfma_f32_32x32x16_bf16(kf[3],qr[1],C1,0,0,0),   P0[14],P0[15],P1[0],P1[1],   pw1[2]=PKW(P0,12),pw1[3]=PKW(P0,14), pw1); \
    VRD(0); SBAR(); GAPA(C0=__builtin_amdgcn_mfma_f32_32x32x16_bf16(kf[4],qr[2],C0,0,0,0),   P1[2],P1[3],P1[4],P1[5],     pw2[0]=PKW(P1,0), pw2[1]=PKW(P1,2), pw2); \
    VRD(1); SBAR(); GAPA(C1=__builtin_amdgcn_mfma_f32_32x32x16_bf16(kf[5],qr[2],C1,0,0,0),   P1[6],P1[7],P1[8],P1[9],     pw2[2]=PKW(P1,4), pw2[3]=PKW(P1,6), pw2); \
    VRD(2); SBAR(); GAPA(C0=__builtin_amdgcn_mfma_f32_32x32x16_bf16(kf[6],qr[3],C0,0,0,0),   P1[10],P1[11],P1[12],P1[13], pw3[0]=PKW(P1,8), pw3[1]=PKW(P1,10), pw3); \
    VRD(3); SBAR(); GAPA(C1=__builtin_amdgcn_mfma_f32_32x32x16_bf16(kf[7],qr[3],C1,0,0,0),   P1[14],P1[15],0.f,0.f,       pw3[2]=PKW(P1,12),pw3[3]=PKW(P1,14), pw3); \
    l_reg+=sacc; \
    if(GK){DMA_K((t)+3,sl_cur);} if(GV){DMA_V((t)+1,sl_next);} \
    CMASK(C0,C1,t); \
    { float a=MX3(C0[0],C0[1],C1[0]),b=MX3(C0[2],C0[3],C1[1]); a=MX3(a,C1[2],C1[3]); \
      _Pragma("unroll") for(int r=4;r<16;r+=4){a=MX3(a,C0[r],C0[r+1]);b=MX3(b,C0[r+2],C0[r+3]);a=MX3(a,C1[r],C1[r+1]);b=MX3(b,C1[r+2],C1[r+3]);} \
      float rm=__builtin_fmaxf(a,b); { auto rr=__builtin_amdgcn_permlane32_swap(__float_as_uint(rm),__float_as_uint(rm),false,false); rm=__builtin_fmaxf(__uint_as_float(rr[0]),__uint_as_float(rr[1])); } \
      resc=false; \
      if(__builtin_expect(__any(rm>(float)THRL),0)){ const float dl=__builtin_fmaxf(rm,0.f); nb-=dl; \
        _Pragma("unroll") for(int r=0;r<16;++r){C0[r]-=dl;C1[r]-=dl;} \
        const float f=__builtin_amdgcn_exp2f(-dl); l_reg*=f; if(hi==0)wsf[r32]=f; resc=true; } } \
    SBAR(); \
    GAPB1(0,0,C0,0); GAPB1(1,0,C0,4); GAPB1(2,0,C0,8); GAPB1(3,0,C0,12); \
    GAPB1(4,1,C1,0); GAPB1(5,1,C1,4); GAPB1(6,1,C1,8); GAPB1(7,1,C1,12); \
    asm volatile("s_waitcnt lgkmcnt(0)":::"memory"); SBAR(); VRD(8); VRD(9); VRD(10); VRD(11); SBAR(); \
    KRD(GL,0); GAPB2(8,2); GAPB2(9,2); KRD(GL,1); GAPB2(10,2); GAPB2(11,2); \
    KRD(GL,2); GAPB2(12,3); GAPB2(13,3); KRD(GL,3); GAPB2(14,3); GAPB2(15,3); \
    }while(0)
  int t=1;
  #undef CMASK
  #define CMASK(P0,P1,t) do{}while(0)
  for(;t+5<NT;t+=2){
    STEP(pB0,pB1,pA0,pA1,t,true,true,true);     WAIT_BAR(3); RESC(); ROT();
    STEP(pA0,pA1,pB0,pB1,t+1,true,true,true);   WAIT_BAR(3); RESC(); ROT();
  }
  #undef CMASK
  #define CMASK(P0,P1,t) do{int jb_=(t)-(NT-4); if(jb_>=0)cmask(P0,P1,jb_,qrel,hi);}while(0)
  #define ENDW(tt) do{ if((tt)+3<NT){WAIT_BAR(3);} else if((tt)+2<NT){WAIT_BAR(2);} else {WAIT_BAR(0);} }while(0)
  for(;t+1<NT;t+=2){
    STEP(pB0,pB1,pA0,pA1,t,(t+3<NT),(t+1<NT),(t+1<NT));       ENDW(t);   RESC(); ROT();
    STEP(pA0,pA1,pB0,pB1,t+1,(t+4<NT),(t+2<NT),(t+2<NT));     ENDW(t+1); RESC(); ROT();
  }
  STEP(pB0,pB1,pA0,pA1,NT-1,false,false,false); RESC();
  { float sacc=pB0[0]+pB0[1]; _Pragma("unroll") for(int r=2;r<16;++r)sacc+=pB0[r]; _Pragma("unroll") for(int r=0;r<16;++r)sacc+=pB1[r]; l_reg+=sacc;
    pw0=(u32x4){PKW(pB0,0),PKW(pB0,2),PKW(pB0,4),PKW(pB0,6)};pw1=(u32x4){PKW(pB0,8),PKW(pB0,10),PKW(pB0,12),PKW(pB0,14)};pw2=(u32x4){PKW(pB1,0),PKW(pB1,2),PKW(pB1,4),PKW(pB1,6)};pw3=(u32x4){PKW(pB1,8),PKW(pB1,10),PKW(pB1,12),PKW(pB1,14)};
    SBAR(); pv(o,vb0+2*sl_cur,PAF(0),PAF(1),PAF(2),PAF(3)); }
  #undef PKW
  #undef PAF
  #undef VFR
  #undef PIN
  #undef MX3
  #undef GAPA
  #undef GAPB
  #undef EX
  #undef VRD
  #undef KRD
  #undef STEP
  #undef ENDW
  {auto rr=__builtin_amdgcn_permlane32_swap(__float_as_uint(l_reg),__float_as_uint(l_reg),false,false);l_reg=__uint_as_float(rr[0])+__uint_as_float(rr[1]);}
  if(hi==0)wsf[32+r32]=l_reg;asm volatile("s_waitcnt lgkmcnt(0)":::"memory");
  float rli[16];
  #pragma unroll
  for(int r=0;r<16;++r)rli[r]=__builtin_amdgcn_rcpf(wsf[32+crow(r,hi)]);
  bf16*Ow=O+(rowbase+q0+wid*QBLK)*DM+hh*VD;
  { bf16*stg=(bf16*)(shm+LDS_OST)+wid*4096;
    #pragma unroll
    for(int r=0;r<16;++r){const int orow=crow(r,hi);
      #pragma unroll
      for(int d0=0;d0<4;++d0)stg[orow*128+d0*32+r32]=__float2bfloat16(o[d0][r]*rli[r]);}
    asm volatile("s_waitcnt lgkmcnt(0)":::"memory");
    if(!fuse){
    #pragma unroll
    for(int i=0;i<8;++i){const int row=i*4+(lane>>4),ch=lane&15; const u32x4 v=*(const u32x4*)(stg+row*128+ch*8); ATTN_STORE16(Ow+(long)row*DM+ch*8,v);} }
    else{
      asm volatile("s_waitcnt vmcnt(0)":::"memory");
      const bf16*GAw=GA+(rowbase+q0+wid*QBLK)*DM+hh*VD; bf16*ARw=AR+(rowbase+q0+wid*QBLK)*(2*DM)+hh*VD; const int ch=lane&15;
      float sgv[8];
      #pragma unroll
      for(int j=0;j<8;++j)sgv[j]=sg[ch*8+j]*osc;
      #pragma unroll 2
      for(int i=0;i<8;++i){const int row=i*4+(lane>>4);
        const bf16x8 o2=*(const bf16x8*)(stg+row*128+ch*8), o1=*(const bf16x8*)(Ow+(long)row*DM+ch*8), ga=*(const bf16x8*)(GAw+(long)row*DM+ch*8);
        float d[8]; float ss=0.f;
        #pragma unroll
        for(int j=0;j<8;++j){ d[j]=__uint_as_float(((unsigned)(unsigned short)o1[j])<<16)-lam*__uint_as_float(((unsigned)(unsigned short)o2[j])<<16); ss+=d[j]*d[j]; }
        ss+=__int_as_float(__builtin_amdgcn_ds_swizzle(__float_as_int(ss),0x041f)); ss+=__int_as_float(__builtin_amdgcn_ds_swizzle(__float_as_int(ss),0x081f));
        ss+=__int_as_float(__builtin_amdgcn_ds_swizzle(__float_as_int(ss),0x101f)); ss+=__int_as_float(__builtin_amdgcn_ds_swizzle(__float_as_int(ss),0x201f));
        const float rn=1.0f/sqrtf(ss*(1.f/128.f)+1e-5f);
        u32x4 w;
        #pragma unroll
        for(int j2=0;j2<4;++j2){ const float g0=__uint_as_float(((unsigned)(unsigned short)ga[2*j2])<<16), g1=__uint_as_float(((unsigned)(unsigned short)ga[2*j2+1])<<16);
          w[j2]=cvtpk_s(d[2*j2]*rn*sgv[2*j2]*(g0/(1.f+__expf(-g0))), d[2*j2+1]*rn*sgv[2*j2+1]*(g1/(1.f+__expf(-g1)))); }
        *(u32x4*)(ARw+(long)row*(2*DM)+ch*8)=w; } } }
  asm volatile("s_waitcnt lgkmcnt(0)\n\ts_barrier":::"memory");
  #undef DMA_K
  #undef DMA_V
  #undef BINIT0
  #undef BINIT1
  #undef CMASK
  #undef START
  #undef RESC
  #undef ROT
}
constexpr int ATTN_LDS_BYTES=LDS_BYTES;
#undef SBAR
#undef WAIT_BAR
}
#define GAS __attribute__((address_space(1)))
#define LAS __attribute__((address_space(3)))
typedef unsigned short bf16;
typedef unsigned v4u __attribute__((ext_vector_type(4)));
typedef float f32x4 __attribute__((ext_vector_type(4)));
typedef short bf16x8 __attribute__((ext_vector_type(8)));
typedef GAS unsigned gu32;
typedef GAS unsigned long long gu64;
#define RLX_AGENT __ATOMIC_RELAXED, __HIP_MEMORY_SCOPE_AGENT
#define LDS_WAIT() asm volatile("s_waitcnt lgkmcnt(0)" ::: "memory")
#define VM_WAIT() asm volatile("s_waitcnt vmcnt(0)" ::: "memory")
__device__ __forceinline__ unsigned long long rt() { return __builtin_amdgcn_s_memrealtime(); }
__device__ __forceinline__ unsigned f2bf(float f) { unsigned u = __builtin_bit_cast(unsigned, f); return (u + 0x7fffu + ((u >> 16) & 1u)) >> 16; }
typedef float f32x2_pk __attribute__((ext_vector_type(2))); typedef __bf16 bf16x2_pk __attribute__((ext_vector_type(2)));
__device__ __forceinline__ unsigned pk2(float lo, float hi) { f32x2_pk v = {lo, hi}; bf16x2_pk b = __builtin_convertvector(v, bf16x2_pk); return __builtin_bit_cast(unsigned, b); }

#define XB_TMO      128
#define XB_XCNT(j)  (256  + 64 * (j))
#define XB_XSUB(j)  (1280 + 64 * (j))
#define XB_XGEN(j)  (2304 + 64 * (j))
#define XB_TOP      3328
#define XB_TOPGEN   3392
#define XCD_BAR_WORDS 3456
#define XB_SPIN_CAP (1u << 18)

__device__ __forceinline__ unsigned xb_ld(unsigned* p)              { return __hip_atomic_load(p, __ATOMIC_RELAXED, __HIP_MEMORY_SCOPE_AGENT); }
__device__ __forceinline__ unsigned xb_add(unsigned* p, unsigned v) { return __hip_atomic_fetch_add(p, v, __ATOMIC_RELAXED, __HIP_MEMORY_SCOPE_AGENT); }
__device__ __forceinline__ unsigned xb_xcc_id() { return (unsigned)__builtin_amdgcn_s_getreg((3 << 11) | 20) & 0xFu; }
#define XB_SPIN(cond, bar) do { unsigned _sp = 0; while (cond) { __builtin_amdgcn_s_sleep(1); \
    if ((++_sp & 255u) == 0u) { if (xb_ld(&(bar)[XB_TMO])) break; if (_sp > XB_SPIN_CAP) { atomicAdd(&(bar)[XB_TMO], 1u); break; } } } } while (0)

struct XcdBarrier {
    unsigned* bar; unsigned x;
    volatile LAS unsigned* st;
};

__device__ __forceinline__ XcdBarrier xcd_barrier_post(unsigned* bar, volatile LAS unsigned* st) {
    XcdBarrier b; b.bar = bar; b.x = xb_xcc_id(); b.st = st;
    if (threadIdx.x == 0) (void)xb_add(&bar[XB_XCNT(b.x)], 1u);
    return b;
}
__device__ __forceinline__ void xcd_barrier_complete(unsigned* bar, unsigned x, unsigned& nloc, unsigned& nx) {
    const unsigned G = gridDim.x * gridDim.y * gridDim.z;
    unsigned sum, cnt, mine, sp = 0u;
    for (;;) {
        sum = 0u; cnt = 0u; mine = 0u;
#pragma unroll
        for (unsigned j = 0; j < 16; ++j) { const unsigned c = xb_ld(&bar[XB_XCNT(j)]); sum += c; cnt += (c > 0u) ? 1u : 0u; mine = (j == x) ? c : mine; }
        if (sum == G) break;
        __builtin_amdgcn_s_sleep(1);
        if ((++sp & 255u) == 0u) { if (xb_ld(&bar[XB_TMO])) break; if (sp > XB_SPIN_CAP) { atomicAdd(&bar[XB_TMO], 1u); break; } }
    }
    nloc = mine > 0u ? mine : 1u; nx = cnt > 0u ? cnt : 1u;
}

__device__ __forceinline__ void xcd_barrier(const XcdBarrier& b) {
    asm volatile("s_waitcnt vmcnt(0)" ::: "memory");
    __syncthreads();
    if (threadIdx.x == 0) {
        unsigned* bar = b.bar;
        __builtin_amdgcn_s_waitcnt(0);
        unsigned nloc = b.st[0], nx = b.st[1];
        if (nloc == 0u) { xcd_barrier_complete(bar, b.x, nloc, nx); b.st[0] = nloc; b.st[1] = nx; }
        const unsigned old = xb_add(&bar[XB_XSUB(b.x)], 1u);
        const unsigned gen = old / nloc;
        if (old + 1u == (gen + 1u) * nloc) {
            __builtin_amdgcn_fence(__ATOMIC_RELEASE, "agent");
            asm volatile("s_waitcnt vmcnt(0)" ::: "memory");
            const unsigned og = xb_add(&bar[XB_TOP], 1u);
            const unsigned tg = og / nx;
            if (og + 1u == (tg + 1u) * nx) xb_add(&bar[XB_TOPGEN], 1u);
            else XB_SPIN(xb_ld(&bar[XB_TOPGEN]) == tg, bar);
            __builtin_amdgcn_fence(__ATOMIC_ACQUIRE, "agent");
            xb_add(&bar[XB_XGEN(b.x)], 1u);
            asm volatile("s_waitcnt vmcnt(0)" ::: "memory");
        } else {
            XB_SPIN(xb_ld(&bar[XB_XGEN(b.x)]) == gen, bar);
            __builtin_amdgcn_fence(__ATOMIC_ACQUIRE, "agent");
            asm volatile("s_waitcnt vmcnt(0)" ::: "memory");
        }
    }
    __syncthreads();
}
constexpr int NWAVES = 8;
constexpr int BATCH = 8, SEQ = 2048, DM = 2048, DEPTH = 2, M = BATCH * SEQ;
constexpr int HEADS = 8, IN_TOTAL = 10240, LRUW = 1024, NBLK = 8, BLKW = 128;
constexpr float LN_EPS = 1e-5f, SUBLN_EPS = 1e-5f, DN_ALPHA = 1.41421356237309515f, LOG2E = 1.4426950408889634f;

constexpr size_t MiB = 1u << 20;
constexpr size_t WS_CTL = 0, CTL_ZERO_BYTES = 1 * MiB;
constexpr size_t WS_GW = 1 * MiB;
constexpr int N_BF = 4096, N_F8 = 6144;
constexpr float W8_SCALE = 64.f;
constexpr size_t WS_WIN = 2 * MiB;
constexpr size_t WS_WG8 = 34 * MiB;
constexpr size_t WS_XQ8 = 66 * MiB;
constexpr size_t WS_WPAB = 98 * MiB;
constexpr size_t WS_WOUT = 114 * MiB;
constexpr size_t WS_XB16 = 130 * MiB;
constexpr size_t WS_O1 = 130 * MiB, WS_O2 = 162 * MiB, WS_MERGED = 130 * MiB;
constexpr size_t WS_STATS = 256 * 1024;
constexpr size_t WS_P6 = 194 * MiB;
constexpr size_t WS_MA = 386 * MiB, WS_MB = 450 * MiB;
constexpr size_t WS_AR = 514 * MiB;
constexpr size_t WS_END = 578 * MiB;
constexpr int CW_TMO = 0, CW_BAR = 4096;

constexpr int RING_OFF = 0, RING_BYTES = 151552;
constexpr int LDSCTL_OFF = RING_BYTES, MISC_OFF = LDSCTL_OFF + 320;
constexpr int LDS_BYTES = 153600;
static_assert(MISC_OFF + 128 <= LDS_BYTES && attn_body::ATTN_LDS_BYTES <= RING_BYTES && pg8::STAGE_BYTES <= RING_BYTES, "LDS map");

struct Frame {
    LAS unsigned char* lds; volatile LAS unsigned* MISC; gu32* ctl;
    int tid, lane, wave, vcu, G;
};
__device__ __forceinline__ float wave_sum(float v, int lane) {
#pragma unroll
    for (int o = 1; o < 64; o <<= 1) v += __int_as_float(__builtin_amdgcn_ds_bpermute((lane ^ o) << 2, __float_as_int(v)));
    return v;
}
__device__ __forceinline__ void p0_transpose_item(const float* W, int ldw, int ncols, bf16* WT, int ldt, int koff, LAS float* scr, int item, int lane) {
    const int nblk = ncols / 32, kb = item / nblk, nb = item % nblk, k0 = 64 * kb, n0 = 32 * nb;
#pragma unroll 8
    for (int i = 0; i < 32; ++i) { const int kk = 2 * i + (lane >> 5); scr[kk * 33 + (lane & 31)] = W[(size_t)(k0 + kk) * ldw + n0 + (lane & 31)]; }
    LDS_WAIT(); asm volatile("" ::: "memory");
    const int c = lane & 7;
#pragma unroll
    for (int j = 0; j < 4; ++j) { const int n = (lane >> 3) + 8 * j; const LAS float* s = scr + (8 * c) * 33 + n;
        v4u o; o.x = pk2(s[0 * 33], s[1 * 33]); o.y = pk2(s[2 * 33], s[3 * 33]); o.z = pk2(s[4 * 33], s[5 * 33]); o.w = pk2(s[6 * 33], s[7 * 33]);
        *(GAS v4u*)(WT + (size_t)(n0 + n) * ldt + koff + k0 + 8 * c) = o; }
    LDS_WAIT(); asm volatile("" ::: "memory");
}
__device__ __forceinline__ unsigned pk4_fp8(float a, float b, float c, float d) { int w = __builtin_amdgcn_cvt_pk_fp8_f32(a, b, 0, false); w = __builtin_amdgcn_cvt_pk_fp8_f32(c, d, w, true); return (unsigned)w; }
__device__ __forceinline__ void p0_transpose_item8(const float* W, int ldw, int ncols, unsigned char* WT8, int ldt, float scale, LAS float* scr, int item, int lane) {
    const int nblk = ncols / 32, kb = item / nblk, nb = item % nblk, k0 = 64 * kb, n0 = 32 * nb;
#pragma unroll 8
    for (int i = 0; i < 32; ++i) { const int kk = 2 * i + (lane >> 5); scr[kk * 33 + (lane & 31)] = W[(size_t)(k0 + kk) * ldw + n0 + (lane & 31)] * scale; }
    LDS_WAIT(); asm volatile("" ::: "memory");
    const int c = lane & 3;
#pragma unroll
    for (int j = 0; j < 2; ++j) { const int n = (lane >> 2) + 16 * j; const LAS float* s = scr + (16 * c) * 33 + n;
        v4u o; o.x = pk4_fp8(s[0 * 33], s[1 * 33], s[2 * 33], s[3 * 33]); o.y = pk4_fp8(s[4 * 33], s[5 * 33], s[6 * 33], s[7 * 33]);
        o.z = pk4_fp8(s[8 * 33], s[9 * 33], s[10 * 33], s[11 * 33]); o.w = pk4_fp8(s[12 * 33], s[13 * 33], s[14 * 33], s[15 * 33]);
        *(GAS v4u*)(WT8 + (size_t)(n0 + n) * ldt + k0 + 16 * c) = o; }
    LDS_WAIT(); asm volatile("" ::: "memory");
}
struct Args { const float* in[19]; float* out; unsigned char* ws; int ph_lo, ph_hi; };

__device__ __forceinline__ void p0_prologue(Frame& F, const Args& a) {
    LAS float* scr = (LAS float*)(F.lds + RING_OFF + F.wave * 16384);
    const int gw = F.vcu * NWAVES + F.wave, NGW = F.G * NWAVES;
    constexpr int I_IN = (DM / 64) * (N_BF / 32), I_G8 = (DM / 64) * (N_F8 / 32), I_P = (1024 / 64) * (DM / 32), I_O = (DM / 64) * (DM / 32), I_L = I_IN + I_G8 + 2 * I_P + I_O;
    for (int it = gw; it < DEPTH * I_L; it += NGW) {
        const int l = it / I_L; int r = it % I_L;
        bf16* win = (bf16*)(a.ws + WS_WIN) + (size_t)l * N_BF * DM; bf16* wpab = (bf16*)(a.ws + WS_WPAB) + (size_t)l * DM * DM; bf16* wout = (bf16*)(a.ws + WS_WOUT) + (size_t)l * DM * DM;
        if (r < I_IN) { p0_transpose_item(a.in[1] + (size_t)l * DM * IN_TOTAL, IN_TOTAL, N_BF, win, DM, 0, scr, r, F.lane); continue; } r -= I_IN;
        if (r < I_G8) { p0_transpose_item8(a.in[1] + (size_t)l * DM * IN_TOTAL + N_BF, IN_TOTAL, N_F8, a.ws + WS_WG8 + (size_t)l * N_F8 * DM, DM, W8_SCALE, scr, r, F.lane); continue; } r -= I_G8;
        if (r < I_P) { p0_transpose_item(a.in[14] + (size_t)l * 1024 * DM, DM, DM, wpab, DM, 0, scr, r, F.lane); continue; } r -= I_P;
        if (r < I_P) { p0_transpose_item(a.in[15] + (size_t)l * 1024 * DM, DM, DM, wpab, DM, 1024, scr, r, F.lane); continue; } r -= I_P;
        p0_transpose_item(a.in[16] + (size_t)l * DM * DM, DM, DM, wout, DM, 0, scr, r, F.lane);
    }
    for (int it = gw; it < DEPTH * NBLK * 4 * 2 * 8; it += NGW) {
        const int s_ = it & 7, g_ = (it >> 3) & 1, jq = (it >> 4) & 3, n = (it >> 6) & 7, l = it >> 9;
        const float* w = a.in[g_ ? 6 : 4] + ((size_t)(l * NBLK + n) * BLKW + 16 * s_ + 8 * (F.lane >> 5)) * BLKW + jq * 32 + (F.lane & 31);
        v4u o; o.x = pk2(w[0], w[BLKW]); o.y = pk2(w[2 * BLKW], w[3 * BLKW]); o.z = pk2(w[4 * BLKW], w[5 * BLKW]); o.w = pk2(w[6 * BLKW], w[7 * BLKW]);
        *(GAS v4u*)((bf16*)(a.ws + WS_GW) + (size_t)it * 512 + F.lane * 8) = o; }
    bf16* xb = (bf16*)(a.ws + WS_XB16); const float* x = a.in[0];
    for (int m = gw; m < M; m += NGW) {
        const GAS f32x4* xr = (const GAS f32x4*)(x + (size_t)m * DM) + F.lane; GAS unsigned long long* o8 = (GAS unsigned long long*)(xb + (size_t)m * DM) + F.lane;
        GAS unsigned* q8 = (GAS unsigned*)(a.ws + WS_XQ8 + (size_t)m * DM) + F.lane;
#pragma unroll
        for (int j = 0; j < 8; ++j) { const f32x4 v = xr[64 * j]; o8[64 * j] = (unsigned long long)pk2(v.x, v.y) | ((unsigned long long)pk2(v.z, v.w) << 32); q8[64 * j] = pk4_fp8(v.x, v.y, v.z, v.w); }
    }
}
__device__ __forceinline__ void ln_phase(Frame& F, float* y, bf16* xb, unsigned char* xq8, const float* g, const float* bta, bool copies, float* st) {
    const int gw = F.vcu * NWAVES + F.wave, NGW = F.G * NWAVES; int lane = F.lane; asm volatile("" : "+v"(lane));
    for (int m = gw; m < M; m += NGW) {
        GAS f32x4* yr = (GAS f32x4*)(y + (size_t)m * DM) + lane; f32x4 v[8]; float s = 0.f;
#pragma unroll
        for (int j = 0; j < 8; ++j) { v[j] = yr[64 * j]; s += (v[j].x + v[j].y) + (v[j].z + v[j].w); }
        const float mean = wave_sum(s, lane) * (1.f / DM); float s2 = 0.f;
#pragma unroll
        for (int j = 0; j < 8; ++j) { v[j] = v[j] - mean; s2 += (v[j].x * v[j].x + v[j].y * v[j].y) + (v[j].z * v[j].z + v[j].w * v[j].w); }
        const float rstd = 1.f / sqrtf(wave_sum(s2, lane) * (1.f / DM) + LN_EPS);
        GAS unsigned long long* o8 = (GAS unsigned long long*)(xb + (size_t)m * DM) + lane; GAS unsigned* q8 = (GAS unsigned*)(xq8 + (size_t)m * DM) + lane;
#pragma unroll
        for (int j = 0; j < 8; ++j) { const f32x4 gg = *((const GAS f32x4*)g + lane + 64 * j), bb = *((const GAS f32x4*)bta + lane + 64 * j);
            const f32x4 o = v[j] * rstd * gg + bb; if (copies) { o8[64 * j] = (unsigned long long)pk2(o.x, o.y) | ((unsigned long long)pk2(o.z, o.w) << 32); q8[64 * j] = pk4_fp8(o.x, o.y, o.z, o.w); } else yr[64 * j] = o; }
        if (copies && lane == 0) { st[2 * (size_t)m] = mean; st[2 * (size_t)m + 1] = rstd; }
    }
}
__device__ __forceinline__ void combine_block(Frame& F, int b, int h, int qb, const bf16* O1, const bf16* O2, const bf16* GA, bf16* AR, const float* subln_g, float lam, float lam_init) {
    typedef short s16x8 __attribute__((ext_vector_type(8)));
    int tid = F.tid; asm volatile("" : "+v"(tid));
#pragma unroll 1
    for (int it = 0; it < 4; ++it) {
        const int idx = tid + 512 * it, row = b * SEQ + qb * 256 + (idx >> 3), c16 = idx & 7, col = h * 128 + c16 * 16;
        const size_t off = (size_t)row * 1024 + col;
        const s16x8 a0 = *(const GAS s16x8*)(O1 + off), a1 = *(const GAS s16x8*)(O1 + off + 8), b0 = *(const GAS s16x8*)(O2 + off), b1 = *(const GAS s16x8*)(O2 + off + 8);
        const s16x8 g0 = *(const GAS s16x8*)(GA + off), g1 = *(const GAS s16x8*)(GA + off + 8);
        float o[16]; float ss = 0.f;
#pragma unroll
        for (int j = 0; j < 8; ++j) { o[j] = pg8::bfbits2f(a0[j]) - lam * pg8::bfbits2f(b0[j]); o[8 + j] = pg8::bfbits2f(a1[j]) - lam * pg8::bfbits2f(b1[j]); }
#pragma unroll
        for (int j = 0; j < 16; ++j) ss += o[j] * o[j];
        ss += __int_as_float(__builtin_amdgcn_ds_swizzle(__float_as_int(ss), 0x041f)); ss += __int_as_float(__builtin_amdgcn_ds_swizzle(__float_as_int(ss), 0x081f)); ss += __int_as_float(__builtin_amdgcn_ds_swizzle(__float_as_int(ss), 0x101f));
        const float rn = (1.f / sqrtf(ss * (1.f / 128.f) + SUBLN_EPS)) * (1.f - lam_init);
        unsigned w[8];
#pragma unroll
        for (int j = 0; j < 8; ++j) {
            const float ga0 = pg8::bfbits2f(j < 4 ? g0[2 * j] : g1[2 * j - 8]), ga1 = pg8::bfbits2f(j < 4 ? g0[2 * j + 1] : g1[2 * j - 7]);
            const float v0 = o[2 * j] * rn * subln_g[c16 * 16 + 2 * j] * (ga0 / (1.f + __expf(-ga0))), v1 = o[2 * j + 1] * rn * subln_g[c16 * 16 + 2 * j + 1] * (ga1 / (1.f + __expf(-ga1)));
            w[j] = pk2(v0, v1); }
        bf16* op = AR + (size_t)row * 2048 + col;
        *(GAS v4u*)op = (v4u){w[0], w[1], w[2], w[3]}; *(GAS v4u*)(op + 8) = (v4u){w[4], w[5], w[6], w[7]};
    }
}
constexpr int LRU_TM = 256, XCS_PITCH = 272, LRU_XCS = 0, LRU_AS = LRU_XCS + LRU_TM * XCS_PITCH, LRU_US = LRU_AS + LRU_TM * 32 * 4, LRU_AH = LRU_US + LRU_TM * 32 * 4, LRU_CARRY = LRU_AH + 16 * 32 * 8, LRU_WI = LRU_CARRY + 2 * 32 * 4, LRU_CW = LRU_WI + 8 * 64 * 16, LRU_END = LRU_CW + 5 * 128 * 4;
static_assert(LRU_END <= RING_BYTES, "LRU LDS map");
constexpr size_t GW_ITEM = 2 * 8 * 64 * 8;
#define LBAR() asm volatile("s_waitcnt lgkmcnt(0)\n\ts_barrier" ::: "memory")
__device__ __forceinline__ void lru_item(Frame& F, int b, int n, int jq, const bf16* XB, const bf16* GB, bf16* AR, const float* conv_w, const float* conv_b, const bf16* gwf, const float* b_r,
                                         const float* b_i, const float* lam) {
    typedef short s16x8 __attribute__((ext_vector_type(8))); typedef float f32x16 __attribute__((ext_vector_type(16))); typedef float f32x2 __attribute__((ext_vector_type(2)));
    LAS unsigned char* L = F.lds + RING_OFF;
    int tid = F.tid; asm volatile("" : "+v"(tid));
    const int lane = tid & 63, wave = F.wave, r32 = lane & 31, hi = lane >> 5;
    const int ch8 = tid & 15, tq = tid >> 4;
    const int cch = n * BLKW + jq * 32 + r32;
    s16x8 wfr[8];
#pragma unroll
    for (int s = 0; s < 8; ++s) wfr[s] = *(const GAS s16x8*)(gwf + (size_t)(s * 64 + lane) * 8);
    *(LAS s16x8*)(L + LRU_WI + tid * 16) = *(const GAS s16x8*)(gwf + (size_t)(8 * 64 + tid) * 8);
    const float bias_r = b_r[cch], bias_i = b_i[cch], lc = -8.f * log1pf(__expf(-lam[cch])), lc2 = lc * LOG2E;
    if (tid < 64) ((LAS float*)(L + LRU_CARRY))[tid] = 0.f;
    const bf16* xbase = XB + (size_t)b * SEQ * 1024 + n * BLKW + ch8 * 8;
    if (tid < 128) { LAS float* cwl = (LAS float*)(L + LRU_CW); cwl[tid] = conv_b[n * BLKW + tid];
#pragma unroll
        for (int j = 0; j < 4; ++j) cwl[(1 + j) * 128 + tid] = conv_w[j * LRUW + n * BLKW + tid]; }
    s16x8 xq[2][7];
#define LRU_LOADX(t0_) do { _Pragma("unroll") for (int g = 0; g < 2; ++g) _Pragma("unroll") for (int rr = 0; rr < 7; ++rr) { const int t = (t0_) + (tq + 32 * g) * 4 - 3 + rr; \
        xq[g][rr] = (t >= 0) ? *(const GAS s16x8*)(xbase + (size_t)t * 1024) : (s16x8){0, 0, 0, 0, 0, 0, 0, 0}; } } while (0)
    LRU_LOADX(0);
    LBAR();
#pragma unroll 1
    for (int ms = 0; ms < SEQ / LRU_TM; ++ms) {
        const int t0 = ms * LRU_TM;
        {
            float cw[4][8], cb[8];
            { unsigned cwb = (unsigned)(LRU_CW + ch8 * 32); asm volatile("" : "+v"(cwb));
              const f32x4 b0 = *(const LAS f32x4*)(L + cwb), b1 = *(const LAS f32x4*)(L + cwb + 16);
              cb[0] = b0.x; cb[1] = b0.y; cb[2] = b0.z; cb[3] = b0.w; cb[4] = b1.x; cb[5] = b1.y; cb[6] = b1.z; cb[7] = b1.w;
#pragma unroll
              for (int j = 0; j < 4; ++j) { const f32x4 w0 = *(const LAS f32x4*)(L + cwb + (1 + j) * 512), w1 = *(const LAS f32x4*)(L + cwb + (1 + j) * 512 + 16);
                  cw[j][0] = w0.x; cw[j][1] = w0.y; cw[j][2] = w0.z; cw[j][3] = w0.w; cw[j][4] = w1.x; cw[j][5] = w1.y; cw[j][6] = w1.z; cw[j][7] = w1.w; } }
            unsigned s1b = (unsigned)(LRU_XCS + tq * 4 * XCS_PITCH + ch8 * 16); asm volatile("" : "+v"(s1b));
#pragma unroll
            for (int g = 0; g < 2; ++g) {
                unsigned w[4][4];
#pragma unroll
                for (int i2 = 0; i2 < 4; ++i2) {
                    float x0[7], x1[7];
#pragma unroll
                    for (int rr = 0; rr < 7; ++rr) { const unsigned d = ((const unsigned*)&xq[g][rr])[i2]; x0[rr] = __uint_as_float(d << 16); x1[rr] = __uint_as_float(d & 0xffff0000u); }
#pragma unroll
                    for (int q = 0; q < 4; ++q) {
                        const float v0 = cb[2 * i2] + cw[0][2 * i2] * x0[q] + cw[1][2 * i2] * x0[q + 1] + cw[2][2 * i2] * x0[q + 2] + cw[3][2 * i2] * x0[q + 3];
                        const float v1 = cb[2 * i2 + 1] + cw[0][2 * i2 + 1] * x1[q] + cw[1][2 * i2 + 1] * x1[q + 1] + cw[2][2 * i2 + 1] * x1[q + 2] + cw[3][2 * i2 + 1] * x1[q + 3];
                        w[q][i2] = pk2(v0, v1); }
                    asm volatile("" : "+v"(w[0][i2]), "+v"(w[1][i2]), "+v"(w[2][i2]), "+v"(w[3][i2]));
                }
#pragma unroll
                for (int q = 0; q < 4; ++q) *(LAS v4u*)(L + s1b + (32 * g * 4 + q) * XCS_PITCH) = (v4u){w[q][0], w[q][1], w[q][2], w[q][3]};
            }
        }
        if (ms + 1 < SEQ / LRU_TM) LRU_LOADX(t0 + LRU_TM);
        LBAR();
        {
            f32x16 ar, ai;
#pragma unroll
            for (int r = 0; r < 16; ++r) { ar[r] = bias_r; ai[r] = bias_i; }
            unsigned s2a = (unsigned)(LRU_XCS + (32 * wave + r32) * XCS_PITCH + hi * 16), s2i = (unsigned)(LRU_WI + lane * 16); asm volatile("" : "+v"(s2a), "+v"(s2i));
#pragma unroll
            for (int s = 0; s < 8; ++s) { const s16x8 af = *(const LAS s16x8*)(L + s2a + s * 32), wi = *(const LAS s16x8*)(L + s2i + s * 1024);
                ar = __builtin_amdgcn_mfma_f32_32x32x16_bf16(af, wfr[s], ar, 0, 0, 0); ai = __builtin_amdgcn_mfma_f32_32x32x16_bf16(af, wi, ai, 0, 0, 0); }
            unsigned s2x = (unsigned)(LRU_XCS + (32 * wave + 4 * hi) * XCS_PITCH + (jq * 32 + r32) * 2), s2w = (unsigned)((32 * wave + 4 * hi) * 128 + r32 * 4); asm volatile("" : "+v"(s2x), "+v"(s2w));
#pragma unroll
            for (int r = 0; r < 16; ++r) { const int cr = (r & 3) + 8 * (r >> 2);
                const float rg = __builtin_amdgcn_rcpf(1.f + __builtin_amdgcn_exp2f(-LOG2E * ar[r])), ig = __builtin_amdgcn_rcpf(1.f + __builtin_amdgcn_exp2f(-LOG2E * ai[r]));
                const float av = __builtin_amdgcn_exp2f(lc2 * rg), t = 2.f * lc * rg;
                const float ser = -t * (1.f + t * (0.5f + t * (0.16666667f + t * (0.041666668f + t * 0.0083333338f))));
                const float om = (t > -0.1f) ? ser : (1.f - av * av);
                const float xc = __uint_as_float(((unsigned)*(const LAS unsigned short*)(L + s2x + cr * XCS_PITCH)) << 16);
                const float uv = __builtin_amdgcn_sqrtf(om) * (ig * xc);
                *(LAS float*)(L + LRU_AS + s2w + cr * 128) = av; *(LAS float*)(L + LRU_US + s2w + cr * 128) = uv; }
        }
        LBAR();
        s16x8 gbv[2];
#pragma unroll
        for (int g = 0; g < 2; ++g) { const int idx = tid + 512 * g, tl = idx >> 2, c8 = idx & 3; gbv[g] = *(const GAS s16x8*)(GB + ((size_t)b * SEQ + t0 + tl) * 1024 + n * BLKW + jq * 32 + c8 * 8); }
        {
            const int sc = tid >> 5, o = tid & 31; unsigned s3b = (unsigned)(((sc * 16) * 32 + o) * 4); asm volatile("" : "+v"(s3b));
            LAS float* as = (LAS float*)(L + LRU_AS + s3b); LAS float* us = (LAS float*)(L + LRU_US + s3b);
            float a[16], u[16];
#pragma unroll
            for (int i = 0; i < 16; ++i) { a[i] = as[i * 32]; u[i] = us[i * 32]; }
            float A = 1.f, H = 0.f;
#pragma unroll
            for (int i = 0; i < 16; ++i) { H = a[i] * H + u[i]; A *= a[i]; }
            unsigned s3o = (unsigned)(LRU_AH + o * 8); asm volatile("" : "+v"(s3o));
            *(LAS f32x2*)(L + s3o + sc * 256) = (f32x2){A, H};
            LBAR();
            float h = ((LAS float*)(L + LRU_CARRY))[(ms & 1) * 32 + o];
            f32x2 p[15];
#pragma unroll
            for (int s2 = 0; s2 < 15; ++s2) p[s2] = *(const LAS f32x2*)(L + s3o + s2 * 256);
#pragma unroll
            for (int s2 = 0; s2 < 15; ++s2) h = (s2 < sc) ? p[s2].x * h + p[s2].y : h;
#pragma unroll
            for (int i = 0; i < 16; ++i) { h = a[i] * h + u[i]; us[i * 32] = h; }
            if (sc == 15) ((LAS float*)(L + LRU_CARRY))[((ms + 1) & 1) * 32 + o] = h;
        }
        LBAR();
#pragma unroll
        for (int g = 0; g < 2; ++g) { const int idx = tid + 512 * g, tl = idx >> 2, c8 = idx & 3; const size_t row = (size_t)b * SEQ + t0 + tl; const int col = n * BLKW + jq * 32 + c8 * 8;
            unsigned s4b = (unsigned)(LRU_US + (tl * 32 + c8 * 8) * 4); asm volatile("" : "+v"(s4b));
            const f32x4 h0 = *(const LAS f32x4*)(L + s4b), h1 = *(const LAS f32x4*)(L + s4b + 16);
            const s16x8 gv = gbv[g]; float hv[8] = {h0.x, h0.y, h0.z, h0.w, h1.x, h1.y, h1.z, h1.w}; unsigned w[4];
#pragma unroll
            for (int i2 = 0; i2 < 4; ++i2) { const float g0 = pg8::bfbits2f(gv[2 * i2]), g1 = pg8::bfbits2f(gv[2 * i2 + 1]);
                w[i2] = pk2(hv[2 * i2] * g0 * __builtin_amdgcn_rcpf(1.f + __builtin_amdgcn_exp2f(-LOG2E * g0)), hv[2 * i2 + 1] * g1 * __builtin_amdgcn_rcpf(1.f + __builtin_amdgcn_exp2f(-LOG2E * g1))); }
            *(GAS v4u*)(AR + row * 2048 + 1024 + col) = (v4u){w[0], w[1], w[2], w[3]}; }
    }
#undef LRU_LOADX
    LBAR();
}

#ifndef MK_DBL
#define MK_DBL 0
#endif
#define DBL(k) for (int rep_ = 0; rep_ < 1 + ((MK_DBL >> (k)) & 1); ++rep_)
constexpr int N_PH_LAYER = 5, N_PHASES = 1 + DEPTH * N_PH_LAYER;
__global__ void __launch_bounds__(NWAVES * 64, 2) mk_fwd(Args args) {
    extern __shared__ __attribute__((aligned(16))) unsigned char lds[];
    Frame F;
    F.lds = (LAS unsigned char*)lds; F.MISC = (volatile LAS unsigned*)(F.lds + MISC_OFF);
    F.tid = threadIdx.x; F.lane = F.tid & 63; F.wave = __builtin_amdgcn_readfirstlane(F.tid >> 6);
    F.G = gridDim.x; { const int bx = blockIdx.x; F.vcu = (F.G % 8 == 0) ? (bx % 8) * (F.G / 8) + bx / 8 : bx; }
    F.ctl = (gu32*)(args.ws + WS_CTL);
    for (int u = F.tid; u < (LDS_BYTES - LDSCTL_OFF) / 4; u += NWAVES * 64) ((LAS unsigned*)(F.lds + LDSCTL_OFF))[u] = 0u;
    __syncthreads();
    const int lo = args.ph_lo, hi = args.ph_hi;
    const bool use_bar = (hi - lo) > 1;
    XcdBarrier bar; bar.bar = (unsigned*)(F.ctl + CW_BAR); bar.x = 0; bar.st = nullptr;
    if (use_bar) bar = xcd_barrier_post((unsigned*)(F.ctl + CW_BAR), F.MISC + 8);
#define IN(k) (lo <= (k) && (k) < hi)
#define SEAM(k) do { if (IN(k) && IN((k) + 1)) xcd_barrier(bar); } while (0)
#define CAS __attribute__((address_space(4)))
    typedef unsigned char* ucp_t; typedef float* fp_t; typedef const float* cfp_t;
#define KARGS() CAS const char* ka_ = (CAS const char*)__builtin_amdgcn_kernarg_segment_ptr(); asm volatile("" : "+s"(ka_)); unsigned char* const ws = *(CAS const ucp_t*)(ka_ + 160); float* const outp = *(CAS const fp_t*)(ka_ + 152); (void)outp; (void)ws
#define KIN(k) (*(CAS const cfp_t*)(ka_ + 8 * (k)))
#define WSP(off) ((bf16*)(ws + (off)))
    if (IN(0)) { DBL(0) p0_prologue(F, args); } SEAM(0);
#pragma unroll 1
    for (int l = 0; l < DEPTH; ++l) {
        const int pb = 1 + l * N_PH_LAYER;
        const float lam_init = 0.8f - 0.6f * __expf(-0.3f * (float)l);
        if (IN(pb)) {
            KARGS(); bf16* const P6 = WSP(WS_P6); bf16* const MA = WSP(WS_MA); bf16* const MB = WSP(WS_MB);
            { pg8::Gemm g{WSP(WS_XB16), WSP(WS_WIN) + (size_t)l * N_BF * DM, M, N_BF, DM}; pg8::StaticOrder S; S.init(M, N_BF, F.G, (int)blockIdx.x);
              pg8::EpiProj E{P6, MA, MB, (size_t)M * 1024, attn_body::C2, 0, 1.f};
              DBL(1) pg8::gemm_phase<pg8::EpiProj, pg8::StaticOrder, PG8_ALIGN, PG8_SP2>(F.lds + RING_OFF, g, S, E); }
            { pg8::Gemm g{(const pg8::bf16_t*)(ws + WS_XQ8), (const pg8::bf16_t*)(ws + WS_WG8 + (size_t)l * N_F8 * DM), M, N_F8, DM / 2}; pg8::StaticOrder S; S.init(M, N_F8, F.G, (int)blockIdx.x);
              pg8::EpiProj E{P6, MA, MB, (size_t)M * 1024, attn_body::C2, N_BF / 256, 1.f / W8_SCALE};
              DBL(1) pg8::gemm_phase<pg8::EpiProj, pg8::StaticOrder, PG8_ALIGN, PG8_SP2, true>(F.lds + RING_OFF, g, S, E); }
        }
        SEAM(pb);
        if (IN(pb + 1)) {
            KARGS(); bf16* const P6 = WSP(WS_P6); bf16* const O1 = WSP(WS_O1); bf16* const O2 = WSP(WS_O2); bf16* const AR = WSP(WS_AR);
            bf16* const Qb = P6; bf16* const Kb = P6 + (size_t)M * 1024; bf16* const Vb = P6 + (size_t)2 * M * 1024; bf16* const GA = P6 + (size_t)3 * M * 1024; bf16* const XBb = P6 + (size_t)4 * M * 1024; bf16* const GBb = P6 + (size_t)5 * M * 1024;
            int ln_ = F.lane; asm volatile("" : "+v"(ln_));
            float d1 = KIN(9)[l * 64 + ln_] * KIN(10)[l * 64 + ln_], d2 = KIN(11)[l * 64 + ln_] * KIN(12)[l * 64 + ln_];
            d1 = wave_sum(d1, ln_); d2 = wave_sum(d2, ln_);
            const float lam = __uint_as_float(__builtin_amdgcn_readfirstlane(__float_as_uint(__expf(d1) - __expf(d2) + lam_init)));
            const int bh = F.vcu >> 2, p = F.vcu & 3, b = bh >> 3, h = bh & 7;
            const float slope2 = exp2f(-(float)(h + 1)) * LOG2E;
            if (F.G == 256) {
#pragma unroll 1
                for (int i = 0; i < 2; ++i) {
                    const int qb = i ? (7 - p) : p;
#pragma unroll 1
                    DBL(2) for (int c = 0; c < 2; ++c) {
                        attn_body::attn_unit<8>(b, 2 * h + c, h, qb, slope2, (const attn_body::bf16*)Qb, (const attn_body::bf16*)Kb, (const attn_body::bf16*)Vb, (attn_body::bf16*)O1, (char*)lds + RING_OFF,
                                                c != 0, lam, 1.f - lam_init, (const attn_body::bf16*)GA, KIN(13) + l * 128, (attn_body::bf16*)AR);
                    }
                }
                DBL(3) lru_item(F, F.vcu >> 5, (F.vcu >> 2) & 7, F.vcu & 3, XBb, GBb, AR, KIN(2) + (size_t)l * 4 * LRUW, KIN(3) + l * LRUW,
                         (const bf16*)(ws + WS_GW) + ((size_t)(l * NBLK + ((F.vcu >> 2) & 7)) * 4 + (F.vcu & 3)) * GW_ITEM, KIN(5) + l * LRUW, KIN(7) + l * LRUW, KIN(8) + l * LRUW);
            }
        }
        SEAM(pb + 1);
        if (IN(pb + 2)) {
            KARGS();
            pg8::Gemm g{WSP(WS_AR), WSP(WS_WPAB) + (size_t)l * DM * DM, M, DM, DM}; pg8::StaticOrder S; S.init(M, DM, F.G, (int)blockIdx.x);
            pg8::EpiMerge E{WSP(WS_MA), WSP(WS_MB), WSP(WS_MERGED)};
            DBL(4) pg8::gemm_phase<pg8::EpiMerge, pg8::StaticOrder, PG8_ALIGN, PG8_SP2>(F.lds + RING_OFF, g, S, E);
        }
        SEAM(pb + 2);
        if (IN(pb + 3)) {
            KARGS();
            pg8::Gemm g{WSP(WS_MERGED), WSP(WS_WOUT) + (size_t)l * DM * DM, M, DM, DM}; pg8::StaticOrder S; S.init(M, DM, F.G, (int)blockIdx.x);
            if (l == 0) { pg8::EpiRes E{KIN(0), outp, DN_ALPHA};
                          pg8::gemm_phase<pg8::EpiRes, pg8::StaticOrder, PG8_ALIGN, PG8_SP2>(F.lds + RING_OFF, g, S, E); }
            else        { pg8::EpiResFromY E{outp, (const float*)(ws + WS_STATS), KIN(17) + (l - 1) * DM, KIN(18) + (l - 1) * DM};
                          pg8::gemm_phase<pg8::EpiResFromY, pg8::StaticOrder, PG8_ALIGN, PG8_SP2>(F.lds + RING_OFF, g, S, E); }
        }
        SEAM(pb + 3);
        if (IN(pb + 4)) { KARGS(); ln_phase(F, outp, WSP(WS_XB16), ws + WS_XQ8, KIN(17) + l * DM, KIN(18) + l * DM, l + 1 < DEPTH, (float*)(ws + WS_STATS)); }
        SEAM(pb + 4);
    }
#undef IN
#undef SEAM
#undef KARGS
#undef KIN
#undef WSP
#undef CAS
}

#ifndef MK_PER_PHASE
#define MK_PER_PHASE 0
#endif
extern "C" void kernel_launch(void* const* d_in, const int* in_sizes, int n_in, void* d_out, int out_size, void* d_ws, size_t ws_size, hipStream_t stream) {
    static int grid = 0;
    if (grid == 0) {
        if (n_in != 19 || in_sizes[0] != M * DM || out_size != M * DM || ws_size < WS_END) { fprintf(stderr, "kernel_launch: unexpected shapes / workspace (n_in %d, ws %zu); nothing launched\n", n_in, ws_size); grid = -1; return; }
        int dev = 0, cus = 0;
        if (hipGetDevice(&dev) != hipSuccess || hipDeviceGetAttribute(&cus, hipDeviceAttributeMultiprocessorCount, dev) != hipSuccess) { grid = -1; return; }
        if (hipFuncSetAttribute((const void*)mk_fwd, hipFuncAttributeMaxDynamicSharedMemorySize, LDS_BYTES) != hipSuccess) { fprintf(stderr, "kernel_launch: hipFuncSetAttribute failed\n"); grid = -1; return; }
        int per_cu = 0;
        if (hipOccupancyMaxActiveBlocksPerMultiprocessor(&per_cu, (const void*)mk_fwd, NWAVES * 64, LDS_BYTES) != hipSuccess || per_cu < 1) fprintf(stderr, "kernel_launch: occupancy query reports %d blocks per CU\n", per_cu);
        (void)hipGetLastError();
        grid = cus;
        if (grid != 256) fprintf(stderr, "kernel_launch: %d CUs; the attention/LRU phase is built for 256\n", grid);
    }
    if (grid < 0) return;
    if (hipMemsetAsync((char*)d_ws + WS_CTL, 0, CTL_ZERO_BYTES, stream) != hipSuccess) return;
    Args a{};
    for (int i = 0; i < 19; ++i) a.in[i] = (const float*)d_in[i];
    a.out = (float*)d_out; a.ws = (unsigned char*)d_ws;
#if MK_PER_PHASE
    for (int p = 0; p < N_PHASES; ++p) { a.ph_lo = p; a.ph_hi = p + 1; hipLaunchKernelGGL(mk_fwd, dim3(grid), dim3(NWAVES * 64), LDS_BYTES, stream, a); }
#else
    a.ph_lo = 0; a.ph_hi = N_PHASES;
    hipLaunchKernelGGL(mk_fwd, dim3(grid), dim3(NWAVES * 64), LDS_BYTES, stream, a);
#endif
}
```

```cpp
#include <hip/hip_runtime.h>
#include <cstdio>
#include <cstdint>
namespace pg8 {
#define PG8_LAS __attribute__((address_space(3)))
typedef unsigned short bf16_t;
typedef short bf16x8 __attribute__((ext_vector_type(8)));
typedef float f32x4 __attribute__((ext_vector_type(4)));
typedef unsigned u32x4 __attribute__((ext_vector_type(4)));
constexpr int BM = 256, BK = 64, HALF = 128, HTB = HALF * BK * 2  , STAGE_BYTES = 8 * HTB, NXCD = 8, WGM = 8;

__host__ __device__ __forceinline__ int lds_byte(int r, int c) { const int st = (r >> 4) * 2 + (c >> 5), rr = r & 15, cc = c & 31, ob = rr * 64 + cc * 2; return st * 1024 + (ob ^ (((ob >> 9) & 1) << 5)); }
__host__ __device__ __forceinline__ void stage_rc(int b, int& R, int& C) { const int st = b / 1024, sb = b % 1024, swz = sb ^ (((sb >> 9) & 1) << 5); R = (st >> 1) * 16 + swz / 64; C = (st & 1) * 32 + (swz % 64) / 2; }
__host__ __device__ __forceinline__ int perm32(int rho) { const int n = rho >> 4, i = rho & 15; return 8 * (i >> 2) + 4 * n + (i & 3); }

struct Unit { int pm, pn; };
struct Gemm { const bf16_t* A; const bf16_t* Bt; int M, N, K; };

struct StaticOrder {
    int nM, nN, nwg, G, c;
    __host__ __device__ void init(int M, int N, int G_, int c_) { nM = M / BM; nN = N / BM; nwg = nM * nN; G = G_; c = c_; }
    __host__ __device__ bool next(int i, Unit& u) const {
        const long L = (long)i * G + c; if (L >= nwg) return false;
        int wgid = (int)L; { const int q = nwg / NXCD, r = nwg % NXCD, xcd = wgid % NXCD, off = wgid / NXCD; wgid = (xcd < r ? xcd * (q + 1) : r * (q + 1) + (xcd - r) * q) + off; }
        const int nig = WGM * nN, gid = wgid / nig, fm = gid * WGM, gsz = (nM - fm) < WGM ? (nM - fm) : WGM;
        u.pm = fm + ((wgid % nig) % gsz); u.pn = (wgid % nig) / gsz; return true;
    }
    __device__ __forceinline__ void a_ready(const Unit&) const {}
    __device__ __forceinline__ void done(const Unit&) const {}
};

__device__ __forceinline__ unsigned cvt_pk_bf16(float lo, float hi) { unsigned r; asm volatile("v_cvt_pk_bf16_f32 %0, %1, %2" : "=v"(r) : "v"(lo), "v"(hi)); return r; }
typedef short s16x8_t __attribute__((ext_vector_type(8)));
typedef float f32x2 __attribute__((ext_vector_type(2)));
__device__ __forceinline__ float bfbits2f(short v) { return __uint_as_float(((unsigned)(unsigned short)v) << 16); }
struct EpiProj {
    static constexpr bool PERM = true, AFTER_DRAIN = false, HAS_MID = false;
    bf16_t* base6; bf16_t* ma; bf16_t* mb; size_t stride6; float qscale; int pn_off; float gscale;
    __device__ __forceinline__ void operator()(const f32x4 (&acc)[2][2][4][2], const Unit& u, int wr, int wc, int fr, int fq) const {
        const int pn = u.pn + pn_off; bf16_t* base; int ldc, colt; float sc = 1.f;
        float qs_ = qscale, gs_ = gscale; asm volatile("" : "+v"(qs_), "+v"(gs_));
        if (pn < 24) { const int t = pn >> 2; base = base6 + (size_t)t * stride6; ldc = 1024; colt = (pn & 3) * BM; sc = (t == 0) ? qs_ : gs_; }
        else if (pn < 32) { base = ma; ldc = 2048; colt = (pn - 24) * BM; sc = gs_; }
        else { base = mb; ldc = 2048; colt = (pn - 32) * BM; sc = gs_; }
        int t_ = threadIdx.x; asm volatile("" : "+v"(t_));
        const int lrow = (t_ >> 8) * 64 + (t_ & 15), lcol = ((t_ >> 6) & 3) * 32 + 8 * ((t_ >> 4) & 3);
        const int row0 = u.pm * BM + lrow, col0 = colt + lcol;
#pragma unroll
        for (int ai = 0; ai < 2; ++ai)
#pragma unroll
            for (int m = 0; m < 4; ++m) { bf16_t* rowp = base + (size_t)(row0 + ai * HALF + m * 16) * ldc + col0;
#pragma unroll
                for (int bj = 0; bj < 2; ++bj) { const f32x4 v0 = acc[ai][bj][m][0] * sc, v1 = acc[ai][bj][m][1] * sc;
                    u32x4 w; w.x = cvt_pk_bf16(v0[0], v0[1]); w.y = cvt_pk_bf16(v0[2], v0[3]); w.z = cvt_pk_bf16(v1[0], v1[1]); w.w = cvt_pk_bf16(v1[2], v1[3]);
                    *(u32x4*)(rowp + bj * HALF) = w; } }
    }
};
struct EpiMerge {
    static constexpr bool PERM = true, AFTER_DRAIN = false, HAS_MID = true;
    const bf16_t* ma; const bf16_t* mb; bf16_t* out;
    __device__ __forceinline__ void mid(f32x4 (&acc)[2][2][4][2], const Unit& u, int wr, int wc, int fr, int fq) const {
        unsigned lofs = (unsigned)((wr * 64 + fr) * 2048 + wc * 32 + 8 * fq); asm volatile("" : "+v"(lofs));
        const size_t tofs = (size_t)u.pm * BM * 2048 + (size_t)u.pn * BM;
#pragma unroll
        for (int ai = 0; ai < 2; ++ai)
#pragma unroll
            for (int m = 0; m < 4; ++m) { const size_t off = tofs + lofs + (size_t)(ai * HALF + m * 16) * 2048;
#pragma unroll
                for (int bj = 0; bj < 2; ++bj) { const s16x8_t a = *(const s16x8_t*)(ma + off + bj * HALF), b = *(const s16x8_t*)(mb + off + bj * HALF);
#pragma unroll
                    for (int j = 0; j < 8; ++j) { const float xa = bfbits2f(a[j]), xb = fmaxf(bfbits2f(b[j]), -30.f);
                        const float f = (1.f + __expf(-xb)) * __builtin_amdgcn_rcpf(1.f + __expf(-xa)); acc[ai][bj][m][j >> 2][j & 3] *= f; } }
                asm volatile("" ::: "memory"); }
    }
    __device__ __forceinline__ void operator()(const f32x4 (&acc)[2][2][4][2], const Unit& u, int wr, int wc, int fr, int fq) const {
        unsigned lofs = (unsigned)((wr * 64 + fr) * 2048 + wc * 32 + 8 * fq); asm volatile("" : "+v"(lofs));
        const size_t tofs = (size_t)u.pm * BM * 2048 + (size_t)u.pn * BM;
#pragma unroll
        for (int ai = 0; ai < 2; ++ai)
#pragma unroll
            for (int m = 0; m < 4; ++m) { const size_t off = tofs + lofs + (size_t)(ai * HALF + m * 16) * 2048;
#pragma unroll
                for (int bj = 0; bj < 2; ++bj) { const s16x8_t b = *(const s16x8_t*)(mb + off + bj * HALF); float v[8];
#pragma unroll
                    for (int j = 0; j < 8; ++j) { const float xb = fmaxf(bfbits2f(b[j]), -30.f); v[j] = acc[ai][bj][m][j >> 2][j & 3] * __builtin_amdgcn_rcpf(1.f + __expf(-xb)); }
                    u32x4 w; w.x = cvt_pk_bf16(v[0], v[1]); w.y = cvt_pk_bf16(v[2], v[3]); w.z = cvt_pk_bf16(v[4], v[5]); w.w = cvt_pk_bf16(v[6], v[7]);
                    *(u32x4*)(out + off + bj * HALF) = w; }
                asm volatile("" ::: "memory"); }
    }
};
struct EpiRes {
    static constexpr bool PERM = false, AFTER_DRAIN = false, HAS_MID = false;
    const float* base; float* out; float alpha;
    __device__ __forceinline__ void operator()(const f32x4 (&acc)[2][2][4][2], const Unit& u, int wr, int wc, int fr, int fq) const {
        const int row0 = u.pm * BM + wr * 64 + fr, col0 = u.pn * BM + wc * 32 + 4 * fq;
#pragma unroll
        for (int ai = 0; ai < 2; ++ai)
#pragma unroll
            for (int m = 0; m < 4; ++m) { const size_t off = (size_t)(row0 + ai * HALF + m * 16) * 2048 + col0;
#pragma unroll
                for (int bj = 0; bj < 2; ++bj)
#pragma unroll
                    for (int n = 0; n < 2; ++n) { const f32x4 bs = *(const f32x4*)(base + off + bj * HALF + n * 16); *(f32x4*)(out + off + bj * HALF + n * 16) = bs * alpha + acc[ai][bj][m][n]; }
                if (m & 1) asm volatile("" ::: "memory"); }
    }
};

struct EpiResFromY {
    static constexpr bool PERM = false, AFTER_DRAIN = false, HAS_MID = false;
    float* out; const float* st; const float* g; const float* b;
    static constexpr float alpha = 1.41421356237309515f;
    __device__ __forceinline__ void operator()(const f32x4 (&acc)[2][2][4][2], const Unit& u, int wr, int wc, int fr, int fq) const {
        int t_ = threadIdx.x; asm volatile("" : "+v"(t_));
        const int lrow = (t_ >> 8) * 64 + (t_ & 15), lcol = ((t_ >> 6) & 3) * 32 + 4 * ((t_ >> 4) & 3);
        const int row0 = u.pm * BM + lrow, col0 = u.pn * BM + lcol;
        f32x4 gv[2][2], bv[2][2];
#pragma unroll
        for (int bj = 0; bj < 2; ++bj)
#pragma unroll
            for (int n = 0; n < 2; ++n) { gv[bj][n] = *(const f32x4*)(g + col0 + bj * HALF + n * 16); bv[bj][n] = *(const f32x4*)(b + col0 + bj * HALF + n * 16); }
#pragma unroll
        for (int ai = 0; ai < 2; ++ai)
#pragma unroll
            for (int m = 0; m < 4; ++m) { const int row = row0 + ai * HALF + m * 16; const size_t off = (size_t)row * 2048 + col0;
                const f32x2 ms = *(const f32x2*)(st + 2 * (size_t)row);
#pragma unroll
                for (int bj = 0; bj < 2; ++bj)
#pragma unroll
                    for (int n = 0; n < 2; ++n) { const f32x4 y = *(const f32x4*)(out + off + bj * HALF + n * 16); const f32x4 x = (y - ms.x) * ms.y * gv[bj][n] + bv[bj][n];
                        *(f32x4*)(out + off + bj * HALF + n * 16) = x * alpha + acc[ai][bj][m][n]; }
                if (m & 1) asm volatile("" ::: "memory"); }
    }
};
typedef int pg8_v4i __attribute__((ext_vector_type(4))); typedef int pg8_v8i __attribute__((ext_vector_type(8)));
template <bool FP8> struct FragSel { struct type { bf16x8 k[2]; }; };
template <> struct FragSel<true> { typedef pg8_v8i type; };
template <bool FP8, class F> __device__ __forceinline__ void ld_frag(F& d, const PG8_LAS unsigned char* p) {
    if constexpr (FP8) { const pg8_v4i lo = *(const PG8_LAS pg8_v4i*)p, hi = *(const PG8_LAS pg8_v4i*)(p + 16); d = __builtin_shufflevector(lo, hi, 0, 1, 2, 3, 4, 5, 6, 7); }
    else { d.k[0] = *(const PG8_LAS bf16x8*)p; d.k[1] = *(const PG8_LAS bf16x8*)(p + 1024); }
}
template <bool FP8, class F> __device__ __forceinline__ void mma_frag(f32x4& c, const F& b, const F& a) {
    if constexpr (FP8) c = __builtin_amdgcn_mfma_scale_f32_16x16x128_f8f6f4(b, a, c, 0, 0, 0, 0, 0, 0);
    else { c = __builtin_amdgcn_mfma_f32_16x16x32_bf16(b.k[0], a.k[0], c, 0, 0, 0); c = __builtin_amdgcn_mfma_f32_16x16x32_bf16(b.k[1], a.k[1], c, 0, 0, 0); }
}
template <class Epi, class Sched, bool ALIGN_EPI = false, bool SP2 = false, bool FP8 = false>
__device__ __forceinline__ void gemm_phase(PG8_LAS unsigned char* lds, const Gemm g, const Sched& S, const Epi& E) {
    int tid_ = threadIdx.x; asm volatile("" : "+v"(tid_));
    const int tid = tid_, wid = __builtin_amdgcn_readfirstlane(tid >> 6), lane = tid & 63, wr = wid >> 2, wc = wid & 3, fr = lane & 15, fq = lane >> 4;
    const int K = g.K, nt = K / BK;
    unsigned voffA[2], voffB[2];
#pragma unroll
    for (int i = 0; i < 2; ++i) { int R, C; stage_rc(tid * 16 + i * 8192, R, C); const int Rb = Epi::PERM ? ((R & ~31) + perm32(R & 31)) : R;
        voffA[i] = (unsigned)(R * K + C) * 2u; voffB[i] = (unsigned)(Rb * K + C) * 2u; }
    const size_t kstep = (size_t)(BK * 2);
    const size_t hstep = (size_t)HALF * K * 2;
    const size_t tstep = 2 * hstep;
    const unsigned lds0 = (unsigned)(uintptr_t)lds;
    const unsigned ldsw = (unsigned)wid * 1024u;
    const int fcol = FP8 ? 32 * (fq >> 1) + 16 * (fq & 1) : fq * 8;
    const int aoff = lds_byte(wr * 64 + fr, fcol), boff = lds_byte(wc * 32 + fr, fcol);
#define PG8_SA(b, h) (((b) * 2 + (h)) * HTB)
#define PG8_SB(b, h) ((4 + (b) * 2 + (h)) * HTB)
#define PG8_STAGE(bufoff, gbase, voff) do { _Pragma("unroll") for (int _i = 0; _i < 2; ++_i) { unsigned keep_; \
        asm volatile("s_mov_b32 %0, m0\n\ts_mov_b32 m0, %3\n\ts_nop 4\n\tglobal_load_lds_dwordx4 %1, %2\n\ts_mov_b32 m0, %0" : "=&s"(keep_) : "v"((voff)[_i]), "s"((const char*)(gbase)), \
                     "s"((unsigned)__builtin_amdgcn_readfirstlane((int)(lds0 + (unsigned)(bufoff) + ldsw + (unsigned)(_i * 8192)))) : "memory"); } } while (0)
#define PG8_LDA(dst, b, h) do { _Pragma("unroll") for (int m = 0; m < 4; ++m) ld_frag<FP8>(dst[m], lds + PG8_SA(b, h) + aoff + m * 2048); } while (0)
#define PG8_LDB(dst, b, h) do { _Pragma("unroll") for (int n = 0; n < 2; ++n) ld_frag<FP8>(dst[n], lds + PG8_SB(b, h) + boff + n * 2048); } while (0)
#define PG8_MMA(ai, bj, At, Bt) do { __builtin_amdgcn_s_setprio(1); _Pragma("unroll") for (int m = 0; m < 4; ++m) _Pragma("unroll") for (int n = 0; n < 2; ++n) \
        mma_frag<FP8>(acc[ai][bj][m][n], Bt[n], At[m]); __builtin_amdgcn_s_setprio(0); } while (0)
#define PG8_WAIT_V(n) asm volatile("s_waitcnt vmcnt(" #n ")" ::: "memory")
#define PG8_WAIT_L(n) asm volatile("s_waitcnt lgkmcnt(" #n ")" ::: "memory")
#define PG8_BAR __builtin_amdgcn_s_barrier()
#define PG8_SCHED __builtin_amdgcn_sched_barrier(0)
    Unit cur, nxt; int ui = 0;
    if (!S.next(0, cur)) return;
    f32x4 acc[2][2][4][2];
#pragma unroll
    for (int a = 0; a < 2; ++a)
#pragma unroll
        for (int b = 0; b < 2; ++b)
#pragma unroll
            for (int m = 0; m < 4; ++m)
#pragma unroll
                for (int n = 0; n < 2; ++n) acc[a][b][m][n] = (f32x4){0.f, 0.f, 0.f, 0.f};
    typename FragSel<FP8>::type At[4], B0[2], B1[2];
    const char* cA = (const char*)g.A + (size_t)cur.pm * tstep; const char* cB = (const char*)g.Bt + (size_t)cur.pn * tstep;
    S.a_ready(cur);
    if constexpr (SP2) {
        PG8_STAGE(PG8_SB(0, 0), cB, voffB); PG8_STAGE(PG8_SB(0, 1), cB + hstep, voffB); PG8_STAGE(PG8_SA(0, 0), cA, voffA); PG8_STAGE(PG8_SA(0, 1), cA + hstep, voffA);
        if (wr == 1) PG8_BAR;
        PG8_WAIT_V(2); PG8_BAR;
        PG8_STAGE(PG8_SB(1, 0), cB + kstep, voffB); PG8_STAGE(PG8_SA(1, 0), cA + kstep, voffA); PG8_STAGE(PG8_SB(1, 1), cB + hstep + kstep, voffB);
        PG8_WAIT_V(6); PG8_BAR;
    } else {
        PG8_STAGE(PG8_SB(0, 0), cB, voffB); PG8_STAGE(PG8_SA(0, 0), cA, voffA); PG8_STAGE(PG8_SB(0, 1), cB + hstep, voffB); PG8_STAGE(PG8_SA(0, 1), cA + hstep, voffA);
        if (wr == 1) PG8_BAR;
        PG8_WAIT_V(4); PG8_BAR;
        PG8_STAGE(PG8_SB(1, 0), cB + kstep, voffB); PG8_STAGE(PG8_SA(1, 0), cA + kstep, voffA); PG8_STAGE(PG8_SB(1, 1), cB + hstep + kstep, voffB);
        PG8_WAIT_V(6); PG8_BAR;
    }
    for (;;) {
        const bool has_next = S.next(ui + 1, nxt);
        const char* nA = has_next ? (const char*)g.A + (size_t)nxt.pm * tstep : cA; const char* nB = has_next ? (const char*)g.Bt + (size_t)nxt.pn * tstep : cB;
        for (int t = 0; t < nt; t += 2) {
            const bool last = (t == nt - 2);
            if constexpr (Epi::HAS_MID) { if (t == nt / 2) E.mid(acc, cur, wr, wc, fr, fq); }
            const char* a1 = cA + (size_t)(t + 1) * kstep;
            const char* a2 = last ? nA : cA + (size_t)(t + 2) * kstep; const char* b2 = last ? nB : cB + (size_t)(t + 2) * kstep;
            const char* a3 = a2 + kstep; const char* b3 = b2 + kstep;
            if (last && has_next) S.a_ready(nxt);
            if constexpr (SP2) {
            PG8_LDB(B0, 0, 0); PG8_LDB(B1, 0, 1); PG8_SCHED; PG8_LDA(At, 0, 0); PG8_STAGE(PG8_SA(1, 1), a1 + hstep, voffA);
            PG8_WAIT_V(8); PG8_WAIT_L(0); PG8_BAR; PG8_MMA(0, 0, At, B0); PG8_MMA(0, 1, At, B1); PG8_BAR; PG8_SCHED;
            PG8_LDA(At, 0, 1); PG8_STAGE(PG8_SB(0, 0), b2, voffB); PG8_STAGE(PG8_SB(0, 1), b2 + hstep, voffB); PG8_STAGE(PG8_SA(0, 0), a2, voffA);
            PG8_WAIT_V(8); PG8_WAIT_L(0); PG8_BAR; PG8_MMA(1, 0, At, B0); PG8_MMA(1, 1, At, B1); PG8_BAR; PG8_SCHED;
            PG8_LDB(B0, 1, 0); PG8_LDB(B1, 1, 1); PG8_SCHED; PG8_LDA(At, 1, 0); PG8_STAGE(PG8_SA(0, 1), a2 + hstep, voffA);
            PG8_WAIT_V(8); PG8_WAIT_L(0); PG8_BAR; PG8_MMA(0, 0, At, B0); PG8_MMA(0, 1, At, B1); PG8_BAR; PG8_SCHED;
            PG8_LDA(At, 1, 1); PG8_STAGE(PG8_SB(1, 0), b3, voffB); PG8_STAGE(PG8_SB(1, 1), b3 + hstep, voffB); PG8_STAGE(PG8_SA(1, 0), a3, voffA);
            PG8_WAIT_V(8); PG8_WAIT_L(0); PG8_BAR; PG8_MMA(1, 0, At, B0); PG8_MMA(1, 1, At, B1); PG8_BAR; PG8_SCHED;
            } else {
            PG8_LDB(B0, 0, 0); PG8_SCHED; PG8_LDA(At, 0, 0); PG8_STAGE(PG8_SA(1, 1), a1 + hstep, voffA);
            PG8_WAIT_L(8); PG8_BAR; PG8_WAIT_L(0); PG8_MMA(0, 0, At, B0); PG8_BAR; PG8_SCHED;
            PG8_LDB(B1, 0, 1); PG8_STAGE(PG8_SB(0, 0), b2, voffB);
            PG8_BAR; PG8_WAIT_L(0); PG8_MMA(0, 1, At, B1); PG8_BAR;
            PG8_LDA(At, 0, 1); PG8_STAGE(PG8_SA(0, 0), a2, voffA);
            PG8_BAR; PG8_WAIT_L(0); PG8_MMA(1, 0, At, B0); PG8_BAR; PG8_SCHED;
            PG8_STAGE(PG8_SB(0, 1), b2 + hstep, voffB);
            PG8_WAIT_V(6); PG8_BAR; PG8_MMA(1, 1, At, B1); PG8_BAR;
            PG8_LDB(B0, 1, 0); PG8_SCHED; PG8_LDA(At, 1, 0); PG8_STAGE(PG8_SA(0, 1), a2 + hstep, voffA);
            PG8_WAIT_L(8); PG8_BAR; PG8_WAIT_L(0); PG8_MMA(0, 0, At, B0); PG8_BAR; PG8_SCHED;
            PG8_LDB(B1, 1, 1); PG8_STAGE(PG8_SB(1, 0), b3, voffB);
            PG8_BAR; PG8_WAIT_L(0); PG8_MMA(0, 1, At, B1); PG8_BAR;
            PG8_LDA(At, 1, 1); PG8_STAGE(PG8_SA(1, 0), a3, voffA);
            PG8_BAR; PG8_WAIT_L(0); PG8_MMA(1, 0, At, B0); PG8_BAR; PG8_SCHED;
            PG8_STAGE(PG8_SB(1, 1), b3 + hstep, voffB);
            PG8_WAIT_V(6); PG8_BAR; PG8_MMA(1, 1, At, B1); PG8_BAR;
            }
        }
        if constexpr (ALIGN_EPI) { if (wr == 0) PG8_BAR; }
        if constexpr (!Epi::AFTER_DRAIN) { E(acc, cur, wr, wc, fr, fq); S.done(cur); }
        if (!has_next) break;
#pragma unroll
        for (int a = 0; a < 2; ++a)
#pragma unroll
            for (int b = 0; b < 2; ++b)
#pragma unroll
                for (int m = 0; m < 4; ++m)
#pragma unroll
                    for (int n = 0; n < 2; ++n) acc[a][b][m][n] = (f32x4){0.f, 0.f, 0.f, 0.f};
        cur = nxt; cA = nA; cB = nB; ++ui;
        if constexpr (ALIGN_EPI) { if (wr == 1) PG8_BAR; }
    }
    PG8_WAIT_V(0);
    if constexpr (!ALIGN_EPI) { if (wr == 0) PG8_BAR; }
    PG8_BAR;
    if constexpr (Epi::AFTER_DRAIN) { E.fused(acc, cur, wr, wc, fr, fq, lds, wid, lane); S.done(cur); }
#undef PG8_SA
#undef PG8_SB
#undef PG8_STAGE
#undef PG8_LDA
#undef PG8_LDB
#undef PG8_MMA
#undef PG8_WAIT_V
#undef PG8_WAIT_L
#undef PG8_BAR
#undef PG8_SCHED
}
}

#ifndef PG8_SP2
#define PG8_SP2 true
#endif
#ifndef PG8_ALIGN
#define PG8_ALIGN true
#endif
#include <hip/hip_bf16.h>
#include <cmath>
namespace attn_body {
using bf16=__hip_bfloat16;
using bf16x8=__attribute__((ext_vector_type(8)))short;
using s16x4=__attribute__((ext_vector_type(4)))short;
using f32x16=__attribute__((ext_vector_type(16)))float;
using u32x4=__attribute__((ext_vector_type(4)))unsigned;
constexpr int BATCH=8,NHEAD=16,SEQ=2048,D=64,DM=NHEAD*D;
constexpr int NW=8,QBLK=32,QB=QBLK*NW,KVBLK=64,NQB=SEQ/QB;
constexpr int ATTN_PITCH=DM, ATTN_UNIT_ROWS=QB;
__device__ __forceinline__ int crow(int r,int hi){return (r&3)+8*(r>>2)+4*hi;}
#define SBAR() __builtin_amdgcn_sched_barrier(0)
__device__ __forceinline__ void cmask(f32x16&p0,f32x16&p1,int jb,int qrel,int hi){
  const float NEG=-INFINITY; int kb=64*jb+4*hi;
  #pragma unroll
  for(int r=0;r<16;++r){int kv=kb+(r&3)+8*(r>>2); if(kv>qrel)p0[r]=NEG; if(kv+32>qrel)p1[r]=NEG;}
}

constexpr int NSLOT=3, SLOTB=8192, VD=128;
constexpr int LDS_K=0, LDS_V=NSLOT*SLOTB, LDS_WS=3*NSLOT*SLOTB, LDS_OST=LDS_WS+NW*64*4, LDS_BYTES=LDS_OST+NW*8192;
constexpr float C2=0.125f*1.4426950408889634f;
__device__ __forceinline__ void glds16(const void*gsrc,unsigned lds_dst){unsigned keep;
  asm volatile("s_mov_b32 %0, m0\n\ts_mov_b32 m0, %2\n\ts_nop 0\n\tglobal_load_lds_dwordx4 %1, off\n\ts_mov_b32 m0, %0":"=&s"(keep):"v"(gsrc),"s"(lds_dst):"memory");}
__device__ __forceinline__ void glds16o(const void*sbase,unsigned voff,unsigned lds_dst){unsigned keep;
  asm volatile("s_mov_b32 %0, m0\n\ts_mov_b32 m0, %3\n\ts_nop 4\n\tglobal_load_lds_dwordx4 %1, %2\n\ts_mov_b32 m0, %0":"=&s"(keep):"v"(voff),"s"(sbase),"s"(lds_dst):"memory");}
__device__ __forceinline__ float max3f(float a,float b,float c){float r;asm("v_max3_f32 %0, %1, %2, %3":"=v"(r):"v"(a),"v"(b),"v"(c));return r;}
__device__ __forceinline__ float max2f(float a,float b){float r;asm("v_max_f32_e32 %0, %1, %2":"=v"(r):"v"(a),"v"(b));return r;}
__device__ __forceinline__ float fadd_s(float a,float b){float r;asm("v_add_f32_e32 %0, %1, %2":"=v"(r):"v"(a),"v"(b));return r;}
__device__ __forceinline__ float fsub_s(float a,float b){float r;asm("v_sub_f32_e32 %0, %1, %2":"=v"(r):"v"(a),"v"(b));return r;}
typedef float f32x2_t __attribute__((ext_vector_type(2))); typedef __bf16 bf16x2_t __attribute__((ext_vector_type(2)));
__device__ __forceinline__ unsigned cvtpk_s(float lo,float hi){f32x2_t v={lo,hi};bf16x2_t b=__builtin_convertvector(v,bf16x2_t);return __builtin_bit_cast(unsigned,b);}
#define WAIT_BAR(N) asm volatile("s_waitcnt vmcnt(" #N ") lgkmcnt(0)\n\ts_barrier":::"memory")

__device__ __forceinline__ void qkt(f32x16&p0,f32x16&p1,const char*Kslot,const bf16x8*qr,int r32,int hi){
  const char*kb=Kslot+hi*1024+r32*16;
  #pragma unroll
  for(int d0=0;d0<4;++d0){
    const bf16x8 b0=*reinterpret_cast<const bf16x8*>(kb+d0*2048);
    const bf16x8 b1=*reinterpret_cast<const bf16x8*>(kb+d0*2048+512);
    {p0=__builtin_amdgcn_mfma_f32_32x32x16_bf16(b0,qr[d0],p0,0,0,0);p1=__builtin_amdgcn_mfma_f32_32x32x16_bf16(b1,qr[d0],p1,0,0,0);}}
}
typedef __attribute__((address_space(3))) const char* lds_cptr;
typedef short v4i16_t __attribute__((ext_vector_type(4)));
__device__ __forceinline__ void kload8(bf16x8*kf,lds_cptr kp){
  kf[0]=*(const __attribute__((address_space(3))) bf16x8*)(kp);      kf[1]=*(const __attribute__((address_space(3))) bf16x8*)(kp+512);
  kf[2]=*(const __attribute__((address_space(3))) bf16x8*)(kp+2048); kf[3]=*(const __attribute__((address_space(3))) bf16x8*)(kp+2560);
  kf[4]=*(const __attribute__((address_space(3))) bf16x8*)(kp+4096); kf[5]=*(const __attribute__((address_space(3))) bf16x8*)(kp+4608);
  kf[6]=*(const __attribute__((address_space(3))) bf16x8*)(kp+6144); kf[7]=*(const __attribute__((address_space(3))) bf16x8*)(kp+6656);
}
__device__ __forceinline__ void kload2(bf16x8*kf,lds_cptr kp,int j){ kf[2*j]=*(const __attribute__((address_space(3))) bf16x8*)(kp+j*2048); kf[2*j+1]=*(const __attribute__((address_space(3))) bf16x8*)(kp+j*2048+512); }
__device__ __forceinline__ s16x4 vtr(lds_cptr p){ return __builtin_bit_cast(s16x4,__builtin_amdgcn_ds_read_tr16_b64_v4i16((__attribute__((address_space(3))) v4i16_t*)p)); }
__device__ __forceinline__ float rowmax(const f32x16&p0,const f32x16&p1){
  float a=max3f(p0[0],p0[1],p1[0]),b=max3f(p0[2],p0[3],p1[1]);a=max3f(a,p1[2],p1[3]);
  #pragma unroll
  for(int r=4;r<16;r+=4){a=max3f(a,p0[r],p0[r+1]);b=max3f(b,p0[r+2],p0[r+3]);a=max3f(a,p1[r],p1[r+1]);b=max3f(b,p1[r+2],p1[r+3]);}
  const float m=max2f(a,b);
  auto rr=__builtin_amdgcn_permlane32_swap(__float_as_uint(m),__float_as_uint(m),false,false);
  return max2f(__uint_as_float(rr[0]),__uint_as_float(rr[1]));
}
__device__ __forceinline__ void pv(f32x16*o,int vb,bf16x8 pa0,bf16x8 pa1,bf16x8 pa2,bf16x8 pa3){
  #pragma unroll
  for(int d0=0;d0<4;++d0){s16x4 lo[4],hi[4];
    #pragma unroll
    for(int ks=0;ks<4;++ks){
      asm volatile("ds_read_b64_tr_b16 %0,%1 offset:%c2":"=&v"(lo[ks]):"v"(vb),"i"(d0*4096+ks*1024):"memory");
      asm volatile("ds_read_b64_tr_b16 %0,%1 offset:%c2":"=&v"(hi[ks]):"v"(vb),"i"(d0*4096+ks*1024+512):"memory");}
    asm volatile("s_waitcnt lgkmcnt(0)":::"memory");SBAR();
    #define PK(k) (bf16x8){lo[k][0],lo[k][1],lo[k][2],lo[k][3],hi[k][0],hi[k][1],hi[k][2],hi[k][3]}
    o[d0]=__builtin_amdgcn_mfma_f32_32x32x16_bf16(pa0,PK(0),o[d0],0,0,0);
    o[d0]=__builtin_amdgcn_mfma_f32_32x32x16_bf16(pa1,PK(1),o[d0],0,0,0);
    o[d0]=__builtin_amdgcn_mfma_f32_32x32x16_bf16(pa2,PK(2),o[d0],0,0,0);
    o[d0]=__builtin_amdgcn_mfma_f32_32x32x16_bf16(pa3,PK(3),o[d0],0,0,0);
    #undef PK
  }
}

#ifndef ATTN_STORE16
#define ATTN_STORE16(p,v) (*(u32x4*)(p)=(v))
#endif
template<int THRL> __device__ __forceinline__ void attn_unit(int b,int hq,int hh,int qb,float slope2,const bf16*Q,const bf16*__restrict__ K,const bf16*__restrict__ V,bf16*O,char*shm,
    bool fuse,float lam,float osc,const bf16*GA,const float*sg,bf16*AR){
  int tid_=threadIdx.x; asm volatile("":"+v"(tid_)); const int tid=tid_,lane=tid&63,r32=lane&31,hi=lane>>5; const int wid=__builtin_amdgcn_readfirstlane(tid>>6);
  const long rowbase=(long)b*SEQ; const int q0=qb*QB;
  const bf16*Qw=Q+(rowbase+q0+wid*QBLK)*DM+hq*D;
  const bf16*Kh=K+rowbase*DM+hq*D,*Vh=V+rowbase*DM+hh*VD;
  const unsigned lds0=(unsigned)(uintptr_t)shm;
  float*wsf=(float*)(shm+LDS_WS)+wid*64;
  const unsigned koff=(unsigned)((lane*DM+wid*8)*2);
  const unsigned voff=(unsigned)(((16*(wid&3)+(lane>>2))*DM+(wid>>2)*32+(lane&3)*8)*2);
  const unsigned kdst=lds0+LDS_K+wid*1024, vdst=lds0+LDS_V+wid*1024;
  #define DMA_K(t,slot) glds16o(Kh+(long)(t)*KVBLK*DM,koff,(unsigned)__builtin_amdgcn_readfirstlane(kdst+(slot)))
  #define DMA_V(t,slot) do{ glds16o(Vh+(long)(t)*KVBLK*DM,voff,(unsigned)__builtin_amdgcn_readfirstlane(vdst+2*(slot))); glds16o(Vh+(long)(t)*KVBLK*DM+64,voff,(unsigned)__builtin_amdgcn_readfirstlane(vdst+2*(slot)+8192)); }while(0)
  const int vb0=(int)(lds0+LDS_V)+((lane>>4)&1)*32+(lane&3)*8+(4*hi+((lane&15)>>2))*64;
  const char*Kbase=shm+LDS_K; bf16x8 kf[8];
  const lds_cptr shm3=(lds_cptr)shm; const lds_cptr kp0=shm3+LDS_K+hi*1024+r32*16; const lds_cptr vp0=shm3+LDS_V+((lane>>4)&1)*32+(lane&3)*8+(4*hi+((lane&15)>>2))*64;
  const int NT=(q0+QB)/KVBLK;
  DMA_K(0,0);DMA_V(0,0);DMA_K(1,SLOTB);
  bf16x8 qr[4];
  #pragma unroll
  for(int d0=0;d0<4;++d0)qr[d0]=*reinterpret_cast<const bf16x8*>(&Qw[(long)r32*DM+d0*16+hi*8]);
  float l_reg=0.f;f32x16 o[4];o[0]=f32x16{};o[1]=f32x16{};o[2]=f32x16{};o[3]=f32x16{};
  float nb=slope2*(float)(4*hi-q0-255); const float sl64=64.f*slope2;
  #define BINIT0(C0,t) do{ _Pragma("unroll") for(int r=0;r<16;++r)C0[r]=fmaf(slope2,(float)((r&3)+8*(r>>2)),nb); }while(0)
  #define BINIT1(C1,t) do{ _Pragma("unroll") for(int r=0;r<16;++r)C1[r]=fmaf(slope2,(float)((r&3)+8*(r>>2)+32),nb); nb+=sl64; }while(0)
  const int qrel=wid*QBLK+r32;
  #define CMASK(P0,P1,t) do{int jb_=(t)-(NT-4); if(jb_>=0)cmask(P0,P1,jb_,qrel,hi);}while(0)
  bool resc=false;
  #define START(P0,P1) do{ const float rm=rowmax(P0,P1); resc=false; \
    { const float dl=rm; nb=fsub_s(nb,dl); \
      _Pragma("unroll") for(int r=0;r<16;++r){P0[r]=fsub_s(P0[r],dl);P1[r]=fsub_s(P1[r],dl);} } \
    _Pragma("unroll") for(int r=0;r<16;++r)P0[r]=__builtin_amdgcn_exp2f(P0[r]); }while(0)
  #define RESC() do{ if(resc){ asm volatile("s_waitcnt lgkmcnt(0)":::"memory"); \
      _Pragma("unroll") for(int d_=0;d_<4;++d_) _Pragma("unroll") for(int r=0;r<16;++r)o[d_][r]*=wsf[crow(r,hi)]; } }while(0)
  f32x16 pA0,pA1,pB0,pB1;
  int sl_prev=0,sl_cur=0,sl_next=SLOTB;
  #define ROT() do{sl_prev=sl_cur;sl_cur=sl_next;sl_next=(sl_next==(NSLOT-1)*SLOTB)?0:sl_next+SLOTB;}while(0)
  DMA_K(2,2*SLOTB);
  WAIT_BAR(3);
  asm volatile("":"+v"(nb));
  BINIT0(pA0,0);BINIT1(pA1,0);qkt(pA0,pA1,Kbase,qr,r32,hi);asm volatile("s_nop 15\n\ts_nop 7":"+v"(pA0),"+v"(pA1));CMASK(pA0,pA1,0);
  START(pA0,pA1);
  _Pragma("unroll") for(int r=0;r<16;++r)pA1[r]=__builtin_amdgcn_exp2f(pA1[r]);
  WAIT_BAR(0);
  DMA_K(3,0);DMA_V(1,SLOTB);
  ROT();
  kload8(kf,kp0+sl_cur);
  WAIT_BAR(3);
  s16x4 vlo[16],vhi[16]; u32x4 pw0,pw1,pw2,pw3;
  #define PKW(P,B) cvtpk_s(P[B],P[B+1])
  #define PAF(k) __builtin_bit_cast(bf16x8,pw##k)
  #define VFR(i) (bf16x8){vlo[i][0],vlo[i][1],vlo[i][2],vlo[i][3],vhi[i][0],vhi[i][1],vhi[i][2],vhi[i][3]}
  #define PIN(x) asm volatile("":"+v"(x))
  #define MX3(a,b,c) __builtin_fmaxf(__builtin_fmaxf((a),(b)),(c))
  #define GAPA(MF,A0,A1,A2,A3,W0,W1,PW) do{ MF; sacc+=A0; sacc+=A1; sacc+=A2; sacc+=A3; PIN(sacc); W0; W1; PIN(PW); SBAR(); }while(0)
  #define EX(v) __builtin_amdgcn_exp2f(v)
  #define VRD(j) do{ vlo[j]=vtr(vp_+(((j)&3)*4096+((j)>>2)*1024)); vhi[j]=vtr(vp_+(((j)&3)*4096+((j)>>2)*1024+512)); }while(0)
  #define GAPB(j,k,X,B) do{ asm volatile("s_waitcnt lgkmcnt(0)":::"memory"); SBAR(); o[(j)&3]=__builtin_amdgcn_mfma_f32_32x32x16_bf16(PAF(k),VFR(j),o[(j)&3],0,0,0); X[B]=EX(X[B]); X[B+1]=EX(X[B+1]); PIN(X); if((j)+4<16){VRD(((j)+4)&15);} SBAR(); }while(0)
  #define GAPB1(j,k,X,B) do{ asm volatile("s_waitcnt lgkmcnt(0)":::"memory"); SBAR(); o[(j)&3]=__builtin_amdgcn_mfma_f32_32x32x16_bf16(PAF(k),VFR(j),o[(j)&3],0,0,0); X[B]=EX(X[B]); X[B+1]=EX(X[B+1]); X[B+2]=EX(X[B+2]); X[B+3]=EX(X[B+3]); PIN(X); if((j)+4<8){VRD(((j)+4)&15);} SBAR(); }while(0)
  #define GAPB2(j,k) do{ o[(j)&3]=__builtin_amdgcn_mfma_f32_32x32x16_bf16(PAF(k),VFR(j),o[(j)&3],0,0,0); if((j)+4<16){VRD(((j)+4)&15);} SBAR(); }while(0)
  #define KRD(G,j) do{ if(G){ kload2(kf,kp0+sl_next,j); SBAR(); } }while(0)
  #define STEP(C0,C1,P0,P1,t,GK,GV,GL) do{ SBAR(); \
    const lds_cptr vp_=vp0+2*sl_prev; \
    BINIT0(C0,t); PIN(C0); SBAR(); float sacc=(P0[0]+P0[1]); \
    GAPA(C0=__builtin_amdgcn_mfma_f32_32x32x16_bf16(kf[0],qr[0],C0,0,0,0), P0[2],P0[3],P0[4],P0[5],     pw0[0]=PKW(P0,0), pw0[1]=PKW(P0,2), pw0); \
    BINIT1(C1,t); PIN(C1); SBAR(); GAPA(C1=__builtin_amdgcn_mfma_f32_32x32x16_bf16(kf[1],qr[0],C1,0,0,0), P0[6],P0[7],P0[8],P0[9],     pw0[2]=PKW(P0,4), pw0[3]=PKW(P0,6), pw0); \
    GAPA(C0=__builtin_amdgcn_mfma_f32_32x32x16_bf16(kf[2],qr[1],C0,0,0,0),   P0[10],P0[11],P0[12],P0[13], pw1[0]=PKW(P0,8), pw1[1]=PKW(P0,10), pw1); \
    GAPA(C1=__builtin_amdgcn_mfma_f32_32x32x16_bf16(kf[3],qr[1],C1,0,0,0),   P0[14],P0[15],P1[0],P1[1],   pw1[2]=PKW(P0,12),pw1[3]=PKW(P0,14), pw1); \
    VRD(0); SBAR(); GAPA(C0=__builtin_amdgcn_mfma_f32_32x32x16_bf16(kf[4],qr[2],C0,0,0,0),   P1[2],P1[3],P1[4],P1[5],     pw2[0]=PKW(P1,0), pw2[1]=PKW(P1,2), pw2); \
    VRD(1); SBAR(); GAPA(C1=__builtin_amdgcn_mfma_f32_32x32x16_bf16(kf[5],qr[2],C1,0,0,0),   P1[6],P1[7],P1[8],P1[9],     pw2[2]=PKW(P1,4), pw2[3]=PKW(P1,6), pw2); \
    VRD(2); SBAR(); GAPA(C0=__builtin_amdgcn_mfma_f32_32x32x16_bf16(kf[6],qr[3],C0,0,0,0),   P1[10],P1[11],P1[12],P1[13], pw3[0]=PKW(P1,8), pw3[1]=PKW(P1,10), pw3); \
    VRD(3); SBAR(); GAPA(C1=__builtin_amdgcn_mfma_f32_32x32x16_bf16(kf[7],qr[3],C1,0,0,0),   P1[14],P1[15],0.f,0.f,       pw3[2]=PKW(P1,12),pw3[3]=PKW(P1,14), pw3); \
    l_reg+=sacc; \
    if(GK){DMA_K((t)+3,sl_cur);} if(GV){DMA_V((t)+1,sl_next);} \
    CMASK(C0,C1,t); \
    { float a=MX3(C0[0],C0[1],C1[0]),b=MX3(C0[2],C0[3],C1[1]); a=MX3(a,C1[2],C1[3]); \
      _Pragma("unroll") for(int r=4;r<16;r+=4){a=MX3(a,C0[r],C0[r+1]);b=MX3(b,C0[r+2],C0[r+3]);a=MX3(a,C1[r],C1[r+1]);b=MX3(b,C1[r+2],C1[r+3]);} \
      float rm=__builtin_fmaxf(a,b); { auto rr=__builtin_amdgcn_permlane32_swap(__float_as_uint(rm),__float_as_uint(rm),false,false); rm=__builtin_fmaxf(__uint_as_float(rr[0]),__uint_as_float(rr[1])); } \
      resc=false; \
      if(__builtin_expect(__any(rm>(float)THRL),0)){ const float dl=__builtin_fmaxf(rm,0.f); nb-=dl; \
        _Pragma("unroll") for(int r=0;r<16;++r){C0[r]-=dl;C1[r]-=dl;} \
        const float f=__builtin_amdgcn_exp2f(-dl); l_reg*=f; if(hi==0)wsf[r32]=f; resc=true; } } \
    SBAR(); \
    GAPB1(0,0,C0,0); GAPB1(1,0,C0,4); GAPB1(2,0,C0,8); GAPB1(3,0,C0,12); \
    GAPB1(4,1,C1,0); GAPB1(5,1,C1,4); GAPB1(6,1,C1,8); GAPB1(7,1,C1,12); \
    asm volatile("s_waitcnt lgkmcnt(0)":::"memory"); SBAR(); VRD(8); VRD(9); VRD(10); VRD(11); SBAR(); \
    KRD(GL,0); GAPB2(8,2); GAPB2(9,2); KRD(GL,1); GAPB2(10,2); GAPB2(11,2); \
    KRD(GL,2); GAPB2(12,3); GAPB2(13,3); KRD(GL,3); GAPB2(14,3); GAPB2(15,3); \
    }while(0)
  int t=1;
  #undef CMASK
  #define CMASK(P0,P1,t) do{}while(0)
  for(;t+5<NT;t+=2){
    STEP(pB0,pB1,pA0,pA1,t,true,true,true);     WAIT_BAR(3); RESC(); ROT();
    STEP(pA0,pA1,pB0,pB1,t+1,true,true,true);   WAIT_BAR(3); RESC(); ROT();
  }
  #undef CMASK
  #define CMASK(P0,P1,t) do{int jb_=(t)-(NT-4); if(jb_>=0)cmask(P0,P1,jb_,qrel,hi);}while(0)
  #define ENDW(tt) do{ if((tt)+3<NT){WAIT_BAR(3);} else if((tt)+2<NT){WAIT_BAR(2);} else {WAIT_BAR(0);} }while(0)
  for(;t+1<NT;t+=2){
    STEP(pB0,pB1,pA0,pA1,t,(t+3<NT),(t+1<NT),(t+1<NT));       ENDW(t);   RESC(); ROT();
    STEP(pA0,pA1,pB0,pB1,t+1,(t+4<NT),(t+2<NT),(t+2<NT));     ENDW(t+1); RESC(); ROT();
  }
  STEP(pB0,pB1,pA0,pA1,NT-1,false,false,false); RESC();
  { float sacc=pB0[0]+pB0[1]; _Pragma("unroll") for(int r=2;r<16;++r)sacc+=pB0[r]; _Pragma("unroll") for(int r=0;r<16;++r)sacc+=pB1[r]; l_reg+=sacc;
    pw0=(u32x4){PKW(pB0,0),PKW(pB0,2),PKW(pB0,4),PKW(pB0,6)};pw1=(u32x4){PKW(pB0,8),PKW(pB0,10),PKW(pB0,12),PKW(pB0,14)};pw2=(u32x4){PKW(pB1,0),PKW(pB1,2),PKW(pB1,4),PKW(pB1,6)};pw3=(u32x4){PKW(pB1,8),PKW(pB1,10),PKW(pB1,12),PKW(pB1,14)};
    SBAR(); pv(o,vb0+2*sl_cur,PAF(0),PAF(1),PAF(2),PAF(3)); }
  #undef PKW
  #undef PAF
  #undef VFR
  #undef PIN
  #undef MX3
  #undef GAPA
  #undef GAPB
  #undef EX
  #undef VRD
  #undef KRD
  #undef STEP
  #undef ENDW
  {auto rr=__builtin_amdgcn_permlane32_swap(__float_as_uint(l_reg),__float_as_uint(l_reg),false,false);l_reg=__uint_as_float(rr[0])+__uint_as_float(rr[1]);}
  if(hi==0)wsf[32+r32]=l_reg;asm volatile("s_waitcnt lgkmcnt(0)":::"memory");
  float rli[16];
  #pragma unroll
  for(int r=0;r<16;++r)rli[r]=__builtin_amdgcn_rcpf(wsf[32+crow(r,hi)]);
  bf16*Ow=O+(rowbase+q0+wid*QBLK)*DM+hh*VD;
  { bf16*stg=(bf16*)(shm+LDS_OST)+wid*4096;
    #pragma unroll
    for(int r=0;r<16;++r){const int orow=crow(r,hi);
      #pragma unroll
      for(int d0=0;d0<4;++d0)stg[orow*128+d0*32+r32]=__float2bfloat16(o[d0][r]*rli[r]);}
    asm volatile("s_waitcnt lgkmcnt(0)":::"memory");
    if(!fuse){
    #pragma unroll
    for(int i=0;i<8;++i){const int row=i*4+(lane>>4),ch=lane&15; const u32x4 v=*(const u32x4*)(stg+row*128+ch*8); ATTN_STORE16(Ow+(long)row*DM+ch*8,v);} }
    else{
      asm volatile("s_waitcnt vmcnt(0)":::"memory");
      const bf16*GAw=GA+(rowbase+q0+wid*QBLK)*DM+hh*VD; bf16*ARw=AR+(rowbase+q0+wid*QBLK)*(2*DM)+hh*VD; const int ch=lane&15;
      float sgv[8];
      #pragma unroll
      for(int j=0;j<8;++j)sgv[j]=sg[ch*8+j]*osc;
      #pragma unroll 2
      for(int i=0;i<8;++i){const int row=i*4+(lane>>4);
        const bf16x8 o2=*(const bf16x8*)(stg+row*128+ch*8), o1=*(const bf16x8*)(Ow+(long)row*DM+ch*8), ga=*(const bf16x8*)(GAw+(long)row*DM+ch*8);
        float d[8]; float ss=0.f;
        #pragma unroll
        for(int j=0;j<8;++j){ d[j]=__uint_as_float(((unsigned)(unsigned short)o1[j])<<16)-lam*__uint_as_float(((unsigned)(unsigned short)o2[j])<<16); ss+=d[j]*d[j]; }
        ss+=__int_as_float(__builtin_amdgcn_ds_swizzle(__float_as_int(ss),0x041f)); ss+=__int_as_float(__builtin_amdgcn_ds_swizzle(__float_as_int(ss),0x081f));
        ss+=__int_as_float(__builtin_amdgcn_ds_swizzle(__float_as_int(ss),0x101f)); ss+=__int_as_float(__builtin_amdgcn_ds_swizzle(__float_as_int(ss),0x201f));
        const float rn=1.0f/sqrtf(ss*(1.f/128.f)+1e-5f);
        u32x4 w;
        #pragma unroll
        for(int j2=0;j2<4;++j2){ const float g0=__uint_as_float(((unsigned)(unsigned short)ga[2*j2])<<16), g1=__uint_as_float(((unsigned)(unsigned short)ga[2*j2+1])<<16);
          w[j2]=cvtpk_s(d[2*j2]*rn*sgv[2*j2]*(g0/(1.f+__expf(-g0))), d[2*j2+1]*rn*sgv[2*j2+1]*(g1/(1.f+__expf(-g1)))); }
        *(u32x4*)(ARw+(long)row*(2*DM)+ch*8)=w; } } }
  asm volatile("s_waitcnt lgkmcnt(0)\n\ts_barrier":::"memory");
  #undef DMA_K
  #undef DMA_V
  #undef BINIT0
  #undef BINIT1
  #undef CMASK
  #undef START
  #undef RESC
  #undef ROT
}
constexpr int ATTN_LDS_BYTES=LDS_BYTES;
#undef SBAR
#undef WAIT_BAR
}
#define GAS __attribute__((address_space(1)))
#define LAS __attribute__((address_space(3)))
typedef unsigned short bf16;
typedef unsigned v4u __attribute__((ext_vector_type(4)));
typedef float f32x4 __attribute__((ext_vector_type(4)));
typedef short bf16x8 __attribute__((ext_vector_type(8)));
typedef GAS unsigned gu32;
typedef GAS unsigned long long gu64;
#define RLX_AGENT __ATOMIC_RELAXED, __HIP_MEMORY_SCOPE_AGENT
#define LDS_WAIT() asm volatile("s_waitcnt lgkmcnt(0)" ::: "memory")
#define VM_WAIT() asm volatile("s_waitcnt vmcnt(0)" ::: "memory")
__device__ __forceinline__ unsigned long long rt() { return __builtin_amdgcn_s_memrealtime(); }
__device__ __forceinline__ unsigned f2bf(float f) { unsigned u = __builtin_bit_cast(unsigned, f); return (u + 0x7fffu + ((u >> 16) & 1u)) >> 16; }
typedef float f32x2_pk __attribute__((ext_vector_type(2))); typedef __bf16 bf16x2_pk __attribute__((ext_vector_type(2)));
__device__ __forceinline__ unsigned pk2(float lo, float hi) { f32x2_pk v = {lo, hi}; bf16x2_pk b = __builtin_convertvector(v, bf16x2_pk); return __builtin_bit_cast(unsigned, b); }

#define XB_TMO      128
#define XB_XCNT(j)  (256  + 64 * (j))
#define XB_XSUB(j)  (1280 + 64 * (j))
#define XB_XGEN(j)  (2304 + 64 * (j))
#define XB_TOP      3328
#define XB_TOPGEN   3392
#define XCD_BAR_WORDS 3456
#define XB_SPIN_CAP (1u << 18)

__device__ __forceinline__ unsigned xb_ld(unsigned* p)              { return __hip_atomic_load(p, __ATOMIC_RELAXED, __HIP_MEMORY_SCOPE_AGENT); }
__device__ __forceinline__ unsigned xb_add(unsigned* p, unsigned v) { return __hip_atomic_fetch_add(p, v, __ATOMIC_RELAXED, __HIP_MEMORY_SCOPE_AGENT); }
__device__ __forceinline__ unsigned xb_xcc_id() { return (unsigned)__builtin_amdgcn_s_getreg((3 << 11) | 20) & 0xFu; }
#define XB_SPIN(cond, bar) do { unsigned _sp = 0; while (cond) { __builtin_amdgcn_s_sleep(1); \
    if ((++_sp & 255u) == 0u) { if (xb_ld(&(bar)[XB_TMO])) break; if (_sp > XB_SPIN_CAP) { atomicAdd(&(bar)[XB_TMO], 1u); break; } } } } while (0)

struct XcdBarrier {
    unsigned* bar; unsigned x;
    volatile LAS unsigned* st;
};

__device__ __forceinline__ XcdBarrier xcd_barrier_post(unsigned* bar, volatile LAS unsigned* st) {
    XcdBarrier b; b.bar = bar; b.x = xb_xcc_id(); b.st = st;
    if (threadIdx.x == 0) (void)xb_add(&bar[XB_XCNT(b.x)], 1u);
    return b;
}
__device__ __forceinline__ void xcd_barrier_complete(unsigned* bar, unsigned x, unsigned& nloc, unsigned& nx) {
    const unsigned G = gridDim.x * gridDim.y * gridDim.z;
    unsigned sum, cnt, mine, sp = 0u;
    for (;;) {
        sum = 0u; cnt = 0u; mine = 0u;
#pragma unroll
        for (unsigned j = 0; j < 16; ++j) { const unsigned c = xb_ld(&bar[XB_XCNT(j)]); sum += c; cnt += (c > 0u) ? 1u : 0u; mine = (j == x) ? c : mine; }
        if (sum == G) break;
        __builtin_amdgcn_s_sleep(1);
        if ((++sp & 255u) == 0u) { if (xb_ld(&bar[XB_TMO])) break; if (sp > XB_SPIN_CAP) { atomicAdd(&bar[XB_TMO], 1u); break; } }
    }
    nloc = mine > 0u ? mine : 1u; nx = cnt > 0u ? cnt : 1u;
}

__device__ __forceinline__ void xcd_barrier(const XcdBarrier& b) {
    asm volatile("s_waitcnt vmcnt(0)" ::: "memory");
    __syncthreads();
    if (threadIdx.x == 0) {
        unsigned* bar = b.bar;
        __builtin_amdgcn_s_waitcnt(0);
        unsigned nloc = b.st[0], nx = b.st[1];
        if (nloc == 0u) { xcd_barrier_complete(bar, b.x, nloc, nx); b.st[0] = nloc; b.st[1] = nx; }
        const unsigned old = xb_add(&bar[XB_XSUB(b.x)], 1u);
        const unsigned gen = old / nloc;
        if (old + 1u == (gen + 1u) * nloc) {
            __builtin_amdgcn_fence(__ATOMIC_RELEASE, "agent");
            asm volatile("s_waitcnt vmcnt(0)" ::: "memory");
            const unsigned og = xb_add(&bar[XB_TOP], 1u);
            const unsigned tg = og / nx;
            if (og + 1u == (tg + 1u) * nx) xb_add(&bar[XB_TOPGEN], 1u);
            else XB_SPIN(xb_ld(&bar[XB_TOPGEN]) == tg, bar);
            __builtin_amdgcn_fence(__ATOMIC_ACQUIRE, "agent");
            xb_add(&bar[XB_XGEN(b.x)], 1u);
            asm volatile("s_waitcnt vmcnt(0)" ::: "memory");
        } else {
            XB_SPIN(xb_ld(&bar[XB_XGEN(b.x)]) == gen, bar);
            __builtin_amdgcn_fence(__ATOMIC_ACQUIRE, "agent");
            asm volatile("s_waitcnt vmcnt(0)" ::: "memory");
        }
    }
    __syncthreads();
}
constexpr int NWAVES = 8;
constexpr int BATCH = 8, SEQ = 2048, DM = 2048, DEPTH = 2, M = BATCH * SEQ;
constexpr int HEADS = 8, IN_TOTAL = 10240, LRUW = 1024, NBLK = 8, BLKW = 128;
constexpr float LN_EPS = 1e-5f, SUBLN_EPS = 1e-5f, DN_ALPHA = 1.41421356237309515f, LOG2E = 1.4426950408889634f;

constexpr size_t MiB = 1u << 20;
constexpr size_t WS_CTL = 0, CTL_ZERO_BYTES = 1 * MiB;
constexpr size_t WS_GW = 1 * MiB;
constexpr int N_BF = 4096, N_F8 = 6144;
constexpr float W8_SCALE = 64.f;
constexpr size_t WS_WIN = 2 * MiB;
constexpr size_t WS_WG8 = 34 * MiB;
constexpr size_t WS_XQ8 = 66 * MiB;
constexpr size_t WS_WPAB = 98 * MiB;
constexpr size_t WS_WOUT = 114 * MiB;
constexpr size_t WS_XB16 = 130 * MiB;
constexpr size_t WS_O1 = 130 * MiB, WS_MERGED = 130 * MiB;
constexpr size_t WS_STATS = 256 * 1024;
constexpr size_t WS_P6 = 194 * MiB;
constexpr size_t WS_MA = 386 * MiB, WS_MB = 450 * MiB;
constexpr size_t WS_AR = 514 * MiB;
constexpr size_t WS_END = 578 * MiB;
constexpr int CW_TMO = 0, CW_BAR = 4096;

constexpr int RING_OFF = 0, RING_BYTES = 151552;
constexpr int LDSCTL_OFF = RING_BYTES, MISC_OFF = LDSCTL_OFF + 320;
constexpr int LDS_BYTES = 153600;
static_assert(MISC_OFF + 128 <= LDS_BYTES && attn_body::ATTN_LDS_BYTES <= RING_BYTES && pg8::STAGE_BYTES <= RING_BYTES, "LDS map");

struct Frame {
    LAS unsigned char* lds; volatile LAS unsigned* MISC; gu32* ctl;
    int tid, lane, wave, vcu, G;
};
__device__ __forceinline__ float wave_sum(float v, int lane) {
#pragma unroll
    for (int o = 1; o < 64; o <<= 1) v += __int_as_float(__builtin_amdgcn_ds_bpermute((lane ^ o) << 2, __float_as_int(v)));
    return v;
}
__device__ __forceinline__ void p0_transpose_item(const float* W, int ldw, int ncols, bf16* WT, int ldt, int koff, LAS float* scr, int item, int lane) {
    const int nblk = ncols / 32, kb = item / nblk, nb = item % nblk, k0 = 64 * kb, n0 = 32 * nb;
#pragma unroll 8
    for (int i = 0; i < 32; ++i) { const int kk = 2 * i + (lane >> 5); scr[kk * 33 + (lane & 31)] = W[(size_t)(k0 + kk) * ldw + n0 + (lane & 31)]; }
    LDS_WAIT(); asm volatile("" ::: "memory");
    const int c = lane & 7;
#pragma unroll
    for (int j = 0; j < 4; ++j) { const int n = (lane >> 3) + 8 * j; const LAS float* s = scr + (8 * c) * 33 + n;
        v4u o; o.x = pk2(s[0 * 33], s[1 * 33]); o.y = pk2(s[2 * 33], s[3 * 33]); o.z = pk2(s[4 * 33], s[5 * 33]); o.w = pk2(s[6 * 33], s[7 * 33]);
        *(GAS v4u*)(WT + (size_t)(n0 + n) * ldt + koff + k0 + 8 * c) = o; }
    LDS_WAIT(); asm volatile("" ::: "memory");
}
__device__ __forceinline__ unsigned pk4_fp8(float a, float b, float c, float d) { int w = __builtin_amdgcn_cvt_pk_fp8_f32(a, b, 0, false); w = __builtin_amdgcn_cvt_pk_fp8_f32(c, d, w, true); return (unsigned)w; }
__device__ __forceinline__ void p0_transpose_item8(const float* W, int ldw, int ncols, unsigned char* WT8, int ldt, float scale, LAS float* scr, int item, int lane) {
    const int nblk = ncols / 32, kb = item / nblk, nb = item % nblk, k0 = 64 * kb, n0 = 32 * nb;
#pragma unroll 8
    for (int i = 0; i < 32; ++i) { const int kk = 2 * i + (lane >> 5); scr[kk * 33 + (lane & 31)] = W[(size_t)(k0 + kk) * ldw + n0 + (lane & 31)] * scale; }
    LDS_WAIT(); asm volatile("" ::: "memory");
    const int c = lane & 3;
#pragma unroll
    for (int j = 0; j < 2; ++j) { const int n = (lane >> 2) + 16 * j; const LAS float* s = scr + (16 * c) * 33 + n;
        v4u o; o.x = pk4_fp8(s[0 * 33], s[1 * 33], s[2 * 33], s[3 * 33]); o.y = pk4_fp8(s[4 * 33], s[5 * 33], s[6 * 33], s[7 * 33]);
        o.z = pk4_fp8(s[8 * 33], s[9 * 33], s[10 * 33], s[11 * 33]); o.w = pk4_fp8(s[12 * 33], s[13 * 33], s[14 * 33], s[15 * 33]);
        *(GAS v4u*)(WT8 + (size_t)(n0 + n) * ldt + k0 + 16 * c) = o; }
    LDS_WAIT(); asm volatile("" ::: "memory");
}
struct Args { const float* in[19]; float* out; unsigned char* ws; int ph_lo, ph_hi; };

__device__ __forceinline__ void p0_prologue(Frame& F, const Args& a) {
    LAS float* scr = (LAS float*)(F.lds + RING_OFF + F.wave * 16384);
    const int gw = F.vcu * NWAVES + F.wave, NGW = F.G * NWAVES;
    constexpr int I_IN = (DM / 64) * (N_BF / 32), I_G8 = (DM / 64) * (N_F8 / 32), I_P = (1024 / 64) * (DM / 32), I_O = (DM / 64) * (DM / 32), I_L = I_IN + I_G8 + 2 * I_P + I_O;
    for (int it = gw; it < DEPTH * I_L; it += NGW) {
        const int l = it / I_L; int r = it % I_L;
        bf16* win = (bf16*)(a.ws + WS_WIN) + (size_t)l * N_BF * DM; bf16* wpab = (bf16*)(a.ws + WS_WPAB) + (size_t)l * DM * DM; bf16* wout = (bf16*)(a.ws + WS_WOUT) + (size_t)l * DM * DM;
        if (r < I_IN) { p0_transpose_item(a.in[1] + (size_t)l * DM * IN_TOTAL, IN_TOTAL, N_BF, win, DM, 0, scr, r, F.lane); continue; } r -= I_IN;
        if (r < I_G8) { p0_transpose_item8(a.in[1] + (size_t)l * DM * IN_TOTAL + N_BF, IN_TOTAL, N_F8, a.ws + WS_WG8 + (size_t)l * N_F8 * DM, DM, W8_SCALE, scr, r, F.lane); continue; } r -= I_G8;
        if (r < I_P) { p0_transpose_item(a.in[14] + (size_t)l * 1024 * DM, DM, DM, wpab, DM, 0, scr, r, F.lane); continue; } r -= I_P;
        if (r < I_P) { p0_transpose_item(a.in[15] + (size_t)l * 1024 * DM, DM, DM, wpab, DM, 1024, scr, r, F.lane); continue; } r -= I_P;
        p0_transpose_item(a.in[16] + (size_t)l * DM * DM, DM, DM, wout, DM, 0, scr, r, F.lane);
    }
    for (int it = gw; it < DEPTH * NBLK * 4 * 2 * 8; it += NGW) {
        const int s_ = it & 7, g_ = (it >> 3) & 1, jq = (it >> 4) & 3, n = (it >> 6) & 7, l = it >> 9;
        const float* w = a.in[g_ ? 6 : 4] + ((size_t)(l * NBLK + n) * BLKW + 16 * s_ + 8 * (F.lane >> 5)) * BLKW + jq * 32 + (F.lane & 31);
        v4u o; o.x = pk2(w[0], w[BLKW]); o.y = pk2(w[2 * BLKW], w[3 * BLKW]); o.z = pk2(w[4 * BLKW], w[5 * BLKW]); o.w = pk2(w[6 * BLKW], w[7 * BLKW]);
        *(GAS v4u*)((bf16*)(a.ws + WS_GW) + (size_t)it * 512 + F.lane * 8) = o; }
    bf16* xb = (bf16*)(a.ws + WS_XB16); const float* x = a.in[0];
    for (int m = gw; m < M; m += NGW) {
        const GAS f32x4* xr = (const GAS f32x4*)(x + (size_t)m * DM) + F.lane; GAS unsigned long long* o8 = (GAS unsigned long long*)(xb + (size_t)m * DM) + F.lane;
        GAS unsigned* q8 = (GAS unsigned*)(a.ws + WS_XQ8 + (size_t)m * DM) + F.lane;
#pragma unroll
        for (int j = 0; j < 8; ++j) { const f32x4 v = xr[64 * j]; o8[64 * j] = (unsigned long long)pk2(v.x, v.y) | ((unsigned long long)pk2(v.z, v.w) << 32); q8[64 * j] = pk4_fp8(v.x, v.y, v.z, v.w); }
    }
}
__device__ __forceinline__ void ln_phase(Frame& F, float* y, bf16* xb, unsigned char* xq8, const float* g, const float* bta, bool copies, float* st) {
    const int gw = F.vcu * NWAVES + F.wave, NGW = F.G * NWAVES; int lane = F.lane; asm volatile("" : "+v"(lane));
    for (int m = gw; m < M; m += NGW) {
        GAS f32x4* yr = (GAS f32x4*)(y + (size_t)m * DM) + lane; f32x4 v[8]; float s = 0.f;
#pragma unroll
        for (int j = 0; j < 8; ++j) { v[j] = yr[64 * j]; s += (v[j].x + v[j].y) + (v[j].z + v[j].w); }
        const float mean = wave_sum(s, lane) * (1.f / DM); float s2 = 0.f;
#pragma unroll
        for (int j = 0; j < 8; ++j) { v[j] = v[j] - mean; s2 += (v[j].x * v[j].x + v[j].y * v[j].y) + (v[j].z * v[j].z + v[j].w * v[j].w); }
        const float rstd = 1.f / sqrtf(wave_sum(s2, lane) * (1.f / DM) + LN_EPS);
        GAS unsigned long long* o8 = (GAS unsigned long long*)(xb + (size_t)m * DM) + lane; GAS unsigned* q8 = (GAS unsigned*)(xq8 + (size_t)m * DM) + lane;
#pragma unroll
        for (int j = 0; j < 8; ++j) { const f32x4 gg = *((const GAS f32x4*)g + lane + 64 * j), bb = *((const GAS f32x4*)bta + lane + 64 * j);
            const f32x4 o = v[j] * rstd * gg + bb; if (copies) { o8[64 * j] = (unsigned long long)pk2(o.x, o.y) | ((unsigned long long)pk2(o.z, o.w) << 32); q8[64 * j] = pk4_fp8(o.x, o.y, o.z, o.w); } else yr[64 * j] = o; }
        if (copies && lane == 0) { st[2 * (size_t)m] = mean; st[2 * (size_t)m + 1] = rstd; }
    }
}
constexpr int LRU_TM = 256, XCS_PITCH = 272, LRU_XCS = 0, LRU_AS = LRU_XCS + LRU_TM * XCS_PITCH, LRU_US = LRU_AS + LRU_TM * 32 * 4, LRU_AH = LRU_US + LRU_TM * 32 * 4, LRU_CARRY = LRU_AH + 16 * 32 * 8, LRU_WI = LRU_CARRY + 2 * 32 * 4, LRU_CW = LRU_WI + 8 * 64 * 16, LRU_END = LRU_CW + 5 * 128 * 4;
static_assert(LRU_END <= RING_BYTES, "LRU LDS map");
constexpr size_t GW_ITEM = 2 * 8 * 64 * 8;
#define LBAR() asm volatile("s_waitcnt lgkmcnt(0)\n\ts_barrier" ::: "memory")
__device__ __forceinline__ void lru_item(Frame& F, int b, int n, int jq, const bf16* XB, const bf16* GB, bf16* AR, const float* conv_w, const float* conv_b, const bf16* gwf, const float* b_r,
                                         const float* b_i, const float* lam) {
    typedef short s16x8 __attribute__((ext_vector_type(8))); typedef float f32x16 __attribute__((ext_vector_type(16))); typedef float f32x2 __attribute__((ext_vector_type(2)));
    LAS unsigned char* L = F.lds + RING_OFF;
    int tid = F.tid; asm volatile("" : "+v"(tid));
    const int lane = tid & 63, wave = F.wave, r32 = lane & 31, hi = lane >> 5;
    const int ch8 = tid & 15, tq = tid >> 4;
    const int cch = n * BLKW + jq * 32 + r32;
    s16x8 wfr[8];
#pragma unroll
    for (int s = 0; s < 8; ++s) wfr[s] = *(const GAS s16x8*)(gwf + (size_t)(s * 64 + lane) * 8);
    *(LAS s16x8*)(L + LRU_WI + tid * 16) = *(const GAS s16x8*)(gwf + (size_t)(8 * 64 + tid) * 8);
    const float bias_r = b_r[cch], bias_i = b_i[cch], lc = -8.f * log1pf(__expf(-lam[cch])), lc2 = lc * LOG2E;
    if (tid < 64) ((LAS float*)(L + LRU_CARRY))[tid] = 0.f;
    const bf16* xbase = XB + (size_t)b * SEQ * 1024 + n * BLKW + ch8 * 8;
    if (tid < 128) { LAS float* cwl = (LAS float*)(L + LRU_CW); cwl[tid] = conv_b[n * BLKW + tid];
#pragma unroll
        for (int j = 0; j < 4; ++j) cwl[(1 + j) * 128 + tid] = conv_w[j * LRUW + n * BLKW + tid]; }
    s16x8 xq[2][7];
#define LRU_LOADX(t0_) do { _Pragma("unroll") for (int g = 0; g < 2; ++g) _Pragma("unroll") for (int rr = 0; rr < 7; ++rr) { const int t = (t0_) + (tq + 32 * g) * 4 - 3 + rr; \
        xq[g][rr] = (t >= 0) ? *(const GAS s16x8*)(xbase + (size_t)t * 1024) : (s16x8){0, 0, 0, 0, 0, 0, 0, 0}; } } while (0)
    LRU_LOADX(0);
    LBAR();
#pragma unroll 1
    for (int ms = 0; ms < SEQ / LRU_TM; ++ms) {
        const int t0 = ms * LRU_TM;
        {
            float cw[4][8], cb[8];
            { unsigned cwb = (unsigned)(LRU_CW + ch8 * 32); asm volatile("" : "+v"(cwb));
              const f32x4 b0 = *(const LAS f32x4*)(L + cwb), b1 = *(const LAS f32x4*)(L + cwb + 16);
              cb[0] = b0.x; cb[1] = b0.y; cb[2] = b0.z; cb[3] = b0.w; cb[4] = b1.x; cb[5] = b1.y; cb[6] = b1.z; cb[7] = b1.w;
#pragma unroll
              for (int j = 0; j < 4; ++j) { const f32x4 w0 = *(const LAS f32x4*)(L + cwb + (1 + j) * 512), w1 = *(const LAS f32x4*)(L + cwb + (1 + j) * 512 + 16);
                  cw[j][0] = w0.x; cw[j][1] = w0.y; cw[j][2] = w0.z; cw[j][3] = w0.w; cw[j][4] = w1.x; cw[j][5] = w1.y; cw[j][6] = w1.z; cw[j][7] = w1.w; } }
            unsigned s1b = (unsigned)(LRU_XCS + tq * 4 * XCS_PITCH + ch8 * 16); asm volatile("" : "+v"(s1b));
#pragma unroll
            for (int g = 0; g < 2; ++g) {
                unsigned w[4][4];
#pragma unroll
                for (int i2 = 0; i2 < 4; ++i2) {
                    float x0[7], x1[7];
#pragma unroll
                    for (int rr = 0; rr < 7; ++rr) { const unsigned d = ((const unsigned*)&xq[g][rr])[i2]; x0[rr] = __uint_as_float(d << 16); x1[rr] = __uint_as_float(d & 0xffff0000u); }
#pragma unroll
                    for (int q = 0; q < 4; ++q) {
                        const float v0 = cb[2 * i2] + cw[0][2 * i2] * x0[q] + cw[1][2 * i2] * x0[q + 1] + cw[2][2 * i2] * x0[q + 2] + cw[3][2 * i2] * x0[q + 3];
                        const float v1 = cb[2 * i2 + 1] + cw[0][2 * i2 + 1] * x1[q] + cw[1][2 * i2 + 1] * x1[q + 1] + cw[2][2 * i2 + 1] * x1[q + 2] + cw[3][2 * i2 + 1] * x1[q + 3];
                        w[q][i2] = pk2(v0, v1); }
                    asm volatile("" : "+v"(w[0][i2]), "+v"(w[1][i2]), "+v"(w[2][i2]), "+v"(w[3][i2]));
                }
#pragma unroll
                for (int q = 0; q < 4; ++q) *(LAS v4u*)(L + s1b + (32 * g * 4 + q) * XCS_PITCH) = (v4u){w[q][0], w[q][1], w[q][2], w[q][3]};
            }
        }
        if (ms + 1 < SEQ / LRU_TM) LRU_LOADX(t0 + LRU_TM);
        LBAR();
        {
            f32x16 ar, ai;
#pragma unroll
            for (int r = 0; r < 16; ++r) { ar[r] = bias_r; ai[r] = bias_i; }
            unsigned s2a = (unsigned)(LRU_XCS + (32 * wave + r32) * XCS_PITCH + hi * 16), s2i = (unsigned)(LRU_WI + lane * 16); asm volatile("" : "+v"(s2a), "+v"(s2i));
#pragma unroll
            for (int s = 0; s < 8; ++s) { const s16x8 af = *(const LAS s16x8*)(L + s2a + s * 32), wi = *(const LAS s16x8*)(L + s2i + s * 1024);
                ar = __builtin_amdgcn_mfma_f32_32x32x16_bf16(af, wfr[s], ar, 0, 0, 0); ai = __builtin_amdgcn_mfma_f32_32x32x16_bf16(af, wi, ai, 0, 0, 0); }
            unsigned s2x = (unsigned)(LRU_XCS + (32 * wave + 4 * hi) * XCS_PITCH + (jq * 32 + r32) * 2), s2w = (unsigned)((32 * wave + 4 * hi) * 128 + r32 * 4); asm volatile("" : "+v"(s2x), "+v"(s2w));
#pragma unroll
            for (int r = 0; r < 16; ++r) { const int cr = (r & 3) + 8 * (r >> 2);
                const float rg = __builtin_amdgcn_rcpf(1.f + __builtin_amdgcn_exp2f(-LOG2E * ar[r])), ig = __builtin_amdgcn_rcpf(1.f + __builtin_amdgcn_exp2f(-LOG2E * ai[r]));
                const float av = __builtin_amdgcn_exp2f(lc2 * rg), t = 2.f * lc * rg;
                const float ser = -t * (1.f + t * (0.5f + t * (0.16666667f + t * (0.041666668f + t * 0.0083333338f))));
                const float om = (t > -0.1f) ? ser : (1.f - av * av);
                const float xc = __uint_as_float(((unsigned)*(const LAS unsigned short*)(L + s2x + cr * XCS_PITCH)) << 16);
                const float uv = __builtin_amdgcn_sqrtf(om) * (ig * xc);
                *(LAS float*)(L + LRU_AS + s2w + cr * 128) = av; *(LAS float*)(L + LRU_US + s2w + cr * 128) = uv; }
        }
        LBAR();
        s16x8 gbv[2];
#pragma unroll
        for (int g = 0; g < 2; ++g) { const int idx = tid + 512 * g, tl = idx >> 2, c8 = idx & 3; gbv[g] = *(const GAS s16x8*)(GB + ((size_t)b * SEQ + t0 + tl) * 1024 + n * BLKW + jq * 32 + c8 * 8); }
        {
            const int sc = tid >> 5, o = tid & 31; unsigned s3b = (unsigned)(((sc * 16) * 32 + o) * 4); asm volatile("" : "+v"(s3b));
            LAS float* as = (LAS float*)(L + LRU_AS + s3b); LAS float* us = (LAS float*)(L + LRU_US + s3b);
            float a[16], u[16];
#pragma unroll
            for (int i = 0; i < 16; ++i) { a[i] = as[i * 32]; u[i] = us[i * 32]; }
            float A = 1.f, H = 0.f;
#pragma unroll
            for (int i = 0; i < 16; ++i) { H = a[i] * H + u[i]; A *= a[i]; }
            unsigned s3o = (unsigned)(LRU_AH + o * 8); asm volatile("" : "+v"(s3o));
            *(LAS f32x2*)(L + s3o + sc * 256) = (f32x2){A, H};
            LBAR();
            float h = ((LAS float*)(L + LRU_CARRY))[(ms & 1) * 32 + o];
            f32x2 p[15];
#pragma unroll
            for (int s2 = 0; s2 < 15; ++s2) p[s2] = *(const LAS f32x2*)(L + s3o + s2 * 256);
#pragma unroll
            for (int s2 = 0; s2 < 15; ++s2) h = (s2 < sc) ? p[s2].x * h + p[s2].y : h;
#pragma unroll
            for (int i = 0; i < 16; ++i) { h = a[i] * h + u[i]; us[i * 32] = h; }
            if (sc == 15) ((LAS float*)(L + LRU_CARRY))[((ms + 1) & 1) * 32 + o] = h;
        }
        LBAR();
#pragma unroll
        for (int g = 0; g < 2; ++g) { const int idx = tid + 512 * g, tl = idx >> 2, c8 = idx & 3; const size_t row = (size_t)b * SEQ + t0 + tl; const int col = n * BLKW + jq * 32 + c8 * 8;
            unsigned s4b = (unsigned)(LRU_US + (tl * 32 + c8 * 8) * 4); asm volatile("" : "+v"(s4b));
            const f32x4 h0 = *(const LAS f32x4*)(L + s4b), h1 = *(const LAS f32x4*)(L + s4b + 16);
            const s16x8 gv = gbv[g]; float hv[8] = {h0.x, h0.y, h0.z, h0.w, h1.x, h1.y, h1.z, h1.w}; unsigned w[4];
#pragma unroll
            for (int i2 = 0; i2 < 4; ++i2) { const float g0 = pg8::bfbits2f(gv[2 * i2]), g1 = pg8::bfbits2f(gv[2 * i2 + 1]);
                w[i2] = pk2(hv[2 * i2] * g0 * __builtin_amdgcn_rcpf(1.f + __builtin_amdgcn_exp2f(-LOG2E * g0)), hv[2 * i2 + 1] * g1 * __builtin_amdgcn_rcpf(1.f + __builtin_amdgcn_exp2f(-LOG2E * g1))); }
            *(GAS v4u*)(AR + row * 2048 + 1024 + col) = (v4u){w[0], w[1], w[2], w[3]}; }
    }
#undef LRU_LOADX
    LBAR();
}

#ifndef MK_DBL
#define MK_DBL 0
#endif
#define DBL(k) for (int rep_ = 0; rep_ < 1 + ((MK_DBL >> (k)) & 1); ++rep_)
constexpr int N_PH_LAYER = 5, N_PHASES = 1 + DEPTH * N_PH_LAYER;
__global__ void __launch_bounds__(NWAVES * 64, 2) mk_fwd(Args args) {
    extern __shared__ __attribute__((aligned(16))) unsigned char lds[];
    Frame F;
    F.lds = (LAS unsigned char*)lds; F.MISC = (volatile LAS unsigned*)(F.lds + MISC_OFF);
    F.tid = threadIdx.x; F.lane = F.tid & 63; F.wave = __builtin_amdgcn_readfirstlane(F.tid >> 6);
    F.G = gridDim.x; { const int bx = blockIdx.x; F.vcu = (F.G % 8 == 0) ? (bx % 8) * (F.G / 8) + bx / 8 : bx; }
    F.ctl = (gu32*)(args.ws + WS_CTL);
    for (int u = F.tid; u < (LDS_BYTES - LDSCTL_OFF) / 4; u += NWAVES * 64) ((LAS unsigned*)(F.lds + LDSCTL_OFF))[u] = 0u;
    __syncthreads();
    const int lo = args.ph_lo, hi = args.ph_hi;
    const bool use_bar = (hi - lo) > 1;
    XcdBarrier bar; bar.bar = (unsigned*)(F.ctl + CW_BAR); bar.x = 0; bar.st = nullptr;
    if (use_bar) bar = xcd_barrier_post((unsigned*)(F.ctl + CW_BAR), F.MISC + 8);
#define IN(k) (lo <= (k) && (k) < hi)
#define SEAM(k) do { if (IN(k) && IN((k) + 1)) xcd_barrier(bar); } while (0)
#define CAS __attribute__((address_space(4)))
    typedef unsigned char* ucp_t; typedef float* fp_t; typedef const float* cfp_t;
#define KARGS() CAS const char* ka_ = (CAS const char*)__builtin_amdgcn_kernarg_segment_ptr(); asm volatile("" : "+s"(ka_)); unsigned char* const ws = *(CAS const ucp_t*)(ka_ + 160); float* const outp = *(CAS const fp_t*)(ka_ + 152); (void)outp; (void)ws
#define KIN(k) (*(CAS const cfp_t*)(ka_ + 8 * (k)))
#define WSP(off) ((bf16*)(ws + (off)))
    if (IN(0)) { DBL(0) p0_prologue(F, args); } SEAM(0);
#pragma unroll 1
    for (int l = 0; l < DEPTH; ++l) {
        const int pb = 1 + l * N_PH_LAYER;
        const float lam_init = 0.8f - 0.6f * __expf(-0.3f * (float)l);
        if (IN(pb)) {
            KARGS(); bf16* const P6 = WSP(WS_P6); bf16* const MA = WSP(WS_MA); bf16* const MB = WSP(WS_MB);
            { pg8::Gemm g{WSP(WS_XB16), WSP(WS_WIN) + (size_t)l * N_BF * DM, M, N_BF, DM}; pg8::StaticOrder S; S.init(M, N_BF, F.G, (int)blockIdx.x);
              pg8::EpiProj E{P6, MA, MB, (size_t)M * 1024, attn_body::C2, 0, 1.f};
              DBL(1) pg8::gemm_phase<pg8::EpiProj, pg8::StaticOrder, PG8_ALIGN, PG8_SP2>(F.lds + RING_OFF, g, S, E); }
            { pg8::Gemm g{(const pg8::bf16_t*)(ws + WS_XQ8), (const pg8::bf16_t*)(ws + WS_WG8 + (size_t)l * N_F8 * DM), M, N_F8, DM / 2}; pg8::StaticOrder S; S.init(M, N_F8, F.G, (int)blockIdx.x);
              pg8::EpiProj E{P6, MA, MB, (size_t)M * 1024, attn_body::C2, N_BF / 256, 1.f / W8_SCALE};
              DBL(1) pg8::gemm_phase<pg8::EpiProj, pg8::StaticOrder, PG8_ALIGN, PG8_SP2, true>(F.lds + RING_OFF, g, S, E); }
        }
        SEAM(pb);
        if (IN(pb + 1)) {
            KARGS(); bf16* const P6 = WSP(WS_P6); bf16* const O1 = WSP(WS_O1); bf16* const AR = WSP(WS_AR);
            bf16* const Qb = P6; bf16* const Kb = P6 + (size_t)M * 1024; bf16* const Vb = P6 + (size_t)2 * M * 1024; bf16* const GA = P6 + (size_t)3 * M * 1024; bf16* const XBb = P6 + (size_t)4 * M * 1024; bf16* const GBb = P6 + (size_t)5 * M * 1024;
            int ln_ = F.lane; asm volatile("" : "+v"(ln_));
            float d1 = KIN(9)[l * 64 + ln_] * KIN(10)[l * 64 + ln_], d2 = KIN(11)[l * 64 + ln_] * KIN(12)[l * 64 + ln_];
            d1 = wave_sum(d1, ln_); d2 = wave_sum(d2, ln_);
            const float lam = __uint_as_float(__builtin_amdgcn_readfirstlane(__float_as_uint(__expf(d1) - __expf(d2) + lam_init)));
            const int bh = F.vcu >> 2, p = F.vcu & 3, b = bh >> 3, h = bh & 7;
            const float slope2 = exp2f(-(float)(h + 1)) * LOG2E;
            if (F.G == 256) {
#pragma unroll 1
                for (int i = 0; i < 2; ++i) {
                    const int qb = i ? (7 - p) : p;
#pragma unroll 1
                    DBL(2) for (int c = 0; c < 2; ++c) {
                        attn_body::attn_unit<8>(b, 2 * h + c, h, qb, slope2, (const attn_body::bf16*)Qb, (const attn_body::bf16*)Kb, (const attn_body::bf16*)Vb, (attn_body::bf16*)O1, (char*)lds + RING_OFF,
                                                c != 0, lam, 1.f - lam_init, (const attn_body::bf16*)GA, KIN(13) + l * 128, (attn_body::bf16*)AR);
                    }
                }
                DBL(3) lru_item(F, F.vcu >> 5, (F.vcu >> 2) & 7, F.vcu & 3, XBb, GBb, AR, KIN(2) + (size_t)l * 4 * LRUW, KIN(3) + l * LRUW,
                         (const bf16*)(ws + WS_GW) + ((size_t)(l * NBLK + ((F.vcu >> 2) & 7)) * 4 + (F.vcu & 3)) * GW_ITEM, KIN(5) + l * LRUW, KIN(7) + l * LRUW, KIN(8) + l * LRUW);
            }
        }
        SEAM(pb + 1);
        if (IN(pb + 2)) {
            KARGS();
            pg8::Gemm g{WSP(WS_AR), WSP(WS_WPAB) + (size_t)l * DM * DM, M, DM, DM}; pg8::StaticOrder S; S.init(M, DM, F.G, (int)blockIdx.x);
            pg8::EpiMerge E{WSP(WS_MA), WSP(WS_MB), WSP(WS_MERGED)};
            DBL(4) pg8::gemm_phase<pg8::EpiMerge, pg8::StaticOrder, PG8_ALIGN, PG8_SP2>(F.lds + RING_OFF, g, S, E);
        }
        SEAM(pb + 2);
        if (IN(pb + 3)) {
            KARGS();
            pg8::Gemm g{WSP(WS_MERGED), WSP(WS_WOUT) + (size_t)l * DM * DM, M, DM, DM}; pg8::StaticOrder S; S.init(M, DM, F.G, (int)blockIdx.x);
            if (l == 0) { pg8::EpiRes E{KIN(0), outp, DN_ALPHA};
                          pg8::gemm_phase<pg8::EpiRes, pg8::StaticOrder, PG8_ALIGN, PG8_SP2>(F.lds + RING_OFF, g, S, E); }
            else        { pg8::EpiResFromY E{outp, (const float*)(ws + WS_STATS), KIN(17) + (l - 1) * DM, KIN(18) + (l - 1) * DM};
                          pg8::gemm_phase<pg8::EpiResFromY, pg8::StaticOrder, PG8_ALIGN, PG8_SP2>(F.lds + RING_OFF, g, S, E); }
        }
        SEAM(pb + 3);
        if (IN(pb + 4)) { KARGS(); ln_phase(F, outp, WSP(WS_XB16), ws + WS_XQ8, KIN(17) + l * DM, KIN(18) + l * DM, l + 1 < DEPTH, (float*)(ws + WS_STATS)); }
        SEAM(pb + 4);
    }
#undef IN
#undef SEAM
#undef KARGS
#undef KIN
#undef WSP
#undef CAS
}

#ifndef MK_PER_PHASE
#define MK_PER_PHASE 0
#endif
extern "C" void kernel_launch(void* const* d_in, const int* in_sizes, int n_in, void* d_out, int out_size, void* d_ws, size_t ws_size, hipStream_t stream) {
    static int grid = 0;
    if (grid == 0) {
        if (n_in != 19 || in_sizes[0] != M * DM || out_size != M * DM || ws_size < WS_END) { fprintf(stderr, "kernel_launch: unexpected shapes / workspace (n_in %d, ws %zu); nothing launched\n", n_in, ws_size); grid = -1; return; }
        int dev = 0, cus = 0;
        if (hipGetDevice(&dev) != hipSuccess || hipDeviceGetAttribute(&cus, hipDeviceAttributeMultiprocessorCount, dev) != hipSuccess) { grid = -1; return; }
        if (hipFuncSetAttribute((const void*)mk_fwd, hipFuncAttributeMaxDynamicSharedMemorySize, LDS_BYTES) != hipSuccess) { fprintf(stderr, "kernel_launch: hipFuncSetAttribute failed\n"); grid = -1; return; }
        int per_cu = 0;
        if (hipOccupancyMaxActiveBlocksPerMultiprocessor(&per_cu, (const void*)mk_fwd, NWAVES * 64, LDS_BYTES) != hipSuccess || per_cu < 1) fprintf(stderr, "kernel_launch: occupancy query reports %d blocks per CU\n", per_cu);
        (void)hipGetLastError();
        grid = cus;
        if (grid != 256) fprintf(stderr, "kernel_launch: %d CUs; the attention/LRU phase is built for 256\n", grid);
    }
    if (grid < 0) return;
    if (hipMemsetAsync((char*)d_ws + WS_CTL, 0, CTL_ZERO_BYTES, stream) != hipSuccess) return;
    Args a{};
    for (int i = 0; i < 19; ++i) a.in[i] = (const float*)d_in[i];
    a.out = (float*)d_out; a.ws = (unsigned char*)d_ws;
#if MK_PER_PHASE
    for (int p = 0; p < N_PHASES; ++p) { a.ph_lo = p; a.ph_hi = p + 1; hipLaunchKernelGGL(mk_fwd, dim3(grid), dim3(NWAVES * 64), LDS_BYTES, stream, a); }
#else
    a.ph_lo = 0; a.ph_hi = N_PHASES;
    hipLaunchKernelGGL(mk_fwd, dim3(grid), dim3(NWAVES * 64), LDS_BYTES, stream, a);
#endif
}
```
